# Optimizing an MI355X kernel written in HIP

```python
import math
import jax, jax.numpy as jnp
from jax import lax
import numpy as np

D_MODEL = 1024
BATCH = 8
SEQ = 2048
DEPTH = 2

CTX_LEN = 256
GRID_W = 64
EPS = 1e-6
HY_WIDTH = 256
HY_ORDER = 2
HY_EMB = 33
HY_BANDS = (HY_EMB - 1) // 2
HY_FILTER_HIDDEN = 64
HY_MIN_DECAY = math.log(1e-2) / 1.5
HY_MAX_DECAY = math.log(1e-2) / 0.3
FN_GROUPS = 4
FN_GROUP_DIM = 64
FN_WIDTH = FN_GROUPS * FN_GROUP_DIM
DA_HEADS = 4
DA_QK_DIM = 64
DA_V_DIM = 2 * DA_QK_DIM
DA_WIDTH = DA_HEADS * DA_V_DIM
ROPE_BASE = 10000.0
Q_BLOCK = 128
N_BRANCH = 3
P_HY = 3 * HY_WIDTH
P_FN = FN_WIDTH
P_Q = DA_HEADS * 2 * DA_QK_DIM
P_K = DA_HEADS * 2 * DA_QK_DIM
P_V = DA_WIDTH
P_GATE = N_BRANCH * D_MODEL
P_IN = P_HY + P_FN + P_Q + P_K + P_V + P_GATE
SPLIT_IDX = (P_HY, P_HY + P_FN, P_HY + P_FN + P_Q, P_HY + P_FN + P_Q + P_K, P_HY + P_FN + P_Q + P_K + P_V)
PEER_HEADS = 8
PEER_NKEYS = 128
PEER_EXPERTS = PEER_NKEYS * PEER_NKEYS
PEER_DQ = 256
PEER_TOPK = 16
PEER_CHUNK = 128

kernel_name = 'hybrid_hyena_fnet_diffattn_peer_dit'


def rms_norm(x, g):
    x32 = x.astype(jnp.float32)
    y = x32 * lax.rsqrt(jnp.mean(x32 * x32, axis=-1, keepdims=True) + EPS)
    return (y * g.astype(jnp.float32)).astype(x.dtype)


def modulate(x, g, shift, scale):
    return rms_norm(x, g) * (1 + scale) + shift


def short_conv(z, w, b):
    zp = jnp.pad(z, ((0, 0), (1, 1), (0, 0)))
    return zp[:, :-2] * w[0] + zp[:, 1:-1] * w[1] + zp[:, 2:] * w[2] + b


def hyena_kernels(L, w1, b1, freq, w2, b2, w3):
    f32 = lambda a: a.astype(jnp.float32)
    pos = jnp.arange(L, dtype=jnp.float32)
    t = pos / max(L - 1, 1)
    w = 2.0 * math.pi * pos / L
    f = jnp.linspace(1e-4, HY_BANDS - 1, HY_BANDS, dtype=jnp.float32)
    feats = jnp.concatenate([t[:, None], jnp.cos(w[:, None] * f), -jnp.sin(w[:, None] * f)], axis=-1)
    fr = f32(freq)
    h = jnp.sin(fr * (feats @ f32(w1) + f32(b1)))
    h = jnp.sin(fr * (h @ f32(w2) + f32(b2)))
    h = (h @ f32(w3)).reshape(L, 2, HY_ORDER, HY_WIDTH)
    deltas = jnp.abs(jnp.linspace(HY_MIN_DECAY, HY_MAX_DECAY, HY_WIDTH, dtype=jnp.float32))
    h = h * jnp.exp(-t[:, None, None, None] * deltas)
    k = jnp.concatenate([h[:, 0], jnp.zeros((1, HY_ORDER, HY_WIDTH), jnp.float32), h[:0:-1, 1]], axis=0)
    k = k / jnp.sum(jnp.abs(k), axis=0, keepdims=True)
    return jnp.fft.rfft(k, axis=0)


def hyena_mix(u, kf, bias):
    L = u.shape[1]
    v, x1, x2 = jnp.split(u.astype(jnp.float32), 3, axis=-1)
    z = v
    for o, gate in enumerate((x1, x2)):
        zf = jnp.fft.rfft(z, n=2 * L, axis=1)
        conv = jnp.fft.irfft(zf * kf[:, o], n=2 * L, axis=1)[:, :L]
        z = gate * (conv + bias[o].astype(jnp.float32) * z)
    return z.astype(u.dtype)


def fourier_mix(z):
    B, L, _ = z.shape
    zg = z.astype(jnp.float32).reshape(B, L, FN_GROUPS, FN_GROUP_DIM)
    y = jnp.fft.fftn(zg, axes=(1, 3), norm='ortho').real
    return y.reshape(B, L, FN_WIDTH).astype(z.dtype)


def axial_rope(L):
    rows = L // GRID_W
    row = jnp.repeat(jnp.arange(rows), GRID_W).astype(jnp.float32)
    col = jnp.tile(jnp.arange(GRID_W), rows).astype(jnp.float32)
    half = DA_QK_DIM // 2
    inv = ROPE_BASE ** (-jnp.arange(0, half, 2, dtype=jnp.float32) / half)
    ang = jnp.stack([row[:, None] * inv, col[:, None] * inv], axis=1)
    return jnp.cos(ang), jnp.sin(ang)


def apply_rope(x, cos, sin):
    shp = x.shape
    xr = x.astype(jnp.float32).reshape(shp[:-1] + (2, 2, DA_QK_DIM // 4))
    x1, x2 = xr[..., 0, :], xr[..., 1, :]
    cc = cos[None, :, None, None]
    ss = sin[None, :, None, None]
    out = jnp.stack([x1 * cc - x2 * ss, x2 * cc + x1 * ss], axis=-2)
    return out.reshape(shp).astype(x.dtype)


def split_in(h):
    B, L, _ = h.shape
    hy, fn, q, k, v, gates = jnp.split(h, SPLIT_IDX, axis=-1)
    q = q.reshape(B, L, DA_HEADS, 2, DA_QK_DIM)
    k = k.reshape(B, L, DA_HEADS, 2, DA_QK_DIM)
    v = v.reshape(B, L, DA_HEADS, DA_V_DIM)
    return hy, fn, q, k, v, gates


def heads_first(a):
    return jnp.moveaxis(a, 2, 1)


def diff_attend(q, k, v, lam_val):
    s = jnp.einsum('bhqcd,bhkcd->bhcqk', q, k).astype(jnp.float32) * (DA_QK_DIM ** -0.5)
    p = jax.nn.softmax(s, axis=-1)
    a = p[:, :, 0] - lam_val * p[:, :, 1]
    return jnp.einsum('bhqk,bhkd->bhqd', a.astype(v.dtype), v)


def diff_out(o, g_sub, lam_init):
    B, H, L, _ = o.shape
    o = rms_norm(o, g_sub) * (1.0 - lam_init)
    return jnp.moveaxis(o, 1, 2).reshape(B, L, DA_WIDTH)


def merge(hy_o, fn_o, at_o, gates, w_hy, w_fn, w_at, w_out):
    g = jax.nn.sigmoid(gates.astype(jnp.float32)).astype(gates.dtype)
    g1, g2, g3 = jnp.split(g, N_BRANCH, axis=-1)
    y = g1 * (hy_o @ w_hy) + g2 * (fn_o @ w_fn) + g3 * (at_o @ w_at)
    return y @ w_out


def peer(t, wq, keys, u, v):
    T = t.shape[0]
    q = (t @ wq).reshape(T, PEER_HEADS, 2, PEER_DQ // 2)
    s = jnp.einsum('thpd,hpnd->thpn', q, keys).astype(jnp.float32)
    s1, i1 = lax.top_k(s[:, :, 0], PEER_TOPK)
    s2, i2 = lax.top_k(s[:, :, 1], PEER_TOPK)
    cand = (s1[..., :, None] + s2[..., None, :]).reshape(T, PEER_HEADS, PEER_TOPK * PEER_TOPK)
    sc, ci = lax.top_k(cand, PEER_TOPK)
    e1 = jnp.take_along_axis(i1, ci // PEER_TOPK, axis=-1)
    e2 = jnp.take_along_axis(i2, ci % PEER_TOPK, axis=-1)
    idx = (e1 * PEER_NKEYS + e2).reshape(T, PEER_HEADS * PEER_TOPK)
    g = jax.nn.softmax(sc, axis=-1).reshape(T, PEER_HEADS * PEER_TOPK).astype(t.dtype)
    nchunk = T // PEER_CHUNK

    def chunk(args):
        tc, ic, gc = args
        hid = jnp.einsum('td,tkd->tk', tc, u[ic])
        return jnp.einsum('tk,tkd->td', gc * jax.nn.gelu(hid, approximate=False), v[ic])

    y = lax.map(chunk, (t.reshape(nchunk, PEER_CHUNK, -1), idx.reshape(nchunk, PEER_CHUNK, -1),
                        g.reshape(nchunk, PEER_CHUNK, -1)))
    return y.reshape(T, -1)


def setup_inputs(seed: int = 0) -> dict:
    key = jax.random.key(seed)
    ks = jax.random.split(key, 32)
    D = D_MODEL
    L = DEPTH

    def nrm(i, shape, scale):
        return jax.random.normal(ks[i], shape, jnp.float32) * scale

    return {
        'x': nrm(0, (BATCH, SEQ, D), 1.0),
        'c': nrm(1, (BATCH, D), 1.0),
        'ctx': nrm(2, (BATCH, CTX_LEN, D), 1.0),
        'c_ctx': nrm(3, (D,), 1.0),
        'w_ada': nrm(4, (L, D, 6 * D), 0.5 * D ** -0.5),
        'b_ada': nrm(5, (L, 6 * D), 0.02),
        'g_mix': 1.0 + nrm(6, (L, D), 0.02),
        'g_ffn': 1.0 + nrm(7, (L, D), 0.02),
        'w_in': nrm(8, (L, D, P_IN), D ** -0.5),
        'hy_conv_w': nrm(9, (L, 3, P_HY), 0.5),
        'hy_conv_b': nrm(10, (L, P_HY), 0.02),
        'hy_w1': nrm(11, (L, HY_EMB, HY_FILTER_HIDDEN), HY_EMB ** -0.5),
        'hy_b1': nrm(12, (L, HY_FILTER_HIDDEN), 0.02),
        'hy_freq': 1.0 + nrm(13, (L, HY_FILTER_HIDDEN), 0.1),
        'hy_w2': nrm(14, (L, HY_FILTER_HIDDEN, HY_FILTER_HIDDEN), HY_FILTER_HIDDEN ** -0.5),
        'hy_b2': nrm(15, (L, HY_FILTER_HIDDEN), 0.02),
        'hy_w3': nrm(16, (L, HY_FILTER_HIDDEN, 2 * HY_ORDER * HY_WIDTH), HY_FILTER_HIDDEN ** -0.5),
        'hy_bias': nrm(17, (L, HY_ORDER, HY_WIDTH), 0.5),
        'g_q': 1.0 + nrm(18, (L, 2, DA_QK_DIM), 0.02),
        'g_k': 1.0 + nrm(19, (L, 2, DA_QK_DIM), 0.02),
        'lam': nrm(20, (L, 4, DA_QK_DIM), 0.1),
        'g_sub': 1.0 + nrm(21, (L, DA_V_DIM), 0.02),
        'w_hy': nrm(22, (L, HY_WIDTH, D), HY_WIDTH ** -0.5),
        'w_fn': nrm(23, (L, FN_WIDTH, D), FN_WIDTH ** -0.5),
        'w_at': nrm(24, (L, DA_WIDTH, D), DA_WIDTH ** -0.5),
        'w_out': nrm(25, (L, D, D), D ** -0.5),
        'peer_wq': nrm(26, (L, D, PEER_HEADS * PEER_DQ), D ** -0.5),
        'peer_keys': nrm(27, (L, PEER_HEADS, 2, PEER_NKEYS, PEER_DQ // 2), (PEER_DQ // 2) ** -0.5),
        'peer_u': nrm(28, (L, PEER_EXPERTS, D), D ** -0.5),
        'peer_v': nrm(29, (L, PEER_EXPERTS, D), 0.25),
    }


def reference(x, c, ctx, c_ctx, w_ada, b_ada, g_mix, g_ffn, w_in, hy_conv_w, hy_conv_b,
              hy_w1, hy_b1, hy_freq, hy_w2, hy_b2, hy_w3, hy_bias, g_q, g_k, lam, g_sub,
              w_hy, w_fn, w_at, w_out, peer_wq, peer_keys, peer_u, peer_v):
    B, S, D = x.shape
    C = ctx.shape[1]
    cos, sin = axial_rope(S)
    xl, xc = x, ctx
    for l in range(DEPTH):
        last = l == DEPTH - 1
        mod_l = jnp.split((jax.nn.silu(c) @ w_ada[l] + b_ada[l])[:, None, :], 6, axis=-1)
        mod_c = jnp.split((jax.nn.silu(c_ctx) @ w_ada[l] + b_ada[l])[None, None, :], 6, axis=-1)
        lam_init = 0.8 - 0.6 * math.exp(-0.3 * l)
        lf = lam[l].astype(jnp.float32)
        lam_val = jnp.exp(jnp.sum(lf[0] * lf[1])) - jnp.exp(jnp.sum(lf[2] * lf[3])) + lam_init
        hy_args = (hy_w1[l], hy_b1[l], hy_freq[l], hy_w2[l], hy_b2[l], hy_w3[l])

        hy_l, fn_l, q_l, k_l, v_l, gate_l = split_in(modulate(xl, g_mix[l], mod_l[0], mod_l[1]) @ w_in[l])
        hy_c, fn_c, q_c, k_c, v_c, gate_c = split_in(modulate(xc, g_mix[l], mod_c[0], mod_c[1]) @ w_in[l])
        q_l = apply_rope(rms_norm(q_l, g_q[l]), cos, sin)
        k_l = apply_rope(rms_norm(k_l, g_k[l]), cos, sin)
        k_c = heads_first(rms_norm(k_c, g_k[l]))
        v_c = heads_first(v_c)
        k_all = jnp.concatenate([heads_first(k_l), k_c], axis=2)
        v_all = jnp.concatenate([heads_first(v_l), v_c], axis=2)
        qb = heads_first(q_l).reshape(B, DA_HEADS, S // Q_BLOCK, Q_BLOCK, 2, DA_QK_DIM)
        o_l = lax.map(lambda qq: diff_attend(qq, k_all, v_all, lam_val), jnp.moveaxis(qb, 2, 0))
        o_l = jnp.moveaxis(o_l, 0, 2).reshape(B, DA_HEADS, S, DA_V_DIM)
        att_l = diff_out(o_l, g_sub[l], lam_init)
        hyo_l = hyena_mix(short_conv(hy_l, hy_conv_w[l], hy_conv_b[l]), hyena_kernels(S, *hy_args), hy_bias[l])
        mix_l = merge(hyo_l, fourier_mix(fn_l), att_l, gate_l, w_hy[l], w_fn[l], w_at[l], w_out[l])
        if not last:
            q_c = heads_first(rms_norm(q_c, g_q[l]))
            att_c = diff_out(diff_attend(q_c, k_c, v_c, lam_val), g_sub[l], lam_init)
            hyo_c = hyena_mix(short_conv(hy_c, hy_conv_w[l], hy_conv_b[l]), hyena_kernels(C, *hy_args), hy_bias[l])
            mix_c = merge(hyo_c, fourier_mix(fn_c), att_c, gate_c, w_hy[l], w_fn[l], w_at[l], w_out[l])
            xc = xc + mod_c[2] * mix_c
        xl = xl + mod_l[2] * mix_l

        n_l = modulate(xl, g_ffn[l], mod_l[3], mod_l[4]).reshape(B * S, D)
        if last:
            y_l = peer(n_l, peer_wq[l], peer_keys[l], peer_u[l], peer_v[l])
        else:
            n_c = modulate(xc, g_ffn[l], mod_c[3], mod_c[4]).reshape(B * C, D)
            y = peer(jnp.concatenate([n_c, n_l], axis=0), peer_wq[l], peer_keys[l], peer_u[l], peer_v[l])
            y_l = y[B * C:]
            xc = xc + mod_c[5] * y[:B * C].reshape(B, C, D)
        xl = xl + mod_l[5] * y_l.reshape(B, S, D)
    return xl
```

```cpp
#include <hip/hip_runtime.h>
#include <cstdio>
#include <cstdint>
#include <math.h>
#define FK_ONE_LAUNCH 1
namespace fk {
#define FK_LAS __attribute__((address_space(3)))
typedef unsigned short bf16_t;
typedef short bf16x8 __attribute__((ext_vector_type(8)));
typedef float f32x4 __attribute__((ext_vector_type(4)));
typedef float f32x16 __attribute__((ext_vector_type(16)));
typedef unsigned u32x4 __attribute__((ext_vector_type(4)));
typedef unsigned u32x2 __attribute__((ext_vector_type(2)));
#ifndef FK_NB
#define FK_NB 8
#endif
constexpr int NB = FK_NB, SEQ = 2048, DM = 1024, CTX = 256, KALL = SEQ + CTX;
constexpr int NLAT = NB * SEQ, NCTX = NB * CTX, NTOK = NLAT + NCTX;
constexpr int PINF = 5888;
constexpr int R_HY = 0, R_FZ = 768, R_Q = 1280, R_K = 1792, R_V = 2304, R_G = 2816;
constexpr float EPS = 1e-6f;
constexpr int NWAVES = 8, NTHR = 512;
constexpr int TLL = 4224, TLC = 576;

__device__ __forceinline__ unsigned f2bf(float f) { unsigned u = __builtin_bit_cast(unsigned, f); return (u + 0x7fffu + ((u >> 16) & 1u)) >> 16; }
__device__ __forceinline__ unsigned pk2(float lo, float hi) { return f2bf(lo) | (f2bf(hi) << 16); }
__device__ __forceinline__ float bf2f(unsigned short h) { return __builtin_bit_cast(float, (unsigned)h << 16); }
__device__ __forceinline__ float bflo(unsigned w) { return __builtin_bit_cast(float, w << 16); }
__device__ __forceinline__ float bfhi(unsigned w) { return __builtin_bit_cast(float, w & 0xffff0000u); }
typedef __bf16 bf16x2_t __attribute__((ext_vector_type(2)));
__device__ __forceinline__ unsigned cvt_pk_bf16(float lo, float hi) { bf16x2_t v = {(__bf16)lo, (__bf16)hi}; return __builtin_bit_cast(unsigned, v); }
typedef float f32x2 __attribute__((ext_vector_type(2)));
constexpr float SU = 64.f, SV = 4.f;
__device__ __forceinline__ unsigned pk4_fp8(float a, float b, float c, float d) { unsigned w = __builtin_amdgcn_cvt_pk_fp8_f32(a, b, 0, false); return __builtin_amdgcn_cvt_pk_fp8_f32(c, d, w, true); }
__device__ __forceinline__ void cvt16_fp8(const float* src, unsigned char* dst, float sc) {
    const f32x4 x0 = *(const f32x4*)(src), x1 = *(const f32x4*)(src + 4), x2 = *(const f32x4*)(src + 8), x3 = *(const f32x4*)(src + 12);
    u32x4 o; o.x = pk4_fp8(x0[0] * sc, x0[1] * sc, x0[2] * sc, x0[3] * sc); o.y = pk4_fp8(x1[0] * sc, x1[1] * sc, x1[2] * sc, x1[3] * sc);
    o.z = pk4_fp8(x2[0] * sc, x2[1] * sc, x2[2] * sc, x2[3] * sc); o.w = pk4_fp8(x3[0] * sc, x3[1] * sc, x3[2] * sc, x3[3] * sc);
    *(u32x4*)dst = o;
}
__device__ __forceinline__ float wave_sum(float v) {
#pragma unroll
    for (int o = 32; o > 0; o >>= 1) v += __shfl_xor(v, o);
    return v;
}

struct WS {
    size_t ctl, mod, misc, h3l, h3c, tapl, tapc, w_in, w_mrg, w_out, w_q, keys, ub, vb, dftl, dftc;
    size_t xn, nn, hyt, ftl, ftc, q, qc, k, vt, g, attlo, atthi, hyo, fno, y, xl, xc, pq, pidx, pg, stash, end;
};
__host__ __device__ constexpr size_t al(size_t x) { return (x + 4095) / 4096 * 4096; }
__host__ __device__ constexpr WS make_ws() {
    WS w{}; size_t o = 0;
    w.ctl = o; o += 65536;
    w.mod = o; o += al((size_t)2 * 9 * 6144 * 4);
    w.misc = o; o += al((size_t)12 << 20);
    w.tapl = o; o += al((size_t)2 * 2 * 256 * TLL * 2);
    w.tapc = o; o += al((size_t)2 * 2 * 256 * TLC * 2);
    w.w_in = o; o += al((size_t)2 * PINF * 1024 * 2);
    w.w_mrg = o; o += al((size_t)2 * 4 * 1024 * 256 * 2);
    w.w_out = o; o += al((size_t)2 * 1024 * 1024 * 2);
    w.w_q = o; o += al((size_t)2 * 2048 * 1024 * 2);
    w.keys = o; o += al((size_t)2 * 16 * 128 * 128 * 2);
    w.ub = o; o += al((size_t)16384 * 1024);
    w.vb = o; o += al((size_t)16384 * 1024);
    w.dftl = o; o += al((size_t)2048 * 4096 * 2);
    w.dftc = o; o += al((size_t)256 * 512 * 2);
    w.xn = o; o += al((size_t)NTOK * 1024 * 2);
    w.nn = o; w.stash = o; { size_t a = al((size_t)NTOK * 1024 * 2), b = al((size_t)256 * 512 * 128 * 4); o += a > b ? a : b; }
    w.hyt = o; w.y = o; { size_t a = al((size_t)768 * NTOK * 2) + al((size_t)NB * 256 * 4096 * 2) + al((size_t)NB * 256 * 512 * 2), b = al((size_t)NTOK * 1024 * 2);
        w.ftl = o + al((size_t)768 * NTOK * 2); w.ftc = w.ftl + al((size_t)NB * 256 * 4096 * 2); o += a > b ? a : b; }
    w.q = o; o += al((size_t)NB * 8 * 2048 * 64 * 2);
    w.qc = o; o += al((size_t)NB * 8 * 256 * 64 * 2);
    w.k = o; o += al((size_t)NB * 8 * KALL * 64 * 2);
    w.vt = o; o += al((size_t)NB * 4 * 128 * KALL * 2);
    w.g = o; w.pq = o; w.h3l = o; { size_t a = al((size_t)NTOK * 3072 * 2), b = al((size_t)2 * 2048 * 1024 * 4) + al((size_t)2 * 256 * 1024 * 4);
        w.h3c = o + al((size_t)2 * 2048 * 1024 * 4); o += a > b ? a : b; }
    w.attlo = o; o += al((size_t)NTOK * 256 * 2);
    w.atthi = o; o += al((size_t)NTOK * 256 * 2);
    w.hyo = o; o += al((size_t)NTOK * 256 * 2);
    w.fno = o; o += al((size_t)NTOK * 256 * 2);
    w.xl = o; o += (NB == 8) ? 0 : al((size_t)NLAT * 1024 * 4);
    w.xc = o; o += al((size_t)NCTX * 1024 * 4);
    w.pidx = o; o += al((size_t)NTOK * 128 * 4);
    w.pg = o; o += al((size_t)NTOK * 128 * 4);
    w.end = o; return w;
}
constexpr WS W = make_ws();
constexpr int MI_LAM = 0, MI_ROPE = 64, MI_HYINV = 4096, MI_HYPART = 8192;

constexpr int BM = 256, BK = 64, HALF = 128, HTB = HALF * BK * 2, STAGE_BYTES = 8 * HTB;
__host__ __device__ __forceinline__ int lds_byte(int r, int c) { const int st = (r >> 4) * 2 + (c >> 5), rr = r & 15, cc = c & 31, ob = rr * 64 + cc * 2; return st * 1024 + (ob ^ (((ob >> 9) & 1) << 5)); }
__host__ __device__ __forceinline__ void stage_rc(int b, int& R, int& C) { const int st = b / 1024, sb = b % 1024, swz = sb ^ (((sb >> 9) & 1) << 5); R = (st >> 1) * 16 + swz / 64; C = (st & 1) * 32 + (swz % 64) / 2; }
__host__ __device__ __forceinline__ int perm32(int rho) { const int n = rho >> 4, i = rho & 15; return 8 * (i >> 2) + 4 * n + (i & 3); }

struct Unit { const char* a; const char* b; int pm, pn, kind, aux; };
typedef f32x4 Acc[2][2][4][2];

template <class Sched, class Epi>
__device__ __forceinline__ void gemm_phase(FK_LAS unsigned char* lds, const int K, const Sched& S, const Epi& E) {
    int tid = threadIdx.x; asm volatile("" : "+v"(tid));
    const int wid = __builtin_amdgcn_readfirstlane(tid >> 6), lane = tid & 63, wr = wid >> 2, wc = wid & 3, fr = lane & 15, fq = lane >> 4;
    const int nt = K / BK;
    unsigned voffA[2], voffB[2];
#pragma unroll
    for (int i = 0; i < 2; ++i) { int R, C; stage_rc(tid * 16 + i * 8192, R, C); const int Rb = (R & ~31) + perm32(R & 31);
        voffA[i] = (unsigned)(R * K + C) * 2u; voffB[i] = (unsigned)(Rb * K + C) * 2u; }
    const size_t kstep = (size_t)(BK * 2);
    const size_t hstep = (size_t)HALF * K * 2;
    const unsigned ldsw = (unsigned)wid * 1024u;
    const int aoff = lds_byte(wr * 64 + fr, fq * 8), boff = lds_byte(wc * 32 + fr, fq * 8);
#define PG8_SA(b, h) (((b) * 2 + (h)) * HTB)
#define PG8_SB(b, h) ((4 + (b) * 2 + (h)) * HTB)
#define PG8_STAGE(bufoff, gbase, voff) do { _Pragma("unroll") for (int _i = 0; _i < 2; ++_i) \
        __builtin_amdgcn_global_load_lds((const unsigned*)((const char*)(gbase) + (voff)[_i]), (FK_LAS unsigned*)(lds + (bufoff) + ldsw + _i * 8192), 16, 0, 0); } while (0)
#define PG8_LDA(dst, b, h) do { _Pragma("unroll") for (int m = 0; m < 4; ++m) _Pragma("unroll") for (int k = 0; k < 2; ++k) dst[m][k] = *(const FK_LAS bf16x8*)(lds + PG8_SA(b, h) + aoff + m * 2048 + k * 1024); } while (0)
#define PG8_LDB(dst, b, h) do { _Pragma("unroll") for (int n = 0; n < 2; ++n) _Pragma("unroll") for (int k = 0; k < 2; ++k) dst[n][k] = *(const FK_LAS bf16x8*)(lds + PG8_SB(b, h) + boff + n * 2048 + k * 1024); } while (0)
#define PG8_MMA(ai, bj, At, Bt) do { __builtin_amdgcn_s_setprio(1); _Pragma("unroll") for (int m = 0; m < 4; ++m) _Pragma("unroll") for (int n = 0; n < 2; ++n) _Pragma("unroll") for (int k = 0; k < 2; ++k) \
        acc[ai][bj][m][n] = __builtin_amdgcn_mfma_f32_16x16x32_bf16(Bt[n][k], At[m][k], acc[ai][bj][m][n], 0, 0, 0); __builtin_amdgcn_s_setprio(0); } while (0)
#define PG8_WAIT_V(n) asm volatile("s_waitcnt vmcnt(" #n ")" ::: "memory")
#define PG8_WAIT_L(n) asm volatile("s_waitcnt lgkmcnt(" #n ")" ::: "memory")
#define PG8_BAR __builtin_amdgcn_s_barrier()
#define PG8_SCHED __builtin_amdgcn_sched_barrier(0)
    Unit cur, nxt; int ui = 0;
    if (!S.next(0, cur)) return;
    Acc acc;
#pragma unroll
    for (int a = 0; a < 2; ++a)
#pragma unroll
        for (int b = 0; b < 2; ++b)
#pragma unroll
            for (int m = 0; m < 4; ++m)
#pragma unroll
                for (int n = 0; n < 2; ++n) acc[a][b][m][n] = (f32x4){0.f, 0.f, 0.f, 0.f};
    bf16x8 At[4][2], B0[2][2], B1[2][2];
    const char* cA = cur.a; const char* cB = cur.b;
    PG8_STAGE(PG8_SB(0, 0), cB, voffB); PG8_STAGE(PG8_SB(0, 1), cB + hstep, voffB); PG8_STAGE(PG8_SA(0, 0), cA, voffA); PG8_STAGE(PG8_SA(0, 1), cA + hstep, voffA);
    if (wr == 1) PG8_BAR;
    PG8_WAIT_V(2); PG8_BAR;
    PG8_STAGE(PG8_SB(1, 0), cB + kstep, voffB); PG8_STAGE(PG8_SA(1, 0), cA + kstep, voffA); PG8_STAGE(PG8_SB(1, 1), cB + hstep + kstep, voffB);
    PG8_WAIT_V(6); PG8_BAR;
    for (;;) {
        const bool has_next = S.next(ui + 1, nxt);
        const char* nA = has_next ? nxt.a : cA; const char* nB = has_next ? nxt.b : cB;
        for (int t = 0; t < nt; t += 2) {
            const bool last = (t == nt - 2);
            const char* a1 = cA + (size_t)(t + 1) * kstep;
            const char* a2 = last ? nA : cA + (size_t)(t + 2) * kstep; const char* b2 = last ? nB : cB + (size_t)(t + 2) * kstep;
            const char* a3 = a2 + kstep; const char* b3 = b2 + kstep;
            PG8_LDB(B0, 0, 0); PG8_LDB(B1, 0, 1); PG8_SCHED; PG8_LDA(At, 0, 0); PG8_STAGE(PG8_SA(1, 1), a1 + hstep, voffA);
            PG8_WAIT_V(8); PG8_WAIT_L(0); PG8_BAR; PG8_MMA(0, 0, At, B0); PG8_MMA(0, 1, At, B1); PG8_BAR; PG8_SCHED;
            PG8_LDA(At, 0, 1); PG8_STAGE(PG8_SB(0, 0), b2, voffB); PG8_STAGE(PG8_SB(0, 1), b2 + hstep, voffB); PG8_STAGE(PG8_SA(0, 0), a2, voffA);
            PG8_WAIT_V(8); PG8_WAIT_L(0); PG8_BAR; PG8_MMA(1, 0, At, B0); PG8_MMA(1, 1, At, B1); PG8_BAR; PG8_SCHED;
            PG8_LDB(B0, 1, 0); PG8_LDB(B1, 1, 1); PG8_SCHED; PG8_LDA(At, 1, 0); PG8_STAGE(PG8_SA(0, 1), a2 + hstep, voffA);
            PG8_WAIT_V(8); PG8_WAIT_L(0); PG8_BAR; PG8_MMA(0, 0, At, B0); PG8_MMA(0, 1, At, B1); PG8_BAR; PG8_SCHED;
            PG8_LDA(At, 1, 1); PG8_STAGE(PG8_SB(1, 0), b3, voffB); PG8_STAGE(PG8_SB(1, 1), b3 + hstep, voffB); PG8_STAGE(PG8_SA(1, 0), a3, voffA);
            PG8_WAIT_V(8); PG8_WAIT_L(0); PG8_BAR; PG8_MMA(1, 0, At, B0); PG8_MMA(1, 1, At, B1); PG8_BAR; PG8_SCHED;
        }
        if (wr == 0) PG8_BAR;
        int fr2 = fr, fq2 = fq; asm volatile("" : "+v"(fr2), "+v"(fq2));
        const bool zero = E(acc, cur, wr, wc, fr2, fq2);
        if (!has_next) break;
        if (zero) {
#pragma unroll
            for (int a = 0; a < 2; ++a)
#pragma unroll
                for (int b = 0; b < 2; ++b)
#pragma unroll
                    for (int m = 0; m < 4; ++m)
#pragma unroll
                        for (int n = 0; n < 2; ++n) acc[a][b][m][n] = (f32x4){0.f, 0.f, 0.f, 0.f};
        }
        cur = nxt; cA = nA; cB = nB; ++ui;
        if (wr == 1) PG8_BAR;
    }
    PG8_WAIT_V(0);
    PG8_BAR;
#undef PG8_SA
#undef PG8_SB
#undef PG8_STAGE
#undef PG8_LDA
#undef PG8_LDB
#undef PG8_MMA
#undef PG8_WAIT_V
#undef PG8_WAIT_L
#undef PG8_BAR
#undef PG8_SCHED
}
#define XB_TMO      128
#define XB_XCNT(j)  (256  + 64 * (j))
#define XB_XSUB(j)  (1280 + 64 * (j))
#define XB_XGEN(j)  (2304 + 64 * (j))
#define XB_TOP      3328
#define XB_TOPGEN   3392
#define XCD_BAR_WORDS 3456
#define XB_SPIN_CAP (1u << 20)
__device__ __forceinline__ unsigned xb_ld(unsigned* p)              { return __hip_atomic_load(p, __ATOMIC_RELAXED, __HIP_MEMORY_SCOPE_AGENT); }
__device__ __forceinline__ unsigned xb_add(unsigned* p, unsigned v) { return __hip_atomic_fetch_add(p, v, __ATOMIC_RELAXED, __HIP_MEMORY_SCOPE_AGENT); }
__device__ __forceinline__ unsigned xb_xcc_id() { return (unsigned)__builtin_amdgcn_s_getreg((3 << 11) | 20) & 0xFu; }
#define XB_SPIN(cond, bar) do { unsigned _sp = 0; while (cond) { __builtin_amdgcn_s_sleep(1); \
    if ((++_sp & 255u) == 0u) { if (xb_ld(&(bar)[XB_TMO])) break; if (_sp > XB_SPIN_CAP) { atomicAdd(&(bar)[XB_TMO], 1u); break; } } } } while (0)
struct XcdBarrier { unsigned* bar; unsigned x; volatile FK_LAS unsigned* st; };
__device__ __forceinline__ XcdBarrier xcd_barrier_post(unsigned* bar, volatile FK_LAS unsigned* st) {
    XcdBarrier b; b.bar = bar; b.x = xb_xcc_id(); b.st = st;
    if (threadIdx.x == 0) (void)xb_add(&bar[XB_XCNT(b.x)], 1u);
    return b;
}
__device__ __forceinline__ void xcd_barrier_complete(unsigned* bar, unsigned x, unsigned& nloc, unsigned& nx) {
    const unsigned G = gridDim.x * gridDim.y * gridDim.z;
    unsigned sum, cnt, mine, sp = 0u;
    for (;;) {
        sum = 0u; cnt = 0u; mine = 0u;
#pragma unroll
        for (unsigned j = 0; j < 16; ++j) { const unsigned c = xb_ld(&bar[XB_XCNT(j)]); sum += c; cnt += (c > 0u) ? 1u : 0u; mine = (j == x) ? c : mine; }
        if (sum == G) break;
        __builtin_amdgcn_s_sleep(1);
        if ((++sp & 255u) == 0u) { if (xb_ld(&bar[XB_TMO])) break; if (sp > XB_SPIN_CAP) { atomicAdd(&bar[XB_TMO], 1u); break; } }
    }
    nloc = mine > 0u ? mine : 1u; nx = cnt > 0u ? cnt : 1u;
}
__device__ __forceinline__ void xcd_barrier(const XcdBarrier& b) {
    asm volatile("s_waitcnt vmcnt(0)" ::: "memory");
    __syncthreads();
    if (threadIdx.x == 0) {
        unsigned* bar = b.bar;
        __builtin_amdgcn_s_waitcnt(0);
        unsigned nloc = b.st[0], nx = b.st[1];
        if (nloc == 0u) { xcd_barrier_complete(bar, b.x, nloc, nx); b.st[0] = nloc; b.st[1] = nx; }
        const unsigned old = xb_add(&bar[XB_XSUB(b.x)], 1u);
        const unsigned gen = old / nloc;
        if (old + 1u == (gen + 1u) * nloc) {
            __builtin_amdgcn_fence(__ATOMIC_RELEASE, "agent");
            asm volatile("s_waitcnt vmcnt(0)" ::: "memory");
            const unsigned og = xb_add(&bar[XB_TOP], 1u);
            const unsigned tg = og / nx;
            if (og + 1u == (tg + 1u) * nx) xb_add(&bar[XB_TOPGEN], 1u);
            else XB_SPIN(xb_ld(&bar[XB_TOPGEN]) == tg, bar);
            __builtin_amdgcn_fence(__ATOMIC_ACQUIRE, "agent");
            xb_add(&bar[XB_XGEN(b.x)], 1u);
            asm volatile("s_waitcnt vmcnt(0)" ::: "memory");
        } else {
            XB_SPIN(xb_ld(&bar[XB_XGEN(b.x)]) == gen, bar);
            __builtin_amdgcn_fence(__ATOMIC_ACQUIRE, "agent");
            asm volatile("s_waitcnt vmcnt(0)" ::: "memory");
        }
    }
    __syncthreads();
}

struct Args { const float* in[30]; float* out; unsigned char* ws; float* xl; int ph_lo, ph_hi, use_bar, pad; };
constexpr int LDS_MISC = 155648, LDS_BYTES = 155648 + 256;

struct Ctx {
    const Args* a; FK_LAS unsigned char* lds; int tid, lane, wave, vcu, G;
};
typedef const Args __attribute__((address_space(4)))* AP;
#define FIN(i) (A->in[i])
template <class T> __device__ __forceinline__ T* wsp(AP A, size_t off) { return (T*)(A->ws + off); }
__device__ __forceinline__ int opaque_tid() { int t = threadIdx.x; asm volatile("" : "+v"(t)); return t; }
__device__ __forceinline__ AP opaque_args(AP a) { asm volatile("" : "+s"(a)); return a; }

__device__ __forceinline__ int inproj_src_col(int p) {
    if (p < R_FZ) return p;
    if (p >= R_V) return p - R_V + 2048;
    const int q0 = p - R_Q, tile = q0 >> 8, pl = q0 & 255;
    const int bj = pl >> 7, wc = (pl >> 5) & 3, fq = (pl >> 3) & 3, e = pl & 7;
    return 1024 + tile * 256 + 64 * wc + 32 * (fq >> 1) + 16 * bj + 8 * (fq & 1) + e;
}
template <class ColFn>
__device__ __forceinline__ void transpose_item(const float* src, int ldsrc, int ksrc0, bf16_t* dst, int Kd, int p0, int k0, FK_LAS float* scr, int lane, ColFn col) {
    const int cidx = col(p0 + (lane & 31));
    float tv[32];
#pragma unroll
    for (int i = 0; i < 32; ++i) tv[i] = src[(size_t)(ksrc0 + k0 + 2 * i + (lane >> 5)) * ldsrc + cidx];
#pragma unroll
    for (int i = 0; i < 32; ++i) scr[(2 * i + (lane >> 5)) * 33 + (lane & 31)] = tv[i];
    asm volatile("s_waitcnt lgkmcnt(0)" ::: "memory");
    const int c = lane & 7;
#pragma unroll
    for (int j = 0; j < 4; ++j) { const int n = (lane >> 3) + 8 * j; const FK_LAS float* s = scr + (8 * c) * 33 + n;
        u32x4 o; o.x = pk2(s[0 * 33], s[1 * 33]); o.y = pk2(s[2 * 33], s[3 * 33]); o.z = pk2(s[4 * 33], s[5 * 33]); o.w = pk2(s[6 * 33], s[7 * 33]);
        *(u32x4*)(dst + (size_t)(p0 + n) * Kd + k0 + 8 * c) = o; }
    asm volatile("s_waitcnt lgkmcnt(0)" ::: "memory");
}
struct IdCol { int off; __device__ int operator()(int p) const { return p + off; } };
struct InprojCol { __device__ int operator()(int p) const { return inproj_src_col(p); } };

__device__ __forceinline__ void phase_pa(AP A, FK_LAS unsigned char* lds, int vcu, int G) {
    const int tid = opaque_tid(), lane = tid & 63, wave = __builtin_amdgcn_readfirstlane(tid >> 6);
    const int gw = vcu * NWAVES + wave, NGW = G * NWAVES;
    const size_t gt = (size_t)vcu * NTHR + tid, NGT = (size_t)G * NTHR;
    float* misc = wsp<float>(A, W.misc);
    FK_LAS float* ctab = (FK_LAS float*)(lds + 131072); FK_LAS float* stab = ctab + 2048;
    for (int i = tid; i < 2048; i += NTHR) { const float a = (float)i * (2.f / 2048.f); ctab[i] = cospif(a); stab[i] = sinpif(a); }
    __syncthreads();
    if (vcu == 0) {
        if (tid < 2) { const float* p = FIN(20) + tid * 256; float a = 0.f, b = 0.f;
            for (int i = 0; i < 64; ++i) { a += p[i] * p[64 + i]; b += p[128 + i] * p[192 + i]; }
            misc[MI_LAM + tid] = expf(a) - expf(b) + (0.8f - 0.6f * expf(-0.3f * (float)tid)); }
        for (int i = tid; i < 64 * 16; i += NTHR) { const int pos = i >> 4, e = i & 15; const float inv = powf(10000.f, -(float)(2 * e) / 32.f), ang = (float)pos * inv;
            misc[MI_ROPE + 2 * i] = cosf(ang); misc[MI_ROPE + 2 * i + 1] = sinf(ang); }
    }
    {
        FK_LAS float* s = (FK_LAS float*)lds;
        FK_LAS float* red = (FK_LAS float*)(lds + 9 * 1024 * 4);
        bool have = false;
        for (int it = vcu; it < 192; it += G) {
            if (!have) { for (int i = tid; i < 9 * 1024; i += NTHR) { const int r = i >> 10, k = i & 1023; const float v = r < 8 ? FIN(1)[r * 1024 + k] : FIN(3)[k]; s[i] = v / (1.f + expf(-v)); } __syncthreads(); have = true; }
            const int l = it / 96, n0 = (it % 96) * 64, kq = tid >> 6, c = tid & 63;
            const float* Wp = FIN(4) + (size_t)l * 1024 * 6144 + n0 + c;
            float acc[9];
#pragma unroll
            for (int r = 0; r < 9; ++r) acc[r] = 0.f;
#pragma unroll 1
            for (int k0 = kq * 128; k0 < kq * 128 + 128; k0 += 16) { float wv[16];
#pragma unroll
                for (int j = 0; j < 16; ++j) wv[j] = Wp[(size_t)(k0 + j) * 6144];
#pragma unroll
                for (int j = 0; j < 16; ++j)
#pragma unroll
                    for (int r = 0; r < 9; ++r) acc[r] += s[r * 1024 + k0 + j] * wv[j]; }
#pragma unroll
            for (int r = 0; r < 9; ++r) red[(kq * 9 + r) * 64 + c] = acc[r];
            __syncthreads();
            for (int i = tid; i < 9 * 64; i += NTHR) { const int r = i >> 6, cc = i & 63; float t = 0.f;
#pragma unroll
                for (int q = 0; q < 8; ++q) t += red[(q * 9 + r) * 64 + cc];
                wsp<float>(A, W.mod)[((size_t)l * 9 + r) * 6144 + n0 + cc] = t + FIN(5)[l * 6144 + n0 + cc]; }
            __syncthreads();
        }
        __syncthreads();
    }
    {
        FK_LAS float* scr = (FK_LAS float*)(lds + wave * 16384);
        constexpr int I_IN = (PINF / 32) * 16;
        constexpr int I_M = (1024 / 32) * 4;
        constexpr int I_O = (1024 / 32) * 16, I_Q = (2048 / 32) * 16;
        constexpr int PER_L = I_IN + 4 * I_M + I_O + I_Q;
        for (int it = gw; it < 2 * PER_L; it += NGW) {
            const int l = it / PER_L; int r = it % PER_L;
            if (r < I_IN) { const int p0 = (r >> 4) * 32, k0 = (r & 15) * 64;
                if (p0 >= R_FZ && p0 < R_Q) continue;
                transpose_item(FIN(8) + (size_t)l * 1024 * 5632, 5632, 0, wsp<bf16_t>(A, W.w_in) + (size_t)l * PINF * 1024, 1024, p0, k0, scr, lane, InprojCol{}); continue; }
            r -= I_IN;
            if (r < 4 * I_M) { const int seg = r / I_M, q = r % I_M, p0 = (q >> 2) * 32, k0 = (q & 3) * 64;
                const float* src = seg == 0 ? FIN(22) + (size_t)l * 256 * 1024 : seg == 1 ? FIN(23) + (size_t)l * 256 * 1024 : FIN(24) + (size_t)l * 512 * 1024;
                transpose_item(src, 1024, seg == 3 ? 256 : 0, wsp<bf16_t>(A, W.w_mrg) + ((size_t)l * 4 + seg) * 1024 * 256, 256, p0, k0, scr, lane, IdCol{0}); continue; }
            r -= 4 * I_M;
            if (r < I_O) { const int p0 = (r >> 4) * 32, k0 = (r & 15) * 64;
                transpose_item(FIN(25) + (size_t)l * 1024 * 1024, 1024, 0, wsp<bf16_t>(A, W.w_out) + (size_t)l * 1024 * 1024, 1024, p0, k0, scr, lane, IdCol{0}); continue; }
            r -= I_O;
            { const int p0 = (r >> 4) * 32, k0 = (r & 15) * 64;
                transpose_item(FIN(26) + (size_t)l * 1024 * 2048, 2048, 0, wsp<bf16_t>(A, W.w_q) + (size_t)l * 2048 * 1024, 1024, p0, k0, scr, lane, IdCol{0}); }
        }
    }
    for (size_t i = gt; i < (size_t)1 << 17; i += NGT) {
        const int k = (int)(i & 1023), mc = (int)((i >> 10) & 7), part = (int)((i >> 13) & 1), g = (int)((i >> 14) & 3), l = (int)(i >> 16);
        const float* src = FIN(8) + (size_t)l * 1024 * 5632 + (size_t)k * 5632 + 768 + g * 64;
        f32x4 sv[16];
#pragma unroll
        for (int q = 0; q < 16; ++q) sv[q] = *(const f32x4*)(src + 4 * q);
        const FK_LAS float* tb = part ? stab : ctab;
        bf16_t* dst = wsp<bf16_t>(A, W.w_in) + ((size_t)l * PINF + R_FZ + part * 256 + g * 64 + mc * 8) * 1024 + k;
#pragma unroll 1
        for (int mm = 0; mm < 8; ++mm) { const int m = mc * 8 + mm; float acc = 0.f;
#pragma unroll
            for (int q = 0; q < 16; ++q)
#pragma unroll
                for (int j = 0; j < 4; ++j) acc += sv[q][j] * tb[((m * (4 * q + j)) & 63) * 32];
            dst[(size_t)mm * 1024] = (bf16_t)f2bf(acc); }
    }
    {
        const size_t nUV = (size_t)16384 * 1024 / 16, nK = (size_t)2 * 16 * 128 * 128 / 8;
        for (size_t i0 = gt; i0 < 2 * nUV + nK; i0 += 2 * NGT) {
#pragma unroll
            for (int rep = 0; rep < 2; ++rep) { const size_t i = i0 + rep * NGT; if (i >= 2 * nUV + nK) break;
                if (i < nUV) cvt16_fp8(FIN(28) + i * 16, wsp<unsigned char>(A, W.ub) + i * 16, SU);
                else if (i < 2 * nUV) cvt16_fp8(FIN(29) + (i - nUV) * 16, wsp<unsigned char>(A, W.vb) + (i - nUV) * 16, SV);
                else { const size_t j = i - 2 * nUV; const float* src = FIN(27); bf16_t* dst = wsp<bf16_t>(A, W.keys);
                    const f32x4 x0 = *(const f32x4*)(src + j * 8), x1 = *(const f32x4*)(src + j * 8 + 4);
                    u32x4 o; o.x = pk2(x0[0], x0[1]); o.y = pk2(x0[2], x0[3]); o.z = pk2(x1[0], x1[1]); o.w = pk2(x1[2], x1[3]);
                    *(u32x4*)(dst + j * 8) = o; } }
        }
    }
    for (size_t i = gt; i < (size_t)2048 * 2048 + 256 * 256; i += NGT) {
        const bool big = i < (size_t)2048 * 2048; const size_t j = big ? i : i - (size_t)2048 * 2048; const int L = big ? 2048 : 256, lg = big ? 11 : 8;
        const int k = (int)(j >> lg), t = (int)(j & (L - 1)); const int ti = ((k * t) & (L - 1)) * (2048 / L); const float sc = rsqrtf(64.f * (float)L);
        bf16_t* d = big ? wsp<bf16_t>(A, W.dftl) : wsp<bf16_t>(A, W.dftc);
        d[(size_t)k * 2 * L + t] = (bf16_t)f2bf(sc * ctab[ti]); d[(size_t)k * 2 * L + L + t] = (bf16_t)f2bf(-sc * stab[ti]);
    }
    {
        constexpr int HPP = 4;
        FK_LAS float* h1 = (FK_LAS float*)lds; FK_LAS float* h2 = h1 + HPP * 64; FK_LAS float* ft = h2 + HPP * 64;
        FK_LAS float* w1s = ft + HPP * 33 + 4; FK_LAS float* w2s = w1s + 33 * 64; FK_LAS float* b1s = w2s + 64 * 64; FK_LAS float* b2s = b1s + 64; FK_LAS float* fqs = b2s + 64;
        constexpr int IT_L = 2048 / HPP, IT_C = 256 / HPP, PER = IT_L + IT_C;
        int lcur = -1;
        for (int it = vcu; it < 2 * PER; it += G) {
            const int l = it / PER, r = it % PER, big = r < IT_L, L = big ? 2048 : 256, p0 = (big ? r : r - IT_L) * HPP;
            __syncthreads();
            if (l != lcur) { lcur = l;
                for (int i = tid; i < 33 * 64; i += NTHR) w1s[i] = FIN(11)[l * 33 * 64 + i];
                for (int i = tid; i < 64 * 64; i += NTHR) w2s[i] = FIN(14)[l * 4096 + i];
                if (tid < 64) { b1s[tid] = FIN(12)[l * 64 + tid]; b2s[tid] = FIN(15)[l * 64 + tid]; fqs[tid] = FIN(13)[l * 64 + tid]; } }
            for (int i = tid; i < HPP * 33; i += NTHR) { const int pp = i / 33, e = i % 33, pos = p0 + pp; const float t = (float)pos / (float)(L - 1), w = 2.0f * 3.14159265358979323846f * (float)pos / (float)L;
                float v; if (e == 0) v = t; else { const int b = (e - 1) & 15; const float f = 1e-4f + (float)b * ((15.f - 1e-4f) / 15.f), a = w * f; v = e <= 16 ? cosf(a) : -sinf(a); }
                ft[i] = v; }
            __syncthreads();
            for (int i = tid; i < HPP * 64; i += NTHR) { const int pp = i >> 6, j = i & 63; float acc = 0.f;
                for (int e = 0; e < 33; ++e) acc += ft[pp * 33 + e] * w1s[e * 64 + j];
                h1[i] = sinf(fqs[j] * (acc + b1s[j])); }
            __syncthreads();
            for (int i = tid; i < HPP * 64; i += NTHR) { const int pp = i >> 6, j = i & 63; float acc = 0.f;
                for (int e = 0; e < 64; ++e) acc += h1[pp * 64 + e] * w2s[e * 64 + j];
                h2[i] = sinf(fqs[j] * (acc + b2s[j])); }
            __syncthreads();
            float* H3 = big ? wsp<float>(A, W.h3l) + (size_t)l * 2048 * 1024 : wsp<float>(A, W.h3c) + (size_t)l * 256 * 1024;
            float* part = misc + MI_HYPART + ((size_t)(l * 2 + (big ? 0 : 1)) * IT_L + (big ? r : r - IT_L)) * 1024;
#pragma unroll
            for (int cc = 0; cc < 2; ++cc) { const int col = tid + cc * 512, ch = col & 255;
                const float mn = -3.0701134573253946f, mx = -15.350567286626973f; const float delta = fabsf(mn + (float)ch * ((mx - mn) / 255.f));
                float acc[HPP];
#pragma unroll
                for (int pp = 0; pp < HPP; ++pp) acc[pp] = 0.f;
                const float* w3 = FIN(16) + (size_t)l * 65536 + col;
#pragma unroll 1
                for (int e0 = 0; e0 < 64; e0 += 16) { float wv[16];
#pragma unroll
                    for (int j = 0; j < 16; ++j) wv[j] = w3[(size_t)(e0 + j) * 1024];
#pragma unroll
                    for (int j = 0; j < 16; ++j)
#pragma unroll
                        for (int pp = 0; pp < HPP; ++pp) acc[pp] += h2[pp * 64 + e0 + j] * wv[j]; }
                float ps = 0.f;
#pragma unroll
                for (int pp = 0; pp < HPP; ++pp) { const int pos = p0 + pp; const float v = acc[pp] * expf(-((float)pos / (float)(L - 1)) * delta); H3[(size_t)pos * 1024 + col] = v;
                    if (!(col >= 512 && pos == 0)) ps += fabsf(v); }
                part[col] = ps; }
        }
        __syncthreads();
    }
}
__device__ __forceinline__ void modulate_row_bf16(const float* xrow, const float* g, const float* scale, const float* shift, bf16_t* orow, int lane) {
    f32x4 v[4]; float ss = 0.f;
#pragma unroll
    for (int j = 0; j < 4; ++j) { v[j] = *(const f32x4*)(xrow + 4 * lane + 256 * j); ss += (v[j][0] * v[j][0] + v[j][1] * v[j][1]) + (v[j][2] * v[j][2] + v[j][3] * v[j][3]); }
    ss = wave_sum(ss); const float rs = rsqrtf(ss * (1.f / 1024.f) + EPS);
#pragma unroll
    for (int j = 0; j < 4; ++j) { const int k = 4 * lane + 256 * j; const f32x4 gg = *(const f32x4*)(g + k), sc = *(const f32x4*)(scale + k), sf = *(const f32x4*)(shift + k);
        const f32x4 o = v[j] * rs * gg * (sc + 1.0f) + sf; u32x2 w; w.x = pk2(o[0], o[1]); w.y = pk2(o[2], o[3]); *(u32x2*)(orow + k) = w; }
}
__device__ __forceinline__ void phase_pb(AP A, int vcu, int G) {
    const int tid = opaque_tid(), lane = tid & 63, wave = __builtin_amdgcn_readfirstlane(tid >> 6); (void)tid;
    const int gw = vcu * NWAVES + wave, NGW = G * NWAVES;
    const float* mod = wsp<float>(A, W.mod);
    for (int t = gw; t < NTOK; t += NGW) {
        const bool lat = t < NLAT; const int mr = lat ? t / SEQ : 8;
        const float* xr = lat ? FIN(0) + (size_t)t * DM : FIN(2) + (size_t)(t - NLAT) * DM;
        modulate_row_bf16(xr, FIN(6), mod + (size_t)mr * 6144 + 1024, mod + (size_t)mr * 6144, wsp<bf16_t>(A, W.xn) + (size_t)t * DM, lane);
    }
    const float* misc = wsp<float>(A, W.misc);
    for (int row = gw; row < 2 * 2 * 512; row += NGW) {
        const int l = row >> 10, big = ((row >> 9) & 1) == 0, oc = row & 511, L = big ? 2048 : 256, TLn = big ? TLL : TLC, nit = big ? 512 : 64;
        const float* part = misc + MI_HYPART + (size_t)(l * 2 + (big ? 0 : 1)) * 512 * 1024;
        float s = 0.f; for (int i = lane; i < nit; i += 64) s += part[(size_t)i * 1024 + oc] + part[(size_t)i * 1024 + 512 + oc];
        s = wave_sum(s); const float inv = 1.f / s;
        const float* H3 = big ? wsp<float>(A, W.h3l) + (size_t)l * 2048 * 1024 : wsp<float>(A, W.h3c) + (size_t)l * 256 * 1024;
        bf16_t* TL = big ? wsp<bf16_t>(A, W.tapl) + ((size_t)l * 512 + oc) * TLL : wsp<bf16_t>(A, W.tapc) + ((size_t)l * 512 + oc) * TLC;
        const int c = L + 32;
        for (int y0 = 0; y0 < TLn; y0 += 64 * 8) { float tv[8];
#pragma unroll
            for (int j = 0; j < 8; ++j) { const int y = y0 + 64 * j + lane, m = c - y, am = m < 0 ? -m : m; const bool ok = (y < TLn) && (am < L);
                const float v = H3[ok ? (size_t)am * 1024 + (m < 0 ? 512 : 0) + oc : (size_t)oc];
                tv[j] = ok ? v : 0.f; }
#pragma unroll
            for (int j = 0; j < 8; ++j) { const int y = y0 + 64 * j + lane; if (y < TLn) TL[y] = (bf16_t)f2bf(tv[j] * inv); } }
    }
}

constexpr int NTT = NTOK / 256, NTL = NLAT / 256;
struct InprojSched {
    int l, G, c; const char* xn; const char* w;
    __device__ bool next(int i, Unit& u) const {
        const long Li = (long)i * G + c;
        const int nM = (l == 0) ? NTT : NTL, nN = 23, nwg = nM * nN;
        if (Li < nwg) {
            int wgid = (int)Li; { const int q = nwg / 8, r = nwg % 8, xcd = wgid % 8, off = wgid / 8; wgid = (xcd < r ? xcd * (q + 1) : r * (q + 1) + (xcd - r) * q) + off; }
            const int nig = 8 * nN, gid = wgid / nig, fm = gid * 8, gsz = (nM - fm) < 8 ? (nM - fm) : 8;
            u.pm = fm + ((wgid % nig) % gsz); u.pn = (wgid % nig) / gsz;
        } else {
            const int r2 = (int)(Li - nwg); if (l == 0 || r2 >= (NTT - NTL) * 4) return false;
            u.pm = NTL + r2 / 4; u.pn = 7 + (r2 & 3);
        }
        const int pn = u.pn; u.kind = pn < 3 ? 0 : pn < 5 ? 1 : pn < 9 ? 2 : pn < 11 ? 3 : 4;
        const char* at = xn + (size_t)u.pm * 256 * 1024 * 2; const char* wt = w + (size_t)pn * 256 * 1024 * 2;
        const bool swapped = (u.kind == 0 || u.kind == 1 || u.kind == 3);
        u.a = swapped ? wt : at; u.b = swapped ? at : wt; u.aux = 0; return true;
    }
};
struct InprojEpi {
    int l; bf16_t *hyt, *ftl, *ftc, *q, *qc, *k, *vt, *g; const float *gq, *gk, *rope;
    __device__ __forceinline__ bool operator()(Acc& acc, const Unit& u, int wr, int wc, int fr, int fq) const {
        const int pm = u.pm, pn = u.pn;
        if (u.kind == 0 || u.kind == 1 || u.kind == 3) {
            const bool lat = pm < NTL; const int b = lat ? pm >> 3 : pm - NTL;
#pragma unroll
            for (int bj = 0; bj < 2; ++bj) {
                const int tl = 128 * bj + 32 * wc + 8 * fq;
                bf16_t* base; size_t rstride;
                if (u.kind == 0) { base = hyt + (size_t)(pn * 256) * NTOK + (size_t)pm * 256 + tl; rstride = NTOK; }
                else if (u.kind == 1) { const int part = pn - 3;
                    if (lat) { base = ftl + (size_t)b * 256 * 4096 + part * 2048 + (pm & 7) * 256 + tl; rstride = 4096; }
                    else { base = ftc + (size_t)b * 256 * 512 + part * 256 + tl; rstride = 512; } }
                else { base = vt + ((size_t)b * 512 + (pn - 9) * 256) * KALL + (lat ? (pm & 7) * 256 : SEQ) + tl; rstride = KALL; }
#pragma unroll
                for (int ai = 0; ai < 2; ++ai)
#pragma unroll
                    for (int m = 0; m < 4; ++m) { const int r = 128 * ai + 64 * wr + 16 * m + fr; const f32x4 v0 = acc[ai][bj][m][0], v1 = acc[ai][bj][m][1];
                        u32x4 w; w.x = cvt_pk_bf16(v0[0], v0[1]); w.y = cvt_pk_bf16(v0[2], v0[3]); w.z = cvt_pk_bf16(v1[0], v1[1]); w.w = cvt_pk_bf16(v1[2], v1[3]);
                        *(u32x4*)(base + (size_t)r * rstride) = w; }
            }
        } else if (u.kind == 4) {
#pragma unroll
            for (int ai = 0; ai < 2; ++ai)
#pragma unroll
                for (int m = 0; m < 4; ++m) { const int t = pm * 256 + 128 * ai + 64 * wr + 16 * m + fr;
#pragma unroll
                    for (int bj = 0; bj < 2; ++bj) { const int cg = (pn - 11) * 256 + 128 * bj + 32 * wc + 8 * fq; f32x4 v0 = acc[ai][bj][m][0], v1 = acc[ai][bj][m][1];
#pragma unroll
                        for (int j = 0; j < 4; ++j) { v0[j] = __builtin_amdgcn_rcpf(1.f + __builtin_amdgcn_exp2f(-1.4426950408889634f * v0[j])); v1[j] = __builtin_amdgcn_rcpf(1.f + __builtin_amdgcn_exp2f(-1.4426950408889634f * v1[j])); }
                        u32x4 w; w.x = cvt_pk_bf16(v0[0], v0[1]); w.y = cvt_pk_bf16(v0[2], v0[3]); w.z = cvt_pk_bf16(v1[0], v1[1]); w.w = cvt_pk_bf16(v1[2], v1[3]);
                        *(u32x4*)(g + (size_t)t * 3072 + cg) = w; } }
        } else {
            const int which = (pn - 5) >> 1, grp = ((pn - 5) & 1) * 4 + wc, h = grp >> 1, map = grp & 1;
            const int d0 = 32 * (fq >> 1) + 8 * (fq & 1);
            const float* gp = (which ? gk : gq) + map * 64 + d0;
            const f32x4 g00 = *(const f32x4*)(gp), g01 = *(const f32x4*)(gp + 4), g10 = *(const f32x4*)(gp + 16), g11 = *(const f32x4*)(gp + 20);
            const bool lat = pm < NTL; const int b = lat ? pm >> 3 : pm - NTL;
#pragma unroll
            for (int ai = 0; ai < 2; ++ai)
#pragma unroll
                for (int m = 0; m < 4; ++m) {
                    const int rl = 128 * ai + 64 * wr + 16 * m + fr;
                    f32x4 a0 = acc[ai][0][m][0], a1 = acc[ai][0][m][1], b0 = acc[ai][1][m][0], b1 = acc[ai][1][m][1];
                    float ss = 0.f;
#pragma unroll
                    for (int j = 0; j < 4; ++j) ss += a0[j] * a0[j] + a1[j] * a1[j] + b0[j] * b0[j] + b1[j] * b1[j];
                    ss += __shfl_xor(ss, 16); ss += __shfl_xor(ss, 32);
                    const float rs = rsqrtf(ss * (1.f / 64.f) + EPS);
                    a0 = a0 * rs * g00; a1 = a1 * rs * g01; b0 = b0 * rs * g10; b1 = b1 * rs * g11;
                    bf16_t* dst;
                    if (lat) { const int pos = (pm & 7) * 256 + rl; const int pa = (fq >> 1) ? (pos & 63) : (pos >> 6);
                        const float* rp = rope + ((size_t)pa * 16 + 8 * (fq & 1)) * 2;
                        const f32x4 r0 = *(const f32x4*)(rp), r1 = *(const f32x4*)(rp + 4), r2 = *(const f32x4*)(rp + 8), r3 = *(const f32x4*)(rp + 12);
                        const float cs[8] = {r0[0], r0[2], r1[0], r1[2], r2[0], r2[2], r3[0], r3[2]}, sn[8] = {r0[1], r0[3], r1[1], r1[3], r2[1], r2[3], r3[1], r3[3]};
#pragma unroll
                        for (int j = 0; j < 4; ++j) { const float x1 = a0[j], x2 = b0[j]; a0[j] = x1 * cs[j] - x2 * sn[j]; b0[j] = x2 * cs[j] + x1 * sn[j];
                            const float y1 = a1[j], y2 = b1[j]; a1[j] = y1 * cs[4 + j] - y2 * sn[4 + j]; b1[j] = y2 * cs[4 + j] + y1 * sn[4 + j]; }
                        dst = which ? k + (((size_t)(b * 4 + h) * 2 + map) * KALL + pos) * 64 : q + (((size_t)(b * 4 + h) * 2 + map) * SEQ + pos) * 64;
                    } else dst = which ? k + (((size_t)(b * 4 + h) * 2 + map) * KALL + SEQ + rl) * 64 : qc + (((size_t)(b * 4 + h) * 2 + map) * CTX + rl) * 64;
                    u32x4 w0, w1; w0.x = cvt_pk_bf16(a0[0], a0[1]); w0.y = cvt_pk_bf16(a0[2], a0[3]); w0.z = cvt_pk_bf16(a1[0], a1[1]); w0.w = cvt_pk_bf16(a1[2], a1[3]);
                    w1.x = cvt_pk_bf16(b0[0], b0[1]); w1.y = cvt_pk_bf16(b0[2], b0[3]); w1.z = cvt_pk_bf16(b1[0], b1[1]); w1.w = cvt_pk_bf16(b1[2], b1[3]);
                    *(u32x4*)(dst + d0) = w0; *(u32x4*)(dst + d0 + 16) = w1;
                }
        }
        return true;
    }
};
__device__ __forceinline__ void phase_inproj(AP A, FK_LAS unsigned char* lds, int l, int G) {
    InprojSched S{l, G, (int)blockIdx.x, (const char*)wsp<bf16_t>(A, W.xn), (const char*)(wsp<bf16_t>(A, W.w_in) + (size_t)l * PINF * 1024)};
    InprojEpi E{l, wsp<bf16_t>(A, W.hyt), wsp<bf16_t>(A, W.ftl), wsp<bf16_t>(A, W.ftc), wsp<bf16_t>(A, W.q), wsp<bf16_t>(A, W.qc), wsp<bf16_t>(A, W.k), wsp<bf16_t>(A, W.vt), wsp<bf16_t>(A, W.g),
                FIN(18) + l * 128, FIN(19) + l * 128, wsp<float>(A, W.misc) + MI_ROPE};
    gemm_phase(lds, 1024, S, E);
}
#define FK_HAVE_MIX 1
namespace attn {
constexpr float SCALE = 0.125f, THR = 8.f;
constexpr int KVBLK = 64;
constexpr int SHM_V = 128 * 64 * 2, SHM_K = 64 * 64 * 2;
constexpr int OFF_V = 0, OFF_K = 2 * SHM_V, OFF_WS = 2 * SHM_V + 2 * SHM_K;
#define ASWZ(row, cb) ((row) * 128 + ((cb) ^ ((((row) >> 1) & 7) << 4)))
#define SBAR() __builtin_amdgcn_sched_barrier(0)
__device__ __forceinline__ int crow(int r, int hi) { return (r & 3) + 8 * (r >> 2) + 4 * hi; }
__device__ __forceinline__ void partialSM(f32x16& p0, f32x16& p1, float& m_reg, float& mn, float& alpha) {
    constexpr float C = SCALE * 1.4426950408889634f;
    float pmax = p0[0];
#pragma unroll
    for (int r = 1; r < 16; ++r) pmax = fmaxf(pmax, p0[r]);
#pragma unroll
    for (int r = 0; r < 16; ++r) pmax = fmaxf(pmax, p1[r]);
    { auto rr = __builtin_amdgcn_permlane32_swap(__float_as_uint(pmax), __float_as_uint(pmax), false, false);
      pmax = fmaxf(__uint_as_float(rr[0]), __uint_as_float(rr[1])); }
    if (__builtin_expect(__all(pmax - m_reg <= THR / SCALE), 1)) { mn = m_reg; alpha = 1.f; }
    else { mn = fmaxf(m_reg, pmax); alpha = __builtin_amdgcn_exp2f((m_reg - mn) * C); m_reg = mn; }
    const float mnC = -mn * C;
#pragma unroll
    for (int r = 0; r < 16; ++r) p0[r] = fmaf(p0[r], C, mnC);
#pragma unroll
    for (int r = 0; r < 16; ++r) p1[r] = fmaf(p1[r], C, mnC);
#pragma unroll
    for (int r = 0; r < 16; ++r) p0[r] = __builtin_amdgcn_exp2f(p0[r]);
}
__device__ __forceinline__ void finishSM(f32x16& p0, f32x16& p1, float alpha, float& l_reg, bf16x8& pa0, bf16x8& pa1, bf16x8& pa2, bf16x8& pa3) {
#pragma unroll
    for (int r = 0; r < 16; ++r) p1[r] = __builtin_amdgcn_exp2f(p1[r]);
    float ps = 0;
#pragma unroll
    for (int r = 0; r < 16; ++r) ps += p0[r];
#pragma unroll
    for (int r = 0; r < 16; ++r) ps += p1[r];
    { auto rr = __builtin_amdgcn_permlane32_swap(__float_as_uint(ps), __float_as_uint(ps), false, false);
      ps = __uint_as_float(rr[0]) + __uint_as_float(rr[1]); }
    l_reg = l_reg * alpha + ps;
#define PK4(P, BASE, OUT) do { unsigned a0 = cvt_pk_bf16(P[BASE + 0], P[BASE + 1]), a1 = cvt_pk_bf16(P[BASE + 2], P[BASE + 3]);   \
    unsigned b0 = cvt_pk_bf16(P[BASE + 4], P[BASE + 5]), b1 = cvt_pk_bf16(P[BASE + 6], P[BASE + 7]);                              \
    auto r0 = __builtin_amdgcn_permlane32_swap(a0, b0, false, false); auto r1 = __builtin_amdgcn_permlane32_swap(a1, b1, false, false); \
    u32x4 w = {r0[0], r1[0], r0[1], r1[1]}; OUT = *reinterpret_cast<bf16x8*>(&w); } while (0)
    PK4(p0, 0, pa0); PK4(p0, 8, pa1); PK4(p1, 0, pa2); PK4(p1, 8, pa3);
#undef PK4
}
__device__ __forceinline__ void qkt(f32x16& p0, f32x16& p1, const FK_LAS char* Ks, const bf16x8* qr, int r32, int hi) {
    p0 = f32x16{}; p1 = f32x16{};
#pragma unroll
    for (int d0 = 0; d0 < 4; ++d0) { const int cb = d0 * 32 + hi * 16;
        const bf16x8 b0 = *(const FK_LAS bf16x8*)(Ks + ASWZ(r32, cb));
        const bf16x8 b1 = *(const FK_LAS bf16x8*)(Ks + ASWZ(32 + r32, cb));
        __builtin_amdgcn_s_setprio(1);
        p0 = __builtin_amdgcn_mfma_f32_32x32x16_bf16(b0, qr[d0], p0, 0, 0, 0);
        p1 = __builtin_amdgcn_mfma_f32_32x32x16_bf16(b1, qr[d0], p1, 0, 0, 0);
        __builtin_amdgcn_s_setprio(0); }
}
__device__ __forceinline__ void pv(f32x16* o, const FK_LAS char* Vs, int r32, int hi, bf16x8 pa0, bf16x8 pa1, bf16x8 pa2, bf16x8 pa3) {
#pragma unroll
    for (int d0 = 0; d0 < 4; ++d0) { const int row = 32 * d0 + r32;
        const bf16x8 v0 = *(const FK_LAS bf16x8*)(Vs + ASWZ(row, 0 * 32 + hi * 16)), v1 = *(const FK_LAS bf16x8*)(Vs + ASWZ(row, 1 * 32 + hi * 16));
        const bf16x8 v2 = *(const FK_LAS bf16x8*)(Vs + ASWZ(row, 2 * 32 + hi * 16)), v3 = *(const FK_LAS bf16x8*)(Vs + ASWZ(row, 3 * 32 + hi * 16));
        __builtin_amdgcn_s_setprio(1);
        o[d0] = __builtin_amdgcn_mfma_f32_32x32x16_bf16(pa0, v0, o[d0], 0, 0, 0);
        o[d0] = __builtin_amdgcn_mfma_f32_32x32x16_bf16(pa1, v1, o[d0], 0, 0, 0);
        o[d0] = __builtin_amdgcn_mfma_f32_32x32x16_bf16(pa2, v2, o[d0], 0, 0, 0);
        o[d0] = __builtin_amdgcn_mfma_f32_32x32x16_bf16(pa3, v3, o[d0], 0, 0, 0);
        __builtin_amdgcn_s_setprio(0); }
}
__device__ __forceinline__ void body(const bf16_t* __restrict__ Qb, const bf16_t* __restrict__ Kh, const bf16_t* __restrict__ VTh, int ldv, int seq, FK_LAS char* lds, f32x16* o, const int tid) {
    const int wid = tid >> 6, lane = tid & 63, r32 = lane & 31, hi = lane >> 5;
    FK_LAS char* V_lds = lds + OFF_V; FK_LAS char* K_lds = lds + OFF_K;
    FK_LAS float* wsf = (FK_LAS float*)(lds + OFF_WS) + wid * 64; FK_LAS float* li_l = wsf; FK_LAS float* al_l = wsf + 32;
    float m_reg = -1e30f, l_reg = 0;
#pragma unroll
    for (int d = 0; d < 4; ++d) o[d] = f32x16{};
    bf16x8 qr[4];
    const bf16_t* Qw = Qb + (size_t)(wid * 32 + r32) * 64 + hi * 8;
#pragma unroll
    for (int d0 = 0; d0 < 4; ++d0) qr[d0] = *(const bf16x8*)(Qw + d0 * 16);
    const int ksr = tid >> 3, kch = tid & 7;
    const int kst = ASWZ(ksr, kch * 16);
    const int vd0 = tid >> 3, vd1 = 64 + (tid >> 3);
    const int vst0 = ASWZ(vd0, kch * 16), vst1 = ASWZ(vd1, kch * 16);
    struct { bf16x8 vs0, vs1, ks; } sr_[2];
#define SLOAD(i, k0) do { sr_[i].vs0 = *(const bf16x8*)(VTh + (size_t)vd0 * ldv + (k0) + kch * 8); sr_[i].vs1 = *(const bf16x8*)(VTh + (size_t)vd1 * ldv + (k0) + kch * 8); \
    sr_[i].ks = *(const bf16x8*)(Kh + (size_t)((k0) + ksr) * 64 + kch * 8); } while (0)
#define SWRITE(b, i) do { *(FK_LAS bf16x8*)(V_lds + (b) * SHM_V + vst0) = sr_[i].vs0; *(FK_LAS bf16x8*)(V_lds + (b) * SHM_V + vst1) = sr_[i].vs1; \
    *(FK_LAS bf16x8*)(K_lds + (b) * SHM_K + kst) = sr_[i].ks; } while (0)
#define SWAIT() asm volatile("s_waitcnt vmcnt(3)" ::: "memory")
#define RESC(a) do { if (__any((a) < 1.f)) { if (hi == 0) al_l[r32] = (a); asm volatile("s_waitcnt lgkmcnt(0)" ::: "memory"); \
    _Pragma("unroll") for (int d = 0; d < 4; ++d) _Pragma("unroll") for (int r = 0; r < 16; ++r) o[d][r] *= al_l[crow(r, hi)]; } } while (0)
    f32x16 pA0, pA1, pB0, pB1; float mnA, mnB, alA, alB; bf16x8 pa0, pa1, pa2, pa3; const int NT = seq / KVBLK;
    SLOAD(0, 0); asm volatile("s_waitcnt vmcnt(0)" ::: "memory"); SWRITE(0, 0); __syncthreads();
    qkt(pA0, pA1, K_lds, qr, r32, hi); partialSM(pA0, pA1, m_reg, mnA, alA);
    SLOAD(1, KVBLK); if (2 < NT) SLOAD(0, 2 * KVBLK);
    if (2 < NT) SWAIT(); else asm volatile("s_waitcnt vmcnt(0)" ::: "memory");
    SWRITE(1, 1); __syncthreads();
    for (int j = 1; j + 1 < NT; j += 2) {
        SBAR(); qkt(pB0, pB1, K_lds + SHM_K, qr, r32, hi);
        finishSM(pA0, pA1, alA, l_reg, pa0, pa1, pa2, pa3); SBAR();
        SLOAD(1, (j + 2) * KVBLK); SBAR();
        pv(o, V_lds, r32, hi, pa0, pa1, pa2, pa3); partialSM(pB0, pB1, m_reg, mnB, alB);
        __syncthreads(); SWAIT(); SWRITE(0, 0);
        RESC(alB); __syncthreads();
        SBAR(); qkt(pA0, pA1, K_lds, qr, r32, hi);
        finishSM(pB0, pB1, alB, l_reg, pa0, pa1, pa2, pa3); SBAR();
        const bool more = (j + 3 < NT);
        if (more) SLOAD(0, (j + 3) * KVBLK);
        SBAR();
        pv(o, V_lds + SHM_V, r32, hi, pa0, pa1, pa2, pa3); partialSM(pA0, pA1, m_reg, mnA, alA);
        __syncthreads(); if (more) SWAIT(); else asm volatile("s_waitcnt vmcnt(0)" ::: "memory");
        SWRITE(1, 1);
        RESC(alA); __syncthreads();
    }
    SBAR(); qkt(pB0, pB1, K_lds + SHM_K, qr, r32, hi);
    finishSM(pA0, pA1, alA, l_reg, pa0, pa1, pa2, pa3); SBAR();
    pv(o, V_lds, r32, hi, pa0, pa1, pa2, pa3); partialSM(pB0, pB1, m_reg, mnB, alB);
    __syncthreads(); RESC(alB);
    finishSM(pB0, pB1, alB, l_reg, pa0, pa1, pa2, pa3); SBAR();
    pv(o, V_lds + SHM_V, r32, hi, pa0, pa1, pa2, pa3);
    if (hi == 0) li_l[r32] = l_reg; asm volatile("s_waitcnt lgkmcnt(0)" ::: "memory");
#pragma unroll
    for (int r = 0; r < 16; ++r) { const float rl = __builtin_amdgcn_rcpf(li_l[crow(r, hi)]);
#pragma unroll
        for (int d = 0; d < 4; ++d) o[d][r] *= rl; }
    __syncthreads();
#undef SLOAD
#undef SWRITE
#undef SWAIT
#undef RESC
}
__device__ __forceinline__ void unit(AP A, FK_LAS char* lds, int l, int b, int h, int qb  ) {
    const int tid = opaque_tid(), wid = tid >> 6, lane = tid & 63, r32 = lane & 31, hi = lane >> 5;
    const bool ctx = qb == 8;
    float* stash = wsp<float>(A, W.stash) + (size_t)blockIdx.x * 128 * 512;
#pragma unroll 1
    for (int map = 0; map < 2; ++map) {
        const size_t hm = (size_t)(b * 4 + h) * 2 + map;
        const bf16_t* Qb = ctx ? wsp<bf16_t>(A, W.qc) + hm * CTX * 64 : wsp<bf16_t>(A, W.q) + (hm * SEQ + (size_t)qb * 256) * 64;
        const bf16_t* Kh = wsp<bf16_t>(A, W.k) + (hm * KALL + (ctx ? SEQ : 0)) * 64;
        const bf16_t* VTh = wsp<bf16_t>(A, W.vt) + (size_t)(b * 4 + h) * 128 * KALL + (ctx ? SEQ : 0);
        f32x16 om[4];
        body(Qb, Kh, VTh, KALL, ctx ? CTX : KALL, lds, om, tid);
#pragma unroll
        for (int d = 0; d < 4; ++d)
#pragma unroll
            for (int r = 0; r < 16; ++r) stash[(size_t)((map * 4 + d) * 16 + r) * 512 + tid] = om[d][r];
    }
    const float lam = wsp<float>(A, W.misc)[MI_LAM + l], post = 1.f - (0.8f - 0.6f * __expf(-0.3f * (float)l));
    f32x16 o[4];
    float ss[16];
#pragma unroll
    for (int r = 0; r < 16; ++r) ss[r] = 0.f;
#pragma unroll
    for (int d = 0; d < 4; ++d)
#pragma unroll
        for (int r = 0; r < 16; ++r) { const float v = stash[(size_t)(d * 16 + r) * 512 + tid] - lam * stash[(size_t)((4 + d) * 16 + r) * 512 + tid]; o[d][r] = v; ss[r] += v * v; }
#pragma unroll
    for (int r = 0; r < 16; ++r) {
#pragma unroll
        for (int s = 1; s < 32; s <<= 1) ss[r] += __shfl_xor(ss[r], s);
        ss[r] = rsqrtf(ss[r] * (1.f / 128.f) + EPS) * post; }
    bf16_t* att = (h < 2) ? wsp<bf16_t>(A, W.attlo) : wsp<bf16_t>(A, W.atthi);
    const size_t t0 = ctx ? (size_t)NLAT + b * CTX : (size_t)b * SEQ + qb * 256;
#pragma unroll
    for (int d = 0; d < 4; ++d) { const float gs = FIN(21)[l * 128 + 32 * d + r32];
#pragma unroll
        for (int r = 0; r < 16; ++r) att[(t0 + wid * 32 + crow(r, hi)) * 256 + (h & 1) * 128 + 32 * d + r32] = (bf16_t)f2bf(o[d][r] * ss[r] * gs); }
}
#undef ASWZ
#undef SBAR
}

namespace hy {
template <int L, int NBH> struct Geo {
    static constexpr int NBLK = L / 32, IB = 32 / NBH, NG = NBLK / IB, GPW = (NG >= 8) ? NG / 8 : 1, AW = NG / GPW;
    static constexpr int PADB = IB * GPW - 1, RL = (NBLK + 2 * PADB) * 32, ZRS = RL * 2 + 16;
    static constexpr int TLn = (L == 2048) ? TLL : TLC, TCS = TLn * 2 + ((L == 2048) ? 32 : 160);
    static constexpr int OFF_Z = 0, OFF_G = NBH * ZRS, OFF_T = 2 * NBH * ZRS, END = OFF_T + 8 * TCS;
};
__device__ __forceinline__ int crow(int r, int hi) { return (r & 3) + 8 * (r >> 2) + 4 * hi; }
template <int L, int NBH>
__device__ __forceinline__ void unit(AP A, FK_LAS char* lds, int l, int ch, int boff) {
    using Gm = Geo<L, NBH>;
    static_assert(Gm::END <= LDS_MISC, "hyena LDS");
    const int tid = opaque_tid(), wid = __builtin_amdgcn_readfirstlane(tid >> 6), lane = tid & 63, r32 = lane & 31, hi = lane >> 5;
    const bf16_t* hyt = wsp<bf16_t>(A, W.hyt);
    const float* cw = FIN(9) + l * 3 * 768; const float* cb = FIN(10) + l * 768;
    const int tbl = tid / (L / 32), tb = boff + tbl, tp0 = (tid % (L / 32)) * 32; const bool ld_act = tid < NBH * (L / 32);
    unsigned x2p[16];
    __syncthreads();
    for (int i = tid; i < 2 * NBH * Gm::ZRS / 16; i += NTHR) *(FK_LAS u32x4*)(lds + i * 16) = (u32x4){0u, 0u, 0u, 0u};
    __syncthreads();
    if (ld_act) {
#pragma unroll
        for (int sel = 0; sel < 3; ++sel) {
            const int row = sel * 256 + ch; const float w0 = cw[row], w1 = cw[768 + row], w2 = cw[1536 + row], bs = cb[row];
            float vals[34];
            if (tb < NB) {
                const size_t tok0 = (L == 2048) ? (size_t)tb * SEQ + tp0 : (size_t)NLAT + tb * CTX + tp0;
                const bf16_t* src = hyt + (size_t)row * NTOK + tok0;
#pragma unroll
                for (int q = 0; q < 4; ++q) { const u32x4 w = *(const u32x4*)(src + q * 8);
                    vals[1 + q * 8 + 0] = bflo(w.x); vals[1 + q * 8 + 1] = bfhi(w.x); vals[1 + q * 8 + 2] = bflo(w.y); vals[1 + q * 8 + 3] = bfhi(w.y);
                    vals[1 + q * 8 + 4] = bflo(w.z); vals[1 + q * 8 + 5] = bfhi(w.z); vals[1 + q * 8 + 6] = bflo(w.w); vals[1 + q * 8 + 7] = bfhi(w.w); }
                vals[0] = tp0 > 0 ? bf2f(src[-1]) : 0.f; vals[33] = tp0 + 32 < L ? bf2f(src[32]) : 0.f;
            } else {
#pragma unroll
                for (int i = 0; i < 34; ++i) vals[i] = 0.f;
            }
            unsigned pk[16];
#pragma unroll
            for (int i = 0; i < 16; ++i) { const float a = tb < NB ? vals[2 * i] * w0 + vals[2 * i + 1] * w1 + vals[2 * i + 2] * w2 + bs : 0.f, b2 = tb < NB ? vals[2 * i + 1] * w0 + vals[2 * i + 2] * w1 + vals[2 * i + 3] * w2 + bs : 0.f;
                pk[i] = cvt_pk_bf16(a, b2); }
            if (sel < 2) { FK_LAS char* dst = lds + (sel == 0 ? Gm::OFF_Z : Gm::OFF_G) + tbl * Gm::ZRS + (Gm::PADB * 32 + tp0) * 2;
#pragma unroll
                for (int q = 0; q < 4; ++q) *(FK_LAS u32x4*)(dst + q * 16) = (u32x4){pk[4 * q], pk[4 * q + 1], pk[4 * q + 2], pk[4 * q + 3]}; }
            else {
#pragma unroll
                for (int i = 0; i < 16; ++i) x2p[i] = pk[i]; }
        }
    }
    const int G0 = wid * Gm::GPW; const bool act = wid < Gm::AW;
    const int dlo = Gm::IB * G0 - (Gm::NBLK - 1), dhi = Gm::IB * (G0 + Gm::GPW) - 1;
    const int il = r32 & (Gm::IB - 1), bb = r32 / Gm::IB;
    for (int o = 0; o < 2; ++o) {
        { const bf16_t* TL = (L == 2048 ? wsp<bf16_t>(A, W.tapl) + ((size_t)l * 512 + o * 256 + ch) * TLL : wsp<bf16_t>(A, W.tapc) + ((size_t)l * 512 + o * 256 + ch) * TLC);
          constexpr int NC = Gm::TLn / 8;
          for (int i = tid; i < NC; i += NTHR) *(FK_LAS u32x4*)(lds + Gm::OFF_T + i * 16) = *(const u32x4*)(TL + i * 8);
          __syncthreads();
          for (int i = tid; i < 7 * NC; i += NTHR) { const int sft = 1 + i / NC, c = i % NC;
              const FK_LAS unsigned* src = (const FK_LAS unsigned*)(lds + Gm::OFF_T + c * 16 + 4 * (sft >> 1)); const unsigned sh = 16u * (unsigned)(sft & 1);
              const bool tail = (c == NC - 1);
              unsigned w0 = src[0], w1 = tail && (1 + (sft >> 1)) >= 4 ? 0u : src[1], w2 = tail && (2 + (sft >> 1)) >= 4 ? 0u : src[2], w3 = tail && (3 + (sft >> 1)) >= 4 ? 0u : src[3], w4 = tail ? 0u : src[4];
              u32x4 ov; ov.x = __builtin_amdgcn_alignbit(w1, w0, sh); ov.y = __builtin_amdgcn_alignbit(w2, w1, sh); ov.z = __builtin_amdgcn_alignbit(w3, w2, sh); ov.w = __builtin_amdgcn_alignbit(w4, w3, sh);
              *(FK_LAS u32x4*)(lds + Gm::OFF_T + sft * Gm::TCS + c * 16) = ov; } }
        __syncthreads();
        f32x16 acc[Gm::GPW];
#pragma unroll
        for (int g = 0; g < Gm::GPW; ++g) acc[g] = f32x16{};
        if (act) {
            const int c0 = (L + 32) - r32 + 8 * hi, sc = c0 & 7;
            int pa = Gm::OFF_T + sc * Gm::TCS + (c0 - sc - 32 * dlo) * 2;
            int pb = Gm::OFF_Z + bb * Gm::ZRS + ((Gm::PADB + Gm::IB * G0 + il - dlo) * 32 + 8 * hi) * 2;
#define HY_LOAD(A0, A1, B0, B1) do { A0 = *(const FK_LAS bf16x8*)(lds + pa); A1 = *(const FK_LAS bf16x8*)(lds + pa + 32); \
                _Pragma("unroll") for (int g = 0; g < Gm::GPW; ++g) { B0[g] = *(const FK_LAS bf16x8*)(lds + pb + g * Gm::IB * 64); B1[g] = *(const FK_LAS bf16x8*)(lds + pb + g * Gm::IB * 64 + 32); } \
                pa -= 64; pb -= 64; } while (0)
#define HY_MMA(A0, A1, B0, B1) do { _Pragma("unroll") for (int g = 0; g < Gm::GPW; ++g) { acc[g] = __builtin_amdgcn_mfma_f32_32x32x16_bf16(A0, B0[g], acc[g], 0, 0, 0); \
                acc[g] = __builtin_amdgcn_mfma_f32_32x32x16_bf16(A1, B1[g], acc[g], 0, 0, 0); } } while (0)
            bf16x8 xa0, xa1, ya0, ya1, xb0[Gm::GPW], xb1[Gm::GPW], yb0[Gm::GPW], yb1[Gm::GPW];
            const int nd = dhi - dlo + 1;
            HY_LOAD(xa0, xa1, xb0, xb1);
            int d = 0;
#pragma unroll 1
            for (; d + 2 <= nd - 1; d += 2) {
                HY_LOAD(ya0, ya1, yb0, yb1);
                HY_MMA(xa0, xa1, xb0, xb1);
                HY_LOAD(xa0, xa1, xb0, xb1);
                HY_MMA(ya0, ya1, yb0, yb1);
            }
            if (d + 1 <= nd - 1) { HY_LOAD(ya0, ya1, yb0, yb1); HY_MMA(xa0, xa1, xb0, xb1); HY_MMA(ya0, ya1, yb0, yb1); }
            else HY_MMA(xa0, xa1, xb0, xb1);
#undef HY_LOAD
#undef HY_MMA
        }
        __syncthreads();
        const float bias = FIN(17)[l * 512 + o * 256 + ch];
        if (act) {
#pragma unroll
            for (int g = 0; g < Gm::GPW; ++g)
#pragma unroll
                for (int r = 0; r < 16; ++r) { const int pos = 32 * (Gm::IB * (G0 + g) + il) + crow(r, hi);
                    FK_LAS unsigned short* zp = (FK_LAS unsigned short*)(lds + Gm::OFF_Z + bb * Gm::ZRS + (Gm::PADB * 32 + pos) * 2);
                    const float gate = bf2f(*(FK_LAS unsigned short*)(lds + Gm::OFF_G + bb * Gm::ZRS + (Gm::PADB * 32 + pos) * 2));
                    const float zn = gate * (acc[g][r] + bias * bf2f(*zp));
                    *zp = (unsigned short)f2bf(zn); }
        }
        __syncthreads();
        if (o == 0 && ld_act) { FK_LAS char* dst = lds + Gm::OFF_G + tbl * Gm::ZRS + (Gm::PADB * 32 + tp0) * 2;
#pragma unroll
            for (int q = 0; q < 4; ++q) *(FK_LAS u32x4*)(dst + q * 16) = (u32x4){x2p[4 * q], x2p[4 * q + 1], x2p[4 * q + 2], x2p[4 * q + 3]}; }
    }
    __syncthreads();
    if (ld_act && tb < NB) { const size_t tok0 = (L == 2048) ? (size_t)tb * SEQ + tp0 : (size_t)NLAT + tb * CTX + tp0;
        bf16_t* dst = wsp<bf16_t>(A, W.hyo) + (size_t)ch * NTOK + tok0; const FK_LAS char* srcz = lds + Gm::OFF_Z + tbl * Gm::ZRS + (Gm::PADB * 32 + tp0) * 2;
#pragma unroll
        for (int q = 0; q < 4; ++q) *(u32x4*)(dst + q * 8) = *(const FK_LAS u32x4*)(srcz + q * 16); }
    __syncthreads();
}
}

struct FnSched {
    int G, c, big; const char* dft; const char* ft;
    __device__ bool next(int i, Unit& u) const {
        const long Li = (long)i * G + (G - 1 - c);
        const int n = big ? NB * 8 : NB; if (Li >= n) return false;
        const int b = big ? (int)Li >> 3 : (int)Li, mt = big ? (int)Li & 7 : 0;
        u.pm = mt; u.pn = b; u.kind = big; u.aux = 0;
        u.a = dft + (size_t)mt * 256 * (big ? 4096 : 512) * 2; u.b = ft + (size_t)b * 256 * (big ? 4096 : 512) * 2; return true;
    }
};
struct FnEpi {
    bf16_t* fno;
    __device__ __forceinline__ bool operator()(Acc& acc, const Unit& u, int wr, int wc, int fr, int fq) const {
        const size_t t0 = u.kind ? (size_t)u.pn * SEQ + u.pm * 256 : (size_t)NLAT + u.pn * CTX;
#pragma unroll
        for (int ai = 0; ai < 2; ++ai)
#pragma unroll
            for (int m = 0; m < 4; ++m) { bf16_t* rowp = fno + (t0 + 128 * ai + 64 * wr + 16 * m + fr) * 256 + 32 * wc + 8 * fq;
#pragma unroll
                for (int bj = 0; bj < 2; ++bj) { const f32x4 v0 = acc[ai][bj][m][0], v1 = acc[ai][bj][m][1];
                    u32x4 w; w.x = cvt_pk_bf16(v0[0], v0[1]); w.y = cvt_pk_bf16(v0[2], v0[3]); w.z = cvt_pk_bf16(v1[0], v1[1]); w.w = cvt_pk_bf16(v1[2], v1[3]);
                    *(u32x4*)(rowp + 128 * bj) = w; } }
        return true;
    }
};

__device__ __forceinline__ void phase_mix(AP A, FK_LAS unsigned char* lds, int l, int vcu, int G) {
    const int n_lat = NB * 32, n_all = n_lat + (l == 0 ? NB * 4 : 0);
#ifndef FK_REP_SUB
#define FK_REP_SUB 0
#endif
#ifndef FK_NO_ATTN
    for (int rp = (FK_REP_SUB == 1 ? 1 : 0); rp >= 0; --rp)
    for (int u = vcu; u < n_all; u += G) {
        if (u < n_lat) attn::unit(A, (FK_LAS char*)lds, l, u >> 5, (u >> 3) & 3, u & 7);
        else { const int v = u - n_lat; attn::unit(A, (FK_LAS char*)lds, l, v >> 2, v & 3, 8); }
    }
#endif
#ifndef FK_NO_HY
    for (int rp = (FK_REP_SUB == 2 ? 1 : 0); rp >= 0; --rp)
    if (G == 256) { if (vcu < 192) hy::unit<2048, 8>(A, (FK_LAS char*)lds, l, vcu, 0); if (vcu >= 64 && vcu < 128) hy::unit<2048, 8>(A, (FK_LAS char*)lds, l, vcu + 128, 0); }
    else for (int ch = vcu; ch < 256; ch += G) hy::unit<2048, 8>(A, (FK_LAS char*)lds, l, ch, 0);
    if (l == 0) for (int ch = vcu; ch < 256; ch += G) hy::unit<256, 8>(A, (FK_LAS char*)lds, l, ch, 0);
#endif
#ifndef FK_NO_FN
    for (int rp = (FK_REP_SUB == 3 ? 1 : 0); rp >= 0; --rp)
    { FnSched S{G, vcu, 1, (const char*)wsp<bf16_t>(A, W.dftl), (const char*)wsp<bf16_t>(A, W.ftl)}; FnEpi E{wsp<bf16_t>(A, W.fno)}; gemm_phase(lds, 4096, S, E); }
    if (l == 0) { FnSched S{G, vcu, 0, (const char*)wsp<bf16_t>(A, W.dftc), (const char*)wsp<bf16_t>(A, W.ftc)}; FnEpi E{wsp<bf16_t>(A, W.fno)}; gemm_phase(lds, 512, S, E); }
#endif
}
#define FK_HAVE_MERGE 1
#define FK_HAVE_OUT 1
#define FK_HAVE_NORM 1
#define FK_HAVE_PQ 1
struct MergeSched {
    int G, c, ntile; const char *a0, *a1, *a2, *a3; const char* w;
    __device__ bool next(int i, Unit& u) const {
        const int j = i >> 2, s = i & 3; const long T = (long)j * G + c; if (T >= ntile) return false;
        u.pm = (int)(T >> 2); u.pn = (int)(T & 3); u.kind = s; u.aux = 0;
        u.a = (s == 0) ? a0 + (size_t)(j * 256 + c) * 256 * 256 * 2 : (s == 1 ? a1 : s == 2 ? a2 : a3) + (size_t)u.pm * 256 * 256 * 2; u.b = w + ((size_t)s * 1024 + u.pn * 256) * 256 * 2; return true;
    }
};
struct MergeEpi {
    const bf16_t* g; bf16_t* y;
    __device__ __forceinline__ bool operator()(Acc& acc, const Unit& u, int wr, int wc, int fr, int fq) const {
        const int s = u.kind; if (s == 2) return false;
        const int gn = (s == 3 ? 2048 : s * 1024), gd = (s + 1) * 1024;
#pragma unroll
        for (int ai = 0; ai < 2; ++ai)
#pragma unroll
            for (int m = 0; m < 4; ++m) { const size_t t = (size_t)u.pm * 256 + 128 * ai + 64 * wr + 16 * m + fr;
#pragma unroll
                for (int bj = 0; bj < 2; ++bj) { const int c = u.pn * 256 + 128 * bj + 32 * wc + 8 * fq; const bf16_t* gp = g + t * 3072 + c;
#pragma unroll
                    for (int n = 0; n < 2; ++n) {
                        const u32x2 wn = *(const u32x2*)(gp + gn + 4 * n);
                        f32x4 f = {bflo(wn.x), bfhi(wn.x), bflo(wn.y), bfhi(wn.y)};
                        if (s != 3) { const u32x2 wd = *(const u32x2*)(gp + gd + 4 * n);
                            f[0] *= __builtin_amdgcn_rcpf(bflo(wd.x)); f[1] *= __builtin_amdgcn_rcpf(bfhi(wd.x)); f[2] *= __builtin_amdgcn_rcpf(bflo(wd.y)); f[3] *= __builtin_amdgcn_rcpf(bfhi(wd.y)); }
                        acc[ai][bj][m][n] = acc[ai][bj][m][n] * f; }
                    if (s == 3) { const f32x4 v0 = acc[ai][bj][m][0], v1 = acc[ai][bj][m][1];
                        u32x4 w; w.x = cvt_pk_bf16(v0[0], v0[1]); w.y = cvt_pk_bf16(v0[2], v0[3]); w.z = cvt_pk_bf16(v1[0], v1[1]); w.w = cvt_pk_bf16(v1[2], v1[3]); *(u32x4*)(y + t * 1024 + c) = w; } }
                if (m == 3) asm volatile("" ::: "memory"); }
        return s == 3;
    }
};
__device__ __forceinline__ void phase_merge(AP A, FK_LAS unsigned char* lds, int l, int G) {
    MergeSched S; S.G = G; S.c = (int)blockIdx.x; S.ntile = (l == 0 ? NTT : NTL) * 4;
    { const int tid = opaque_tid(); const bf16_t* hyot = wsp<bf16_t>(A, W.hyo); bf16_t* scr = wsp<bf16_t>(A, W.q);
      constexpr int RS = 516;
      for (int j = 0; (long)j * G + S.c < S.ntile; ++j) { const int pm = (int)(((long)j * G + S.c) >> 2); bf16_t* dst = scr + (size_t)(j * 256 + S.c) * 65536;
          for (int cq = 0; cq < 4; ++cq) {
              __syncthreads();
#pragma unroll
              for (int i = 0; i < 4; ++i) { const int idx = tid + 512 * i, chl = idx >> 5, t8 = (idx & 31) * 8;
                  const u32x4 v = *(const u32x4*)(hyot + (size_t)(cq * 64 + chl) * NTOK + (size_t)pm * 256 + t8);
                  FK_LAS unsigned* p = (FK_LAS unsigned*)(lds + chl * RS + t8 * 2); p[0] = v.x; p[1] = v.y; p[2] = v.z; p[3] = v.w; }
              __syncthreads();
#pragma unroll
              for (int i = 0; i < 4; ++i) { const int idx = tid + 512 * i, tok = idx >> 3, c8 = (idx & 7) * 8; unsigned short e[8];
#pragma unroll
                  for (int q = 0; q < 8; ++q) e[q] = *(const FK_LAS unsigned short*)(lds + (c8 + q) * RS + tok * 2);
                  *(u32x4*)(dst + (size_t)tok * 256 + cq * 64 + c8) = (u32x4){(unsigned)e[0] | ((unsigned)e[1] << 16), (unsigned)e[2] | ((unsigned)e[3] << 16), (unsigned)e[4] | ((unsigned)e[5] << 16), (unsigned)e[6] | ((unsigned)e[7] << 16)}; }
          } }
      asm volatile("s_waitcnt vmcnt(0)" ::: "memory"); __syncthreads(); }
    S.a0 = (const char*)wsp<bf16_t>(A, W.q); S.a1 = (const char*)wsp<bf16_t>(A, W.fno); S.a2 = (const char*)wsp<bf16_t>(A, W.attlo); S.a3 = (const char*)wsp<bf16_t>(A, W.atthi);
    S.w = (const char*)(wsp<bf16_t>(A, W.w_mrg) + (size_t)l * 4 * 1024 * 256);
    MergeEpi E{wsp<bf16_t>(A, W.g), wsp<bf16_t>(A, W.y)};
    gemm_phase(lds, 256, S, E);
}
struct PlainSched {
    int G, c, nM, nN, K; const char* a; const char* w;
    __device__ bool next(int i, Unit& u) const {
        const long T = (long)i * G + c; if (T >= (long)nM * nN) return false;
        int wgid = (int)T; const int nwg = nM * nN; { const int q = nwg / 8, r = nwg % 8, xcd = wgid % 8, off = wgid / 8; wgid = (xcd < r ? xcd * (q + 1) : r * (q + 1) + (xcd - r) * q) + off; }
        const int nig = 8 * nN, gid = wgid / nig, fm = gid * 8, gsz = (nM - fm) < 8 ? (nM - fm) : 8;
        u.pm = fm + ((wgid % nig) % gsz); u.pn = (wgid % nig) / gsz; u.kind = 0; u.aux = 0;
        u.a = a + (size_t)u.pm * 256 * K * 2; u.b = w + (size_t)u.pn * 256 * K * 2; return true;
    }
};
struct OutEpi {
    const float* x_in; const float* ctx_in; const float* xl; float* xc; const float* mod; int l; float* xo;
    __device__ __forceinline__ bool operator()(Acc& acc, const Unit& u, int wr, int wc, int fr, int fq) const {
        const bool lat = u.pm < NTL; const int mr = lat ? u.pm >> 3 : 8;
        const float* gate = mod + (size_t)mr * 6144 + 2 * 1024;
#pragma unroll
        for (int bj = 0; bj < 2; ++bj) { const int c = u.pn * 256 + 128 * bj + 32 * wc + 8 * fq;
            const f32x4 g0 = *(const f32x4*)(gate + c), g1 = *(const f32x4*)(gate + c + 4);
#pragma unroll
            for (int ai = 0; ai < 2; ++ai)
#pragma unroll
                for (int m = 0; m < 4; ++m) { const int rl = 128 * ai + 64 * wr + 16 * m + fr;
                    const size_t t = (size_t)u.pm * 256 + rl, tc = t - NLAT;
                    const float* bp = lat ? ((l == 0 ? x_in : xl) + t * 1024 + c) : (ctx_in + tc * 1024 + c);
                    float* op = lat ? (xo + t * 1024 + c) : (xc + tc * 1024 + c);
                    const f32x4 b0 = *(const f32x4*)bp, b1 = *(const f32x4*)(bp + 4);
                    *(f32x4*)op = b0 + g0 * acc[ai][bj][m][0]; *(f32x4*)(op + 4) = b1 + g1 * acc[ai][bj][m][1]; } }
        return true;
    }
};
__device__ __forceinline__ void phase_outproj(AP A, FK_LAS unsigned char* lds, int l, int G, int dry) {
    PlainSched S{G, (int)blockIdx.x, l == 0 ? NTT : NTL, 4, 1024, (const char*)wsp<bf16_t>(A, W.y), (const char*)(wsp<bf16_t>(A, W.w_out) + (size_t)l * 1024 * 1024)};
    OutEpi E{FIN(0), FIN(2), A->xl, wsp<float>(A, W.xc), wsp<float>(A, W.mod) + (size_t)l * 9 * 6144, l, dry ? wsp<float>(A, W.g) : A->xl};
    gemm_phase(lds, 1024, S, E);
}
__device__ __forceinline__ void phase_norm(AP A, int l, int vcu, int G) {
    const int tid = opaque_tid(), lane = tid & 63, wave = __builtin_amdgcn_readfirstlane(tid >> 6);
    const int gw = vcu * NWAVES + wave, NGW = G * NWAVES;
    const float* mod = wsp<float>(A, W.mod) + (size_t)l * 9 * 6144;
    const int nrow = l == 0 ? NTOK : NLAT;
    for (int t = gw; t < nrow; t += NGW) {
        const bool lat = t < NLAT; const int mr = lat ? t / SEQ : 8;
        const float* xr = lat ? A->xl + (size_t)t * DM : wsp<float>(A, W.xc) + (size_t)(t - NLAT) * DM;
        modulate_row_bf16(xr, FIN(7) + l * DM, mod + (size_t)mr * 6144 + 4 * 1024, mod + (size_t)mr * 6144 + 3 * 1024, wsp<bf16_t>(A, W.nn) + (size_t)t * DM, lane);
    }
    if (l == 1) {
        const size_t gt = (size_t)vcu * NTHR + tid, NGT = (size_t)G * NTHR, nUV = (size_t)16384 * 1024 / 16;
        for (size_t i = gt; i < 2 * nUV; i += NGT) {
            if (i < nUV) cvt16_fp8(FIN(28) + (size_t)16384 * 1024 + i * 16, wsp<unsigned char>(A, W.ub) + i * 16, SU);
            else cvt16_fp8(FIN(29) + (size_t)16384 * 1024 + (i - nUV) * 16, wsp<unsigned char>(A, W.vb) + (i - nUV) * 16, SV);
        }
    }
}
struct PqEpi {
    bf16_t* pq;
    __device__ __forceinline__ bool operator()(Acc& acc, const Unit& u, int wr, int wc, int fr, int fq) const {
#pragma unroll
        for (int ai = 0; ai < 2; ++ai)
#pragma unroll
            for (int m = 0; m < 4; ++m) { bf16_t* rowp = pq + ((size_t)u.pm * 256 + 128 * ai + 64 * wr + 16 * m + fr) * 2048 + u.pn * 256 + 32 * wc + 8 * fq;
#pragma unroll
                for (int bj = 0; bj < 2; ++bj) { const f32x4 v0 = acc[ai][bj][m][0], v1 = acc[ai][bj][m][1];
                    u32x4 w; w.x = cvt_pk_bf16(v0[0], v0[1]); w.y = cvt_pk_bf16(v0[2], v0[3]); w.z = cvt_pk_bf16(v1[0], v1[1]); w.w = cvt_pk_bf16(v1[2], v1[3]);
                    *(u32x4*)(rowp + 128 * bj) = w; } }
        return true;
    }
};
__device__ __forceinline__ void phase_peerq(AP A, FK_LAS unsigned char* lds, int l, int G) {
    PlainSched S{G, (int)blockIdx.x, l == 0 ? NTT : NTL, 8, 1024, (const char*)wsp<bf16_t>(A, W.nn), (const char*)(wsp<bf16_t>(A, W.w_q) + (size_t)l * 2048 * 1024)};
    PqEpi E{wsp<bf16_t>(A, W.pq)};
    gemm_phase(lds, 1024, S, E);
}
#define FK_HAVE_PEER 1
namespace peer {
typedef __bf16 bf16x2v __attribute__((ext_vector_type(2)));
__device__ __forceinline__ float dot2(unsigned a, unsigned b, float c) { return __builtin_amdgcn_fdot2_f32_bf16(__builtin_bit_cast(bf16x2v, a), __builtin_bit_cast(bf16x2v, b), c, false); }
__device__ __forceinline__ unsigned ford(float f) { const unsigned u = __float_as_uint(f); return (u & 0x80000000u) ? ~u : (u | 0x80000000u); }
__device__ __forceinline__ float funord(unsigned o) { return __uint_as_float((o & 0x80000000u) ? (o & 0x7fffffffu) : ~o); }
__device__ __forceinline__ unsigned umax(unsigned a, unsigned b) { return a > b ? a : b; }
__device__ __forceinline__ unsigned umin(unsigned a, unsigned b) { return a < b ? a : b; }
template <int N> __device__ __forceinline__ void sort_desc(unsigned (&v)[N]) {
#pragma unroll
    for (int k = 2; k <= N; k <<= 1)
#pragma unroll
        for (int j = k >> 1; j > 0; j >>= 1)
#pragma unroll
            for (int i = 0; i < N; ++i) { const int l = i ^ j;
                if (l > i) { const unsigned a = v[i], b = v[l], mx = umax(a, b), mn = umin(a, b); if ((i & k) == 0) { v[i] = mx; v[l] = mn; } else { v[i] = mn; v[l] = mx; } } }
}
template <int N> __device__ __forceinline__ void merge_desc(unsigned (&v)[N]) {
#pragma unroll
    for (int j = N >> 1; j > 0; j >>= 1)
#pragma unroll
        for (int i = 0; i < N; ++i) { const int l = i ^ j; if (l > i) { const unsigned a = v[i], b = v[l]; v[i] = umax(a, b); v[l] = umin(a, b); } }
}
__device__ __forceinline__ int crow(int r, int hi) { return (r & 3) + 8 * (r >> 2) + 4 * hi; }
constexpr int L_RIDX = 0, L_RG = 32 * 128 * 2, L_TBL = L_RG + 32 * 128 * 4, L_WK = L_TBL + 8 * 32 * 32, L_END = L_WK + 8 * 128 * 4;

__device__ __forceinline__ void score_top16(const bf16_t* keys  , const bf16_t* qrow  , int r32, int hi, unsigned (&top)[16]) {
    f32x16 acc[4];
    int koff = r32 * 128 + 8 * hi; asm volatile("" : "+v"(koff));
    const bf16_t* kbase = keys + koff; const bf16_t* qb = qrow + 8 * hi;
#pragma unroll
    for (int kt = 0; kt < 4; ++kt) acc[kt] = f32x16{};
    bf16x8 bq[8], ka[8], kb2[8];
#pragma unroll
    for (int ks = 0; ks < 8; ++ks) bq[ks] = *(const bf16x8*)(qb + 16 * ks);
#define KLOAD(dst, kt) do { _Pragma("unroll") for (int ks = 0; ks < 8; ++ks) dst[ks] = *(const bf16x8*)(kbase + 32 * (kt) * 128 + 16 * ks); } while (0)
#define KMMA(src, kt) do { _Pragma("unroll") for (int ks = 0; ks < 8; ++ks) acc[kt] = __builtin_amdgcn_mfma_f32_32x32x16_bf16(src[ks], bq[ks], acc[kt], 0, 0, 0); } while (0)
    KLOAD(ka, 0); asm volatile("" ::: "memory");
    KLOAD(kb2, 1); KMMA(ka, 0); asm volatile("" ::: "memory");
    KLOAD(ka, 2); KMMA(kb2, 1); asm volatile("" ::: "memory");
    KLOAD(kb2, 3); KMMA(ka, 2); asm volatile("" ::: "memory");
    KMMA(kb2, 3);
#undef KLOAD
#undef KMMA
    unsigned v[64]; const unsigned hi4 = 4u * (unsigned)hi;
#pragma unroll
    for (int kt = 0; kt < 4; ++kt)
#pragma unroll
        for (int r = 0; r < 16; ++r) v[kt * 16 + r] = ((ford(acc[kt][r]) & ~0x7fu) | (unsigned)(127 - (32 * kt + (r & 3) + 8 * (r >> 2)))) - hi4;
    unsigned g0[16], g1[16], g2[16], g3[16];
#pragma unroll
    for (int i = 0; i < 16; ++i) { g0[i] = v[i]; g1[i] = v[16 + i]; g2[i] = v[32 + i]; g3[i] = v[48 + i]; }
    sort_desc<16>(g0); sort_desc<16>(g1); sort_desc<16>(g2); sort_desc<16>(g3);
#pragma unroll
    for (int i = 0; i < 16; ++i) { g0[i] = umax(g0[i], g1[15 - i]); g2[i] = umax(g2[i], g3[15 - i]); }
    merge_desc<16>(g0); merge_desc<16>(g2);
#pragma unroll
    for (int i = 0; i < 16; ++i) g0[i] = umax(g0[i], g2[15 - i]);
    merge_desc<16>(g0);
#pragma unroll
    for (int i = 0; i < 16; ++i) { const unsigned o = (unsigned)__shfl_xor((int)g0[15 - i], 32); top[i] = umax(g0[i], o); }
    merge_desc<16>(top);
}
__device__ __forceinline__ void phase(AP A, FK_LAS unsigned char* lds, int l, int vcu, int G, int dry) {
    const int tid = opaque_tid(), lane = tid & 63, wave = __builtin_amdgcn_readfirstlane(tid >> 6), r32 = lane & 31, hi = lane >> 5;
    const int TS = (l == 0 && (NTOK % 24) == 0) ? 24 : 32, TPW = TS / 8;
    const int ntile = (l == 0 ? NTOK : NLAT) / TS;
    const bf16_t* keys = wsp<bf16_t>(A, W.keys) + (size_t)l * 16 * 128 * 128;
    const float* mod = wsp<float>(A, W.mod) + (size_t)l * 9 * 6144;
    FK_LAS unsigned short* ridx = (FK_LAS unsigned short*)(lds + L_RIDX); FK_LAS float* rg = (FK_LAS float*)(lds + L_RG);
    FK_LAS unsigned char* tbl = (FK_LAS unsigned char*)(lds + L_TBL) + wave * 32 * 32; FK_LAS float* wk = (FK_LAS float*)(lds + L_WK) + wave * 128;
    for (int tile = vcu; tile < ntile; tile += G) {
        const int t0 = tile * TS; const int rtok = r32 < TS ? r32 : TS - 1;
        __syncthreads();
#ifndef FK_REP_SUB
#define FK_REP_SUB 0
#endif
        for (int rp = (FK_REP_SUB == 4 ? 1 : 0); rp >= 0; --rp) {
            const int h = wave; unsigned s1[16], s2[16];
            const bf16_t* qrow = wsp<bf16_t>(A, W.pq) + (size_t)(t0 + rtok) * 2048 + h * 256;
            score_top16(keys + (size_t)(h * 2 + 0) * 128 * 128, qrow, r32, hi, s1);
            score_top16(keys + (size_t)(h * 2 + 1) * 128 * 128, qrow + 128, r32, hi, s2);
            if (hi == 0) {
#pragma unroll
                for (int i = 0; i < 16; ++i) { tbl[r32 * 32 + i] = (unsigned char)(127 - (s1[i] & 127u)); tbl[r32 * 32 + 16 + i] = (unsigned char)(127 - (s2[i] & 127u)); } }
            float f1[16], f2[16];
#pragma unroll
            for (int i = 0; i < 16; ++i) { f1[i] = funord(s1[i] & ~0x7fu); f2[i] = funord(s2[i] & ~0x7fu); }
            unsigned c[32]; int cn = 0;
#pragma unroll
            for (int i = 0; i < 16; ++i)
#pragma unroll
                for (int j = 0; j < 16; ++j) if ((i + 1) * (j + 1) <= 16) {
                    const unsigned pk = (ford(f1[i] + f2[j]) & ~0xffu) | (unsigned)(255 - (i * 16 + j));
                    if ((cn & 1) == 0) c[cn >> 1] = pk; else c[cn >> 1] = hi ? pk : c[cn >> 1];
                    ++cn; }
#pragma unroll
            for (int q = 25; q < 32; ++q) c[q] = 0u;
            sort_desc<32>(c);
            unsigned ct[16];
#pragma unroll
            for (int i = 0; i < 16; ++i) { const unsigned o = (unsigned)__shfl_xor((int)c[15 - i], 32); ct[i] = umax(c[i], o); }
            merge_desc<16>(ct);
            if (hi == 0 && r32 < TS) {
                float e[16]; float sum = 0.f; const float mx = funord(ct[0] & ~0xffu);
#pragma unroll
                for (int t = 0; t < 16; ++t) { e[t] = __expf(funord(ct[t] & ~0xffu) - mx); sum += e[t]; }
                const float inv = 1.f / sum;
#pragma unroll
                for (int t = 0; t < 16; ++t) { const int ci = 255 - (int)(ct[t] & 0xffu); const int e1 = tbl[r32 * 32 + (ci >> 4)], e2 = tbl[r32 * 32 + 16 + (ci & 15)];
                    const int idx = e1 * 128 + e2; const float gg = e[t] * inv;
                    ridx[r32 * 128 + h * 16 + t] = (unsigned short)idx; rg[r32 * 128 + h * 16 + t] = gg;
                    wsp<int>(A, W.pidx)[(size_t)(t0 + r32) * 128 + h * 16 + t] = idx; wsp<float>(A, W.pg)[(size_t)(t0 + r32) * 128 + h * 16 + t] = gg; }
            }
        }
        __syncthreads();
        const unsigned char* UB = wsp<unsigned char>(A, W.ub); const unsigned char* VB = wsp<unsigned char>(A, W.vb);
#pragma unroll 1
        for (int tt = 0; tt < TPW; ++tt) {
            const int tl = wave * TPW + tt, t = t0 + tl; const bool lat = t < NLAT; const int mr = lat ? t / SEQ : 8;
            const bf16_t* nrow = wsp<bf16_t>(A, W.nn) + (size_t)t * DM + 16 * lane;
            float nf[16];
            { const u32x4 n0 = *(const u32x4*)(nrow), n1 = *(const u32x4*)(nrow + 8);
              nf[0] = bflo(n0.x); nf[1] = bfhi(n0.x); nf[2] = bflo(n0.y); nf[3] = bfhi(n0.y); nf[4] = bflo(n0.z); nf[5] = bfhi(n0.z); nf[6] = bflo(n0.w); nf[7] = bfhi(n0.w);
              nf[8] = bflo(n1.x); nf[9] = bfhi(n1.x); nf[10] = bflo(n1.y); nf[11] = bfhi(n1.y); nf[12] = bflo(n1.z); nf[13] = bfhi(n1.z); nf[14] = bflo(n1.w); nf[15] = bfhi(n1.w); }
            const FK_LAS unsigned short* ri = ridx + tl * 128;
#define LD8X(buf, TAB, rip, kb) do { _Pragma("unroll") for (int i = 0; i < 8; ++i) buf[i] = *(const u32x4*)(TAB + (size_t)(rip)[(kb) * 8 + i] * DM + 16 * lane); } while (0)
#define LD8(buf, TAB, kb) LD8X(buf, TAB, ri, kb)
#define HID8(buf, kb) do { float p[8]; \
                _Pragma("unroll") for (int i = 0; i < 8; ++i) { const unsigned aw[4] = {buf[i].x, buf[i].y, buf[i].z, buf[i].w}; float d = 0.f; \
                    _Pragma("unroll") for (int q = 0; q < 4; ++q) { const f32x2 lo = __builtin_amdgcn_cvt_pk_f32_fp8(aw[q], false), hh = __builtin_amdgcn_cvt_pk_f32_fp8(aw[q], true); \
                        d = fmaf(lo[0], nf[4 * q], d); d = fmaf(lo[1], nf[4 * q + 1], d); d = fmaf(hh[0], nf[4 * q + 2], d); d = fmaf(hh[1], nf[4 * q + 3], d); } \
                    p[i] = d; } \
                _Pragma("unroll") for (int i = 0; i < 4; ++i) { const float send = (lane & 32) ? p[i] : p[i + 4], keep = (lane & 32) ? p[i + 4] : p[i]; p[i] = keep + __shfl_xor(send, 32); } \
                _Pragma("unroll") for (int i = 0; i < 2; ++i) { const float send = (lane & 16) ? p[i] : p[i + 2], keep = (lane & 16) ? p[i + 2] : p[i]; p[i] = keep + __shfl_xor(send, 16); } \
                { const float send = (lane & 8) ? p[0] : p[1], keep = (lane & 8) ? p[1] : p[0]; p[0] = keep + __shfl_xor(send, 8); } \
                float hsum = p[0]; hsum += __shfl_xor(hsum, 4); hsum += __shfl_xor(hsum, 2); hsum += __shfl_xor(hsum, 1); \
                hsum *= (1.f / SU); \
                const int k = (kb) * 8 + ((lane >> 5) & 1) * 4 + ((lane >> 4) & 1) * 2 + ((lane >> 3) & 1); \
                const float w = rg[tl * 128 + k] * 0.5f * hsum * (1.f + erff(hsum * 0.70710678118654752f)) * (1.f / SV); \
                if ((lane & 7) == 0) wk[k] = w; } while (0)
#define ACC8(buf, kb) do { _Pragma("unroll") for (int i = 0; i < 8; ++i) { const float w = wk[(kb) * 8 + i]; const unsigned aw[4] = {buf[i].x, buf[i].y, buf[i].z, buf[i].w}; \
                    _Pragma("unroll") for (int q = 0; q < 4; ++q) { const f32x2 lo = __builtin_amdgcn_cvt_pk_f32_fp8(aw[q], false), hh = __builtin_amdgcn_cvt_pk_f32_fp8(aw[q], true); \
                        y[4 * q] = fmaf(w, lo[0], y[4 * q]); y[4 * q + 1] = fmaf(w, lo[1], y[4 * q + 1]); y[4 * q + 2] = fmaf(w, hh[0], y[4 * q + 2]); y[4 * q + 3] = fmaf(w, hh[1], y[4 * q + 3]); } } } while (0)
            u32x4 ba[8], bb[8];
            LD8(ba, UB, 0);
#pragma unroll 1
            for (int kb = 0; kb < 16; kb += 2) {
                LD8(bb, UB, kb + 1);
                HID8(ba, kb);
                if (kb + 2 < 16) LD8(ba, UB, kb + 2); else LD8(ba, VB, 0);
                HID8(bb, kb + 1);
            }
            float y[16];
#pragma unroll
            for (int i = 0; i < 16; ++i) y[i] = 0.f;
#pragma unroll 1
            for (int kb = 0; kb < 16; kb += 2) {
                LD8(bb, VB, kb + 1);
                ACC8(ba, kb);
                if (kb + 2 < 16) LD8(ba, VB, kb + 2);
                ACC8(bb, kb + 1);
            }
#undef LD8
#undef LD8X
#undef HID8
#undef ACC8
            float* xr = lat ? A->xl + (size_t)t * DM : wsp<float>(A, W.xc) + (size_t)(t - NLAT) * DM;
            const float* gate = mod + (size_t)mr * 6144 + 5 * 1024;
            f32x4 x[4]; float ss = 0.f;
#pragma unroll
            for (int q = 0; q < 4; ++q) { const int e0 = 16 * lane + 4 * q; const f32x4 gq = *(const f32x4*)(gate + e0); f32x4 xv = *(const f32x4*)(xr + e0);
                xv[0] += gq[0] * y[q * 4 + 0]; xv[1] += gq[1] * y[q * 4 + 1]; xv[2] += gq[2] * y[q * 4 + 2]; xv[3] += gq[3] * y[q * 4 + 3];
                if (!dry) *(f32x4*)(xr + e0) = xv; x[q] = xv; ss += (xv[0] * xv[0] + xv[1] * xv[1]) + (xv[2] * xv[2] + xv[3] * xv[3]); }
            if (l == 0 && !dry) {
                ss = wave_sum(ss); const float rs = rsqrtf(ss * (1.f / 1024.f) + EPS);
                const float* mod1 = wsp<float>(A, W.mod) + (size_t)9 * 6144 + (size_t)mr * 6144; const float* g1 = FIN(6) + DM;
                bf16_t* orow = wsp<bf16_t>(A, W.xn) + (size_t)t * DM + 16 * lane; unsigned w8[8];
#pragma unroll
                for (int q = 0; q < 4; ++q) { const int e = 16 * lane + 4 * q; const f32x4 gg = *(const f32x4*)(g1 + e), sc = *(const f32x4*)(mod1 + 1024 + e), sf = *(const f32x4*)(mod1 + e);
                    const f32x4 o = x[q] * rs * gg * (sc + 1.0f) + sf; w8[2 * q] = cvt_pk_bf16(o[0], o[1]); w8[2 * q + 1] = cvt_pk_bf16(o[2], o[3]); }
                *(u32x4*)(orow) = (u32x4){w8[0], w8[1], w8[2], w8[3]}; *(u32x4*)(orow + 8) = (u32x4){w8[4], w8[5], w8[6], w8[7]};
            }
        }
    }
}
}
__device__ __forceinline__ void phase_peer(AP A, FK_LAS unsigned char* lds, int l, int vcu, int G, int dry) { peer::phase(A, lds, l, vcu, G, dry); }
constexpr int N_PHASES = 16;
__global__ void __launch_bounds__(NTHR, 2) mega(Args A_unused) {
    extern __shared__ __attribute__((aligned(16))) unsigned char lds_raw[];
    FK_LAS unsigned char* lds = (FK_LAS unsigned char*)lds_raw;
    const int tid = threadIdx.x;
    AP A0 = (AP)__builtin_amdgcn_kernarg_segment_ptr();
#define AA() opaque_args(A0)
    const int G = gridDim.x, bx = blockIdx.x, vcu = (G % 8 == 0) ? (bx % 8) * (G / 8) + bx / 8 : bx;
    volatile FK_LAS unsigned* MISC = (volatile FK_LAS unsigned*)(lds + LDS_MISC);
    if (tid < 64) MISC[tid] = 0u;
    __syncthreads();
    XcdBarrier bar; bar.bar = wsp<unsigned>(A0, W.ctl) + 1024; bar.x = 0; bar.st = MISC + 8;
    if (A0->use_bar) bar = xcd_barrier_post(wsp<unsigned>(A0, W.ctl) + 1024, MISC + 8);
    const int lo = A0->ph_lo, hi = A0->ph_hi;
#define IN(k) (lo <= (k) && (k) < hi)
#ifndef FK_REP_PHASE
#define FK_REP_PHASE -1
#endif
#define REP(k) for (int rep_ = (FK_REP_PHASE == (k)) ? 1 : 0; rep_ >= 0; --rep_)
#ifndef FK_REP_BAR
#define FK_REP_BAR 0
#endif
#define SEAM(k) do { if (IN(k) && IN((k) + 1)) { xcd_barrier(bar); if (FK_REP_BAR) xcd_barrier(bar); } } while (0)
#ifndef FK_REP_ALL
#define FK_REP_ALL 0
#endif
    for (int pass = FK_REP_ALL ? 1 : 0; pass >= 0; --pass) {
    if (IN(0)) REP(0) phase_pa(AA(), lds, vcu, G);
    SEAM(0);
    if (IN(1)) REP(1) phase_pb(AA(), vcu, G);
    SEAM(1);
    for (int l = 0; l < 2; ++l) {
        const int pb = 2 + 7 * l;
        if (IN(pb + 0)) REP(pb + 0) phase_inproj(AA(), lds, l, G);
        SEAM(pb + 0);
#ifdef FK_HAVE_MIX
        if (IN(pb + 1)) REP(pb + 1) phase_mix(AA(), lds, l, vcu, G);
#endif
        SEAM(pb + 1);
#ifdef FK_HAVE_MERGE
        if (IN(pb + 2)) REP(pb + 2) phase_merge(AA(), lds, l, G);
#endif
        SEAM(pb + 2);
#ifdef FK_HAVE_OUT
        if (IN(pb + 3)) REP(pb + 3) phase_outproj(AA(), lds, l, G, rep_ | (pass & l));
#endif
        SEAM(pb + 3);
#ifdef FK_HAVE_NORM
        if (IN(pb + 4)) REP(pb + 4) phase_norm(AA(), l, vcu, G);
#endif
        SEAM(pb + 4);
#ifdef FK_HAVE_PQ
        if (IN(pb + 5)) REP(pb + 5) phase_peerq(AA(), lds, l, G);
#endif
        SEAM(pb + 5);
#ifdef FK_HAVE_PEER
        if (IN(pb + 6)) REP(pb + 6) phase_peer(AA(), lds, l, vcu, G, rep_ | pass);
#endif
        SEAM(pb + 6);
    }
    if (pass) xcd_barrier(bar);
    }
#undef IN
#undef SEAM
}
inline void launch(void* const* d_in, float* out, unsigned char* ws, float* xl, int lo, int hi, bool one_launch, hipStream_t st) {
    static int ok = 0;
    if (!ok) { if (hipFuncSetAttribute((const void*)mega, hipFuncAttributeMaxDynamicSharedMemorySize, LDS_BYTES) != hipSuccess) { fprintf(stderr, "hipFuncSetAttribute failed\n"); return; } ok = 1; }
    (void)hipMemsetAsync(ws + W.ctl, 0, 65536, st);
    Args a{}; for (int i = 0; i < 30; ++i) a.in[i] = (const float*)d_in[i];
    a.out = out; a.ws = ws; a.xl = xl; a.pad = 0;
    if (one_launch) { a.ph_lo = lo; a.ph_hi = hi; a.use_bar = 1; hipLaunchKernelGGL(mega, dim3(256), dim3(NTHR), LDS_BYTES, st, a); }
    else for (int p = lo; p < hi; ++p) { a.ph_lo = p; a.ph_hi = p + 1; a.use_bar = 0; hipLaunchKernelGGL(mega, dim3(256), dim3(NTHR), LDS_BYTES, st, a); }
}
}
#ifndef FK_ONE_LAUNCH
#define FK_ONE_LAUNCH 1
#endif
extern "C" void kernel_launch(void* const* d_in, const int* in_sizes, int n_in, void* d_out, int out_size, void* d_ws, size_t ws_size, hipStream_t stream) {
    if (n_in != 30 || ws_size < fk::W.end || out_size != fk::NLAT * 1024) { fprintf(stderr, "kernel_launch: n_in %d ws %zu (need %zu) out %d\n", n_in, ws_size, (size_t)fk::W.end, out_size); return; }
    fk::launch(d_in, (float*)d_out, (unsigned char*)d_ws, (float*)d_out, 0, fk::N_PHASES, FK_ONE_LAUNCH != 0, stream);
}
```

```cpp
#include <hip/hip_runtime.h>
#include <cstdio>
#include <cstdint>
#include <math.h>
#define FK_ONE_LAUNCH 1
namespace fk {
#define FK_LAS __attribute__((address_space(3)))
typedef unsigned short bf16_t;
typedef short bf16x8 __attribute__((ext_vector_type(8)));
typedef float f32x4 __attribute__((ext_vector_type(4)));
typedef float f32x16 __attribute__((ext_vector_type(16)));
typedef unsigned u32x4 __attribute__((ext_vector_type(4)));
typedef unsigned u32x2 __attribute__((ext_vector_type(2)));
#ifndef FK_NB
#define FK_NB 8
#endif
constexpr int NB = FK_NB, SEQ = 2048, DM = 1024, CTX = 256, KALL = SEQ + CTX;
constexpr int NLAT = NB * SEQ, NCTX = NB * CTX, NTOK = NLAT + NCTX;
constexpr int PINF = 5888;
constexpr int R_HY = 0, R_FZ = 768, R_Q = 1280, R_K = 1792, R_V = 2304, R_G = 2816;
constexpr float EPS = 1e-6f;
constexpr int NWAVES = 8, NTHR = 512;
constexpr int TLL = 4224, TLC = 576;

__device__ __forceinline__ unsigned f2bf(float f) { unsigned u = __builtin_bit_cast(unsigned, f); return (u + 0x7fffu + ((u >> 16) & 1u)) >> 16; }
__device__ __forceinline__ unsigned pk2(float lo, float hi) { return f2bf(lo) | (f2bf(hi) << 16); }
__device__ __forceinline__ float bf2f(unsigned short h) { return __builtin_bit_cast(float, (unsigned)h << 16); }
__device__ __forceinline__ float bflo(unsigned w) { return __builtin_bit_cast(float, w << 16); }
__device__ __forceinline__ float bfhi(unsigned w) { return __builtin_bit_cast(float, w & 0xffff0000u); }
typedef __bf16 bf16x2_t __attribute__((ext_vector_type(2)));
__device__ __forceinline__ unsigned cvt_pk_bf16(float lo, float hi) { bf16x2_t v = {(__bf16)lo, (__bf16)hi}; return __builtin_bit_cast(unsigned, v); }
typedef float f32x2 __attribute__((ext_vector_type(2)));
constexpr float SU = 64.f, SV = 4.f;
__device__ __forceinline__ unsigned pk4_fp8(float a, float b, float c, float d) { unsigned w = __builtin_amdgcn_cvt_pk_fp8_f32(a, b, 0, false); return __builtin_amdgcn_cvt_pk_fp8_f32(c, d, w, true); }
__device__ __forceinline__ size_t tab_chunk_off(size_t i  ) { const size_t e = i >> 6, c16 = i & 63; return (((c16 >> 3) * 16384 + e) * 128) + (c16 & 7) * 16; }
__device__ __forceinline__ void cvt16_fp8(const float* src, unsigned char* dst, float sc) {
    const f32x4 x0 = *(const f32x4*)(src), x1 = *(const f32x4*)(src + 4), x2 = *(const f32x4*)(src + 8), x3 = *(const f32x4*)(src + 12);
    u32x4 o; o.x = pk4_fp8(x0[0] * sc, x0[1] * sc, x0[2] * sc, x0[3] * sc); o.y = pk4_fp8(x1[0] * sc, x1[1] * sc, x1[2] * sc, x1[3] * sc);
    o.z = pk4_fp8(x2[0] * sc, x2[1] * sc, x2[2] * sc, x2[3] * sc); o.w = pk4_fp8(x3[0] * sc, x3[1] * sc, x3[2] * sc, x3[3] * sc);
    *(u32x4*)dst = o;
}
__device__ __forceinline__ float wave_sum(float v) {
#pragma unroll
    for (int o = 32; o > 0; o >>= 1) v += __shfl_xor(v, o);
    return v;
}

struct WS {
    size_t ctl, mod, misc, h3l, h3c, tapl, tapc, w_in, w_mrg, w_out, w_q, keys, ub, vb, dftl, dftc;
    size_t xn, nn, hyt, ftl, ftc, q, qc, k, vt, g, attlo, atthi, hyo, fno, y, xl, xc, pq, pidx, pg, stash, end;
};
__host__ __device__ constexpr size_t al(size_t x) { return (x + 4095) / 4096 * 4096; }
__host__ __device__ constexpr WS make_ws() {
    WS w{}; size_t o = 0;
    w.ctl = o; o += 65536;
    w.mod = o; o += al((size_t)2 * 9 * 6144 * 4);
    w.misc = o; o += al((size_t)12 << 20);
    w.tapl = o; o += al((size_t)2 * 2 * 256 * TLL * 2);
    w.tapc = o; o += al((size_t)2 * 2 * 256 * TLC * 2);
    w.w_in = o; o += al((size_t)2 * PINF * 1024 * 2);
    w.w_mrg = o; o += al((size_t)2 * 4 * 1024 * 256 * 2);
    w.w_out = o; o += al((size_t)2 * 1024 * 1024 * 2);
    w.w_q = o; o += al((size_t)2 * 2048 * 1024 * 2);
    w.keys = o; o += al((size_t)2 * 16 * 128 * 128 * 2);
    w.ub = o; o += al((size_t)16384 * 1024);
    w.vb = o; o += al((size_t)16384 * 1024);
    w.dftl = o; o += al((size_t)2048 * 4096 * 2);
    w.dftc = o; o += al((size_t)256 * 512 * 2);
    w.xn = o; o += al((size_t)NTOK * 1024 * 2);
    w.nn = o; w.stash = o; { size_t a = al((size_t)NTOK * 1024 * 2), b = al((size_t)256 * 512 * 128 * 4); o += a > b ? a : b; }
    w.hyt = o; w.y = o; { size_t a = al((size_t)768 * NTOK * 2) + al((size_t)NB * 256 * 4096 * 2) + al((size_t)NB * 256 * 512 * 2), b = al((size_t)NTOK * 1024 * 2);
        w.ftl = o + al((size_t)768 * NTOK * 2); w.ftc = w.ftl + al((size_t)NB * 256 * 4096 * 2); o += a > b ? a : b; }
    w.q = o; o += al((size_t)NB * 8 * 2048 * 64 * 2);
    w.qc = o; o += al((size_t)NB * 8 * 256 * 64 * 2);
    w.k = o; o += al((size_t)NB * 8 * KALL * 64 * 2);
    w.vt = o; o += al((size_t)NB * 4 * 128 * KALL * 2);
    w.g = o; w.pq = o; w.h3l = o; { size_t a = al((size_t)NTOK * 3072 * 2), b = al((size_t)2 * 2048 * 1024 * 4) + al((size_t)2 * 256 * 1024 * 4);
        w.h3c = o + al((size_t)2 * 2048 * 1024 * 4); o += a > b ? a : b; }
    w.attlo = o; o += al((size_t)NTOK * 256 * 2);
    w.atthi = o; o += al((size_t)NTOK * 256 * 2);
    w.hyo = o; o += al((size_t)NTOK * 256 * 2);
    w.fno = o; o += al((size_t)NTOK * 256 * 2);
    w.xl = o; o += (NB == 8) ? 0 : al((size_t)NLAT * 1024 * 4);
    w.xc = o; o += al((size_t)NCTX * 1024 * 4);
    w.pidx = o; o += al((size_t)NTOK * 128 * 4);
    w.pg = o; o += al((size_t)NTOK * 128 * 4);
    w.end = o; return w;
}
constexpr WS W = make_ws();
constexpr int MI_LAM = 0, MI_ROPE = 64, MI_HYINV = 4096, MI_HYPART = 8192;

constexpr int BM = 256, BK = 64, HALF = 128, HTB = HALF * BK * 2, STAGE_BYTES = 8 * HTB;
__host__ __device__ __forceinline__ int lds_byte(int r, int c) { const int st = (r >> 4) * 2 + (c >> 5), rr = r & 15, cc = c & 31, ob = rr * 64 + cc * 2; return st * 1024 + (ob ^ (((ob >> 9) & 1) << 5)); }
__host__ __device__ __forceinline__ void stage_rc(int b, int& R, int& C) { const int st = b / 1024, sb = b % 1024, swz = sb ^ (((sb >> 9) & 1) << 5); R = (st >> 1) * 16 + swz / 64; C = (st & 1) * 32 + (swz % 64) / 2; }
__host__ __device__ __forceinline__ int perm32(int rho) { const int n = rho >> 4, i = rho & 15; return 8 * (i >> 2) + 4 * n + (i & 3); }

struct Unit { const char* a; const char* b; int pm, pn, kind, aux; };
typedef f32x4 Acc[2][2][4][2];

template <class Sched, class Epi>
__device__ __forceinline__ void gemm_phase(FK_LAS unsigned char* lds, const int K, const Sched& S, const Epi& E) {
    int tid = threadIdx.x; asm volatile("" : "+v"(tid));
    const int wid = __builtin_amdgcn_readfirstlane(tid >> 6), lane = tid & 63, wr = wid >> 2, wc = wid & 3, fr = lane & 15, fq = lane >> 4;
    const int nt = K / BK;
    unsigned voffA[2], voffB[2];
#pragma unroll
    for (int i = 0; i < 2; ++i) { int R, C; stage_rc(tid * 16 + i * 8192, R, C); const int Rb = (R & ~31) + perm32(R & 31);
        voffA[i] = (unsigned)(R * K + C) * 2u; voffB[i] = (unsigned)(Rb * K + C) * 2u; }
    const size_t kstep = (size_t)(BK * 2);
    const size_t hstep = (size_t)HALF * K * 2;
    const unsigned ldsw = (unsigned)wid * 1024u;
    const int aoff = lds_byte(wr * 64 + fr, fq * 8), boff = lds_byte(wc * 32 + fr, fq * 8);
#define PG8_SA(b, h) (((b) * 2 + (h)) * HTB)
#define PG8_SB(b, h) ((4 + (b) * 2 + (h)) * HTB)
#define PG8_STAGE(bufoff, gbase, voff) do { _Pragma("unroll") for (int _i = 0; _i < 2; ++_i) \
        __builtin_amdgcn_global_load_lds((const unsigned*)((const char*)(gbase) + (voff)[_i]), (FK_LAS unsigned*)(lds + (bufoff) + ldsw + _i * 8192), 16, 0, 0); } while (0)
#define PG8_LDA(dst, b, h) do { _Pragma("unroll") for (int m = 0; m < 4; ++m) _Pragma("unroll") for (int k = 0; k < 2; ++k) dst[m][k] = *(const FK_LAS bf16x8*)(lds + PG8_SA(b, h) + aoff + m * 2048 + k * 1024); } while (0)
#define PG8_LDB(dst, b, h) do { _Pragma("unroll") for (int n = 0; n < 2; ++n) _Pragma("unroll") for (int k = 0; k < 2; ++k) dst[n][k] = *(const FK_LAS bf16x8*)(lds + PG8_SB(b, h) + boff + n * 2048 + k * 1024); } while (0)
#define PG8_MMA(ai, bj, At, Bt) do { __builtin_amdgcn_s_setprio(1); _Pragma("unroll") for (int m = 0; m < 4; ++m) _Pragma("unroll") for (int n = 0; n < 2; ++n) _Pragma("unroll") for (int k = 0; k < 2; ++k) \
        acc[ai][bj][m][n] = __builtin_amdgcn_mfma_f32_16x16x32_bf16(Bt[n][k], At[m][k], acc[ai][bj][m][n], 0, 0, 0); __builtin_amdgcn_s_setprio(0); } while (0)
#define PG8_WAIT_V(n) asm volatile("s_waitcnt vmcnt(" #n ")" ::: "memory")
#define PG8_WAIT_L(n) asm volatile("s_waitcnt lgkmcnt(" #n ")" ::: "memory")
#define PG8_BAR __builtin_amdgcn_s_barrier()
#define PG8_SCHED __builtin_amdgcn_sched_barrier(0)
    Unit cur, nxt; int ui = 0;
    if (!S.next(0, cur)) return;
    Acc acc;
#pragma unroll
    for (int a = 0; a < 2; ++a)
#pragma unroll
        for (int b = 0; b < 2; ++b)
#pragma unroll
            for (int m = 0; m < 4; ++m)
#pragma unroll
                for (int n = 0; n < 2; ++n) acc[a][b][m][n] = (f32x4){0.f, 0.f, 0.f, 0.f};
    bf16x8 At[4][2], B0[2][2], B1[2][2];
    const char* cA = cur.a; const char* cB = cur.b;
    PG8_STAGE(PG8_SB(0, 0), cB, voffB); PG8_STAGE(PG8_SB(0, 1), cB + hstep, voffB); PG8_STAGE(PG8_SA(0, 0), cA, voffA); PG8_STAGE(PG8_SA(0, 1), cA + hstep, voffA);
    if (wr == 1) PG8_BAR;
    PG8_WAIT_V(2); PG8_BAR;
    PG8_STAGE(PG8_SB(1, 0), cB + kstep, voffB); PG8_STAGE(PG8_SA(1, 0), cA + kstep, voffA); PG8_STAGE(PG8_SB(1, 1), cB + hstep + kstep, voffB);
    PG8_WAIT_V(6); PG8_BAR;
    for (;;) {
        const bool has_next = S.next(ui + 1, nxt);
        const char* nA = has_next ? nxt.a : cA; const char* nB = has_next ? nxt.b : cB;
        for (int t = 0; t < nt; t += 2) {
            const bool last = (t == nt - 2);
            const char* a1 = cA + (size_t)(t + 1) * kstep;
            const char* a2 = last ? nA : cA + (size_t)(t + 2) * kstep; const char* b2 = last ? nB : cB + (size_t)(t + 2) * kstep;
            const char* a3 = a2 + kstep; const char* b3 = b2 + kstep;
            PG8_LDB(B0, 0, 0); PG8_LDB(B1, 0, 1); PG8_SCHED; PG8_LDA(At, 0, 0); PG8_STAGE(PG8_SA(1, 1), a1 + hstep, voffA);
            PG8_WAIT_V(8); PG8_WAIT_L(0); PG8_BAR; PG8_MMA(0, 0, At, B0); PG8_MMA(0, 1, At, B1); PG8_BAR; PG8_SCHED;
            PG8_LDA(At, 0, 1); PG8_STAGE(PG8_SB(0, 0), b2, voffB); PG8_STAGE(PG8_SB(0, 1), b2 + hstep, voffB); PG8_STAGE(PG8_SA(0, 0), a2, voffA);
            PG8_WAIT_V(8); PG8_WAIT_L(0); PG8_BAR; PG8_MMA(1, 0, At, B0); PG8_MMA(1, 1, At, B1); PG8_BAR; PG8_SCHED;
            PG8_LDB(B0, 1, 0); PG8_LDB(B1, 1, 1); PG8_SCHED; PG8_LDA(At, 1, 0); PG8_STAGE(PG8_SA(0, 1), a2 + hstep, voffA);
            PG8_WAIT_V(8); PG8_WAIT_L(0); PG8_BAR; PG8_MMA(0, 0, At, B0); PG8_MMA(0, 1, At, B1); PG8_BAR; PG8_SCHED;
            PG8_LDA(At, 1, 1); PG8_STAGE(PG8_SB(1, 0), b3, voffB); PG8_STAGE(PG8_SB(1, 1), b3 + hstep, voffB); PG8_STAGE(PG8_SA(1, 0), a3, voffA);
            PG8_WAIT_V(8); PG8_WAIT_L(0); PG8_BAR; PG8_MMA(1, 0, At, B0); PG8_MMA(1, 1, At, B1); PG8_BAR; PG8_SCHED;
        }
        if (wr == 0) PG8_BAR;
        int fr2 = fr, fq2 = fq; asm volatile("" : "+v"(fr2), "+v"(fq2));
        const bool zero = E(acc, cur, wr, wc, fr2, fq2);
        if (!has_next) break;
        if (zero) {
#pragma unroll
            for (int a = 0; a < 2; ++a)
#pragma unroll
                for (int b = 0; b < 2; ++b)
#pragma unroll
                    for (int m = 0; m < 4; ++m)
#pragma unroll
                        for (int n = 0; n < 2; ++n) acc[a][b][m][n] = (f32x4){0.f, 0.f, 0.f, 0.f};
        }
        cur = nxt; cA = nA; cB = nB; ++ui;
        if (wr == 1) PG8_BAR;
    }
    PG8_WAIT_V(0);
    PG8_BAR;
#undef PG8_SA
#undef PG8_SB
#undef PG8_STAGE
#undef PG8_LDA
#undef PG8_LDB
#undef PG8_MMA
#undef PG8_WAIT_V
#undef PG8_WAIT_L
#undef PG8_BAR
#undef PG8_SCHED
}
#define XB_TMO      128
#define XB_XCNT(j)  (256  + 64 * (j))
#define XB_XSUB(j)  (1280 + 64 * (j))
#define XB_XGEN(j)  (2304 + 64 * (j))
#define XB_TOP      3328
#define XB_TOPGEN   3392
#define XCD_BAR_WORDS 3456
#define XB_SPIN_CAP (1u << 20)
__device__ __forceinline__ unsigned xb_ld(unsigned* p)              { return __hip_atomic_load(p, __ATOMIC_RELAXED, __HIP_MEMORY_SCOPE_AGENT); }
__device__ __forceinline__ unsigned xb_add(unsigned* p, unsigned v) { return __hip_atomic_fetch_add(p, v, __ATOMIC_RELAXED, __HIP_MEMORY_SCOPE_AGENT); }
__device__ __forceinline__ unsigned xb_xcc_id() { return (unsigned)__builtin_amdgcn_s_getreg((3 << 11) | 20) & 0xFu; }
#define XB_SPIN(cond, bar) do { unsigned _sp = 0; while (cond) { __builtin_amdgcn_s_sleep(1); \
    if ((++_sp & 255u) == 0u) { if (xb_ld(&(bar)[XB_TMO])) break; if (_sp > XB_SPIN_CAP) { atomicAdd(&(bar)[XB_TMO], 1u); break; } } } } while (0)
struct XcdBarrier { unsigned* bar; unsigned x; volatile FK_LAS unsigned* st; };
__device__ __forceinline__ XcdBarrier xcd_barrier_post(unsigned* bar, volatile FK_LAS unsigned* st) {
    XcdBarrier b; b.bar = bar; b.x = xb_xcc_id(); b.st = st;
    if (threadIdx.x == 0) (void)xb_add(&bar[XB_XCNT(b.x)], 1u);
    return b;
}
__device__ __forceinline__ void xcd_barrier_complete(unsigned* bar, unsigned x, unsigned& nloc, unsigned& nx) {
    const unsigned G = gridDim.x * gridDim.y * gridDim.z;
    unsigned sum, cnt, mine, sp = 0u;
    for (;;) {
        sum = 0u; cnt = 0u; mine = 0u;
#pragma unroll
        for (unsigned j = 0; j < 16; ++j) { const unsigned c = xb_ld(&bar[XB_XCNT(j)]); sum += c; cnt += (c > 0u) ? 1u : 0u; mine = (j == x) ? c : mine; }
        if (sum == G) break;
        __builtin_amdgcn_s_sleep(1);
        if ((++sp & 255u) == 0u) { if (xb_ld(&bar[XB_TMO])) break; if (sp > XB_SPIN_CAP) { atomicAdd(&bar[XB_TMO], 1u); break; } }
    }
    nloc = mine > 0u ? mine : 1u; nx = cnt > 0u ? cnt : 1u;
}
__device__ __forceinline__ void xcd_barrier(const XcdBarrier& b) {
    asm volatile("s_waitcnt vmcnt(0)" ::: "memory");
    __syncthreads();
    if (threadIdx.x == 0) {
        unsigned* bar = b.bar;
        __builtin_amdgcn_s_waitcnt(0);
        unsigned nloc = b.st[0], nx = b.st[1];
        if (nloc == 0u) { xcd_barrier_complete(bar, b.x, nloc, nx); b.st[0] = nloc; b.st[1] = nx; }
        const unsigned old = xb_add(&bar[XB_XSUB(b.x)], 1u);
        const unsigned gen = old / nloc;
        if (old + 1u == (gen + 1u) * nloc) {
            __builtin_amdgcn_fence(__ATOMIC_RELEASE, "agent");
            asm volatile("s_waitcnt vmcnt(0)" ::: "memory");
            const unsigned og = xb_add(&bar[XB_TOP], 1u);
            const unsigned tg = og / nx;
            if (og + 1u == (tg + 1u) * nx) xb_add(&bar[XB_TOPGEN], 1u);
            else XB_SPIN(xb_ld(&bar[XB_TOPGEN]) == tg, bar);
            __builtin_amdgcn_fence(__ATOMIC_ACQUIRE, "agent");
            xb_add(&bar[XB_XGEN(b.x)], 1u);
            asm volatile("s_waitcnt vmcnt(0)" ::: "memory");
        } else {
            XB_SPIN(xb_ld(&bar[XB_XGEN(b.x)]) == gen, bar);
            __builtin_amdgcn_fence(__ATOMIC_ACQUIRE, "agent");
            asm volatile("s_waitcnt vmcnt(0)" ::: "memory");
        }
    }
    __syncthreads();
}

struct Args { const float* in[30]; float* out; unsigned char* ws; float* xl; int ph_lo, ph_hi, use_bar, pad; };
constexpr int LDS_MISC = 155648, LDS_BYTES = 155648 + 256;

struct Ctx {
    const Args* a; FK_LAS unsigned char* lds; int tid, lane, wave, vcu, G;
};
typedef const Args __attribute__((address_space(4)))* AP;
#define FIN(i) (A->in[i])
template <class T> __device__ __forceinline__ T* wsp(AP A, size_t off) { return (T*)(A->ws + off); }
__device__ __forceinline__ int opaque_tid() { int t = threadIdx.x; asm volatile("" : "+v"(t)); return t; }
__device__ __forceinline__ AP opaque_args(AP a) { asm volatile("" : "+s"(a)); return a; }

__device__ __forceinline__ int inproj_src_col(int p) {
    if (p < R_FZ) return p;
    if (p >= R_V) return p - R_V + 2048;
    const int q0 = p - R_Q, tile = q0 >> 8, pl = q0 & 255;
    const int bj = pl >> 7, wc = (pl >> 5) & 3, fq = (pl >> 3) & 3, e = pl & 7;
    return 1024 + tile * 256 + 64 * wc + 32 * (fq >> 1) + 16 * bj + 8 * (fq & 1) + e;
}
template <class ColFn>
__device__ __forceinline__ void transpose_item(const float* src, int ldsrc, int ksrc0, bf16_t* dst, int Kd, int p0, int k0, FK_LAS float* scr, int lane, ColFn col) {
    const int cidx = col(p0 + (lane & 31));
    float tv[32];
#pragma unroll
    for (int i = 0; i < 32; ++i) tv[i] = src[(size_t)(ksrc0 + k0 + 2 * i + (lane >> 5)) * ldsrc + cidx];
#pragma unroll
    for (int i = 0; i < 32; ++i) scr[(2 * i + (lane >> 5)) * 33 + (lane & 31)] = tv[i];
    asm volatile("s_waitcnt lgkmcnt(0)" ::: "memory");
    const int c = lane & 7;
#pragma unroll
    for (int j = 0; j < 4; ++j) { const int n = (lane >> 3) + 8 * j; const FK_LAS float* s = scr + (8 * c) * 33 + n;
        u32x4 o; o.x = pk2(s[0 * 33], s[1 * 33]); o.y = pk2(s[2 * 33], s[3 * 33]); o.z = pk2(s[4 * 33], s[5 * 33]); o.w = pk2(s[6 * 33], s[7 * 33]);
        *(u32x4*)(dst + (size_t)(p0 + n) * Kd + k0 + 8 * c) = o; }
    asm volatile("s_waitcnt lgkmcnt(0)" ::: "memory");
}
struct IdCol { int off; __device__ int operator()(int p) const { return p + off; } };
struct InprojCol { __device__ int operator()(int p) const { return inproj_src_col(p); } };

__device__ __forceinline__ void phase_pa(AP A, FK_LAS unsigned char* lds, int vcu, int G) {
    const int tid = opaque_tid(), lane = tid & 63, wave = __builtin_amdgcn_readfirstlane(tid >> 6);
    const int gw = vcu * NWAVES + wave, NGW = G * NWAVES;
    const size_t gt = (size_t)vcu * NTHR + tid, NGT = (size_t)G * NTHR;
    float* misc = wsp<float>(A, W.misc);
    FK_LAS float* ctab = (FK_LAS float*)(lds + 131072); FK_LAS float* stab = ctab + 2048;
    for (int i = tid; i < 2048; i += NTHR) { const float a = (float)i * (2.f / 2048.f); ctab[i] = cospif(a); stab[i] = sinpif(a); }
    __syncthreads();
    if (vcu == 0) {
        if (tid < 2) { const float* p = FIN(20) + tid * 256; float a = 0.f, b = 0.f;
            for (int i = 0; i < 64; ++i) { a += p[i] * p[64 + i]; b += p[128 + i] * p[192 + i]; }
            misc[MI_LAM + tid] = expf(a) - expf(b) + (0.8f - 0.6f * expf(-0.3f * (float)tid)); }
        for (int i = tid; i < 64 * 16; i += NTHR) { const int pos = i >> 4, e = i & 15; const float inv = powf(10000.f, -(float)(2 * e) / 32.f), ang = (float)pos * inv;
            misc[MI_ROPE + 2 * i] = cosf(ang); misc[MI_ROPE + 2 * i + 1] = sinf(ang); }
    }
    {
        FK_LAS float* s = (FK_LAS float*)lds;
        FK_LAS float* red = (FK_LAS float*)(lds + 9 * 1024 * 4);
        bool have = false;
        for (int it = vcu; it < 192; it += G) {
            if (!have) { for (int i = tid; i < 9 * 1024; i += NTHR) { const int r = i >> 10, k = i & 1023; const float v = r < 8 ? FIN(1)[r * 1024 + k] : FIN(3)[k]; s[i] = v / (1.f + expf(-v)); } __syncthreads(); have = true; }
            const int l = it / 96, n0 = (it % 96) * 64, kq = tid >> 6, c = tid & 63;
            const float* Wp = FIN(4) + (size_t)l * 1024 * 6144 + n0 + c;
            float acc[9];
#pragma unroll
            for (int r = 0; r < 9; ++r) acc[r] = 0.f;
#pragma unroll 1
            for (int k0 = kq * 128; k0 < kq * 128 + 128; k0 += 16) { float wv[16];
#pragma unroll
                for (int j = 0; j < 16; ++j) wv[j] = Wp[(size_t)(k0 + j) * 6144];
#pragma unroll
                for (int j = 0; j < 16; ++j)
#pragma unroll
                    for (int r = 0; r < 9; ++r) acc[r] += s[r * 1024 + k0 + j] * wv[j]; }
#pragma unroll
            for (int r = 0; r < 9; ++r) red[(kq * 9 + r) * 64 + c] = acc[r];
            __syncthreads();
            for (int i = tid; i < 9 * 64; i += NTHR) { const int r = i >> 6, cc = i & 63; float t = 0.f;
#pragma unroll
                for (int q = 0; q < 8; ++q) t += red[(q * 9 + r) * 64 + cc];
                wsp<float>(A, W.mod)[((size_t)l * 9 + r) * 6144 + n0 + cc] = t + FIN(5)[l * 6144 + n0 + cc]; }
            __syncthreads();
        }
        __syncthreads();
    }
    {
        FK_LAS float* scr = (FK_LAS float*)(lds + wave * 16384);
        constexpr int I_IN = (PINF / 32) * 16;
        constexpr int I_M = (1024 / 32) * 4;
        constexpr int I_O = (1024 / 32) * 16, I_Q = (2048 / 32) * 16;
        constexpr int PER_L = I_IN + 4 * I_M + I_O + I_Q;
        for (int it = gw; it < 2 * PER_L; it += NGW) {
            const int l = it / PER_L; int r = it % PER_L;
            if (r < I_IN) { const int p0 = (r >> 4) * 32, k0 = (r & 15) * 64;
                if (p0 >= R_FZ && p0 < R_Q) continue;
                transpose_item(FIN(8) + (size_t)l * 1024 * 5632, 5632, 0, wsp<bf16_t>(A, W.w_in) + (size_t)l * PINF * 1024, 1024, p0, k0, scr, lane, InprojCol{}); continue; }
            r -= I_IN;
            if (r < 4 * I_M) { const int seg = r / I_M, q = r % I_M, p0 = (q >> 2) * 32, k0 = (q & 3) * 64;
                const float* src = seg == 0 ? FIN(22) + (size_t)l * 256 * 1024 : seg == 1 ? FIN(23) + (size_t)l * 256 * 1024 : FIN(24) + (size_t)l * 512 * 1024;
                transpose_item(src, 1024, seg == 3 ? 256 : 0, wsp<bf16_t>(A, W.w_mrg) + ((size_t)l * 4 + seg) * 1024 * 256, 256, p0, k0, scr, lane, IdCol{0}); continue; }
            r -= 4 * I_M;
            if (r < I_O) { const int p0 = (r >> 4) * 32, k0 = (r & 15) * 64;
                transpose_item(FIN(25) + (size_t)l * 1024 * 1024, 1024, 0, wsp<bf16_t>(A, W.w_out) + (size_t)l * 1024 * 1024, 1024, p0, k0, scr, lane, IdCol{0}); continue; }
            r -= I_O;
            { const int p0 = (r >> 4) * 32, k0 = (r & 15) * 64;
                transpose_item(FIN(26) + (size_t)l * 1024 * 2048, 2048, 0, wsp<bf16_t>(A, W.w_q) + (size_t)l * 2048 * 1024, 1024, p0, k0, scr, lane, IdCol{0}); }
        }
    }
    for (size_t i = gt; i < (size_t)1 << 17; i += NGT) {
        const int k = (int)(i & 1023), mc = (int)((i >> 10) & 7), part = (int)((i >> 13) & 1), g = (int)((i >> 14) & 3), l = (int)(i >> 16);
        const float* src = FIN(8) + (size_t)l * 1024 * 5632 + (size_t)k * 5632 + 768 + g * 64;
        f32x4 sv[16];
#pragma unroll
        for (int q = 0; q < 16; ++q) sv[q] = *(const f32x4*)(src + 4 * q);
        const FK_LAS float* tb = part ? stab : ctab;
        bf16_t* dst = wsp<bf16_t>(A, W.w_in) + ((size_t)l * PINF + R_FZ + part * 256 + g * 64 + mc * 8) * 1024 + k;
#pragma unroll 1
        for (int mm = 0; mm < 8; ++mm) { const int m = mc * 8 + mm; float acc = 0.f;
#pragma unroll
            for (int q = 0; q < 16; ++q)
#pragma unroll
                for (int j = 0; j < 4; ++j) acc += sv[q][j] * tb[((m * (4 * q + j)) & 63) * 32];
            dst[(size_t)mm * 1024] = (bf16_t)f2bf(acc); }
    }
    {
        const size_t nUV = (size_t)16384 * 1024 / 16, nK = (size_t)2 * 16 * 128 * 128 / 8;
        for (size_t i0 = gt; i0 < 2 * nUV + nK; i0 += 2 * NGT) {
#pragma unroll
            for (int rep = 0; rep < 2; ++rep) { const size_t i = i0 + rep * NGT; if (i >= 2 * nUV + nK) break;
                if (i < nUV) cvt16_fp8(FIN(28) + i * 16, wsp<unsigned char>(A, W.ub) + tab_chunk_off(i), SU);
                else if (i < 2 * nUV) cvt16_fp8(FIN(29) + (i - nUV) * 16, wsp<unsigned char>(A, W.vb) + tab_chunk_off(i - nUV), SV);
                else { const size_t j = i - 2 * nUV; const float* src = FIN(27); bf16_t* dst = wsp<bf16_t>(A, W.keys);
                    const f32x4 x0 = *(const f32x4*)(src + j * 8), x1 = *(const f32x4*)(src + j * 8 + 4);
                    u32x4 o; o.x = pk2(x0[0], x0[1]); o.y = pk2(x0[2], x0[3]); o.z = pk2(x1[0], x1[1]); o.w = pk2(x1[2], x1[3]);
                    *(u32x4*)(dst + j * 8) = o; } }
        }
    }
    for (size_t i = gt; i < (size_t)2048 * 2048 + 256 * 256; i += NGT) {
        const bool big = i < (size_t)2048 * 2048; const size_t j = big ? i : i - (size_t)2048 * 2048; const int L = big ? 2048 : 256, lg = big ? 11 : 8;
        const int k = (int)(j >> lg), t = (int)(j & (L - 1)); const int ti = ((k * t) & (L - 1)) * (2048 / L); const float sc = rsqrtf(64.f * (float)L);
        bf16_t* d = big ? wsp<bf16_t>(A, W.dftl) : wsp<bf16_t>(A, W.dftc);
        d[(size_t)k * 2 * L + t] = (bf16_t)f2bf(sc * ctab[ti]); d[(size_t)k * 2 * L + L + t] = (bf16_t)f2bf(-sc * stab[ti]);
    }
    {
        constexpr int HPP = 4;
        FK_LAS float* h1 = (FK_LAS float*)lds; FK_LAS float* h2 = h1 + HPP * 64; FK_LAS float* ft = h2 + HPP * 64;
        FK_LAS float* w1s = ft + HPP * 33 + 4; FK_LAS float* w2s = w1s + 33 * 64; FK_LAS float* b1s = w2s + 64 * 64; FK_LAS float* b2s = b1s + 64; FK_LAS float* fqs = b2s + 64;
        constexpr int IT_L = 2048 / HPP, IT_C = 256 / HPP, PER = IT_L + IT_C;
        int lcur = -1;
        for (int it = vcu; it < 2 * PER; it += G) {
            const int l = it / PER, r = it % PER, big = r < IT_L, L = big ? 2048 : 256, p0 = (big ? r : r - IT_L) * HPP;
            __syncthreads();
            if (l != lcur) { lcur = l;
                for (int i = tid; i < 33 * 64; i += NTHR) w1s[i] = FIN(11)[l * 33 * 64 + i];
                for (int i = tid; i < 64 * 64; i += NTHR) w2s[i] = FIN(14)[l * 4096 + i];
                if (tid < 64) { b1s[tid] = FIN(12)[l * 64 + tid]; b2s[tid] = FIN(15)[l * 64 + tid]; fqs[tid] = FIN(13)[l * 64 + tid]; } }
            for (int i = tid; i < HPP * 33; i += NTHR) { const int pp = i / 33, e = i % 33, pos = p0 + pp; const float t = (float)pos / (float)(L - 1), w = 2.0f * 3.14159265358979323846f * (float)pos / (float)L;
                float v; if (e == 0) v = t; else { const int b = (e - 1) & 15; const float f = 1e-4f + (float)b * ((15.f - 1e-4f) / 15.f), a = w * f; v = e <= 16 ? cosf(a) : -sinf(a); }
                ft[i] = v; }
            __syncthreads();
            for (int i = tid; i < HPP * 64; i += NTHR) { const int pp = i >> 6, j = i & 63; float acc = 0.f;
                for (int e = 0; e < 33; ++e) acc += ft[pp * 33 + e] * w1s[e * 64 + j];
                h1[i] = sinf(fqs[j] * (acc + b1s[j])); }
            __syncthreads();
            for (int i = tid; i < HPP * 64; i += NTHR) { const int pp = i >> 6, j = i & 63; float acc = 0.f;
                for (int e = 0; e < 64; ++e) acc += h1[pp * 64 + e] * w2s[e * 64 + j];
                h2[i] = sinf(fqs[j] * (acc + b2s[j])); }
            __syncthreads();
            float* H3 = big ? wsp<float>(A, W.h3l) + (size_t)l * 2048 * 1024 : wsp<float>(A, W.h3c) + (size_t)l * 256 * 1024;
            float* part = misc + MI_HYPART + ((size_t)(l * 2 + (big ? 0 : 1)) * IT_L + (big ? r : r - IT_L)) * 1024;
#pragma unroll
            for (int cc = 0; cc < 2; ++cc) { const int col = tid + cc * 512, ch = col & 255;
                const float mn = -3.0701134573253946f, mx = -15.350567286626973f; const float delta = fabsf(mn + (float)ch * ((mx - mn) / 255.f));
                float acc[HPP];
#pragma unroll
                for (int pp = 0; pp < HPP; ++pp) acc[pp] = 0.f;
                const float* w3 = FIN(16) + (size_t)l * 65536 + col;
#pragma unroll 1
                for (int e0 = 0; e0 < 64; e0 += 16) { float wv[16];
#pragma unroll
                    for (int j = 0; j < 16; ++j) wv[j] = w3[(size_t)(e0 + j) * 1024];
#pragma unroll
                    for (int j = 0; j < 16; ++j)
#pragma unroll
                        for (int pp = 0; pp < HPP; ++pp) acc[pp] += h2[pp * 64 + e0 + j] * wv[j]; }
                float ps = 0.f;
#pragma unroll
                for (int pp = 0; pp < HPP; ++pp) { const int pos = p0 + pp; const float v = acc[pp] * expf(-((float)pos / (float)(L - 1)) * delta); H3[(size_t)pos * 1024 + col] = v;
                    if (!(col >= 512 && pos == 0)) ps += fabsf(v); }
                part[col] = ps; }
        }
        __syncthreads();
    }
}
__device__ __forceinline__ void modulate_row_bf16(const float* xrow, const float* g, const float* scale, const float* shift, bf16_t* orow, int lane) {
    f32x4 v[4]; float ss = 0.f;
#pragma unroll
    for (int j = 0; j < 4; ++j) { v[j] = *(const f32x4*)(xrow + 4 * lane + 256 * j); ss += (v[j][0] * v[j][0] + v[j][1] * v[j][1]) + (v[j][2] * v[j][2] + v[j][3] * v[j][3]); }
    ss = wave_sum(ss); const float rs = rsqrtf(ss * (1.f / 1024.f) + EPS);
#pragma unroll
    for (int j = 0; j < 4; ++j) { const int k = 4 * lane + 256 * j; const f32x4 gg = *(const f32x4*)(g + k), sc = *(const f32x4*)(scale + k), sf = *(const f32x4*)(shift + k);
        const f32x4 o = v[j] * rs * gg * (sc + 1.0f) + sf; u32x2 w; w.x = pk2(o[0], o[1]); w.y = pk2(o[2], o[3]); *(u32x2*)(orow + k) = w; }
}
__device__ __forceinline__ void phase_pb(AP A, int vcu, int G) {
    const int tid = opaque_tid(), lane = tid & 63, wave = __builtin_amdgcn_readfirstlane(tid >> 6); (void)tid;
    const int gw = vcu * NWAVES + wave, NGW = G * NWAVES;
    const float* mod = wsp<float>(A, W.mod);
    for (int t = gw; t < NTOK; t += NGW) {
        const bool lat = t < NLAT; const int mr = lat ? t / SEQ : 8;
        const float* xr = lat ? FIN(0) + (size_t)t * DM : FIN(2) + (size_t)(t - NLAT) * DM;
        modulate_row_bf16(xr, FIN(6), mod + (size_t)mr * 6144 + 1024, mod + (size_t)mr * 6144, wsp<bf16_t>(A, W.xn) + (size_t)t * DM, lane);
    }
    const float* misc = wsp<float>(A, W.misc);
    for (int row = gw; row < 2 * 2 * 512; row += NGW) {
        const int l = row >> 10, big = ((row >> 9) & 1) == 0, oc = row & 511, L = big ? 2048 : 256, TLn = big ? TLL : TLC, nit = big ? 512 : 64;
        const float* part = misc + MI_HYPART + (size_t)(l * 2 + (big ? 0 : 1)) * 512 * 1024;
        float s = 0.f; for (int i = lane; i < nit; i += 64) s += part[(size_t)i * 1024 + oc] + part[(size_t)i * 1024 + 512 + oc];
        s = wave_sum(s); const float inv = 1.f / s;
        const float* H3 = big ? wsp<float>(A, W.h3l) + (size_t)l * 2048 * 1024 : wsp<float>(A, W.h3c) + (size_t)l * 256 * 1024;
        bf16_t* TL = big ? wsp<bf16_t>(A, W.tapl) + ((size_t)l * 512 + oc) * TLL : wsp<bf16_t>(A, W.tapc) + ((size_t)l * 512 + oc) * TLC;
        const int c = L + 32;
        for (int y0 = 0; y0 < TLn; y0 += 64 * 8) { float tv[8];
#pragma unroll
            for (int j = 0; j < 8; ++j) { const int y = y0 + 64 * j + lane, m = c - y, am = m < 0 ? -m : m; const bool ok = (y < TLn) && (am < L);
                const float v = H3[ok ? (size_t)am * 1024 + (m < 0 ? 512 : 0) + oc : (size_t)oc];
                tv[j] = ok ? v : 0.f; }
#pragma unroll
            for (int j = 0; j < 8; ++j) { const int y = y0 + 64 * j + lane; if (y < TLn) TL[y] = (bf16_t)f2bf(tv[j] * inv); } }
    }
}

constexpr int NTT = NTOK / 256, NTL = NLAT / 256;
struct InprojSched {
    int l, G, c; const char* xn; const char* w;
    __device__ bool next(int i, Unit& u) const {
        const long Li = (long)i * G + c;
        const int nM = (l == 0) ? NTT : NTL, nN = 23, nwg = nM * nN;
        if (Li < nwg) {
            int wgid = (int)Li; { const int q = nwg / 8, r = nwg % 8, xcd = wgid % 8, off = wgid / 8; wgid = (xcd < r ? xcd * (q + 1) : r * (q + 1) + (xcd - r) * q) + off; }
            const int nig = 8 * nN, gid = wgid / nig, fm = gid * 8, gsz = (nM - fm) < 8 ? (nM - fm) : 8;
            u.pm = fm + ((wgid % nig) % gsz); u.pn = (wgid % nig) / gsz;
        } else {
            const int r2 = (int)(Li - nwg); if (l == 0 || r2 >= (NTT - NTL) * 4) return false;
            u.pm = NTL + r2 / 4; u.pn = 7 + (r2 & 3);
        }
        const int pn = u.pn; u.kind = pn < 3 ? 0 : pn < 5 ? 1 : pn < 9 ? 2 : pn < 11 ? 3 : 4;
        const char* at = xn + (size_t)u.pm * 256 * 1024 * 2; const char* wt = w + (size_t)pn * 256 * 1024 * 2;
        const bool swapped = (u.kind == 0 || u.kind == 1 || u.kind == 3);
        u.a = swapped ? wt : at; u.b = swapped ? at : wt; u.aux = 0; return true;
    }
};
struct InprojEpi {
    int l; bf16_t *hyt, *ftl, *ftc, *q, *qc, *k, *vt, *g; const float *gq, *gk, *rope;
    __device__ __forceinline__ bool operator()(Acc& acc, const Unit& u, int wr, int wc, int fr, int fq) const {
        const int pm = u.pm, pn = u.pn;
        if (u.kind == 0 || u.kind == 1 || u.kind == 3) {
            const bool lat = pm < NTL; const int b = lat ? pm >> 3 : pm - NTL;
#pragma unroll
            for (int bj = 0; bj < 2; ++bj) {
                const int tl = 128 * bj + 32 * wc + 8 * fq;
                bf16_t* base; size_t rstride;
                if (u.kind == 0) { base = hyt + (size_t)(pn * 256) * NTOK + (size_t)pm * 256 + tl; rstride = NTOK; }
                else if (u.kind == 1) { const int part = pn - 3;
                    if (lat) { base = ftl + (size_t)b * 256 * 4096 + part * 2048 + (pm & 7) * 256 + tl; rstride = 4096; }
                    else { base = ftc + (size_t)b * 256 * 512 + part * 256 + tl; rstride = 512; } }
                else { base = vt + ((size_t)b * 512 + (pn - 9) * 256) * KALL + (lat ? (pm & 7) * 256 : SEQ) + tl; rstride = KALL; }
#pragma unroll
                for (int ai = 0; ai < 2; ++ai)
#pragma unroll
                    for (int m = 0; m < 4; ++m) { const int r = 128 * ai + 64 * wr + 16 * m + fr; const f32x4 v0 = acc[ai][bj][m][0], v1 = acc[ai][bj][m][1];
                        u32x4 w; w.x = cvt_pk_bf16(v0[0], v0[1]); w.y = cvt_pk_bf16(v0[2], v0[3]); w.z = cvt_pk_bf16(v1[0], v1[1]); w.w = cvt_pk_bf16(v1[2], v1[3]);
                        *(u32x4*)(base + (size_t)r * rstride) = w; }
            }
        } else if (u.kind == 4) {
#pragma unroll
            for (int ai = 0; ai < 2; ++ai)
#pragma unroll
                for (int m = 0; m < 4; ++m) { const int t = pm * 256 + 128 * ai + 64 * wr + 16 * m + fr;
#pragma unroll
                    for (int bj = 0; bj < 2; ++bj) { const int cg = (pn - 11) * 256 + 128 * bj + 32 * wc + 8 * fq; f32x4 v0 = acc[ai][bj][m][0], v1 = acc[ai][bj][m][1];
#pragma unroll
                        for (int j = 0; j < 4; ++j) { v0[j] = __builtin_amdgcn_rcpf(1.f + __builtin_amdgcn_exp2f(-1.4426950408889634f * v0[j])); v1[j] = __builtin_amdgcn_rcpf(1.f + __builtin_amdgcn_exp2f(-1.4426950408889634f * v1[j])); }
                        u32x4 w; w.x = cvt_pk_bf16(v0[0], v0[1]); w.y = cvt_pk_bf16(v0[2], v0[3]); w.z = cvt_pk_bf16(v1[0], v1[1]); w.w = cvt_pk_bf16(v1[2], v1[3]);
                        *(u32x4*)(g + (size_t)t * 3072 + cg) = w; } }
        } else {
            const int which = (pn - 5) >> 1, grp = ((pn - 5) & 1) * 4 + wc, h = grp >> 1, map = grp & 1;
            const int d0 = 32 * (fq >> 1) + 8 * (fq & 1);
            const float* gp = (which ? gk : gq) + map * 64 + d0;
            const f32x4 g00 = *(const f32x4*)(gp), g01 = *(const f32x4*)(gp + 4), g10 = *(const f32x4*)(gp + 16), g11 = *(const f32x4*)(gp + 20);
            const bool lat = pm < NTL; const int b = lat ? pm >> 3 : pm - NTL;
#pragma unroll
            for (int ai = 0; ai < 2; ++ai)
#pragma unroll
                for (int m = 0; m < 4; ++m) {
                    const int rl = 128 * ai + 64 * wr + 16 * m + fr;
                    f32x4 a0 = acc[ai][0][m][0], a1 = acc[ai][0][m][1], b0 = acc[ai][1][m][0], b1 = acc[ai][1][m][1];
                    float ss = 0.f;
#pragma unroll
                    for (int j = 0; j < 4; ++j) ss += a0[j] * a0[j] + a1[j] * a1[j] + b0[j] * b0[j] + b1[j] * b1[j];
                    ss += __shfl_xor(ss, 16); ss += __shfl_xor(ss, 32);
                    const float rs = rsqrtf(ss * (1.f / 64.f) + EPS);
                    a0 = a0 * rs * g00; a1 = a1 * rs * g01; b0 = b0 * rs * g10; b1 = b1 * rs * g11;
                    bf16_t* dst;
                    if (lat) { const int pos = (pm & 7) * 256 + rl; const int pa = (fq >> 1) ? (pos & 63) : (pos >> 6);
                        const float* rp = rope + ((size_t)pa * 16 + 8 * (fq & 1)) * 2;
                        const f32x4 r0 = *(const f32x4*)(rp), r1 = *(const f32x4*)(rp + 4), r2 = *(const f32x4*)(rp + 8), r3 = *(const f32x4*)(rp + 12);
                        const float cs[8] = {r0[0], r0[2], r1[0], r1[2], r2[0], r2[2], r3[0], r3[2]}, sn[8] = {r0[1], r0[3], r1[1], r1[3], r2[1], r2[3], r3[1], r3[3]};
#pragma unroll
                        for (int j = 0; j < 4; ++j) { const float x1 = a0[j], x2 = b0[j]; a0[j] = x1 * cs[j] - x2 * sn[j]; b0[j] = x2 * cs[j] + x1 * sn[j];
                            const float y1 = a1[j], y2 = b1[j]; a1[j] = y1 * cs[4 + j] - y2 * sn[4 + j]; b1[j] = y2 * cs[4 + j] + y1 * sn[4 + j]; }
                        dst = which ? k + (((size_t)(b * 4 + h) * 2 + map) * KALL + pos) * 64 : q + (((size_t)(b * 4 + h) * 2 + map) * SEQ + pos) * 64;
                    } else dst = which ? k + (((size_t)(b * 4 + h) * 2 + map) * KALL + SEQ + rl) * 64 : qc + (((size_t)(b * 4 + h) * 2 + map) * CTX + rl) * 64;
                    u32x4 w0, w1; w0.x = cvt_pk_bf16(a0[0], a0[1]); w0.y = cvt_pk_bf16(a0[2], a0[3]); w0.z = cvt_pk_bf16(a1[0], a1[1]); w0.w = cvt_pk_bf16(a1[2], a1[3]);
                    w1.x = cvt_pk_bf16(b0[0], b0[1]); w1.y = cvt_pk_bf16(b0[2], b0[3]); w1.z = cvt_pk_bf16(b1[0], b1[1]); w1.w = cvt_pk_bf16(b1[2], b1[3]);
                    *(u32x4*)(dst + d0) = w0; *(u32x4*)(dst + d0 + 16) = w1;
                }
        }
        return true;
    }
};
__device__ __forceinline__ void phase_inproj(AP A, FK_LAS unsigned char* lds, int l, int G) {
    InprojSched S{l, G, (int)blockIdx.x, (const char*)wsp<bf16_t>(A, W.xn), (const char*)(wsp<bf16_t>(A, W.w_in) + (size_t)l * PINF * 1024)};
    InprojEpi E{l, wsp<bf16_t>(A, W.hyt), wsp<bf16_t>(A, W.ftl), wsp<bf16_t>(A, W.ftc), wsp<bf16_t>(A, W.q), wsp<bf16_t>(A, W.qc), wsp<bf16_t>(A, W.k), wsp<bf16_t>(A, W.vt), wsp<bf16_t>(A, W.g),
                FIN(18) + l * 128, FIN(19) + l * 128, wsp<float>(A, W.misc) + MI_ROPE};
    gemm_phase(lds, 1024, S, E);
}
#define FK_HAVE_MIX 1
namespace attn {
constexpr float SCALE = 0.125f, THR = 8.f;
constexpr int KVBLK = 64;
constexpr int SHM_V = 128 * 64 * 2, SHM_K = 64 * 64 * 2;
constexpr int OFF_V = 0, OFF_K = 2 * SHM_V, OFF_WS = 2 * SHM_V + 2 * SHM_K;
#define ASWZ(row, cb) ((row) * 128 + ((cb) ^ ((((row) >> 1) & 7) << 4)))
#define SBAR() __builtin_amdgcn_sched_barrier(0)
__device__ __forceinline__ int crow(int r, int hi) { return (r & 3) + 8 * (r >> 2) + 4 * hi; }
__device__ __forceinline__ void partialSM(f32x16& p0, f32x16& p1, float& m_reg, float& mn, float& alpha) {
    constexpr float C = SCALE * 1.4426950408889634f;
    float pmax = p0[0];
#pragma unroll
    for (int r = 1; r < 16; ++r) pmax = fmaxf(pmax, p0[r]);
#pragma unroll
    for (int r = 0; r < 16; ++r) pmax = fmaxf(pmax, p1[r]);
    { auto rr = __builtin_amdgcn_permlane32_swap(__float_as_uint(pmax), __float_as_uint(pmax), false, false);
      pmax = fmaxf(__uint_as_float(rr[0]), __uint_as_float(rr[1])); }
    if (__builtin_expect(__all(pmax - m_reg <= THR / SCALE), 1)) { mn = m_reg; alpha = 1.f; }
    else { mn = fmaxf(m_reg, pmax); alpha = __builtin_amdgcn_exp2f((m_reg - mn) * C); m_reg = mn; }
    const float mnC = -mn * C;
#pragma unroll
    for (int r = 0; r < 16; ++r) p0[r] = fmaf(p0[r], C, mnC);
#pragma unroll
    for (int r = 0; r < 16; ++r) p1[r] = fmaf(p1[r], C, mnC);
#pragma unroll
    for (int r = 0; r < 16; ++r) p0[r] = __builtin_amdgcn_exp2f(p0[r]);
}
__device__ __forceinline__ void finishSM(f32x16& p0, f32x16& p1, float alpha, float& l_reg, bf16x8& pa0, bf16x8& pa1, bf16x8& pa2, bf16x8& pa3) {
#pragma unroll
    for (int r = 0; r < 16; ++r) p1[r] = __builtin_amdgcn_exp2f(p1[r]);
    float ps = 0;
#pragma unroll
    for (int r = 0; r < 16; ++r) ps += p0[r];
#pragma unroll
    for (int r = 0; r < 16; ++r) ps += p1[r];
    { auto rr = __builtin_amdgcn_permlane32_swap(__float_as_uint(ps), __float_as_uint(ps), false, false);
      ps = __uint_as_float(rr[0]) + __uint_as_float(rr[1]); }
    l_reg = l_reg * alpha + ps;
#define PK4(P, BASE, OUT) do { unsigned a0 = cvt_pk_bf16(P[BASE + 0], P[BASE + 1]), a1 = cvt_pk_bf16(P[BASE + 2], P[BASE + 3]);   \
    unsigned b0 = cvt_pk_bf16(P[BASE + 4], P[BASE + 5]), b1 = cvt_pk_bf16(P[BASE + 6], P[BASE + 7]);                              \
    auto r0 = __builtin_amdgcn_permlane32_swap(a0, b0, false, false); auto r1 = __builtin_amdgcn_permlane32_swap(a1, b1, false, false); \
    u32x4 w = {r0[0], r1[0], r0[1], r1[1]}; OUT = *reinterpret_cast<bf16x8*>(&w); } while (0)
    PK4(p0, 0, pa0); PK4(p0, 8, pa1); PK4(p1, 0, pa2); PK4(p1, 8, pa3);
#undef PK4
}
__device__ __forceinline__ void qkt(f32x16& p0, f32x16& p1, const FK_LAS char* Ks, const bf16x8* qr, int r32, int hi) {
    p0 = f32x16{}; p1 = f32x16{};
#pragma unroll
    for (int d0 = 0; d0 < 4; ++d0) { const int cb = d0 * 32 + hi * 16;
        const bf16x8 b0 = *(const FK_LAS bf16x8*)(Ks + ASWZ(r32, cb));
        const bf16x8 b1 = *(const FK_LAS bf16x8*)(Ks + ASWZ(32 + r32, cb));
        __builtin_amdgcn_s_setprio(1);
        p0 = __builtin_amdgcn_mfma_f32_32x32x16_bf16(b0, qr[d0], p0, 0, 0, 0);
        p1 = __builtin_amdgcn_mfma_f32_32x32x16_bf16(b1, qr[d0], p1, 0, 0, 0);
        __builtin_amdgcn_s_setprio(0); }
}
__device__ __forceinline__ void pv(f32x16* o, const FK_LAS char* Vs, int r32, int hi, bf16x8 pa0, bf16x8 pa1, bf16x8 pa2, bf16x8 pa3) {
#pragma unroll
    for (int d0 = 0; d0 < 4; ++d0) { const int row = 32 * d0 + r32;
        const bf16x8 v0 = *(const FK_LAS bf16x8*)(Vs + ASWZ(row, 0 * 32 + hi * 16)), v1 = *(const FK_LAS bf16x8*)(Vs + ASWZ(row, 1 * 32 + hi * 16));
        const bf16x8 v2 = *(const FK_LAS bf16x8*)(Vs + ASWZ(row, 2 * 32 + hi * 16)), v3 = *(const FK_LAS bf16x8*)(Vs + ASWZ(row, 3 * 32 + hi * 16));
        __builtin_amdgcn_s_setprio(1);
        o[d0] = __builtin_amdgcn_mfma_f32_32x32x16_bf16(pa0, v0, o[d0], 0, 0, 0);
        o[d0] = __builtin_amdgcn_mfma_f32_32x32x16_bf16(pa1, v1, o[d0], 0, 0, 0);
        o[d0] = __builtin_amdgcn_mfma_f32_32x32x16_bf16(pa2, v2, o[d0], 0, 0, 0);
        o[d0] = __builtin_amdgcn_mfma_f32_32x32x16_bf16(pa3, v3, o[d0], 0, 0, 0);
        __builtin_amdgcn_s_setprio(0); }
}
__device__ __forceinline__ void body(const bf16_t* __restrict__ Qb, const bf16_t* __restrict__ Kh, const bf16_t* __restrict__ VTh, int ldv, int seq, FK_LAS char* lds, f32x16* o, const int tid) {
    const int wid = tid >> 6, lane = tid & 63, r32 = lane & 31, hi = lane >> 5;
    FK_LAS char* V_lds = lds + OFF_V; FK_LAS char* K_lds = lds + OFF_K;
    FK_LAS float* wsf = (FK_LAS float*)(lds + OFF_WS) + wid * 64; FK_LAS float* li_l = wsf; FK_LAS float* al_l = wsf + 32;
    float m_reg = -1e30f, l_reg = 0;
#pragma unroll
    for (int d = 0; d < 4; ++d) o[d] = f32x16{};
    bf16x8 qr[4];
    const bf16_t* Qw = Qb + (size_t)(wid * 32 + r32) * 64 + hi * 8;
#pragma unroll
    for (int d0 = 0; d0 < 4; ++d0) qr[d0] = *(const bf16x8*)(Qw + d0 * 16);
    const int ksr = tid >> 3, kch = tid & 7;
    const int kst = ASWZ(ksr, kch * 16);
    const int vd0 = tid >> 3, vd1 = 64 + (tid >> 3);
    const int vst0 = ASWZ(vd0, kch * 16), vst1 = ASWZ(vd1, kch * 16);
    struct { bf16x8 vs0, vs1, ks; } sr_[2];
#define SLOAD(i, k0) do { sr_[i].vs0 = *(const bf16x8*)(VTh + (size_t)vd0 * ldv + (k0) + kch * 8); sr_[i].vs1 = *(const bf16x8*)(VTh + (size_t)vd1 * ldv + (k0) + kch * 8); \
    sr_[i].ks = *(const bf16x8*)(Kh + (size_t)((k0) + ksr) * 64 + kch * 8); } while (0)
#define SWRITE(b, i) do { *(FK_LAS bf16x8*)(V_lds + (b) * SHM_V + vst0) = sr_[i].vs0; *(FK_LAS bf16x8*)(V_lds + (b) * SHM_V + vst1) = sr_[i].vs1; \
    *(FK_LAS bf16x8*)(K_lds + (b) * SHM_K + kst) = sr_[i].ks; } while (0)
#define SWAIT() asm volatile("s_waitcnt vmcnt(3)" ::: "memory")
#define RESC(a) do { if (__any((a) < 1.f)) { if (hi == 0) al_l[r32] = (a); asm volatile("s_waitcnt lgkmcnt(0)" ::: "memory"); \
    _Pragma("unroll") for (int d = 0; d < 4; ++d) _Pragma("unroll") for (int r = 0; r < 16; ++r) o[d][r] *= al_l[crow(r, hi)]; } } while (0)
    f32x16 pA0, pA1, pB0, pB1; float mnA, mnB, alA, alB; bf16x8 pa0, pa1, pa2, pa3; const int NT = seq / KVBLK;
    SLOAD(0, 0); asm volatile("s_waitcnt vmcnt(0)" ::: "memory"); SWRITE(0, 0); __syncthreads();
    qkt(pA0, pA1, K_lds, qr, r32, hi); partialSM(pA0, pA1, m_reg, mnA, alA);
    SLOAD(1, KVBLK); if (2 < NT) SLOAD(0, 2 * KVBLK);
    if (2 < NT) SWAIT(); else asm volatile("s_waitcnt vmcnt(0)" ::: "memory");
    SWRITE(1, 1); __syncthreads();
    for (int j = 1; j + 1 < NT; j += 2) {
        SBAR(); qkt(pB0, pB1, K_lds + SHM_K, qr, r32, hi);
        finishSM(pA0, pA1, alA, l_reg, pa0, pa1, pa2, pa3); SBAR();
        SLOAD(1, (j + 2) * KVBLK); SBAR();
        pv(o, V_lds, r32, hi, pa0, pa1, pa2, pa3); partialSM(pB0, pB1, m_reg, mnB, alB);
        __syncthreads(); SWAIT(); SWRITE(0, 0);
        RESC(alB); __syncthreads();
        SBAR(); qkt(pA0, pA1, K_lds, qr, r32, hi);
        finishSM(pB0, pB1, alB, l_reg, pa0, pa1, pa2, pa3); SBAR();
        const bool more = (j + 3 < NT);
        if (more) SLOAD(0, (j + 3) * KVBLK);
        SBAR();
        pv(o, V_lds + SHM_V, r32, hi, pa0, pa1, pa2, pa3); partialSM(pA0, pA1, m_reg, mnA, alA);
        __syncthreads(); if (more) SWAIT(); else asm volatile("s_waitcnt vmcnt(0)" ::: "memory");
        SWRITE(1, 1);
        RESC(alA); __syncthreads();
    }
    SBAR(); qkt(pB0, pB1, K_lds + SHM_K, qr, r32, hi);
    finishSM(pA0, pA1, alA, l_reg, pa0, pa1, pa2, pa3); SBAR();
    pv(o, V_lds, r32, hi, pa0, pa1, pa2, pa3); partialSM(pB0, pB1, m_reg, mnB, alB);
    __syncthreads(); RESC(alB);
    finishSM(pB0, pB1, alB, l_reg, pa0, pa1, pa2, pa3); SBAR();
    pv(o, V_lds + SHM_V, r32, hi, pa0, pa1, pa2, pa3);
    if (hi == 0) li_l[r32] = l_reg; asm volatile("s_waitcnt lgkmcnt(0)" ::: "memory");
#pragma unroll
    for (int r = 0; r < 16; ++r) { const float rl = __builtin_amdgcn_rcpf(li_l[crow(r, hi)]);
#pragma unroll
        for (int d = 0; d < 4; ++d) o[d][r] *= rl; }
    __syncthreads();
#undef SLOAD
#undef SWRITE
#undef SWAIT
#undef RESC
}
__device__ __forceinline__ void unit(AP A, FK_LAS char* lds, int l, int b, int h, int qb  ) {
    const int tid = opaque_tid(), wid = tid >> 6, lane = tid & 63, r32 = lane & 31, hi = lane >> 5;
    const bool ctx = qb == 8;
    float* stash = wsp<float>(A, W.stash) + (size_t)blockIdx.x * 128 * 512;
#pragma unroll 1
    for (int map = 0; map < 2; ++map) {
        const size_t hm = (size_t)(b * 4 + h) * 2 + map;
        const bf16_t* Qb = ctx ? wsp<bf16_t>(A, W.qc) + hm * CTX * 64 : wsp<bf16_t>(A, W.q) + (hm * SEQ + (size_t)qb * 256) * 64;
        const bf16_t* Kh = wsp<bf16_t>(A, W.k) + (hm * KALL + (ctx ? SEQ : 0)) * 64;
        const bf16_t* VTh = wsp<bf16_t>(A, W.vt) + (size_t)(b * 4 + h) * 128 * KALL + (ctx ? SEQ : 0);
        f32x16 om[4];
        body(Qb, Kh, VTh, KALL, ctx ? CTX : KALL, lds, om, tid);
#pragma unroll
        for (int d = 0; d < 4; ++d)
#pragma unroll
            for (int r = 0; r < 16; ++r) stash[(size_t)((map * 4 + d) * 16 + r) * 512 + tid] = om[d][r];
    }
    const float lam = wsp<float>(A, W.misc)[MI_LAM + l], post = 1.f - (0.8f - 0.6f * __expf(-0.3f * (float)l));
    f32x16 o[4];
    float ss[16];
#pragma unroll
    for (int r = 0; r < 16; ++r) ss[r] = 0.f;
#pragma unroll
    for (int d = 0; d < 4; ++d)
#pragma unroll
        for (int r = 0; r < 16; ++r) { const float v = stash[(size_t)(d * 16 + r) * 512 + tid] - lam * stash[(size_t)((4 + d) * 16 + r) * 512 + tid]; o[d][r] = v; ss[r] += v * v; }
#pragma unroll
    for (int r = 0; r < 16; ++r) {
#pragma unroll
        for (int s = 1; s < 32; s <<= 1) ss[r] += __shfl_xor(ss[r], s);
        ss[r] = rsqrtf(ss[r] * (1.f / 128.f) + EPS) * post; }
    bf16_t* att = (h < 2) ? wsp<bf16_t>(A, W.attlo) : wsp<bf16_t>(A, W.atthi);
    const size_t t0 = ctx ? (size_t)NLAT + b * CTX : (size_t)b * SEQ + qb * 256;
#pragma unroll
    for (int d = 0; d < 4; ++d) { const float gs = FIN(21)[l * 128 + 32 * d + r32];
#pragma unroll
        for (int r = 0; r < 16; ++r) att[(t0 + wid * 32 + crow(r, hi)) * 256 + (h & 1) * 128 + 32 * d + r32] = (bf16_t)f2bf(o[d][r] * ss[r] * gs); }
}
#undef ASWZ
#undef SBAR
}

namespace hy {
template <int L, int NBH> struct Geo {
    static constexpr int NBLK = L / 32, IB = 32 / NBH, NG = NBLK / IB, GPW = (NG >= 8) ? NG / 8 : 1, AW = NG / GPW;
    static constexpr int PADB = IB * GPW - 1, RL = (NBLK + 2 * PADB) * 32, ZRS = RL * 2 + 16;
    static constexpr int TLn = (L == 2048) ? TLL : TLC, TCS = TLn * 2 + ((L == 2048) ? 32 : 160);
    static constexpr int OFF_Z = 0, OFF_G = NBH * ZRS, OFF_T = 2 * NBH * ZRS, END = OFF_T + 8 * TCS;
};
__device__ __forceinline__ int crow(int r, int hi) { return (r & 3) + 8 * (r >> 2) + 4 * hi; }
template <int L, int NBH>
__device__ __forceinline__ void unit(AP A, FK_LAS char* lds, int l, int ch, int boff) {
    using Gm = Geo<L, NBH>;
    static_assert(Gm::END <= LDS_MISC, "hyena LDS");
    const int tid = opaque_tid(), wid = __builtin_amdgcn_readfirstlane(tid >> 6), lane = tid & 63, r32 = lane & 31, hi = lane >> 5;
    const bf16_t* hyt = wsp<bf16_t>(A, W.hyt);
    const float* cw = FIN(9) + l * 3 * 768; const float* cb = FIN(10) + l * 768;
    const int tbl = tid / (L / 32), tb = boff + tbl, tp0 = (tid % (L / 32)) * 32; const bool ld_act = tid < NBH * (L / 32);
    unsigned x2p[16];
    __syncthreads();
    for (int i = tid; i < 2 * NBH * Gm::ZRS / 16; i += NTHR) *(FK_LAS u32x4*)(lds + i * 16) = (u32x4){0u, 0u, 0u, 0u};
    __syncthreads();
    if (ld_act) {
#pragma unroll
        for (int sel = 0; sel < 3; ++sel) {
            const int row = sel * 256 + ch; const float w0 = cw[row], w1 = cw[768 + row], w2 = cw[1536 + row], bs = cb[row];
            float vals[34];
            if (tb < NB) {
                const size_t tok0 = (L == 2048) ? (size_t)tb * SEQ + tp0 : (size_t)NLAT + tb * CTX + tp0;
                const bf16_t* src = hyt + (size_t)row * NTOK + tok0;
#pragma unroll
                for (int q = 0; q < 4; ++q) { const u32x4 w = *(const u32x4*)(src + q * 8);
                    vals[1 + q * 8 + 0] = bflo(w.x); vals[1 + q * 8 + 1] = bfhi(w.x); vals[1 + q * 8 + 2] = bflo(w.y); vals[1 + q * 8 + 3] = bfhi(w.y);
                    vals[1 + q * 8 + 4] = bflo(w.z); vals[1 + q * 8 + 5] = bfhi(w.z); vals[1 + q * 8 + 6] = bflo(w.w); vals[1 + q * 8 + 7] = bfhi(w.w); }
                vals[0] = tp0 > 0 ? bf2f(src[-1]) : 0.f; vals[33] = tp0 + 32 < L ? bf2f(src[32]) : 0.f;
            } else {
#pragma unroll
                for (int i = 0; i < 34; ++i) vals[i] = 0.f;
            }
            unsigned pk[16];
#pragma unroll
            for (int i = 0; i < 16; ++i) { const float a = tb < NB ? vals[2 * i] * w0 + vals[2 * i + 1] * w1 + vals[2 * i + 2] * w2 + bs : 0.f, b2 = tb < NB ? vals[2 * i + 1] * w0 + vals[2 * i + 2] * w1 + vals[2 * i + 3] * w2 + bs : 0.f;
                pk[i] = cvt_pk_bf16(a, b2); }
            if (sel < 2) { FK_LAS char* dst = lds + (sel == 0 ? Gm::OFF_Z : Gm::OFF_G) + tbl * Gm::ZRS + (Gm::PADB * 32 + tp0) * 2;
#pragma unroll
                for (int q = 0; q < 4; ++q) *(FK_LAS u32x4*)(dst + q * 16) = (u32x4){pk[4 * q], pk[4 * q + 1], pk[4 * q + 2], pk[4 * q + 3]}; }
            else {
#pragma unroll
                for (int i = 0; i < 16; ++i) x2p[i] = pk[i]; }
        }
    }
    const int G0 = wid * Gm::GPW; const bool act = wid < Gm::AW;
    const int dlo = Gm::IB * G0 - (Gm::NBLK - 1), dhi = Gm::IB * (G0 + Gm::GPW) - 1;
    const int il = r32 & (Gm::IB - 1), bb = r32 / Gm::IB;
    for (int o = 0; o < 2; ++o) {
        { const bf16_t* TL = (L == 2048 ? wsp<bf16_t>(A, W.tapl) + ((size_t)l * 512 + o * 256 + ch) * TLL : wsp<bf16_t>(A, W.tapc) + ((size_t)l * 512 + o * 256 + ch) * TLC);
          constexpr int NC = Gm::TLn / 8;
          for (int i = tid; i < NC; i += NTHR) *(FK_LAS u32x4*)(lds + Gm::OFF_T + i * 16) = *(const u32x4*)(TL + i * 8);
          __syncthreads();
          for (int i = tid; i < 7 * NC; i += NTHR) { const int sft = 1 + i / NC, c = i % NC;
              const FK_LAS unsigned* src = (const FK_LAS unsigned*)(lds + Gm::OFF_T + c * 16 + 4 * (sft >> 1)); const unsigned sh = 16u * (unsigned)(sft & 1);
              const bool tail = (c == NC - 1);
              unsigned w0 = src[0], w1 = tail && (1 + (sft >> 1)) >= 4 ? 0u : src[1], w2 = tail && (2 + (sft >> 1)) >= 4 ? 0u : src[2], w3 = tail && (3 + (sft >> 1)) >= 4 ? 0u : src[3], w4 = tail ? 0u : src[4];
              u32x4 ov; ov.x = __builtin_amdgcn_alignbit(w1, w0, sh); ov.y = __builtin_amdgcn_alignbit(w2, w1, sh); ov.z = __builtin_amdgcn_alignbit(w3, w2, sh); ov.w = __builtin_amdgcn_alignbit(w4, w3, sh);
              *(FK_LAS u32x4*)(lds + Gm::OFF_T + sft * Gm::TCS + c * 16) = ov; } }
        __syncthreads();
        f32x16 acc[Gm::GPW];
#pragma unroll
        for (int g = 0; g < Gm::GPW; ++g) acc[g] = f32x16{};
        if (act) {
            const int c0 = (L + 32) - r32 + 8 * hi, sc = c0 & 7;
            int pa = Gm::OFF_T + sc * Gm::TCS + (c0 - sc - 32 * dlo) * 2;
            int pb = Gm::OFF_Z + bb * Gm::ZRS + ((Gm::PADB + Gm::IB * G0 + il - dlo) * 32 + 8 * hi) * 2;
#define HY_LOAD(A0, A1, B0, B1) do { A0 = *(const FK_LAS bf16x8*)(lds + pa); A1 = *(const FK_LAS bf16x8*)(lds + pa + 32); \
                _Pragma("unroll") for (int g = 0; g < Gm::GPW; ++g) { B0[g] = *(const FK_LAS bf16x8*)(lds + pb + g * Gm::IB * 64); B1[g] = *(const FK_LAS bf16x8*)(lds + pb + g * Gm::IB * 64 + 32); } \
                pa -= 64; pb -= 64; } while (0)
#define HY_MMA(A0, A1, B0, B1) do { _Pragma("unroll") for (int g = 0; g < Gm::GPW; ++g) { acc[g] = __builtin_amdgcn_mfma_f32_32x32x16_bf16(A0, B0[g], acc[g], 0, 0, 0); \
                acc[g] = __builtin_amdgcn_mfma_f32_32x32x16_bf16(A1, B1[g], acc[g], 0, 0, 0); } } while (0)
            bf16x8 xa0, xa1, ya0, ya1, xb0[Gm::GPW], xb1[Gm::GPW], yb0[Gm::GPW], yb1[Gm::GPW];
            const int nd = dhi - dlo + 1;
            HY_LOAD(xa0, xa1, xb0, xb1);
            int d = 0;
#pragma unroll 1
            for (; d + 2 <= nd - 1; d += 2) {
                HY_LOAD(ya0, ya1, yb0, yb1);
                HY_MMA(xa0, xa1, xb0, xb1);
                HY_LOAD(xa0, xa1, xb0, xb1);
                HY_MMA(ya0, ya1, yb0, yb1);
            }
            if (d + 1 <= nd - 1) { HY_LOAD(ya0, ya1, yb0, yb1); HY_MMA(xa0, xa1, xb0, xb1); HY_MMA(ya0, ya1, yb0, yb1); }
            else HY_MMA(xa0, xa1, xb0, xb1);
#undef HY_LOAD
#undef HY_MMA
        }
        __syncthreads();
        const float bias = FIN(17)[l * 512 + o * 256 + ch];
        if (act) {
#pragma unroll
            for (int g = 0; g < Gm::GPW; ++g)
#pragma unroll
                for (int r = 0; r < 16; ++r) { const int pos = 32 * (Gm::IB * (G0 + g) + il) + crow(r, hi);
                    FK_LAS unsigned short* zp = (FK_LAS unsigned short*)(lds + Gm::OFF_Z + bb * Gm::ZRS + (Gm::PADB * 32 + pos) * 2);
                    const float gate = bf2f(*(FK_LAS unsigned short*)(lds + Gm::OFF_G + bb * Gm::ZRS + (Gm::PADB * 32 + pos) * 2));
                    const float zn = gate * (acc[g][r] + bias * bf2f(*zp));
                    *zp = (unsigned short)f2bf(zn); }
        }
        __syncthreads();
        if (o == 0 && ld_act) { FK_LAS char* dst = lds + Gm::OFF_G + tbl * Gm::ZRS + (Gm::PADB * 32 + tp0) * 2;
#pragma unroll
            for (int q = 0; q < 4; ++q) *(FK_LAS u32x4*)(dst + q * 16) = (u32x4){x2p[4 * q], x2p[4 * q + 1], x2p[4 * q + 2], x2p[4 * q + 3]}; }
    }
    __syncthreads();
    if (ld_act && tb < NB) { const size_t tok0 = (L == 2048) ? (size_t)tb * SEQ + tp0 : (size_t)NLAT + tb * CTX + tp0;
        bf16_t* dst = wsp<bf16_t>(A, W.hyo) + (size_t)ch * NTOK + tok0; const FK_LAS char* srcz = lds + Gm::OFF_Z + tbl * Gm::ZRS + (Gm::PADB * 32 + tp0) * 2;
#pragma unroll
        for (int q = 0; q < 4; ++q) *(u32x4*)(dst + q * 8) = *(const FK_LAS u32x4*)(srcz + q * 16); }
    __syncthreads();
}
}

struct FnSched {
    int G, c, big; const char* dft; const char* ft;
    __device__ bool next(int i, Unit& u) const {
        const long Li = (long)i * G + (G - 1 - c);
        const int n = big ? NB * 8 : NB; if (Li >= n) return false;
        const int b = big ? (int)Li >> 3 : (int)Li, mt = big ? (int)Li & 7 : 0;
        u.pm = mt; u.pn = b; u.kind = big; u.aux = 0;
        u.a = dft + (size_t)mt * 256 * (big ? 4096 : 512) * 2; u.b = ft + (size_t)b * 256 * (big ? 4096 : 512) * 2; return true;
    }
};
struct FnEpi {
    bf16_t* fno;
    __device__ __forceinline__ bool operator()(Acc& acc, const Unit& u, int wr, int wc, int fr, int fq) const {
        const size_t t0 = u.kind ? (size_t)u.pn * SEQ + u.pm * 256 : (size_t)NLAT + u.pn * CTX;
#pragma unroll
        for (int ai = 0; ai < 2; ++ai)
#pragma unroll
            for (int m = 0; m < 4; ++m) { bf16_t* rowp = fno + (t0 + 128 * ai + 64 * wr + 16 * m + fr) * 256 + 32 * wc + 8 * fq;
#pragma unroll
                for (int bj = 0; bj < 2; ++bj) { const f32x4 v0 = acc[ai][bj][m][0], v1 = acc[ai][bj][m][1];
                    u32x4 w; w.x = cvt_pk_bf16(v0[0], v0[1]); w.y = cvt_pk_bf16(v0[2], v0[3]); w.z = cvt_pk_bf16(v1[0], v1[1]); w.w = cvt_pk_bf16(v1[2], v1[3]);
                    *(u32x4*)(rowp + 128 * bj) = w; } }
        return true;
    }
};

__device__ __forceinline__ void phase_mix(AP A, FK_LAS unsigned char* lds, int l, int vcu, int G) {
    const int n_lat = NB * 32, n_all = n_lat + (l == 0 ? NB * 4 : 0);
#ifndef FK_REP_SUB
#define FK_REP_SUB 0
#endif
#ifndef FK_NO_ATTN
    for (int rp = (FK_REP_SUB == 1 ? 1 : 0); rp >= 0; --rp)
    for (int u = vcu; u < n_all; u += G) {
        if (u < n_lat) attn::unit(A, (FK_LAS char*)lds, l, u >> 5, (u >> 3) & 3, u & 7);
        else { const int v = u - n_lat; attn::unit(A, (FK_LAS char*)lds, l, v >> 2, v & 3, 8); }
    }
#endif
#ifndef FK_NO_HY
    for (int rp = (FK_REP_SUB == 2 ? 1 : 0); rp >= 0; --rp)
    if (G == 256) { if (vcu < 192) hy::unit<2048, 8>(A, (FK_LAS char*)lds, l, vcu, 0); if (vcu >= 64 && vcu < 128) hy::unit<2048, 8>(A, (FK_LAS char*)lds, l, vcu + 128, 0); }
    else for (int ch = vcu; ch < 256; ch += G) hy::unit<2048, 8>(A, (FK_LAS char*)lds, l, ch, 0);
    if (l == 0) for (int ch = vcu; ch < 256; ch += G) hy::unit<256, 8>(A, (FK_LAS char*)lds, l, ch, 0);
#endif
#ifndef FK_NO_FN
    for (int rp = (FK_REP_SUB == 3 ? 1 : 0); rp >= 0; --rp)
    { FnSched S{G, vcu, 1, (const char*)wsp<bf16_t>(A, W.dftl), (const char*)wsp<bf16_t>(A, W.ftl)}; FnEpi E{wsp<bf16_t>(A, W.fno)}; gemm_phase(lds, 4096, S, E); }
    if (l == 0) { FnSched S{G, vcu, 0, (const char*)wsp<bf16_t>(A, W.dftc), (const char*)wsp<bf16_t>(A, W.ftc)}; FnEpi E{wsp<bf16_t>(A, W.fno)}; gemm_phase(lds, 512, S, E); }
#endif
}
#define FK_HAVE_MERGE 1
#define FK_HAVE_OUT 1
#define FK_HAVE_NORM 1
#define FK_HAVE_PQ 1
struct MergeSched {
    int G, c, ntile; const char *a0, *a1, *a2, *a3; const char* w;
    __device__ bool next(int i, Unit& u) const {
        const int j = i >> 2, s = i & 3; const long T = (long)j * G + c; if (T >= ntile) return false;
        u.pm = (int)(T >> 2); u.pn = (int)(T & 3); u.kind = s; u.aux = 0;
        u.a = (s == 0) ? a0 + (size_t)(j * 256 + c) * 256 * 256 * 2 : (s == 1 ? a1 : s == 2 ? a2 : a3) + (size_t)u.pm * 256 * 256 * 2; u.b = w + ((size_t)s * 1024 + u.pn * 256) * 256 * 2; return true;
    }
};
struct MergeEpi {
    const bf16_t* g; bf16_t* y;
    __device__ __forceinline__ bool operator()(Acc& acc, const Unit& u, int wr, int wc, int fr, int fq) const {
        const int s = u.kind; if (s == 2) return false;
        const int gn = (s == 3 ? 2048 : s * 1024), gd = (s + 1) * 1024;
#pragma unroll
        for (int ai = 0; ai < 2; ++ai)
#pragma unroll
            for (int m = 0; m < 4; ++m) { const size_t t = (size_t)u.pm * 256 + 128 * ai + 64 * wr + 16 * m + fr;
#pragma unroll
                for (int bj = 0; bj < 2; ++bj) { const int c = u.pn * 256 + 128 * bj + 32 * wc + 8 * fq; const bf16_t* gp = g + t * 3072 + c;
#pragma unroll
                    for (int n = 0; n < 2; ++n) {
                        const u32x2 wn = *(const u32x2*)(gp + gn + 4 * n);
                        f32x4 f = {bflo(wn.x), bfhi(wn.x), bflo(wn.y), bfhi(wn.y)};
                        if (s != 3) { const u32x2 wd = *(const u32x2*)(gp + gd + 4 * n);
                            f[0] *= __builtin_amdgcn_rcpf(bflo(wd.x)); f[1] *= __builtin_amdgcn_rcpf(bfhi(wd.x)); f[2] *= __builtin_amdgcn_rcpf(bflo(wd.y)); f[3] *= __builtin_amdgcn_rcpf(bfhi(wd.y)); }
                        acc[ai][bj][m][n] = acc[ai][bj][m][n] * f; }
                    if (s == 3) { const f32x4 v0 = acc[ai][bj][m][0], v1 = acc[ai][bj][m][1];
                        u32x4 w; w.x = cvt_pk_bf16(v0[0], v0[1]); w.y = cvt_pk_bf16(v0[2], v0[3]); w.z = cvt_pk_bf16(v1[0], v1[1]); w.w = cvt_pk_bf16(v1[2], v1[3]); *(u32x4*)(y + t * 1024 + c) = w; } }
                if (m == 3) asm volatile("" ::: "memory"); }
        return s == 3;
    }
};
__device__ __forceinline__ void phase_merge(AP A, FK_LAS unsigned char* lds, int l, int G) {
    MergeSched S; S.G = G; S.c = (int)blockIdx.x; S.ntile = (l == 0 ? NTT : NTL) * 4;
    { const int tid = opaque_tid(); const bf16_t* hyot = wsp<bf16_t>(A, W.hyo); bf16_t* scr = wsp<bf16_t>(A, W.q);
      constexpr int RS = 516;
      for (int j = 0; (long)j * G + S.c < S.ntile; ++j) { const int pm = (int)(((long)j * G + S.c) >> 2); bf16_t* dst = scr + (size_t)(j * 256 + S.c) * 65536;
          for (int cq = 0; cq < 4; ++cq) {
              __syncthreads();
#pragma unroll
              for (int i = 0; i < 4; ++i) { const int idx = tid + 512 * i, chl = idx >> 5, t8 = (idx & 31) * 8;
                  const u32x4 v = *(const u32x4*)(hyot + (size_t)(cq * 64 + chl) * NTOK + (size_t)pm * 256 + t8);
                  FK_LAS unsigned* p = (FK_LAS unsigned*)(lds + chl * RS + t8 * 2); p[0] = v.x; p[1] = v.y; p[2] = v.z; p[3] = v.w; }
              __syncthreads();
#pragma unroll
              for (int i = 0; i < 4; ++i) { const int idx = tid + 512 * i, tok = idx >> 3, c8 = (idx & 7) * 8; unsigned short e[8];
#pragma unroll
                  for (int q = 0; q < 8; ++q) e[q] = *(const FK_LAS unsigned short*)(lds + (c8 + q) * RS + tok * 2);
                  *(u32x4*)(dst + (size_t)tok * 256 + cq * 64 + c8) = (u32x4){(unsigned)e[0] | ((unsigned)e[1] << 16), (unsigned)e[2] | ((unsigned)e[3] << 16), (unsigned)e[4] | ((unsigned)e[5] << 16), (unsigned)e[6] | ((unsigned)e[7] << 16)}; }
          } }
      asm volatile("s_waitcnt vmcnt(0)" ::: "memory"); __syncthreads(); }
    S.a0 = (const char*)wsp<bf16_t>(A, W.q); S.a1 = (const char*)wsp<bf16_t>(A, W.fno); S.a2 = (const char*)wsp<bf16_t>(A, W.attlo); S.a3 = (const char*)wsp<bf16_t>(A, W.atthi);
    S.w = (const char*)(wsp<bf16_t>(A, W.w_mrg) + (size_t)l * 4 * 1024 * 256);
    MergeEpi E{wsp<bf16_t>(A, W.g), wsp<bf16_t>(A, W.y)};
    gemm_phase(lds, 256, S, E);
}
struct PlainSched {
    int G, c, nM, nN, K; const char* a; const char* w;
    __device__ bool next(int i, Unit& u) const {
        const long T = (long)i * G + c; if (T >= (long)nM * nN) return false;
        int wgid = (int)T; const int nwg = nM * nN; { const int q = nwg / 8, r = nwg % 8, xcd = wgid % 8, off = wgid / 8; wgid = (xcd < r ? xcd * (q + 1) : r * (q + 1) + (xcd - r) * q) + off; }
        const int nig = 8 * nN, gid = wgid / nig, fm = gid * 8, gsz = (nM - fm) < 8 ? (nM - fm) : 8;
        u.pm = fm + ((wgid % nig) % gsz); u.pn = (wgid % nig) / gsz; u.kind = 0; u.aux = 0;
        u.a = a + (size_t)u.pm * 256 * K * 2; u.b = w + (size_t)u.pn * 256 * K * 2; return true;
    }
};
struct OutEpi {
    const float* x_in; const float* ctx_in; const float* xl; float* xc; const float* mod; int l; float* xo;
    __device__ __forceinline__ bool operator()(Acc& acc, const Unit& u, int wr, int wc, int fr, int fq) const {
        const bool lat = u.pm < NTL; const int mr = lat ? u.pm >> 3 : 8;
        const float* gate = mod + (size_t)mr * 6144 + 2 * 1024;
#pragma unroll
        for (int bj = 0; bj < 2; ++bj) { const int c = u.pn * 256 + 128 * bj + 32 * wc + 8 * fq;
            const f32x4 g0 = *(const f32x4*)(gate + c), g1 = *(const f32x4*)(gate + c + 4);
#pragma unroll
            for (int ai = 0; ai < 2; ++ai)
#pragma unroll
                for (int m = 0; m < 4; ++m) { const int rl = 128 * ai + 64 * wr + 16 * m + fr;
                    const size_t t = (size_t)u.pm * 256 + rl, tc = t - NLAT;
                    const float* bp = lat ? ((l == 0 ? x_in : xl) + t * 1024 + c) : (ctx_in + tc * 1024 + c);
                    float* op = lat ? (xo + t * 1024 + c) : (xc + tc * 1024 + c);
                    const f32x4 b0 = *(const f32x4*)bp, b1 = *(const f32x4*)(bp + 4);
                    *(f32x4*)op = b0 + g0 * acc[ai][bj][m][0]; *(f32x4*)(op + 4) = b1 + g1 * acc[ai][bj][m][1]; } }
        return true;
    }
};
__device__ __forceinline__ void phase_outproj(AP A, FK_LAS unsigned char* lds, int l, int G, int dry) {
    PlainSched S{G, (int)blockIdx.x, l == 0 ? NTT : NTL, 4, 1024, (const char*)wsp<bf16_t>(A, W.y), (const char*)(wsp<bf16_t>(A, W.w_out) + (size_t)l * 1024 * 1024)};
    OutEpi E{FIN(0), FIN(2), A->xl, wsp<float>(A, W.xc), wsp<float>(A, W.mod) + (size_t)l * 9 * 6144, l, dry ? wsp<float>(A, W.g) : A->xl};
    gemm_phase(lds, 1024, S, E);
}
__device__ __forceinline__ void phase_norm(AP A, int l, int vcu, int G) {
    const int tid = opaque_tid(), lane = tid & 63, wave = __builtin_amdgcn_readfirstlane(tid >> 6);
    const int gw = vcu * NWAVES + wave, NGW = G * NWAVES;
    const float* mod = wsp<float>(A, W.mod) + (size_t)l * 9 * 6144;
    const int nrow = l == 0 ? NTOK : NLAT;
    for (int t = gw; t < nrow; t += NGW) {
        const bool lat = t < NLAT; const int mr = lat ? t / SEQ : 8;
        const float* xr = lat ? A->xl + (size_t)t * DM : wsp<float>(A, W.xc) + (size_t)(t - NLAT) * DM;
        modulate_row_bf16(xr, FIN(7) + l * DM, mod + (size_t)mr * 6144 + 4 * 1024, mod + (size_t)mr * 6144 + 3 * 1024, wsp<bf16_t>(A, W.nn) + (size_t)t * DM, lane);
    }
    if (l == 1) {
        const size_t gt = (size_t)vcu * NTHR + tid, NGT = (size_t)G * NTHR, nUV = (size_t)16384 * 1024 / 16;
        for (size_t i = gt; i < 2 * nUV; i += NGT) {
            if (i < nUV) cvt16_fp8(FIN(28) + (size_t)16384 * 1024 + i * 16, wsp<unsigned char>(A, W.ub) + tab_chunk_off(i), SU);
            else cvt16_fp8(FIN(29) + (size_t)16384 * 1024 + (i - nUV) * 16, wsp<unsigned char>(A, W.vb) + tab_chunk_off(i - nUV), SV);
        }
    }
}
struct PqEpi {
    bf16_t* pq;
    __device__ __forceinline__ bool operator()(Acc& acc, const Unit& u, int wr, int wc, int fr, int fq) const {
#pragma unroll
        for (int ai = 0; ai < 2; ++ai)
#pragma unroll
            for (int m = 0; m < 4; ++m) { bf16_t* rowp = pq + ((size_t)u.pm * 256 + 128 * ai + 64 * wr + 16 * m + fr) * 2048 + u.pn * 256 + 32 * wc + 8 * fq;
#pragma unroll
                for (int bj = 0; bj < 2; ++bj) { const f32x4 v0 = acc[ai][bj][m][0], v1 = acc[ai][bj][m][1];
                    u32x4 w; w.x = cvt_pk_bf16(v0[0], v0[1]); w.y = cvt_pk_bf16(v0[2], v0[3]); w.z = cvt_pk_bf16(v1[0], v1[1]); w.w = cvt_pk_bf16(v1[2], v1[3]);
                    *(u32x4*)(rowp + 128 * bj) = w; } }
        return true;
    }
};
__device__ __forceinline__ void phase_peerq(AP A, FK_LAS unsigned char* lds, int l, int G) {
    PlainSched S{G, (int)blockIdx.x, l == 0 ? NTT : NTL, 8, 1024, (const char*)wsp<bf16_t>(A, W.nn), (const char*)(wsp<bf16_t>(A, W.w_q) + (size_t)l * 2048 * 1024)};
    PqEpi E{wsp<bf16_t>(A, W.pq)};
    gemm_phase(lds, 1024, S, E);
}
#define FK_HAVE_PEER 1
namespace peer {
typedef __bf16 bf16x2v __attribute__((ext_vector_type(2)));
__device__ __forceinline__ float dot2(unsigned a, unsigned b, float c) { return __builtin_amdgcn_fdot2_f32_bf16(__builtin_bit_cast(bf16x2v, a), __builtin_bit_cast(bf16x2v, b), c, false); }
__device__ __forceinline__ unsigned ford(float f) { const unsigned u = __float_as_uint(f); return (u & 0x80000000u) ? ~u : (u | 0x80000000u); }
__device__ __forceinline__ float funord(unsigned o) { return __uint_as_float((o & 0x80000000u) ? (o & 0x7fffffffu) : ~o); }
__device__ __forceinline__ unsigned umax(unsigned a, unsigned b) { return a > b ? a : b; }
__device__ __forceinline__ unsigned umin(unsigned a, unsigned b) { return a < b ? a : b; }
template <int N> __device__ __forceinline__ void sort_desc(unsigned (&v)[N]) {
#pragma unroll
    for (int k = 2; k <= N; k <<= 1)
#pragma unroll
        for (int j = k >> 1; j > 0; j >>= 1)
#pragma unroll
            for (int i = 0; i < N; ++i) { const int l = i ^ j;
                if (l > i) { const unsigned a = v[i], b = v[l], mx = umax(a, b), mn = umin(a, b); if ((i & k) == 0) { v[i] = mx; v[l] = mn; } else { v[i] = mn; v[l] = mx; } } }
}
template <int N> __device__ __forceinline__ void merge_desc(unsigned (&v)[N]) {
#pragma unroll
    for (int j = N >> 1; j > 0; j >>= 1)
#pragma unroll
        for (int i = 0; i < N; ++i) { const int l = i ^ j; if (l > i) { const unsigned a = v[i], b = v[l]; v[i] = umax(a, b); v[l] = umin(a, b); } }
}
__device__ __forceinline__ int crow(int r, int hi) { return (r & 3) + 8 * (r >> 2) + 4 * hi; }
constexpr int L_RIDX = 0, L_RG = 32 * 128 * 2, L_TBL = L_RG + 32 * 128 * 4, L_WK = L_TBL + 8 * 32 * 32, L_END = L_WK + 8 * 128 * 4;

__device__ __forceinline__ void score_top16(const bf16_t* keys  , const bf16_t* qrow  , int r32, int hi, unsigned (&top)[16]) {
    f32x16 acc[4];
    int koff = r32 * 128 + 8 * hi; asm volatile("" : "+v"(koff));
    const bf16_t* kbase = keys + koff; const bf16_t* qb = qrow + 8 * hi;
#pragma unroll
    for (int kt = 0; kt < 4; ++kt) acc[kt] = f32x16{};
    bf16x8 bq[8], ka[8], kb2[8];
#pragma unroll
    for (int ks = 0; ks < 8; ++ks) bq[ks] = *(const bf16x8*)(qb + 16 * ks);
#define KLOAD(dst, kt) do { _Pragma("unroll") for (int ks = 0; ks < 8; ++ks) dst[ks] = *(const bf16x8*)(kbase + 32 * (kt) * 128 + 16 * ks); } while (0)
#define KMMA(src, kt) do { _Pragma("unroll") for (int ks = 0; ks < 8; ++ks) acc[kt] = __builtin_amdgcn_mfma_f32_32x32x16_bf16(src[ks], bq[ks], acc[kt], 0, 0, 0); } while (0)
    KLOAD(ka, 0); asm volatile("" ::: "memory");
    KLOAD(kb2, 1); KMMA(ka, 0); asm volatile("" ::: "memory");
    KLOAD(ka, 2); KMMA(kb2, 1); asm volatile("" ::: "memory");
    KLOAD(kb2, 3); KMMA(ka, 2); asm volatile("" ::: "memory");
    KMMA(kb2, 3);
#undef KLOAD
#undef KMMA
    unsigned v[64]; const unsigned hi4 = 4u * (unsigned)hi;
#pragma unroll
    for (int kt = 0; kt < 4; ++kt)
#pragma unroll
        for (int r = 0; r < 16; ++r) v[kt * 16 + r] = ((ford(acc[kt][r]) & ~0x7fu) | (unsigned)(127 - (32 * kt + (r & 3) + 8 * (r >> 2)))) - hi4;
    unsigned g0[16], g1[16], g2[16], g3[16];
#pragma unroll
    for (int i = 0; i < 16; ++i) { g0[i] = v[i]; g1[i] = v[16 + i]; g2[i] = v[32 + i]; g3[i] = v[48 + i]; }
    sort_desc<16>(g0); sort_desc<16>(g1); sort_desc<16>(g2); sort_desc<16>(g3);
#pragma unroll
    for (int i = 0; i < 16; ++i) { g0[i] = umax(g0[i], g1[15 - i]); g2[i] = umax(g2[i], g3[15 - i]); }
    merge_desc<16>(g0); merge_desc<16>(g2);
#pragma unroll
    for (int i = 0; i < 16; ++i) g0[i] = umax(g0[i], g2[15 - i]);
    merge_desc<16>(g0);
#pragma unroll
    for (int i = 0; i < 16; ++i) { const unsigned o = (unsigned)__shfl_xor((int)g0[15 - i], 32); top[i] = umax(g0[i], o); }
    merge_desc<16>(top);
}
__device__ __forceinline__ void phase(AP A, FK_LAS unsigned char* lds, int l, int vcu, int G, int dry, const XcdBarrier bar, const int use_bar) {
#define GBAR() do { if (use_bar) xcd_barrier(bar); } while (0)
    const int tid = opaque_tid(), lane = tid & 63, wave = __builtin_amdgcn_readfirstlane(tid >> 6), r32 = lane & 31, hi = lane >> 5;
    const int TS = (l == 0 && (NTOK % 24) == 0) ? 24 : 32, TPW = TS / 8;
    const int ntile = (l == 0 ? NTOK : NLAT) / TS;
    const bf16_t* keys = wsp<bf16_t>(A, W.keys) + (size_t)l * 16 * 128 * 128;
    const float* mod = wsp<float>(A, W.mod) + (size_t)l * 9 * 6144;
    FK_LAS unsigned short* ridx = (FK_LAS unsigned short*)(lds + L_RIDX); FK_LAS float* rg = (FK_LAS float*)(lds + L_RG);
    FK_LAS unsigned char* tbl = (FK_LAS unsigned char*)(lds + L_TBL) + wave * 32 * 32; FK_LAS float* wk = (FK_LAS float*)(lds + L_WK) + wave * 128;
    for (int tile = vcu; tile < ntile; tile += G) {
        const int t0 = tile * TS; const int rtok = r32 < TS ? r32 : TS - 1;
        __syncthreads();
#ifndef FK_REP_SUB
#define FK_REP_SUB 0
#endif
        for (int rp = (FK_REP_SUB == 4 ? 1 : 0); rp >= 0; --rp) {
            const int h = wave; unsigned s1[16], s2[16];
            const bf16_t* qrow = wsp<bf16_t>(A, W.pq) + (size_t)(t0 + rtok) * 2048 + h * 256;
            score_top16(keys + (size_t)(h * 2 + 0) * 128 * 128, qrow, r32, hi, s1);
            score_top16(keys + (size_t)(h * 2 + 1) * 128 * 128, qrow + 128, r32, hi, s2);
            if (hi == 0) {
#pragma unroll
                for (int i = 0; i < 16; ++i) { tbl[r32 * 32 + i] = (unsigned char)(127 - (s1[i] & 127u)); tbl[r32 * 32 + 16 + i] = (unsigned char)(127 - (s2[i] & 127u)); } }
            float f1[16], f2[16];
#pragma unroll
            for (int i = 0; i < 16; ++i) { f1[i] = funord(s1[i] & ~0x7fu); f2[i] = funord(s2[i] & ~0x7fu); }
            unsigned c[32]; int cn = 0;
#pragma unroll
            for (int i = 0; i < 16; ++i)
#pragma unroll
                for (int j = 0; j < 16; ++j) if ((i + 1) * (j + 1) <= 16) {
                    const unsigned pk = (ford(f1[i] + f2[j]) & ~0xffu) | (unsigned)(255 - (i * 16 + j));
                    if ((cn & 1) == 0) c[cn >> 1] = pk; else c[cn >> 1] = hi ? pk : c[cn >> 1];
                    ++cn; }
#pragma unroll
            for (int q = 25; q < 32; ++q) c[q] = 0u;
            sort_desc<32>(c);
            unsigned ct[16];
#pragma unroll
            for (int i = 0; i < 16; ++i) { const unsigned o = (unsigned)__shfl_xor((int)c[15 - i], 32); ct[i] = umax(c[i], o); }
            merge_desc<16>(ct);
            if (hi == 0 && r32 < TS) {
                float e[16]; float sum = 0.f; const float mx = funord(ct[0] & ~0xffu);
#pragma unroll
                for (int t = 0; t < 16; ++t) { e[t] = __expf(funord(ct[t] & ~0xffu) - mx); sum += e[t]; }
                const float inv = 1.f / sum;
#pragma unroll
                for (int t = 0; t < 16; ++t) { const int ci = 255 - (int)(ct[t] & 0xffu); const int e1 = tbl[r32 * 32 + (ci >> 4)], e2 = tbl[r32 * 32 + 16 + (ci & 15)];
                    const int idx = e1 * 128 + e2; const float gg = e[t] * inv;
                    ridx[r32 * 128 + h * 16 + t] = (unsigned short)idx; rg[r32 * 128 + h * 16 + t] = gg;
                    wsp<unsigned short>(A, W.pidx)[(size_t)(t0 + r32) * 128 + ((h * 16 + t) & 7) * 16 + ((h * 16 + t) >> 3)] = (unsigned short)idx; wsp<float>(A, W.pg)[(size_t)(t0 + r32) * 128 + h * 16 + t] = gg; }
            }
        }
    }
    if (G != 256) return;
    GBAR();
    const int sl = (int)blockIdx.x & 7, rk = (int)blockIdx.x >> 3, ntok = (l == 0 ? NTOK : NLAT);
    const int r8 = lane >> 3, cc = lane & 7;
    A = opaque_args(A);
    const unsigned short* pidx = wsp<unsigned short>(A, W.pidx); const float* pgw = wsp<float>(A, W.pg);
    float* hidp = wsp<float>(A, W.pq);
    {
        const unsigned char* Us = wsp<unsigned char>(A, W.ub) + (size_t)sl * 16384 * 128; const unsigned cc16 = 16u * (unsigned)cc;
        const bf16_t* nn = wsp<bf16_t>(A, W.nn) + 128 * sl + 16 * cc;
#define TLOAD(IK, N0, N1, t) do { const u32x4 i0_ = *(const u32x4*)(pidx + (size_t)(t) * 128 + r8 * 16), i1_ = *(const u32x4*)(pidx + (size_t)(t) * 128 + r8 * 16 + 8); \
            IK[0] = i0_.x; IK[1] = i0_.y; IK[2] = i0_.z; IK[3] = i0_.w; IK[4] = i1_.x; IK[5] = i1_.y; IK[6] = i1_.z; IK[7] = i1_.w; \
            N0 = *(const u32x4*)(nn + (size_t)(t) * DM); N1 = *(const u32x4*)(nn + (size_t)(t) * DM + 8); } while (0)
#define GLOAD(GB, IK, h) do { _Pragma("unroll") for (int i = 0; i < 8; ++i) GB[i] = *(const u32x4*)(Us + (((IK[4 * (h) + (i >> 1)] >> (16 * (i & 1))) & 0xffffu) * 128u + cc16)); } while (0)
#define NUNPK(N0, N1) do { nf[0] = bflo(N0.x); nf[1] = bfhi(N0.x); nf[2] = bflo(N0.y); nf[3] = bfhi(N0.y); nf[4] = bflo(N0.z); nf[5] = bfhi(N0.z); nf[6] = bflo(N0.w); nf[7] = bfhi(N0.w); \
            nf[8] = bflo(N1.x); nf[9] = bfhi(N1.x); nf[10] = bflo(N1.y); nf[11] = bfhi(N1.y); nf[12] = bflo(N1.z); nf[13] = bfhi(N1.z); nf[14] = bflo(N1.w); nf[15] = bfhi(N1.w); } while (0)
#define HDOT(GB, t, h) do { float p[8]; \
            _Pragma("unroll") for (int i = 0; i < 8; ++i) { const unsigned aw[4] = {GB[i].x, GB[i].y, GB[i].z, GB[i].w}; float d = 0.f; \
                _Pragma("unroll") for (int q = 0; q < 4; ++q) { const f32x2 lo = __builtin_amdgcn_cvt_pk_f32_fp8(aw[q], false), hh = __builtin_amdgcn_cvt_pk_f32_fp8(aw[q], true); \
                    d = fmaf(lo[0], nf[4 * q], d); d = fmaf(lo[1], nf[4 * q + 1], d); d = fmaf(hh[0], nf[4 * q + 2], d); d = fmaf(hh[1], nf[4 * q + 3], d); } \
                p[i] = d; } \
            _Pragma("unroll") for (int i = 0; i < 4; ++i) { const float send = (cc & 1) ? p[i] : p[i + 4], keep = (cc & 1) ? p[i + 4] : p[i]; p[i] = keep + __shfl_xor(send, 1); } \
            _Pragma("unroll") for (int i = 0; i < 2; ++i) { const float send = (cc & 2) ? p[i] : p[i + 2], keep = (cc & 2) ? p[i + 2] : p[i]; p[i] = keep + __shfl_xor(send, 2); } \
            { const float send = (cc & 4) ? p[0] : p[1], keep = (cc & 4) ? p[1] : p[0]; p[0] = keep + __shfl_xor(send, 4); } \
            const int v = 4 * (cc & 1) + 2 * ((cc >> 1) & 1) + ((cc >> 2) & 1); \
            hidp[((size_t)(t) * 8 + sl) * 128 + 8 * (8 * (h) + v) + r8] = p[0]; } while (0)
        unsigned ikA[8], ikB[8]; u32x4 nA0, nA1, nB0, nB1, ga[8], gb[8]; float nf[16];
        int t = rk + 32 * wave;
        if (t < ntok) { TLOAD(ikA, nA0, nA1, t); GLOAD(ga, ikA, 0); }
#pragma unroll 1
        while (t < ntok) {
            const int t1 = t + 256;
            if (t1 < ntok) TLOAD(ikB, nB0, nB1, t1);
            GLOAD(gb, ikA, 1); NUNPK(nA0, nA1); HDOT(ga, t, 0);
            if (t1 < ntok) GLOAD(ga, ikB, 0);
            HDOT(gb, t, 1);
            if (t1 >= ntok) break;
            const int t2 = t1 + 256;
            if (t2 < ntok) TLOAD(ikA, nA0, nA1, t2);
            GLOAD(gb, ikB, 1); NUNPK(nB0, nB1); HDOT(ga, t1, 0);
            if (t2 < ntok) GLOAD(ga, ikA, 0);
            HDOT(gb, t1, 1);
            t = t2;
        }
#undef TLOAD
#undef GLOAD
#undef NUNPK
#undef HDOT
    }
    GBAR();
    {
        const unsigned char* Vs = wsp<unsigned char>(A, W.vb) + (size_t)sl * 16384 * 128; const unsigned cc16 = 16u * (unsigned)cc;
#define TLOADI(IK, t) do { const u32x4 i0_ = *(const u32x4*)(pidx + (size_t)(t) * 128 + r8 * 16), i1_ = *(const u32x4*)(pidx + (size_t)(t) * 128 + r8 * 16 + 8); \
            IK[0] = i0_.x; IK[1] = i0_.y; IK[2] = i0_.z; IK[3] = i0_.w; IK[4] = i1_.x; IK[5] = i1_.y; IK[6] = i1_.z; IK[7] = i1_.w; } while (0)
#define TLOADH(H, PGV, t) do { const float* hp_ = hidp + (size_t)(t) * 1024 + lane; _Pragma("unroll") for (int q = 0; q < 8; ++q) { H[2 * q] = hp_[q * 128]; H[2 * q + 1] = hp_[q * 128 + 64]; } \
            PGV[0] = pgw[(size_t)(t) * 128 + lane]; PGV[1] = pgw[(size_t)(t) * 128 + 64 + lane]; } while (0)
#define GLOAD2(GB, IK, h) do { _Pragma("unroll") for (int i = 0; i < 8; ++i) GB[i] = *(const u32x4*)(Vs + (((IK[4 * (h) + (i >> 1)] >> (16 * (i & 1))) & 0xffffu) * 128u + cc16)); } while (0)
#define WCALC(H, PGV) do { float h0 = 0.f, h1 = 0.f; _Pragma("unroll") for (int q = 0; q < 8; ++q) { h0 += H[2 * q]; h1 += H[2 * q + 1]; } h0 *= (1.f / SU); h1 *= (1.f / SU); \
            w0 = PGV[0] * 0.5f * h0 * (1.f + erff(h0 * 0.70710678118654752f)) * (1.f / SV); w1 = PGV[1] * 0.5f * h1 * (1.f + erff(h1 * 0.70710678118654752f)) * (1.f / SV); } while (0)
#define VACC(GB, h) do { _Pragma("unroll") for (int i = 0; i < 8; ++i) { const float w = __shfl((h) ? w1 : w0, 8 * i + r8); const unsigned aw[4] = {GB[i].x, GB[i].y, GB[i].z, GB[i].w}; \
                _Pragma("unroll") for (int q = 0; q < 4; ++q) { const f32x2 lo = __builtin_amdgcn_cvt_pk_f32_fp8(aw[q], false), hh = __builtin_amdgcn_cvt_pk_f32_fp8(aw[q], true); \
                    y[4 * q] = fmaf(w, lo[0], y[4 * q]); y[4 * q + 1] = fmaf(w, lo[1], y[4 * q + 1]); y[4 * q + 2] = fmaf(w, hh[0], y[4 * q + 2]); y[4 * q + 3] = fmaf(w, hh[1], y[4 * q + 3]); } } } while (0)
#define XUPD(t) do { \
            _Pragma("unroll") for (int q = 0; q < 8; ++q) { const float send = (r8 & 1) ? y[q] : y[q + 8], keep = (r8 & 1) ? y[q + 8] : y[q]; y[q] = keep + __shfl_xor(send, 8); } \
            _Pragma("unroll") for (int q = 0; q < 4; ++q) { const float send = (r8 & 2) ? y[q] : y[q + 4], keep = (r8 & 2) ? y[q + 4] : y[q]; y[q] = keep + __shfl_xor(send, 16); } \
            _Pragma("unroll") for (int q = 0; q < 2; ++q) { const float send = (r8 & 4) ? y[q] : y[q + 2], keep = (r8 & 4) ? y[q + 2] : y[q]; y[q] = keep + __shfl_xor(send, 32); } \
            const int col = 128 * sl + 16 * cc + 8 * (r8 & 1) + 4 * ((r8 >> 1) & 1) + 2 * ((r8 >> 2) & 1); const bool lat_ = (t) < NLAT; \
            float* xr_ = (lat_ ? A->xl + (size_t)(t) * DM : wsp<float>(A, W.xc) + (size_t)((t) - NLAT) * DM) + col; \
            const float* gt_ = mod + (size_t)(lat_ ? (t) / SEQ : 8) * 6144 + 5 * 1024 + col; \
            f32x2 xv_ = *(const f32x2*)xr_; const f32x2 gv_ = *(const f32x2*)gt_; xv_[0] += gv_[0] * y[0]; xv_[1] += gv_[1] * y[1]; if (!dry) *(f32x2*)xr_ = xv_; } while (0)
        unsigned ikA[8], ikB[8]; float hN[16], pgN[2]; u32x4 ga[8], gb[8]; float y[16], w0, w1;
        int t = rk + 32 * wave;
        if (t < ntok) { TLOADI(ikA, t); TLOADH(hN, pgN, t); GLOAD2(ga, ikA, 0); }
#pragma unroll 1
        while (t < ntok) {
            WCALC(hN, pgN);
            const int t1 = t + 256;
            if (t1 < ntok) { TLOADI(ikB, t1); TLOADH(hN, pgN, t1); }
            GLOAD2(gb, ikA, 1);
#pragma unroll
            for (int i = 0; i < 16; ++i) y[i] = 0.f;
            VACC(ga, 0);
            if (t1 < ntok) GLOAD2(ga, ikB, 0);
            VACC(gb, 1); XUPD(t);
            if (t1 >= ntok) break;
            WCALC(hN, pgN);
            const int t2 = t1 + 256;
            if (t2 < ntok) { TLOADI(ikA, t2); TLOADH(hN, pgN, t2); }
            GLOAD2(gb, ikB, 1);
#pragma unroll
            for (int i = 0; i < 16; ++i) y[i] = 0.f;
            VACC(ga, 0);
            if (t2 < ntok) GLOAD2(ga, ikA, 0);
            VACC(gb, 1); XUPD(t1);
            t = t2;
        }
#undef TLOADI
#undef TLOADH
#undef GLOAD2
#undef WCALC
#undef VACC
#undef XUPD
    }
    if (l == 0 && !dry) {
        GBAR();
        const float* mod1 = wsp<float>(A, W.mod) + (size_t)9 * 6144; const int gw = vcu * NWAVES + wave, NGW = G * NWAVES;
        for (int t = gw; t < NTOK; t += NGW) { const bool lat = t < NLAT; const int mr = lat ? t / SEQ : 8;
            const float* xr = lat ? A->xl + (size_t)t * DM : wsp<float>(A, W.xc) + (size_t)(t - NLAT) * DM;
            modulate_row_bf16(xr, FIN(6) + DM, mod1 + (size_t)mr * 6144 + 1024, mod1 + (size_t)mr * 6144, wsp<bf16_t>(A, W.xn) + (size_t)t * DM, lane); }
    }
}
#undef GBAR
}
__device__ __forceinline__ void phase_peer(AP A, FK_LAS unsigned char* lds, int l, int vcu, int G, int dry, const XcdBarrier bar, const int use_bar) { peer::phase(A, lds, l, vcu, G, dry, bar, use_bar); }
constexpr int N_PHASES = 16;
__global__ void __launch_bounds__(NTHR, 2) mega(Args A_unused) {
    extern __shared__ __attribute__((aligned(16))) unsigned char lds_raw[];
    FK_LAS unsigned char* lds = (FK_LAS unsigned char*)lds_raw;
    const int tid = threadIdx.x;
    AP A0 = (AP)__builtin_amdgcn_kernarg_segment_ptr();
#define AA() opaque_args(A0)
    const int G = gridDim.x, bx = blockIdx.x, vcu = (G % 8 == 0) ? (bx % 8) * (G / 8) + bx / 8 : bx;
    volatile FK_LAS unsigned* MISC = (volatile FK_LAS unsigned*)(lds + LDS_MISC);
    if (tid < 64) MISC[tid] = 0u;
    __syncthreads();
    XcdBarrier bar; bar.bar = wsp<unsigned>(A0, W.ctl) + 1024; bar.x = 0; bar.st = MISC + 8;
    if (A0->use_bar) bar = xcd_barrier_post(wsp<unsigned>(A0, W.ctl) + 1024, MISC + 8);
    const int lo = A0->ph_lo, hi = A0->ph_hi;
#define IN(k) (lo <= (k) && (k) < hi)
#ifndef FK_REP_PHASE
#define FK_REP_PHASE -1
#endif
#define REP(k) for (int rep_ = (FK_REP_PHASE == (k)) ? 1 : 0; rep_ >= 0; --rep_)
#ifndef FK_REP_BAR
#define FK_REP_BAR 0
#endif
#define SEAM(k) do { if (IN(k) && IN((k) + 1)) { xcd_barrier(bar); if (FK_REP_BAR) xcd_barrier(bar); } } while (0)
#ifndef FK_REP_ALL
#define FK_REP_ALL 0
#endif
    for (int pass = FK_REP_ALL ? 1 : 0; pass >= 0; --pass) {
    if (IN(0)) REP(0) phase_pa(AA(), lds, vcu, G);
    SEAM(0);
    if (IN(1)) REP(1) phase_pb(AA(), vcu, G);
    SEAM(1);
    for (int l = 0; l < 2; ++l) {
        const int pb = 2 + 7 * l;
        if (IN(pb + 0)) REP(pb + 0) phase_inproj(AA(), lds, l, G);
        SEAM(pb + 0);
#ifdef FK_HAVE_MIX
        if (IN(pb + 1)) REP(pb + 1) phase_mix(AA(), lds, l, vcu, G);
#endif
        SEAM(pb + 1);
#ifdef FK_HAVE_MERGE
        if (IN(pb + 2)) REP(pb + 2) phase_merge(AA(), lds, l, G);
#endif
        SEAM(pb + 2);
#ifdef FK_HAVE_OUT
        if (IN(pb + 3)) REP(pb + 3) phase_outproj(AA(), lds, l, G, rep_ | (pass & l));
#endif
        SEAM(pb + 3);
#ifdef FK_HAVE_NORM
        if (IN(pb + 4)) REP(pb + 4) phase_norm(AA(), l, vcu, G);
#endif
        SEAM(pb + 4);
#ifdef FK_HAVE_PQ
        if (IN(pb + 5)) REP(pb + 5) phase_peerq(AA(), lds, l, G);
#endif
        SEAM(pb + 5);
#ifdef FK_HAVE_PEER
        if (IN(pb + 6)) REP(pb + 6) phase_peer(AA(), lds, l, vcu, G, rep_ | pass, bar, A0->use_bar);
#endif
        SEAM(pb + 6);
    }
    if (pass) xcd_barrier(bar);
    }
#undef IN
#undef SEAM
}
inline void launch(void* const* d_in, float* out, unsigned char* ws, float* xl, int lo, int hi, bool one_launch, hipStream_t st) {
    static int ok = 0;
    if (!ok) { if (hipFuncSetAttribute((const void*)mega, hipFuncAttributeMaxDynamicSharedMemorySize, LDS_BYTES) != hipSuccess) { fprintf(stderr, "hipFuncSetAttribute failed\n"); return; } ok = 1; }
    (void)hipMemsetAsync(ws + W.ctl, 0, 65536, st);
    Args a{}; for (int i = 0; i < 30; ++i) a.in[i] = (const float*)d_in[i];
    a.out = out; a.ws = ws; a.xl = xl; a.pad = 0;
    if (one_launch) { a.ph_lo = lo; a.ph_hi = hi; a.use_bar = 1; hipLaunchKernelGGL(mega, dim3(256), dim3(NTHR), LDS_BYTES, st, a); }
    else for (int p = lo; p < hi; ++p) { a.ph_lo = p; a.ph_hi = p + 1; a.use_bar = 0; hipLaunchKernelGGL(mega, dim3(256), dim3(NTHR), LDS_BYTES, st, a); }
}
}
#ifndef FK_ONE_LAUNCH
#define FK_ONE_LAUNCH 1
#endif
extern "C" void kernel_launch(void* const* d_in, const int* in_sizes, int n_in, void* d_out, int out_size, void* d_ws, size_t ws_size, hipStream_t stream) {
    if (n_in != 30 || ws_size < fk::W.end || out_size != fk::NLAT * 1024) { fprintf(stderr, "kernel_launch: n_in %d ws %zu (need %zu) out %d\n", n_in, ws_size, (size_t)fk::W.end, out_size); return; }
    fk::launch(d_in, (float*)d_out, (unsigned char*)d_ws, (float*)d_out, 0, fk::N_PHASES, FK_ONE_LAUNCH != 0, stream);
}
```

```cpp
#include <hip/hip_runtime.h>
#include <cstdio>
#include <cstdint>
#include <math.h>
#define FK_ONE_LAUNCH 1
namespace fk {
#define FK_LAS __attribute__((address_space(3)))
typedef unsigned short bf16_t;
typedef short bf16x8 __attribute__((ext_vector_type(8)));
typedef float f32x4 __attribute__((ext_vector_type(4)));
typedef float f32x16 __attribute__((ext_vector_type(16)));
typedef unsigned u32x4 __attribute__((ext_vector_type(4)));
typedef unsigned u32x2 __attribute__((ext_vector_type(2)));
#ifndef FK_NB
#define FK_NB 8
#endif
constexpr int NB = FK_NB, SEQ = 2048, DM = 1024, CTX = 256, KALL = SEQ + CTX;
constexpr int NLAT = NB * SEQ, NCTX = NB * CTX, NTOK = NLAT + NCTX;
constexpr int PINF = 5888;
constexpr int R_HY = 0, R_FZ = 768, R_Q = 1280, R_K = 1792, R_V = 2304, R_G = 2816;
constexpr float EPS = 1e-6f;
constexpr int NWAVES = 8, NTHR = 512;
constexpr int TLL = 4224, TLC = 576;

__device__ __forceinline__ unsigned f2bf(float f) { unsigned u = __builtin_bit_cast(unsigned, f); return (u + 0x7fffu + ((u >> 16) & 1u)) >> 16; }
__device__ __forceinline__ unsigned pk2(float lo, float hi) { return f2bf(lo) | (f2bf(hi) << 16); }
__device__ __forceinline__ float bf2f(unsigned short h) { return __builtin_bit_cast(float, (unsigned)h << 16); }
__device__ __forceinline__ float bflo(unsigned w) { return __builtin_bit_cast(float, w << 16); }
__device__ __forceinline__ float bfhi(unsigned w) { return __builtin_bit_cast(float, w & 0xffff0000u); }
typedef __bf16 bf16x2_t __attribute__((ext_vector_type(2)));
__device__ __forceinline__ unsigned cvt_pk_bf16(float lo, float hi) { bf16x2_t v = {(__bf16)lo, (__bf16)hi}; return __builtin_bit_cast(unsigned, v); }
typedef float f32x2 __attribute__((ext_vector_type(2)));
constexpr float SU = 64.f, SV = 4.f;
__device__ __forceinline__ unsigned pk4_fp8(float a, float b, float c, float d) { unsigned w = __builtin_amdgcn_cvt_pk_fp8_f32(a, b, 0, false); return __builtin_amdgcn_cvt_pk_fp8_f32(c, d, w, true); }
__device__ __forceinline__ size_t tab_chunk_off(size_t i  ) { const size_t e = i >> 6, c16 = i & 63; return (((c16 >> 3) * 16384 + e) * 128) + (c16 & 7) * 16; }
__device__ __forceinline__ void cvt16_fp8(const float* src, unsigned char* dst, float sc) {
    const f32x4 x0 = *(const f32x4*)(src), x1 = *(const f32x4*)(src + 4), x2 = *(const f32x4*)(src + 8), x3 = *(const f32x4*)(src + 12);
    u32x4 o; o.x = pk4_fp8(x0[0] * sc, x0[1] * sc, x0[2] * sc, x0[3] * sc); o.y = pk4_fp8(x1[0] * sc, x1[1] * sc, x1[2] * sc, x1[3] * sc);
    o.z = pk4_fp8(x2[0] * sc, x2[1] * sc, x2[2] * sc, x2[3] * sc); o.w = pk4_fp8(x3[0] * sc, x3[1] * sc, x3[2] * sc, x3[3] * sc);
    *(u32x4*)dst = o;
}
__device__ __forceinline__ float wave_sum(float v) {
#pragma unroll
    for (int o = 32; o > 0; o >>= 1) v += __shfl_xor(v, o);
    return v;
}

struct WS {
    size_t ctl, mod, misc, h3l, h3c, tapl, tapc, w_in, w_mrg, w_out, w_q, keys, ub, vb, dftl, dftc;
    size_t xn, nn, hyt, ftl, ftc, q, qc, k, vt, g, attlo, atthi, hyo, fno, y, xl, xc, pq, pidx, pg, stash, end;
};
__host__ __device__ constexpr size_t al(size_t x) { return (x + 4095) / 4096 * 4096; }
__host__ __device__ constexpr WS make_ws() {
    WS w{}; size_t o = 0;
    w.ctl = o; o += 65536;
    w.mod = o; o += al((size_t)2 * 9 * 6144 * 4);
    w.misc = o; o += al((size_t)12 << 20);
    w.tapl = o; o += al((size_t)2 * 2 * 256 * TLL * 2);
    w.tapc = o; o += al((size_t)2 * 2 * 256 * TLC * 2);
    w.w_in = o; o += al((size_t)2 * PINF * 1024 * 2);
    w.w_mrg = o; o += al((size_t)2 * 4 * 1024 * 256 * 2);
    w.w_out = o; o += al((size_t)2 * 1024 * 1024 * 2);
    w.w_q = o; o += al((size_t)2 * 2048 * 1024 * 2);
    w.keys = o; o += al((size_t)2 * 16 * 128 * 128 * 2);
    w.ub = o; o += al((size_t)16384 * 1024);
    w.vb = o; o += al((size_t)16384 * 1024);
    w.dftl = o; o += al((size_t)2048 * 4096 * 2);
    w.dftc = o; o += al((size_t)256 * 512 * 2);
    w.xn = o; o += al((size_t)NTOK * 1024 * 2);
    w.nn = o; w.stash = o; { size_t a = al((size_t)NTOK * 1024 * 2), b = al((size_t)256 * 512 * 128 * 4); o += a > b ? a : b; }
    w.hyt = o; w.y = o; { size_t a = al((size_t)768 * NTOK * 2) + al((size_t)NB * 256 * 4096 * 2) + al((size_t)NB * 256 * 512 * 2), b = al((size_t)NTOK * 1024 * 2);
        w.ftl = o + al((size_t)768 * NTOK * 2); w.ftc = w.ftl + al((size_t)NB * 256 * 4096 * 2); o += a > b ? a : b; }
    w.q = o; o += al((size_t)NB * 8 * 2048 * 64 * 2);
    w.qc = o; o += al((size_t)NB * 8 * 256 * 64 * 2);
    w.k = o; o += al((size_t)NB * 8 * KALL * 64 * 2);
    w.vt = o; o += al((size_t)NB * 4 * 128 * KALL * 2);
    w.g = o; w.pq = o; w.h3l = o; { size_t a = al((size_t)NTOK * 3072 * 2), b = al((size_t)2 * 2048 * 1024 * 4) + al((size_t)2 * 256 * 1024 * 4);
        w.h3c = o + al((size_t)2 * 2048 * 1024 * 4); o += a > b ? a : b; }
    w.attlo = o; o += al((size_t)NTOK * 256 * 2);
    w.atthi = o; o += al((size_t)NTOK * 256 * 2);
    w.hyo = o; o += al((size_t)NTOK * 256 * 2);
    w.fno = o; o += al((size_t)NTOK * 256 * 2);
    w.xl = o; o += (NB == 8) ? 0 : al((size_t)NLAT * 1024 * 4);
    w.xc = o; o += al((size_t)NCTX * 1024 * 4);
    w.pidx = o; o += al((size_t)NTOK * 128 * 4);
    w.pg = o; o += al((size_t)NTOK * 128 * 4);
    w.end = o; return w;
}
constexpr WS W = make_ws();
constexpr int MI_LAM = 0, MI_ROPE = 64, MI_HYINV = 4096, MI_HYPART = 8192;

constexpr int BM = 256, BK = 64, HALF = 128, HTB = HALF * BK * 2, STAGE_BYTES = 8 * HTB;
__host__ __device__ __forceinline__ int lds_byte(int r, int c) { const int st = (r >> 4) * 2 + (c >> 5), rr = r & 15, cc = c & 31, ob = rr * 64 + cc * 2; return st * 1024 + (ob ^ (((ob >> 9) & 1) << 5)); }
__host__ __device__ __forceinline__ void stage_rc(int b, int& R, int& C) { const int st = b / 1024, sb = b % 1024, swz = sb ^ (((sb >> 9) & 1) << 5); R = (st >> 1) * 16 + swz / 64; C = (st & 1) * 32 + (swz % 64) / 2; }
__host__ __device__ __forceinline__ int perm32(int rho) { const int n = rho >> 4, i = rho & 15; return 8 * (i >> 2) + 4 * n + (i & 3); }

struct Unit { const char* a; const char* b; int pm, pn, kind, aux; };
typedef f32x4 Acc[2][2][4][2];

template <class Sched, class Epi>
__device__ __forceinline__ void gemm_phase(FK_LAS unsigned char* lds, const int K, const Sched& S, const Epi& E) {
    int tid = threadIdx.x; asm volatile("" : "+v"(tid));
    const int wid = __builtin_amdgcn_readfirstlane(tid >> 6), lane = tid & 63, wr = wid >> 2, wc = wid & 3, fr = lane & 15, fq = lane >> 4;
    const int nt = K / BK;
    unsigned voffA[2], voffB[2];
#pragma unroll
    for (int i = 0; i < 2; ++i) { int R, C; stage_rc(tid * 16 + i * 8192, R, C); const int Rb = (R & ~31) + perm32(R & 31);
        voffA[i] = (unsigned)(R * K + C) * 2u; voffB[i] = (unsigned)(Rb * K + C) * 2u; }
    const size_t kstep = (size_t)(BK * 2);
    const size_t hstep = (size_t)HALF * K * 2;
    const unsigned ldsw = (unsigned)wid * 1024u;
    const int aoff = lds_byte(wr * 64 + fr, fq * 8), boff = lds_byte(wc * 32 + fr, fq * 8);
#define PG8_SA(b, h) (((b) * 2 + (h)) * HTB)
#define PG8_SB(b, h) ((4 + (b) * 2 + (h)) * HTB)
#define PG8_STAGE(bufoff, gbase, voff) do { _Pragma("unroll") for (int _i = 0; _i < 2; ++_i) \
        __builtin_amdgcn_global_load_lds((const unsigned*)((const char*)(gbase) + (voff)[_i]), (FK_LAS unsigned*)(lds + (bufoff) + ldsw + _i * 8192), 16, 0, 0); } while (0)
#define PG8_LDA(dst, b, h) do { _Pragma("unroll") for (int m = 0; m < 4; ++m) _Pragma("unroll") for (int k = 0; k < 2; ++k) dst[m][k] = *(const FK_LAS bf16x8*)(lds + PG8_SA(b, h) + aoff + m * 2048 + k * 1024); } while (0)
#define PG8_LDB(dst, b, h) do { _Pragma("unroll") for (int n = 0; n < 2; ++n) _Pragma("unroll") for (int k = 0; k < 2; ++k) dst[n][k] = *(const FK_LAS bf16x8*)(lds + PG8_SB(b, h) + boff + n * 2048 + k * 1024); } while (0)
#define PG8_MMA(ai, bj, At, Bt) do { __builtin_amdgcn_s_setprio(1); _Pragma("unroll") for (int m = 0; m < 4; ++m) _Pragma("unroll") for (int n = 0; n < 2; ++n) _Pragma("unroll") for (int k = 0; k < 2; ++k) \
        acc[ai][bj][m][n] = __builtin_amdgcn_mfma_f32_16x16x32_bf16(Bt[n][k], At[m][k], acc[ai][bj][m][n], 0, 0, 0); __builtin_amdgcn_s_setprio(0); } while (0)
#define PG8_WAIT_V(n) asm volatile("s_waitcnt vmcnt(" #n ")" ::: "memory")
#define PG8_WAIT_L(n) asm volatile("s_waitcnt lgkmcnt(" #n ")" ::: "memory")
#define PG8_BAR __builtin_amdgcn_s_barrier()
#define PG8_SCHED __builtin_amdgcn_sched_barrier(0)
    Unit cur, nxt; int ui = 0;
    if (!S.next(0, cur)) return;
    Acc acc;
#pragma unroll
    for (int a = 0; a < 2; ++a)
#pragma unroll
        for (int b = 0; b < 2; ++b)
#pragma unroll
            for (int m = 0; m < 4; ++m)
#pragma unroll
                for (int n = 0; n < 2; ++n) acc[a][b][m][n] = (f32x4){0.f, 0.f, 0.f, 0.f};
    bf16x8 At[4][2], B0[2][2], B1[2][2];
    const char* cA = cur.a; const char* cB = cur.b;
    PG8_STAGE(PG8_SB(0, 0), cB, voffB); PG8_STAGE(PG8_SB(0, 1), cB + hstep, voffB); PG8_STAGE(PG8_SA(0, 0), cA, voffA); PG8_STAGE(PG8_SA(0, 1), cA + hstep, voffA);
    if (wr == 1) PG8_BAR;
    PG8_WAIT_V(2); PG8_BAR;
    PG8_STAGE(PG8_SB(1, 0), cB + kstep, voffB); PG8_STAGE(PG8_SA(1, 0), cA + kstep, voffA); PG8_STAGE(PG8_SB(1, 1), cB + hstep + kstep, voffB);
    PG8_WAIT_V(6); PG8_BAR;
    for (;;) {
        const bool has_next = S.next(ui + 1, nxt);
        const char* nA = has_next ? nxt.a : cA; const char* nB = has_next ? nxt.b : cB;
        for (int t = 0; t < nt; t += 2) {
            const bool last = (t == nt - 2);
            const char* a1 = cA + (size_t)(t + 1) * kstep;
            const char* a2 = last ? nA : cA + (size_t)(t + 2) * kstep; const char* b2 = last ? nB : cB + (size_t)(t + 2) * kstep;
            const char* a3 = a2 + kstep; const char* b3 = b2 + kstep;
            PG8_LDB(B0, 0, 0); PG8_LDB(B1, 0, 1); PG8_SCHED; PG8_LDA(At, 0, 0); PG8_STAGE(PG8_SA(1, 1), a1 + hstep, voffA);
            PG8_WAIT_V(8); PG8_WAIT_L(0); PG8_BAR; PG8_MMA(0, 0, At, B0); PG8_MMA(0, 1, At, B1); PG8_BAR; PG8_SCHED;
            PG8_LDA(At, 0, 1); PG8_STAGE(PG8_SB(0, 0), b2, voffB); PG8_STAGE(PG8_SB(0, 1), b2 + hstep, voffB); PG8_STAGE(PG8_SA(0, 0), a2, voffA);
            PG8_WAIT_V(8); PG8_WAIT_L(0); PG8_BAR; PG8_MMA(1, 0, At, B0); PG8_MMA(1, 1, At, B1); PG8_BAR; PG8_SCHED;
            PG8_LDB(B0, 1, 0); PG8_LDB(B1, 1, 1); PG8_SCHED; PG8_LDA(At, 1, 0); PG8_STAGE(PG8_SA(0, 1), a2 + hstep, voffA);
            PG8_WAIT_V(8); PG8_WAIT_L(0); PG8_BAR; PG8_MMA(0, 0, At, B0); PG8_MMA(0, 1, At, B1); PG8_BAR; PG8_SCHED;
            PG8_LDA(At, 1, 1); PG8_STAGE(PG8_SB(1, 0), b3, voffB); PG8_STAGE(PG8_SB(1, 1), b3 + hstep, voffB); PG8_STAGE(PG8_SA(1, 0), a3, voffA);
            PG8_WAIT_V(8); PG8_WAIT_L(0); PG8_BAR; PG8_MMA(1, 0, At, B0); PG8_MMA(1, 1, At, B1); PG8_BAR; PG8_SCHED;
        }
        if (wr == 0) PG8_BAR;
        int fr2 = fr, fq2 = fq; asm volatile("" : "+v"(fr2), "+v"(fq2));
        const bool zero = E(acc, cur, wr, wc, fr2, fq2);
        if (!has_next) break;
        if (zero) {
#pragma unroll
            for (int a = 0; a < 2; ++a)
#pragma unroll
                for (int b = 0; b < 2; ++b)
#pragma unroll
                    for (int m = 0; m < 4; ++m)
#pragma unroll
                        for (int n = 0; n < 2; ++n) acc[a][b][m][n] = (f32x4){0.f, 0.f, 0.f, 0.f};
        }
        cur = nxt; cA = nA; cB = nB; ++ui;
        if (wr == 1) PG8_BAR;
    }
    PG8_WAIT_V(0);
    PG8_BAR;
#undef PG8_SA
#undef PG8_SB
#undef PG8_STAGE
#undef PG8_LDA
#undef PG8_LDB
#undef PG8_MMA
#undef PG8_WAIT_V
#undef PG8_WAIT_L
#undef PG8_BAR
#undef PG8_SCHED
}
#define XB_TMO      128
#define XB_XCNT(j)  (256  + 64 * (j))
#define XB_XSUB(j)  (1280 + 64 * (j))
#define XB_XGEN(j)  (2304 + 64 * (j))
#define XB_TOP      3328
#define XB_TOPGEN   3392
#define XCD_BAR_WORDS 3456
#define XB_SPIN_CAP (1u << 20)
__device__ __forceinline__ unsigned xb_ld(unsigned* p)              { return __hip_atomic_load(p, __ATOMIC_RELAXED, __HIP_MEMORY_SCOPE_AGENT); }
__device__ __forceinline__ unsigned xb_add(unsigned* p, unsigned v) { return __hip_atomic_fetch_add(p, v, __ATOMIC_RELAXED, __HIP_MEMORY_SCOPE_AGENT); }
__device__ __forceinline__ unsigned xb_xcc_id() { return (unsigned)__builtin_amdgcn_s_getreg((3 << 11) | 20) & 0xFu; }
#define XB_SPIN(cond, bar) do { unsigned _sp = 0; while (cond) { __builtin_amdgcn_s_sleep(1); \
    if ((++_sp & 255u) == 0u) { if (xb_ld(&(bar)[XB_TMO])) break; if (_sp > XB_SPIN_CAP) { atomicAdd(&(bar)[XB_TMO], 1u); break; } } } } while (0)
struct XcdBarrier { unsigned* bar; unsigned x; volatile FK_LAS unsigned* st; };
__device__ __forceinline__ XcdBarrier xcd_barrier_post(unsigned* bar, volatile FK_LAS unsigned* st) {
    XcdBarrier b; b.bar = bar; b.x = xb_xcc_id(); b.st = st;
    if (threadIdx.x == 0) (void)xb_add(&bar[XB_XCNT(b.x)], 1u);
    return b;
}
__device__ __forceinline__ void xcd_barrier_complete(unsigned* bar, unsigned x, unsigned& nloc, unsigned& nx) {
    const unsigned G = gridDim.x * gridDim.y * gridDim.z;
    unsigned sum, cnt, mine, sp = 0u;
    for (;;) {
        sum = 0u; cnt = 0u; mine = 0u;
#pragma unroll
        for (unsigned j = 0; j < 16; ++j) { const unsigned c = xb_ld(&bar[XB_XCNT(j)]); sum += c; cnt += (c > 0u) ? 1u : 0u; mine = (j == x) ? c : mine; }
        if (sum == G) break;
        __builtin_amdgcn_s_sleep(1);
        if ((++sp & 255u) == 0u) { if (xb_ld(&bar[XB_TMO])) break; if (sp > XB_SPIN_CAP) { atomicAdd(&bar[XB_TMO], 1u); break; } }
    }
    nloc = mine > 0u ? mine : 1u; nx = cnt > 0u ? cnt : 1u;
}
__device__ __forceinline__ void xcd_barrier(const XcdBarrier& b) {
    asm volatile("s_waitcnt vmcnt(0)" ::: "memory");
    __syncthreads();
    if (threadIdx.x == 0) {
        unsigned* bar = b.bar;
        __builtin_amdgcn_s_waitcnt(0);
        unsigned nloc = b.st[0], nx = b.st[1];
        if (nloc == 0u) { xcd_barrier_complete(bar, b.x, nloc, nx); b.st[0] = nloc; b.st[1] = nx; }
        const unsigned old = xb_add(&bar[XB_XSUB(b.x)], 1u);
        const unsigned gen = old / nloc;
        if (old + 1u == (gen + 1u) * nloc) {
            __builtin_amdgcn_fence(__ATOMIC_RELEASE, "agent");
            asm volatile("s_waitcnt vmcnt(0)" ::: "memory");
            const unsigned og = xb_add(&bar[XB_TOP], 1u);
            const unsigned tg = og / nx;
            if (og + 1u == (tg + 1u) * nx) xb_add(&bar[XB_TOPGEN], 1u);
            else XB_SPIN(xb_ld(&bar[XB_TOPGEN]) == tg, bar);
            __builtin_amdgcn_fence(__ATOMIC_ACQUIRE, "agent");
            xb_add(&bar[XB_XGEN(b.x)], 1u);
            asm volatile("s_waitcnt vmcnt(0)" ::: "memory");
        } else {
            XB_SPIN(xb_ld(&bar[XB_XGEN(b.x)]) == gen, bar);
            __builtin_amdgcn_fence(__ATOMIC_ACQUIRE, "agent");
            asm volatile("s_waitcnt vmcnt(0)" ::: "memory");
        }
    }
    __syncthreads();
}

struct Args { const float* in[30]; float* out; unsigned char* ws; float* xl; int ph_lo, ph_hi, use_bar, pad; };
constexpr int LDS_MISC = 155648, LDS_BYTES = 155648 + 256;

struct Ctx {
    const Args* a; FK_LAS unsigned char* lds; int tid, lane, wave, vcu, G;
};
typedef const Args __attribute__((address_space(4)))* AP;
#define FIN(i) (A->in[i])
template <class T> __device__ __forceinline__ T* wsp(AP A, size_t off) { return (T*)(A->ws + off); }
__device__ __forceinline__ int opaque_tid() { int t = threadIdx.x; asm volatile("" : "+v"(t)); return t; }
__device__ __forceinline__ AP opaque_args(AP a) { asm volatile("" : "+s"(a)); return a; }

__device__ __forceinline__ int inproj_src_col(int p) {
    if (p < R_FZ) return p;
    if (p >= R_V) return p - R_V + 2048;
    const int q0 = p - R_Q, tile = q0 >> 8, pl = q0 & 255;
    const int bj = pl >> 7, wc = (pl >> 5) & 3, fq = (pl >> 3) & 3, e = pl & 7;
    return 1024 + tile * 256 + 64 * wc + 32 * (fq >> 1) + 16 * bj + 8 * (fq & 1) + e;
}
template <class ColFn>
__device__ __forceinline__ void transpose_item(const float* src, int ldsrc, int ksrc0, bf16_t* dst, int Kd, int p0, int k0, FK_LAS float* scr, int lane, ColFn col) {
    const int cidx = col(p0 + (lane & 31));
    float tv[32];
#pragma unroll
    for (int i = 0; i < 32; ++i) tv[i] = src[(size_t)(ksrc0 + k0 + 2 * i + (lane >> 5)) * ldsrc + cidx];
#pragma unroll
    for (int i = 0; i < 32; ++i) scr[(2 * i + (lane >> 5)) * 33 + (lane & 31)] = tv[i];
    asm volatile("s_waitcnt lgkmcnt(0)" ::: "memory");
    const int c = lane & 7;
#pragma unroll
    for (int j = 0; j < 4; ++j) { const int n = (lane >> 3) + 8 * j; const FK_LAS float* s = scr + (8 * c) * 33 + n;
        u32x4 o; o.x = pk2(s[0 * 33], s[1 * 33]); o.y = pk2(s[2 * 33], s[3 * 33]); o.z = pk2(s[4 * 33], s[5 * 33]); o.w = pk2(s[6 * 33], s[7 * 33]);
        *(u32x4*)(dst + (size_t)(p0 + n) * Kd + k0 + 8 * c) = o; }
    asm volatile("s_waitcnt lgkmcnt(0)" ::: "memory");
}
struct IdCol { int off; __device__ int operator()(int p) const { return p + off; } };
struct InprojCol { __device__ int operator()(int p) const { return inproj_src_col(p); } };

__device__ __forceinline__ void phase_pa(AP A, FK_LAS unsigned char* lds, int vcu, int G) {
    const int tid = opaque_tid(), lane = tid & 63, wave = __builtin_amdgcn_readfirstlane(tid >> 6);
    const int gw = vcu * NWAVES + wave, NGW = G * NWAVES;
    const size_t gt = (size_t)vcu * NTHR + tid, NGT = (size_t)G * NTHR;
    float* misc = wsp<float>(A, W.misc);
    FK_LAS float* ctab = (FK_LAS float*)(lds + 131072); FK_LAS float* stab = ctab + 2048;
    for (int i = tid; i < 2048; i += NTHR) { const float a = (float)i * (2.f / 2048.f); ctab[i] = cospif(a); stab[i] = sinpif(a); }
    __syncthreads();
    if (vcu == 0) {
        if (tid < 2) { const float* p = FIN(20) + tid * 256; float a = 0.f, b = 0.f;
            for (int i = 0; i < 64; ++i) { a += p[i] * p[64 + i]; b += p[128 + i] * p[192 + i]; }
            misc[MI_LAM + tid] = expf(a) - expf(b) + (0.8f - 0.6f * expf(-0.3f * (float)tid)); }
        for (int i = tid; i < 64 * 16; i += NTHR) { const int pos = i >> 4, e = i & 15; const float inv = powf(10000.f, -(float)(2 * e) / 32.f), ang = (float)pos * inv;
            misc[MI_ROPE + 2 * i] = cosf(ang); misc[MI_ROPE + 2 * i + 1] = sinf(ang); }
    }
    {
        FK_LAS float* s = (FK_LAS float*)lds;
        FK_LAS float* red = (FK_LAS float*)(lds + 9 * 1024 * 4);
        bool have = false;
        for (int it = vcu; it < 192; it += G) {
            if (!have) { for (int i = tid; i < 9 * 1024; i += NTHR) { const int r = i >> 10, k = i & 1023; const float v = r < 8 ? FIN(1)[r * 1024 + k] : FIN(3)[k]; s[i] = v / (1.f + expf(-v)); } __syncthreads(); have = true; }
            const int l = it / 96, n0 = (it % 96) * 64, kq = tid >> 6, c = tid & 63;
            const float* Wp = FIN(4) + (size_t)l * 1024 * 6144 + n0 + c;
            float acc[9];
#pragma unroll
            for (int r = 0; r < 9; ++r) acc[r] = 0.f;
#pragma unroll 1
            for (int k0 = kq * 128; k0 < kq * 128 + 128; k0 += 16) { float wv[16];
#pragma unroll
                for (int j = 0; j < 16; ++j) wv[j] = Wp[(size_t)(k0 + j) * 6144];
#pragma unroll
                for (int j = 0; j < 16; ++j)
#pragma unroll
                    for (int r = 0; r < 9; ++r) acc[r] += s[r * 1024 + k0 + j] * wv[j]; }
#pragma unroll
            for (int r = 0; r < 9; ++r) red[(kq * 9 + r) * 64 + c] = acc[r];
            __syncthreads();
            for (int i = tid; i < 9 * 64; i += NTHR) { const int r = i >> 6, cc = i & 63; float t = 0.f;
#pragma unroll
                for (int q = 0; q < 8; ++q) t += red[(q * 9 + r) * 64 + cc];
                wsp<float>(A, W.mod)[((size_t)l * 9 + r) * 6144 + n0 + cc] = t + FIN(5)[l * 6144 + n0 + cc]; }
            __syncthreads();
        }
        __syncthreads();
    }
    {
        FK_LAS float* scr = (FK_LAS float*)(lds + wave * 16384);
        constexpr int I_IN = (PINF / 32) * 16;
        constexpr int I_M = (1024 / 32) * 4;
        constexpr int I_O = (1024 / 32) * 16, I_Q = (2048 / 32) * 16;
        constexpr int PER_L = I_IN + 4 * I_M + I_O + I_Q;
        for (int it = gw; it < 2 * PER_L; it += NGW) {
            const int l = it / PER_L; int r = it % PER_L;
            if (r < I_IN) { const int p0 = (r >> 4) * 32, k0 = (r & 15) * 64;
                if (p0 >= R_FZ && p0 < R_Q) continue;
                transpose_item(FIN(8) + (size_t)l * 1024 * 5632, 5632, 0, wsp<bf16_t>(A, W.w_in) + (size_t)l * PINF * 1024, 1024, p0, k0, scr, lane, InprojCol{}); continue; }
            r -= I_IN;
            if (r < 4 * I_M) { const int seg = r / I_M, q = r % I_M, p0 = (q >> 2) * 32, k0 = (q & 3) * 64;
                const float* src = seg == 0 ? FIN(22) + (size_t)l * 256 * 1024 : seg == 1 ? FIN(23) + (size_t)l * 256 * 1024 : FIN(24) + (size_t)l * 512 * 1024;
                transpose_item(src, 1024, seg == 3 ? 256 : 0, wsp<bf16_t>(A, W.w_mrg) + ((size_t)l * 4 + seg) * 1024 * 256, 256, p0, k0, scr, lane, IdCol{0}); continue; }
            r -= 4 * I_M;
            if (r < I_O) { const int p0 = (r >> 4) * 32, k0 = (r & 15) * 64;
                transpose_item(FIN(25) + (size_t)l * 1024 * 1024, 1024, 0, wsp<bf16_t>(A, W.w_out) + (size_t)l * 1024 * 1024, 1024, p0, k0, scr, lane, IdCol{0}); continue; }
            r -= I_O;
            { const int p0 = (r >> 4) * 32, k0 = (r & 15) * 64;
                transpose_item(FIN(26) + (size_t)l * 1024 * 2048, 2048, 0, wsp<bf16_t>(A, W.w_q) + (size_t)l * 2048 * 1024, 1024, p0, k0, scr, lane, IdCol{0}); }
        }
    }
    for (size_t i = gt; i < (size_t)1 << 17; i += NGT) {
        const int k = (int)(i & 1023), mc = (int)((i >> 10) & 7), part = (int)((i >> 13) & 1), g = (int)((i >> 14) & 3), l = (int)(i >> 16);
        const float* src = FIN(8) + (size_t)l * 1024 * 5632 + (size_t)k * 5632 + 768 + g * 64;
        f32x4 sv[16];
#pragma unroll
        for (int q = 0; q < 16; ++q) sv[q] = *(const f32x4*)(src + 4 * q);
        const FK_LAS float* tb = part ? stab : ctab;
        bf16_t* dst = wsp<bf16_t>(A, W.w_in) + ((size_t)l * PINF + R_FZ + part * 256 + g * 64 + mc * 8) * 1024 + k;
#pragma unroll 1
        for (int mm = 0; mm < 8; ++mm) { const int m = mc * 8 + mm; float acc = 0.f;
#pragma unroll
            for (int q = 0; q < 16; ++q)
#pragma unroll
                for (int j = 0; j < 4; ++j) acc += sv[q][j] * tb[((m * (4 * q + j)) & 63) * 32];
            dst[(size_t)mm * 1024] = (bf16_t)f2bf(acc); }
    }
    {
        const size_t nUV = (size_t)16384 * 1024 / 16, nK = (size_t)2 * 16 * 128 * 128 / 8;
        for (size_t i0 = gt; i0 < 2 * nUV + nK; i0 += 2 * NGT) {
#pragma unroll
            for (int rep = 0; rep < 2; ++rep) { const size_t i = i0 + rep * NGT; if (i >= 2 * nUV + nK) break;
                if (i < nUV) cvt16_fp8(FIN(28) + i * 16, wsp<unsigned char>(A, W.ub) + tab_chunk_off(i), SU);
                else if (i < 2 * nUV) cvt16_fp8(FIN(29) + (i - nUV) * 16, wsp<unsigned char>(A, W.vb) + tab_chunk_off(i - nUV), SV);
                else { const size_t j = i - 2 * nUV; const float* src = FIN(27); bf16_t* dst = wsp<bf16_t>(A, W.keys);
                    const f32x4 x0 = *(const f32x4*)(src + j * 8), x1 = *(const f32x4*)(src + j * 8 + 4);
                    u32x4 o; o.x = pk2(x0[0], x0[1]); o.y = pk2(x0[2], x0[3]); o.z = pk2(x1[0], x1[1]); o.w = pk2(x1[2], x1[3]);
                    *(u32x4*)(dst + j * 8) = o; } }
        }
    }
    for (size_t i = gt; i < (size_t)2048 * 2048 + 256 * 256; i += NGT) {
        const bool big = i < (size_t)2048 * 2048; const size_t j = big ? i : i - (size_t)2048 * 2048; const int L = big ? 2048 : 256, lg = big ? 11 : 8;
        const int k = (int)(j >> lg), t = (int)(j & (L - 1)); const int ti = ((k * t) & (L - 1)) * (2048 / L); const float sc = rsqrtf(64.f * (float)L);
        bf16_t* d = big ? wsp<bf16_t>(A, W.dftl) : wsp<bf16_t>(A, W.dftc);
        d[(size_t)k * 2 * L + t] = (bf16_t)f2bf(sc * ctab[ti]); d[(size_t)k * 2 * L + L + t] = (bf16_t)f2bf(-sc * stab[ti]);
    }
    {
        constexpr int HPP = 4;
        FK_LAS float* h1 = (FK_LAS float*)lds; FK_LAS float* h2 = h1 + HPP * 64; FK_LAS float* ft = h2 + HPP * 64;
        FK_LAS float* w1s = ft + HPP * 33 + 4; FK_LAS float* w2s = w1s + 33 * 64; FK_LAS float* b1s = w2s + 64 * 64; FK_LAS float* b2s = b1s + 64; FK_LAS float* fqs = b2s + 64;
        constexpr int IT_L = 2048 / HPP, IT_C = 256 / HPP, PER = IT_L + IT_C;
        int lcur = -1;
        for (int it = vcu; it < 2 * PER; it += G) {
            const int l = it / PER, r = it % PER, big = r < IT_L, L = big ? 2048 : 256, p0 = (big ? r : r - IT_L) * HPP;
            __syncthreads();
            if (l != lcur) { lcur = l;
                for (int i = tid; i < 33 * 64; i += NTHR) w1s[i] = FIN(11)[l * 33 * 64 + i];
                for (int i = tid; i < 64 * 64; i += NTHR) w2s[i] = FIN(14)[l * 4096 + i];
                if (tid < 64) { b1s[tid] = FIN(12)[l * 64 + tid]; b2s[tid] = FIN(15)[l * 64 + tid]; fqs[tid] = FIN(13)[l * 64 + tid]; } }
            for (int i = tid; i < HPP * 33; i += NTHR) { const int pp = i / 33, e = i % 33, pos = p0 + pp; const float t = (float)pos / (float)(L - 1), w = 2.0f * 3.14159265358979323846f * (float)pos / (float)L;
                float v; if (e == 0) v = t; else { const int b = (e - 1) & 15; const float f = 1e-4f + (float)b * ((15.f - 1e-4f) / 15.f), a = w * f; v = e <= 16 ? cosf(a) : -sinf(a); }
                ft[i] = v; }
            __syncthreads();
            for (int i = tid; i < HPP * 64; i += NTHR) { const int pp = i >> 6, j = i & 63; float acc = 0.f;
                for (int e = 0; e < 33; ++e) acc += ft[pp * 33 + e] * w1s[e * 64 + j];
                h1[i] = sinf(fqs[j] * (acc + b1s[j])); }
            __syncthreads();
            for (int i = tid; i < HPP * 64; i += NTHR) { const int pp = i >> 6, j = i & 63; float acc = 0.f;
                for (int e = 0; e < 64; ++e) acc += h1[pp * 64 + e] * w2s[e * 64 + j];
                h2[i] = sinf(fqs[j] * (acc + b2s[j])); }
            __syncthreads();
            float* H3 = big ? wsp<float>(A, W.h3l) + (size_t)l * 2048 * 1024 : wsp<float>(A, W.h3c) + (size_t)l * 256 * 1024;
            float* part = misc + MI_HYPART + ((size_t)(l * 2 + (big ? 0 : 1)) * IT_L + (big ? r : r - IT_L)) * 1024;
#pragma unroll
            for (int cc = 0; cc < 2; ++cc) { const int col = tid + cc * 512, ch = col & 255;
                const float mn = -3.0701134573253946f, mx = -15.350567286626973f; const float delta = fabsf(mn + (float)ch * ((mx - mn) / 255.f));
                float acc[HPP];
#pragma unroll
                for (int pp = 0; pp < HPP; ++pp) acc[pp] = 0.f;
                const float* w3 = FIN(16) + (size_t)l * 65536 + col;
#pragma unroll 1
                for (int e0 = 0; e0 < 64; e0 += 16) { float wv[16];
#pragma unroll
                    for (int j = 0; j < 16; ++j) wv[j] = w3[(size_t)(e0 + j) * 1024];
#pragma unroll
                    for (int j = 0; j < 16; ++j)
#pragma unroll
                        for (int pp = 0; pp < HPP; ++pp) acc[pp] += h2[pp * 64 + e0 + j] * wv[j]; }
                float ps = 0.f;
#pragma unroll
                for (int pp = 0; pp < HPP; ++pp) { const int pos = p0 + pp; const float v = acc[pp] * expf(-((float)pos / (float)(L - 1)) * delta); H3[(size_t)pos * 1024 + col] = v;
                    if (!(col >= 512 && pos == 0)) ps += fabsf(v); }
                part[col] = ps; }
        }
        __syncthreads();
    }
}
__device__ __forceinline__ void modulate_row_bf16(const float* xrow, const float* g, const float* scale, const float* shift, bf16_t* orow, int lane) {
    f32x4 v[4]; float ss = 0.f;
#pragma unroll
    for (int j = 0; j < 4; ++j) { v[j] = *(const f32x4*)(xrow + 4 * lane + 256 * j); ss += (v[j][0] * v[j][0] + v[j][1] * v[j][1]) + (v[j][2] * v[j][2] + v[j][3] * v[j][3]); }
    ss = wave_sum(ss); const float rs = rsqrtf(ss * (1.f / 1024.f) + EPS);
#pragma unroll
    for (int j = 0; j < 4; ++j) { const int k = 4 * lane + 256 * j; const f32x4 gg = *(const f32x4*)(g + k), sc = *(const f32x4*)(scale + k), sf = *(const f32x4*)(shift + k);
        const f32x4 o = v[j] * rs * gg * (sc + 1.0f) + sf; u32x2 w; w.x = pk2(o[0], o[1]); w.y = pk2(o[2], o[3]); *(u32x2*)(orow + k) = w; }
}
__device__ __forceinline__ void phase_pb(AP A, int vcu, int G) {
    const int tid = opaque_tid(), lane = tid & 63, wave = __builtin_amdgcn_readfirstlane(tid >> 6); (void)tid;
    const int gw = vcu * NWAVES + wave, NGW = G * NWAVES;
    const float* mod = wsp<float>(A, W.mod);
    for (int t = gw; t < NTOK; t += NGW) {
        const bool lat = t < NLAT; const int mr = lat ? t / SEQ : 8;
        const float* xr = lat ? FIN(0) + (size_t)t * DM : FIN(2) + (size_t)(t - NLAT) * DM;
        modulate_row_bf16(xr, FIN(6), mod + (size_t)mr * 6144 + 1024, mod + (size_t)mr * 6144, wsp<bf16_t>(A, W.xn) + (size_t)t * DM, lane);
    }
    const float* misc = wsp<float>(A, W.misc);
    for (int row = gw; row < 2 * 2 * 512; row += NGW) {
        const int l = row >> 10, big = ((row >> 9) & 1) == 0, oc = row & 511, L = big ? 2048 : 256, TLn = big ? TLL : TLC, nit = big ? 512 : 64;
        const float* part = misc + MI_HYPART + (size_t)(l * 2 + (big ? 0 : 1)) * 512 * 1024;
        float s = 0.f; for (int i = lane; i < nit; i += 64) s += part[(size_t)i * 1024 + oc] + part[(size_t)i * 1024 + 512 + oc];
        s = wave_sum(s); const float inv = 1.f / s;
        const float* H3 = big ? wsp<float>(A, W.h3l) + (size_t)l * 2048 * 1024 : wsp<float>(A, W.h3c) + (size_t)l * 256 * 1024;
        bf16_t* TL = big ? wsp<bf16_t>(A, W.tapl) + ((size_t)l * 512 + oc) * TLL : wsp<bf16_t>(A, W.tapc) + ((size_t)l * 512 + oc) * TLC;
        const int c = L + 32;
        for (int y0 = 0; y0 < TLn; y0 += 64 * 8) { float tv[8];
#pragma unroll
            for (int j = 0; j < 8; ++j) { const int y = y0 + 64 * j + lane, m = c - y, am = m < 0 ? -m : m; const bool ok = (y < TLn) && (am < L);
                const float v = H3[ok ? (size_t)am * 1024 + (m < 0 ? 512 : 0) + oc : (size_t)oc];
                tv[j] = ok ? v : 0.f; }
#pragma unroll
            for (int j = 0; j < 8; ++j) { const int y = y0 + 64 * j + lane; if (y < TLn) TL[y] = (bf16_t)f2bf(tv[j] * inv); } }
    }
}

constexpr int NTT = NTOK / 256, NTL = NLAT / 256;
struct InprojSched {
    int l, G, c; const char* xn; const char* w;
    __device__ bool next(int i, Unit& u) const {
        const long Li = (long)i * G + c;
        const int nM = (l == 0) ? NTT : NTL, nN = 23, nwg = nM * nN;
        if (Li < nwg) {
            int wgid = (int)Li; { const int q = nwg / 8, r = nwg % 8, xcd = wgid % 8, off = wgid / 8; wgid = (xcd < r ? xcd * (q + 1) : r * (q + 1) + (xcd - r) * q) + off; }
            const int nig = 8 * nN, gid = wgid / nig, fm = gid * 8, gsz = (nM - fm) < 8 ? (nM - fm) : 8;
            u.pm = fm + ((wgid % nig) % gsz); u.pn = (wgid % nig) / gsz;
        } else {
            const int r2 = (int)(Li - nwg); if (l == 0 || r2 >= (NTT - NTL) * 4) return false;
            u.pm = NTL + r2 / 4; u.pn = 7 + (r2 & 3);
        }
        const int pn = u.pn; u.kind = pn < 3 ? 0 : pn < 5 ? 1 : pn < 9 ? 2 : pn < 11 ? 3 : 4;
        const char* at = xn + (size_t)u.pm * 256 * 1024 * 2; const char* wt = w + (size_t)pn * 256 * 1024 * 2;
        const bool swapped = (u.kind == 0 || u.kind == 1 || u.kind == 3);
        u.a = swapped ? wt : at; u.b = swapped ? at : wt; u.aux = 0; return true;
    }
};
struct InprojEpi {
    int l; bf16_t *hyt, *ftl, *ftc, *q, *qc, *k, *vt, *g; const float *gq, *gk, *rope;
    __device__ __forceinline__ bool operator()(Acc& acc, const Unit& u, int wr, int wc, int fr, int fq) const {
        const int pm = u.pm, pn = u.pn;
        if (u.kind == 0 || u.kind == 1 || u.kind == 3) {
            const bool lat = pm < NTL; const int b = lat ? pm >> 3 : pm - NTL;
#pragma unroll
            for (int bj = 0; bj < 2; ++bj) {
                const int tl = 128 * bj + 32 * wc + 8 * fq;
                bf16_t* base; size_t rstride;
                if (u.kind == 0) { base = hyt + (size_t)(pn * 256) * NTOK + (size_t)pm * 256 + tl; rstride = NTOK; }
                else if (u.kind == 1) { const int part = pn - 3;
                    if (lat) { base = ftl + (size_t)b * 256 * 4096 + part * 2048 + (pm & 7) * 256 + tl; rstride = 4096; }
                    else { base = ftc + (size_t)b * 256 * 512 + part * 256 + tl; rstride = 512; } }
                else { base = vt + ((size_t)b * 512 + (pn - 9) * 256) * KALL + (lat ? (pm & 7) * 256 : SEQ) + tl; rstride = KALL; }
#pragma unroll
                for (int ai = 0; ai < 2; ++ai)
#pragma unroll
                    for (int m = 0; m < 4; ++m) { const int r = 128 * ai + 64 * wr + 16 * m + fr; const f32x4 v0 = acc[ai][bj][m][0], v1 = acc[ai][bj][m][1];
                        u32x4 w; w.x = cvt_pk_bf16(v0[0], v0[1]); w.y = cvt_pk_bf16(v0[2], v0[3]); w.z = cvt_pk_bf16(v1[0], v1[1]); w.w = cvt_pk_bf16(v1[2], v1[3]);
                        *(u32x4*)(base + (size_t)r * rstride) = w; }
            }
        } else if (u.kind == 4) {
#pragma unroll
            for (int ai = 0; ai < 2; ++ai)
#pragma unroll
                for (int m = 0; m < 4; ++m) { const int t = pm * 256 + 128 * ai + 64 * wr + 16 * m + fr;
#pragma unroll
                    for (int bj = 0; bj < 2; ++bj) { const int cg = (pn - 11) * 256 + 128 * bj + 32 * wc + 8 * fq; f32x4 v0 = acc[ai][bj][m][0], v1 = acc[ai][bj][m][1];
#pragma unroll
                        for (int j = 0; j < 4; ++j) { v0[j] = __builtin_amdgcn_rcpf(1.f + __builtin_amdgcn_exp2f(-1.4426950408889634f * v0[j])); v1[j] = __builtin_amdgcn_rcpf(1.f + __builtin_amdgcn_exp2f(-1.4426950408889634f * v1[j])); }
                        u32x4 w; w.x = cvt_pk_bf16(v0[0], v0[1]); w.y = cvt_pk_bf16(v0[2], v0[3]); w.z = cvt_pk_bf16(v1[0], v1[1]); w.w = cvt_pk_bf16(v1[2], v1[3]);
                        *(u32x4*)(g + (size_t)t * 3072 + cg) = w; } }
        } else {
            const int which = (pn - 5) >> 1, grp = ((pn - 5) & 1) * 4 + wc, h = grp >> 1, map = grp & 1;
            const int d0 = 32 * (fq >> 1) + 8 * (fq & 1);
            const float* gp = (which ? gk : gq) + map * 64 + d0;
            const f32x4 g00 = *(const f32x4*)(gp), g01 = *(const f32x4*)(gp + 4), g10 = *(const f32x4*)(gp + 16), g11 = *(const f32x4*)(gp + 20);
            const bool lat = pm < NTL; const int b = lat ? pm >> 3 : pm - NTL;
#pragma unroll
            for (int ai = 0; ai < 2; ++ai)
#pragma unroll
                for (int m = 0; m < 4; ++m) {
                    const int rl = 128 * ai + 64 * wr + 16 * m + fr;
                    f32x4 a0 = acc[ai][0][m][0], a1 = acc[ai][0][m][1], b0 = acc[ai][1][m][0], b1 = acc[ai][1][m][1];
                    float ss = 0.f;
#pragma unroll
                    for (int j = 0; j < 4; ++j) ss += a0[j] * a0[j] + a1[j] * a1[j] + b0[j] * b0[j] + b1[j] * b1[j];
                    ss += __shfl_xor(ss, 16); ss += __shfl_xor(ss, 32);
                    const float rs = rsqrtf(ss * (1.f / 64.f) + EPS);
                    a0 = a0 * rs * g00; a1 = a1 * rs * g01; b0 = b0 * rs * g10; b1 = b1 * rs * g11;
                    bf16_t* dst;
                    if (lat) { const int pos = (pm & 7) * 256 + rl; const int pa = (fq >> 1) ? (pos & 63) : (pos >> 6);
                        const float* rp = rope + ((size_t)pa * 16 + 8 * (fq & 1)) * 2;
                        const f32x4 r0 = *(const f32x4*)(rp), r1 = *(const f32x4*)(rp + 4), r2 = *(const f32x4*)(rp + 8), r3 = *(const f32x4*)(rp + 12);
                        const float cs[8] = {r0[0], r0[2], r1[0], r1[2], r2[0], r2[2], r3[0], r3[2]}, sn[8] = {r0[1], r0[3], r1[1], r1[3], r2[1], r2[3], r3[1], r3[3]};
#pragma unroll
                        for (int j = 0; j < 4; ++j) { const float x1 = a0[j], x2 = b0[j]; a0[j] = x1 * cs[j] - x2 * sn[j]; b0[j] = x2 * cs[j] + x1 * sn[j];
                            const float y1 = a1[j], y2 = b1[j]; a1[j] = y1 * cs[4 + j] - y2 * sn[4 + j]; b1[j] = y2 * cs[4 + j] + y1 * sn[4 + j]; }
                        dst = which ? k + (((size_t)(b * 4 + h) * 2 + map) * KALL + pos) * 64 : q + (((size_t)(b * 4 + h) * 2 + map) * SEQ + pos) * 64;
                    } else dst = which ? k + (((size_t)(b * 4 + h) * 2 + map) * KALL + SEQ + rl) * 64 : qc + (((size_t)(b * 4 + h) * 2 + map) * CTX + rl) * 64;
                    u32x4 w0, w1; w0.x = cvt_pk_bf16(a0[0], a0[1]); w0.y = cvt_pk_bf16(a0[2], a0[3]); w0.z = cvt_pk_bf16(a1[0], a1[1]); w0.w = cvt_pk_bf16(a1[2], a1[3]);
                    w1.x = cvt_pk_bf16(b0[0], b0[1]); w1.y = cvt_pk_bf16(b0[2], b0[3]); w1.z = cvt_pk_bf16(b1[0], b1[1]); w1.w = cvt_pk_bf16(b1[2], b1[3]);
                    *(u32x4*)(dst + d0) = w0; *(u32x4*)(dst + d0 + 16) = w1;
                }
        }
        return true;
    }
};
__device__ __forceinline__ void phase_inproj(AP A, FK_LAS unsigned char* lds, int l, int G) {
    InprojSched S{l, G, (int)blockIdx.x, (const char*)wsp<bf16_t>(A, W.xn), (const char*)(wsp<bf16_t>(A, W.w_in) + (size_t)l * PINF * 1024)};
    InprojEpi E{l, wsp<bf16_t>(A, W.hyt), wsp<bf16_t>(A, W.ftl), wsp<bf16_t>(A, W.ftc), wsp<bf16_t>(A, W.q), wsp<bf16_t>(A, W.qc), wsp<bf16_t>(A, W.k), wsp<bf16_t>(A, W.vt), wsp<bf16_t>(A, W.g),
                FIN(18) + l * 128, FIN(19) + l * 128, wsp<float>(A, W.misc) + MI_ROPE};
    gemm_phase(lds, 1024, S, E);
}
#define FK_HAVE_MIX 1
namespace attn {
constexpr float SCALE = 0.125f, THR = 8.f;
constexpr int KVBLK = 64;
constexpr int SHM_V = 128 * 64 * 2, SHM_K = 64 * 64 * 2;
constexpr int OFF_V = 0, OFF_K = 2 * SHM_V, OFF_WS = 2 * SHM_V + 2 * SHM_K;
#define ASWZ(row, cb) ((row) * 128 + ((cb) ^ ((((row) >> 1) & 7) << 4)))
#define SBAR() __builtin_amdgcn_sched_barrier(0)
__device__ __forceinline__ int crow(int r, int hi) { return (r & 3) + 8 * (r >> 2) + 4 * hi; }
__device__ __forceinline__ void partialSM(f32x16& p0, f32x16& p1, float& m_reg, float& mn, float& alpha) {
    constexpr float C = SCALE * 1.4426950408889634f;
    float pmax = p0[0];
#pragma unroll
    for (int r = 1; r < 16; ++r) pmax = fmaxf(pmax, p0[r]);
#pragma unroll
    for (int r = 0; r < 16; ++r) pmax = fmaxf(pmax, p1[r]);
    { auto rr = __builtin_amdgcn_permlane32_swap(__float_as_uint(pmax), __float_as_uint(pmax), false, false);
      pmax = fmaxf(__uint_as_float(rr[0]), __uint_as_float(rr[1])); }
    if (__builtin_expect(__all(pmax - m_reg <= THR / SCALE), 1)) { mn = m_reg; alpha = 1.f; }
    else { mn = fmaxf(m_reg, pmax); alpha = __builtin_amdgcn_exp2f((m_reg - mn) * C); m_reg = mn; }
    const float mnC = -mn * C;
#pragma unroll
    for (int r = 0; r < 16; ++r) p0[r] = fmaf(p0[r], C, mnC);
#pragma unroll
    for (int r = 0; r < 16; ++r) p1[r] = fmaf(p1[r], C, mnC);
#pragma unroll
    for (int r = 0; r < 16; ++r) p0[r] = __builtin_amdgcn_exp2f(p0[r]);
}
__device__ __forceinline__ void finishSM(f32x16& p0, f32x16& p1, float alpha, float& l_reg, bf16x8& pa0, bf16x8& pa1, bf16x8& pa2, bf16x8& pa3) {
#pragma unroll
    for (int r = 0; r < 16; ++r) p1[r] = __builtin_amdgcn_exp2f(p1[r]);
    float ps = 0;
#pragma unroll
    for (int r = 0; r < 16; ++r) ps += p0[r];
#pragma unroll
    for (int r = 0; r < 16; ++r) ps += p1[r];
    { auto rr = __builtin_amdgcn_permlane32_swap(__float_as_uint(ps), __float_as_uint(ps), false, false);
      ps = __uint_as_float(rr[0]) + __uint_as_float(rr[1]); }
    l_reg = l_reg * alpha + ps;
#define PK4(P, BASE, OUT) do { unsigned a0 = cvt_pk_bf16(P[BASE + 0], P[BASE + 1]), a1 = cvt_pk_bf16(P[BASE + 2], P[BASE + 3]);   \
    unsigned b0 = cvt_pk_bf16(P[BASE + 4], P[BASE + 5]), b1 = cvt_pk_bf16(P[BASE + 6], P[BASE + 7]);                              \
    auto r0 = __builtin_amdgcn_permlane32_swap(a0, b0, false, false); auto r1 = __builtin_amdgcn_permlane32_swap(a1, b1, false, false); \
    u32x4 w = {r0[0], r1[0], r0[1], r1[1]}; OUT = *reinterpret_cast<bf16x8*>(&w); } while (0)
    PK4(p0, 0, pa0); PK4(p0, 8, pa1); PK4(p1, 0, pa2); PK4(p1, 8, pa3);
#undef PK4
}
__device__ __forceinline__ void qkt(f32x16& p0, f32x16& p1, const FK_LAS char* Ks, const bf16x8* qr, int r32, int hi) {
    p0 = f32x16{}; p1 = f32x16{};
#pragma unroll
    for (int d0 = 0; d0 < 4; ++d0) { const int cb = d0 * 32 + hi * 16;
        const bf16x8 b0 = *(const FK_LAS bf16x8*)(Ks + ASWZ(r32, cb));
        const bf16x8 b1 = *(const FK_LAS bf16x8*)(Ks + ASWZ(32 + r32, cb));
        __builtin_amdgcn_s_setprio(1);
        p0 = __builtin_amdgcn_mfma_f32_32x32x16_bf16(b0, qr[d0], p0, 0, 0, 0);
        p1 = __builtin_amdgcn_mfma_f32_32x32x16_bf16(b1, qr[d0], p1, 0, 0, 0);
        __builtin_amdgcn_s_setprio(0); }
}
__device__ __forceinline__ void pv(f32x16* o, const FK_LAS char* Vs, int r32, int hi, bf16x8 pa0, bf16x8 pa1, bf16x8 pa2, bf16x8 pa3) {
#pragma unroll
    for (int d0 = 0; d0 < 4; ++d0) { const int row = 32 * d0 + r32;
        const bf16x8 v0 = *(const FK_LAS bf16x8*)(Vs + ASWZ(row, 0 * 32 + hi * 16)), v1 = *(const FK_LAS bf16x8*)(Vs + ASWZ(row, 1 * 32 + hi * 16));
        const bf16x8 v2 = *(const FK_LAS bf16x8*)(Vs + ASWZ(row, 2 * 32 + hi * 16)), v3 = *(const FK_LAS bf16x8*)(Vs + ASWZ(row, 3 * 32 + hi * 16));
        __builtin_amdgcn_s_setprio(1);
        o[d0] = __builtin_amdgcn_mfma_f32_32x32x16_bf16(pa0, v0, o[d0], 0, 0, 0);
        o[d0] = __builtin_amdgcn_mfma_f32_32x32x16_bf16(pa1, v1, o[d0], 0, 0, 0);
        o[d0] = __builtin_amdgcn_mfma_f32_32x32x16_bf16(pa2, v2, o[d0], 0, 0, 0);
        o[d0] = __builtin_amdgcn_mfma_f32_32x32x16_bf16(pa3, v3, o[d0], 0, 0, 0);
        __builtin_amdgcn_s_setprio(0); }
}
__device__ __forceinline__ void body(const bf16_t* __restrict__ Qb, const bf16_t* __restrict__ Kh, const bf16_t* __restrict__ VTh, int ldv, int seq, FK_LAS char* lds, f32x16* o, const int tid) {
    const int wid = tid >> 6, lane = tid & 63, r32 = lane & 31, hi = lane >> 5;
    FK_LAS char* V_lds = lds + OFF_V; FK_LAS char* K_lds = lds + OFF_K;
    FK_LAS float* wsf = (FK_LAS float*)(lds + OFF_WS) + wid * 64; FK_LAS float* li_l = wsf; FK_LAS float* al_l = wsf + 32;
    float m_reg = -1e30f, l_reg = 0;
#pragma unroll
    for (int d = 0; d < 4; ++d) o[d] = f32x16{};
    bf16x8 qr[4];
    const bf16_t* Qw = Qb + (size_t)(wid * 32 + r32) * 64 + hi * 8;
#pragma unroll
    for (int d0 = 0; d0 < 4; ++d0) qr[d0] = *(const bf16x8*)(Qw + d0 * 16);
    const int ksr = tid >> 3, kch = tid & 7;
    const int kst = ASWZ(ksr, kch * 16);
    const int vd0 = tid >> 3, vd1 = 64 + (tid >> 3);
    const int vst0 = ASWZ(vd0, kch * 16), vst1 = ASWZ(vd1, kch * 16);
    struct { bf16x8 vs0, vs1, ks; } sr_[2];
#define SLOAD(i, k0) do { sr_[i].vs0 = *(const bf16x8*)(VTh + (size_t)vd0 * ldv + (k0) + kch * 8); sr_[i].vs1 = *(const bf16x8*)(VTh + (size_t)vd1 * ldv + (k0) + kch * 8); \
    sr_[i].ks = *(const bf16x8*)(Kh + (size_t)((k0) + ksr) * 64 + kch * 8); } while (0)
#define SWRITE(b, i) do { *(FK_LAS bf16x8*)(V_lds + (b) * SHM_V + vst0) = sr_[i].vs0; *(FK_LAS bf16x8*)(V_lds + (b) * SHM_V + vst1) = sr_[i].vs1; \
    *(FK_LAS bf16x8*)(K_lds + (b) * SHM_K + kst) = sr_[i].ks; } while (0)
#define SWAIT() asm volatile("s_waitcnt vmcnt(3)" ::: "memory")
#define RESC(a) do { if (__any((a) < 1.f)) { if (hi == 0) al_l[r32] = (a); asm volatile("s_waitcnt lgkmcnt(0)" ::: "memory"); \
    _Pragma("unroll") for (int d = 0; d < 4; ++d) _Pragma("unroll") for (int r = 0; r < 16; ++r) o[d][r] *= al_l[crow(r, hi)]; } } while (0)
    f32x16 pA0, pA1, pB0, pB1; float mnA, mnB, alA, alB; bf16x8 pa0, pa1, pa2, pa3; const int NT = seq / KVBLK;
    SLOAD(0, 0); asm volatile("s_waitcnt vmcnt(0)" ::: "memory"); SWRITE(0, 0); __syncthreads();
    qkt(pA0, pA1, K_lds, qr, r32, hi); partialSM(pA0, pA1, m_reg, mnA, alA);
    SLOAD(1, KVBLK); if (2 < NT) SLOAD(0, 2 * KVBLK);
    if (2 < NT) SWAIT(); else asm volatile("s_waitcnt vmcnt(0)" ::: "memory");
    SWRITE(1, 1); __syncthreads();
    for (int j = 1; j + 1 < NT; j += 2) {
        SBAR(); qkt(pB0, pB1, K_lds + SHM_K, qr, r32, hi);
        finishSM(pA0, pA1, alA, l_reg, pa0, pa1, pa2, pa3); SBAR();
        SLOAD(1, (j + 2) * KVBLK); SBAR();
        pv(o, V_lds, r32, hi, pa0, pa1, pa2, pa3); partialSM(pB0, pB1, m_reg, mnB, alB);
        __syncthreads(); SWAIT(); SWRITE(0, 0);
        RESC(alB); __syncthreads();
        SBAR(); qkt(pA0, pA1, K_lds, qr, r32, hi);
        finishSM(pB0, pB1, alB, l_reg, pa0, pa1, pa2, pa3); SBAR();
        const bool more = (j + 3 < NT);
        if (more) SLOAD(0, (j + 3) * KVBLK);
        SBAR();
        pv(o, V_lds + SHM_V, r32, hi, pa0, pa1, pa2, pa3); partialSM(pA0, pA1, m_reg, mnA, alA);
        __syncthreads(); if (more) SWAIT(); else asm volatile("s_waitcnt vmcnt(0)" ::: "memory");
        SWRITE(1, 1);
        RESC(alA); __syncthreads();
    }
    SBAR(); qkt(pB0, pB1, K_lds + SHM_K, qr, r32, hi);
    finishSM(pA0, pA1, alA, l_reg, pa0, pa1, pa2, pa3); SBAR();
    pv(o, V_lds, r32, hi, pa0, pa1, pa2, pa3); partialSM(pB0, pB1, m_reg, mnB, alB);
    __syncthreads(); RESC(alB);
    finishSM(pB0, pB1, alB, l_reg, pa0, pa1, pa2, pa3); SBAR();
    pv(o, V_lds + SHM_V, r32, hi, pa0, pa1, pa2, pa3);
    if (hi == 0) li_l[r32] = l_reg; asm volatile("s_waitcnt lgkmcnt(0)" ::: "memory");
#pragma unroll
    for (int r = 0; r < 16; ++r) { const float rl = __builtin_amdgcn_rcpf(li_l[crow(r, hi)]);
#pragma unroll
        for (int d = 0; d < 4; ++d) o[d][r] *= rl; }
    __syncthreads();
#undef SLOAD
#undef SWRITE
#undef SWAIT
#undef RESC
}
__device__ __forceinline__ void unit(AP A, FK_LAS char* lds, int l, int b, int h, int qb  ) {
    const int tid = opaque_tid(), wid = tid >> 6, lane = tid & 63, r32 = lane & 31, hi = lane >> 5;
    const bool ctx = qb == 8;
    float* stash = wsp<float>(A, W.stash) + (size_t)blockIdx.x * 128 * 512;
#pragma unroll 1
    for (int map = 0; map < 2; ++map) {
        const size_t hm = (size_t)(b * 4 + h) * 2 + map;
        const bf16_t* Qb = ctx ? wsp<bf16_t>(A, W.qc) + hm * CTX * 64 : wsp<bf16_t>(A, W.q) + (hm * SEQ + (size_t)qb * 256) * 64;
        const bf16_t* Kh = wsp<bf16_t>(A, W.k) + (hm * KALL + (ctx ? SEQ : 0)) * 64;
        const bf16_t* VTh = wsp<bf16_t>(A, W.vt) + (size_t)(b * 4 + h) * 128 * KALL + (ctx ? SEQ : 0);
        f32x16 om[4];
        body(Qb, Kh, VTh, KALL, ctx ? CTX : KALL, lds, om, tid);
#pragma unroll
        for (int d = 0; d < 4; ++d)
#pragma unroll
            for (int r = 0; r < 16; ++r) stash[(size_t)((map * 4 + d) * 16 + r) * 512 + tid] = om[d][r];
    }
    const float lam = wsp<float>(A, W.misc)[MI_LAM + l], post = 1.f - (0.8f - 0.6f * __expf(-0.3f * (float)l));
    f32x16 o[4];
    float ss[16];
#pragma unroll
    for (int r = 0; r < 16; ++r) ss[r] = 0.f;
#pragma unroll
    for (int d = 0; d < 4; ++d)
#pragma unroll
        for (int r = 0; r < 16; ++r) { const float v = stash[(size_t)(d * 16 + r) * 512 + tid] - lam * stash[(size_t)((4 + d) * 16 + r) * 512 + tid]; o[d][r] = v; ss[r] += v * v; }
#pragma unroll
    for (int r = 0; r < 16; ++r) {
#pragma unroll
        for (int s = 1; s < 32; s <<= 1) ss[r] += __shfl_xor(ss[r], s);
        ss[r] = rsqrtf(ss[r] * (1.f / 128.f) + EPS) * post; }
    bf16_t* att = (h < 2) ? wsp<bf16_t>(A, W.attlo) : wsp<bf16_t>(A, W.atthi);
    const size_t t0 = ctx ? (size_t)NLAT + b * CTX : (size_t)b * SEQ + qb * 256;
#pragma unroll
    for (int d = 0; d < 4; ++d) { const float gs = FIN(21)[l * 128 + 32 * d + r32];
#pragma unroll
        for (int r = 0; r < 16; ++r) att[(t0 + wid * 32 + crow(r, hi)) * 256 + (h & 1) * 128 + 32 * d + r32] = (bf16_t)f2bf(o[d][r] * ss[r] * gs); }
}
#undef ASWZ
#undef SBAR
}

namespace hy {
template <int L, int NBH> struct Geo {
    static constexpr int NBLK = L / 32, IB = 32 / NBH, NG = NBLK / IB, GPW = (NG >= 8) ? NG / 8 : 1, AW = NG / GPW;
    static constexpr int PADB = IB * GPW - 1, RL = (NBLK + 2 * PADB) * 32, ZRS = RL * 2 + 16;
    static constexpr int TLn = (L == 2048) ? TLL : TLC, TCS = TLn * 2 + ((L == 2048) ? 32 : 160);
    static constexpr int OFF_Z = 0, OFF_G = NBH * ZRS, OFF_T = 2 * NBH * ZRS, END = OFF_T + 8 * TCS;
};
__device__ __forceinline__ int crow(int r, int hi) { return (r & 3) + 8 * (r >> 2) + 4 * hi; }
template <int L, int NBH>
__device__ __forceinline__ void unit(AP A, FK_LAS char* lds, int l, int ch, int boff) {
    using Gm = Geo<L, NBH>;
    static_assert(Gm::END <= LDS_MISC, "hyena LDS");
    const int tid = opaque_tid(), wid = __builtin_amdgcn_readfirstlane(tid >> 6), lane = tid & 63, r32 = lane & 31, hi = lane >> 5;
    const bf16_t* hyt = wsp<bf16_t>(A, W.hyt);
    const float* cw = FIN(9) + l * 3 * 768; const float* cb = FIN(10) + l * 768;
    const int tbl = tid / (L / 32), tb = boff + tbl, tp0 = (tid % (L / 32)) * 32; const bool ld_act = tid < NBH * (L / 32);
    unsigned x2p[16];
    __syncthreads();
    for (int i = tid; i < 2 * NBH * Gm::ZRS / 16; i += NTHR) *(FK_LAS u32x4*)(lds + i * 16) = (u32x4){0u, 0u, 0u, 0u};
    __syncthreads();
    if (ld_act) {
#pragma unroll
        for (int sel = 0; sel < 3; ++sel) {
            const int row = sel * 256 + ch; const float w0 = cw[row], w1 = cw[768 + row], w2 = cw[1536 + row], bs = cb[row];
            float vals[34];
            if (tb < NB) {
                const size_t tok0 = (L == 2048) ? (size_t)tb * SEQ + tp0 : (size_t)NLAT + tb * CTX + tp0;
                const bf16_t* src = hyt + (size_t)row * NTOK + tok0;
#pragma unroll
                for (int q = 0; q < 4; ++q) { const u32x4 w = *(const u32x4*)(src + q * 8);
                    vals[1 + q * 8 + 0] = bflo(w.x); vals[1 + q * 8 + 1] = bfhi(w.x); vals[1 + q * 8 + 2] = bflo(w.y); vals[1 + q * 8 + 3] = bfhi(w.y);
                    vals[1 + q * 8 + 4] = bflo(w.z); vals[1 + q * 8 + 5] = bfhi(w.z); vals[1 + q * 8 + 6] = bflo(w.w); vals[1 + q * 8 + 7] = bfhi(w.w); }
                vals[0] = tp0 > 0 ? bf2f(src[-1]) : 0.f; vals[33] = tp0 + 32 < L ? bf2f(src[32]) : 0.f;
            } else {
#pragma unroll
                for (int i = 0; i < 34; ++i) vals[i] = 0.f;
            }
            unsigned pk[16];
#pragma unroll
            for (int i = 0; i < 16; ++i) { const float a = tb < NB ? vals[2 * i] * w0 + vals[2 * i + 1] * w1 + vals[2 * i + 2] * w2 + bs : 0.f, b2 = tb < NB ? vals[2 * i + 1] * w0 + vals[2 * i + 2] * w1 + vals[2 * i + 3] * w2 + bs : 0.f;
                pk[i] = cvt_pk_bf16(a, b2); }
            if (sel < 2) { FK_LAS char* dst = lds + (sel == 0 ? Gm::OFF_Z : Gm::OFF_G) + tbl * Gm::ZRS + (Gm::PADB * 32 + tp0) * 2;
#pragma unroll
                for (int q = 0; q < 4; ++q) *(FK_LAS u32x4*)(dst + q * 16) = (u32x4){pk[4 * q], pk[4 * q + 1], pk[4 * q + 2], pk[4 * q + 3]}; }
            else {
#pragma unroll
                for (int i = 0; i < 16; ++i) x2p[i] = pk[i]; }
        }
    }
    const int G0 = wid * Gm::GPW; const bool act = wid < Gm::AW;
    const int dlo = Gm::IB * G0 - (Gm::NBLK - 1), dhi = Gm::IB * (G0 + Gm::GPW) - 1;
    const int il = r32 & (Gm::IB - 1), bb = r32 / Gm::IB;
    for (int o = 0; o < 2; ++o) {
        { const bf16_t* TL = (L == 2048 ? wsp<bf16_t>(A, W.tapl) + ((size_t)l * 512 + o * 256 + ch) * TLL : wsp<bf16_t>(A, W.tapc) + ((size_t)l * 512 + o * 256 + ch) * TLC);
          constexpr int NC = Gm::TLn / 8;
          for (int i = tid; i < NC; i += NTHR) *(FK_LAS u32x4*)(lds + Gm::OFF_T + i * 16) = *(const u32x4*)(TL + i * 8);
          __syncthreads();
          for (int i = tid; i < 7 * NC; i += NTHR) { const int sft = 1 + i / NC, c = i % NC;
              const FK_LAS unsigned* src = (const FK_LAS unsigned*)(lds + Gm::OFF_T + c * 16 + 4 * (sft >> 1)); const unsigned sh = 16u * (unsigned)(sft & 1);
              const bool tail = (c == NC - 1);
              unsigned w0 = src[0], w1 = tail && (1 + (sft >> 1)) >= 4 ? 0u : src[1], w2 = tail && (2 + (sft >> 1)) >= 4 ? 0u : src[2], w3 = tail && (3 + (sft >> 1)) >= 4 ? 0u : src[3], w4 = tail ? 0u : src[4];
              u32x4 ov; ov.x = __builtin_amdgcn_alignbit(w1, w0, sh); ov.y = __builtin_amdgcn_alignbit(w2, w1, sh); ov.z = __builtin_amdgcn_alignbit(w3, w2, sh); ov.w = __builtin_amdgcn_alignbit(w4, w3, sh);
              *(FK_LAS u32x4*)(lds + Gm::OFF_T + sft * Gm::TCS + c * 16) = ov; } }
        __syncthreads();
        f32x16 acc[Gm::GPW];
#pragma unroll
        for (int g = 0; g < Gm::GPW; ++g) acc[g] = f32x16{};
        if (act) {
            const int c0 = (L + 32) - r32 + 8 * hi, sc = c0 & 7;
            int pa = Gm::OFF_T + sc * Gm::TCS + (c0 - sc - 32 * dlo) * 2;
            int pb = Gm::OFF_Z + bb * Gm::ZRS + ((Gm::PADB + Gm::IB * G0 + il - dlo) * 32 + 8 * hi) * 2;
#define HY_LOAD(A0, A1, B0, B1) do { A0 = *(const FK_LAS bf16x8*)(lds + pa); A1 = *(const FK_LAS bf16x8*)(lds + pa + 32); \
                _Pragma("unroll") for (int g = 0; g < Gm::GPW; ++g) { B0[g] = *(const FK_LAS bf16x8*)(lds + pb + g * Gm::IB * 64); B1[g] = *(const FK_LAS bf16x8*)(lds + pb + g * Gm::IB * 64 + 32); } \
                pa -= 64; pb -= 64; } while (0)
#define HY_MMA(A0, A1, B0, B1) do { _Pragma("unroll") for (int g = 0; g < Gm::GPW; ++g) { acc[g] = __builtin_amdgcn_mfma_f32_32x32x16_bf16(A0, B0[g], acc[g], 0, 0, 0); \
                acc[g] = __builtin_amdgcn_mfma_f32_32x32x16_bf16(A1, B1[g], acc[g], 0, 0, 0); } } while (0)
            bf16x8 xa0, xa1, ya0, ya1, xb0[Gm::GPW], xb1[Gm::GPW], yb0[Gm::GPW], yb1[Gm::GPW];
            const int nd = dhi - dlo + 1;
            HY_LOAD(xa0, xa1, xb0, xb1);
            int d = 0;
#pragma unroll 1
            for (; d + 2 <= nd - 1; d += 2) {
                HY_LOAD(ya0, ya1, yb0, yb1);
                HY_MMA(xa0, xa1, xb0, xb1);
                HY_LOAD(xa0, xa1, xb0, xb1);
                HY_MMA(ya0, ya1, yb0, yb1);
            }
            if (d + 1 <= nd - 1) { HY_LOAD(ya0, ya1, yb0, yb1); HY_MMA(xa0, xa1, xb0, xb1); HY_MMA(ya0, ya1, yb0, yb1); }
            else HY_MMA(xa0, xa1, xb0, xb1);
#undef HY_LOAD
#undef HY_MMA
        }
        __syncthreads();
        const float bias = FIN(17)[l * 512 + o * 256 + ch];
        if (act) {
#pragma unroll
            for (int g = 0; g < Gm::GPW; ++g)
#pragma unroll
                for (int r = 0; r < 16; ++r) { const int pos = 32 * (Gm::IB * (G0 + g) + il) + crow(r, hi);
                    FK_LAS unsigned short* zp = (FK_LAS unsigned short*)(lds + Gm::OFF_Z + bb * Gm::ZRS + (Gm::PADB * 32 + pos) * 2);
                    const float gate = bf2f(*(FK_LAS unsigned short*)(lds + Gm::OFF_G + bb * Gm::ZRS + (Gm::PADB * 32 + pos) * 2));
                    const float zn = gate * (acc[g][r] + bias * bf2f(*zp));
                    *zp = (unsigned short)f2bf(zn); }
        }
        __syncthreads();
        if (o == 0 && ld_act) { FK_LAS char* dst = lds + Gm::OFF_G + tbl * Gm::ZRS + (Gm::PADB * 32 + tp0) * 2;
#pragma unroll
            for (int q = 0; q < 4; ++q) *(FK_LAS u32x4*)(dst + q * 16) = (u32x4){x2p[4 * q], x2p[4 * q + 1], x2p[4 * q + 2], x2p[4 * q + 3]}; }
    }
    __syncthreads();
    if (ld_act && tb < NB) { const size_t tok0 = (L == 2048) ? (size_t)tb * SEQ + tp0 : (size_t)NLAT + tb * CTX + tp0;
        bf16_t* dst = wsp<bf16_t>(A, W.hyo) + (size_t)ch * NTOK + tok0; const FK_LAS char* srcz = lds + Gm::OFF_Z + tbl * Gm::ZRS + (Gm::PADB * 32 + tp0) * 2;
#pragma unroll
        for (int q = 0; q < 4; ++q) *(u32x4*)(dst + q * 8) = *(const FK_LAS u32x4*)(srcz + q * 16); }
    __syncthreads();
}
}

struct FnSched {
    int G, c, big; const char* dft; const char* ft;
    __device__ bool next(int i, Unit& u) const {
        const long Li = (long)i * G + (G - 1 - c);
        const int n = big ? NB * 8 : NB; if (Li >= n) return false;
        const int b = big ? (int)Li >> 3 : (int)Li, mt = big ? (int)Li & 7 : 0;
        u.pm = mt; u.pn = b; u.kind = big; u.aux = 0;
        u.a = dft + (size_t)mt * 256 * (big ? 4096 : 512) * 2; u.b = ft + (size_t)b * 256 * (big ? 4096 : 512) * 2; return true;
    }
};
struct FnEpi {
    bf16_t* fno;
    __device__ __forceinline__ bool operator()(Acc& acc, const Unit& u, int wr, int wc, int fr, int fq) const {
        const size_t t0 = u.kind ? (size_t)u.pn * SEQ + u.pm * 256 : (size_t)NLAT + u.pn * CTX;
#pragma unroll
        for (int ai = 0; ai < 2; ++ai)
#pragma unroll
            for (int m = 0; m < 4; ++m) { bf16_t* rowp = fno + (t0 + 128 * ai + 64 * wr + 16 * m + fr) * 256 + 32 * wc + 8 * fq;
#pragma unroll
                for (int bj = 0; bj < 2; ++bj) { const f32x4 v0 = acc[ai][bj][m][0], v1 = acc[ai][bj][m][1];
                    u32x4 w; w.x = cvt_pk_bf16(v0[0], v0[1]); w.y = cvt_pk_bf16(v0[2], v0[3]); w.z = cvt_pk_bf16(v1[0], v1[1]); w.w = cvt_pk_bf16(v1[2], v1[3]);
                    *(u32x4*)(rowp + 128 * bj) = w; } }
        return true;
    }
};

__device__ __forceinline__ void phase_mix(AP A, FK_LAS unsigned char* lds, int l, int vcu, int G) {
    const int n_lat = NB * 32, n_all = n_lat + (l == 0 ? NB * 4 : 0);
#ifndef FK_REP_SUB
#define FK_REP_SUB 0
#endif
#ifndef FK_NO_ATTN
    for (int rp = (FK_REP_SUB == 1 ? 1 : 0); rp >= 0; --rp)
    for (int u = vcu; u < n_all; u += G) {
        if (u < n_lat) attn::unit(A, (FK_LAS char*)lds, l, u >> 5, (u >> 3) & 3, u & 7);
        else { const int v = u - n_lat; attn::unit(A, (FK_LAS char*)lds, l, v >> 2, v & 3, 8); }
    }
#endif
#ifndef FK_NO_HY
    for (int rp = (FK_REP_SUB == 2 ? 1 : 0); rp >= 0; --rp)
    if (G == 256) { if (vcu < 192) hy::unit<2048, 8>(A, (FK_LAS char*)lds, l, vcu, 0); if (vcu >= 64 && vcu < 128) hy::unit<2048, 8>(A, (FK_LAS char*)lds, l, vcu + 128, 0); }
    else for (int ch = vcu; ch < 256; ch += G) hy::unit<2048, 8>(A, (FK_LAS char*)lds, l, ch, 0);
    if (l == 0) for (int ch = vcu; ch < 256; ch += G) hy::unit<256, 8>(A, (FK_LAS char*)lds, l, ch, 0);
#endif
#ifndef FK_NO_FN
    for (int rp = (FK_REP_SUB == 3 ? 1 : 0); rp >= 0; --rp)
    { FnSched S{G, vcu, 1, (const char*)wsp<bf16_t>(A, W.dftl), (const char*)wsp<bf16_t>(A, W.ftl)}; FnEpi E{wsp<bf16_t>(A, W.fno)}; gemm_phase(lds, 4096, S, E); }
    if (l == 0) { FnSched S{G, vcu, 0, (const char*)wsp<bf16_t>(A, W.dftc), (const char*)wsp<bf16_t>(A, W.ftc)}; FnEpi E{wsp<bf16_t>(A, W.fno)}; gemm_phase(lds, 512, S, E); }
#endif
}
#define FK_HAVE_MERGE 1
#define FK_HAVE_OUT 1
#define FK_HAVE_NORM 1
#define FK_HAVE_PQ 1
struct MergeSched {
    int G, c, ntile; const char *a0, *a1, *a2, *a3; const char* w;
    __device__ bool next(int i, Unit& u) const {
        const int j = i >> 2, s = i & 3; const long T = (long)j * G + c; if (T >= ntile) return false;
        u.pm = (int)(T >> 2); u.pn = (int)(T & 3); u.kind = s; u.aux = 0;
        u.a = (s == 0) ? a0 + (size_t)(j * 256 + c) * 256 * 256 * 2 : (s == 1 ? a1 : s == 2 ? a2 : a3) + (size_t)u.pm * 256 * 256 * 2; u.b = w + ((size_t)s * 1024 + u.pn * 256) * 256 * 2; return true;
    }
};
struct MergeEpi {
    const bf16_t* g; bf16_t* y;
    __device__ __forceinline__ bool operator()(Acc& acc, const Unit& u, int wr, int wc, int fr, int fq) const {
        const int s = u.kind; if (s == 2) return false;
        const int gn = (s == 3 ? 2048 : s * 1024), gd = (s + 1) * 1024;
#pragma unroll
        for (int ai = 0; ai < 2; ++ai)
#pragma unroll
            for (int m = 0; m < 4; ++m) { const size_t t = (size_t)u.pm * 256 + 128 * ai + 64 * wr + 16 * m + fr;
#pragma unroll
                for (int bj = 0; bj < 2; ++bj) { const int c = u.pn * 256 + 128 * bj + 32 * wc + 8 * fq; const bf16_t* gp = g + t * 3072 + c;
#pragma unroll
                    for (int n = 0; n < 2; ++n) {
                        const u32x2 wn = *(const u32x2*)(gp + gn + 4 * n);
                        f32x4 f = {bflo(wn.x), bfhi(wn.x), bflo(wn.y), bfhi(wn.y)};
                        if (s != 3) { const u32x2 wd = *(const u32x2*)(gp + gd + 4 * n);
                            f[0] *= __builtin_amdgcn_rcpf(bflo(wd.x)); f[1] *= __builtin_amdgcn_rcpf(bfhi(wd.x)); f[2] *= __builtin_amdgcn_rcpf(bflo(wd.y)); f[3] *= __builtin_amdgcn_rcpf(bfhi(wd.y)); }
                        acc[ai][bj][m][n] = acc[ai][bj][m][n] * f; }
                    if (s == 3) { const f32x4 v0 = acc[ai][bj][m][0], v1 = acc[ai][bj][m][1];
                        u32x4 w; w.x = cvt_pk_bf16(v0[0], v0[1]); w.y = cvt_pk_bf16(v0[2], v0[3]); w.z = cvt_pk_bf16(v1[0], v1[1]); w.w = cvt_pk_bf16(v1[2], v1[3]); *(u32x4*)(y + t * 1024 + c) = w; } }
                if (m == 3) asm volatile("" ::: "memory"); }
        return s == 3;
    }
};
__device__ __forceinline__ void phase_merge(AP A, FK_LAS unsigned char* lds, int l, int G) {
    MergeSched S; S.G = G; S.c = (int)blockIdx.x; S.ntile = (l == 0 ? NTT : NTL) * 4;
    { const int tid = opaque_tid(); const bf16_t* hyot = wsp<bf16_t>(A, W.hyo); bf16_t* scr = wsp<bf16_t>(A, W.q);
      constexpr int RS = 516;
      for (int j = 0; (long)j * G + S.c < S.ntile; ++j) { const int pm = (int)(((long)j * G + S.c) >> 2); bf16_t* dst = scr + (size_t)(j * 256 + S.c) * 65536;
          for (int cq = 0; cq < 4; ++cq) {
              __syncthreads();
#pragma unroll
              for (int i = 0; i < 4; ++i) { const int idx = tid + 512 * i, chl = idx >> 5, t8 = (idx & 31) * 8;
                  const u32x4 v = *(const u32x4*)(hyot + (size_t)(cq * 64 + chl) * NTOK + (size_t)pm * 256 + t8);
                  FK_LAS unsigned* p = (FK_LAS unsigned*)(lds + chl * RS + t8 * 2); p[0] = v.x; p[1] = v.y; p[2] = v.z; p[3] = v.w; }
              __syncthreads();
#pragma unroll
              for (int i = 0; i < 4; ++i) { const int idx = tid + 512 * i, tok = idx >> 3, c8 = (idx & 7) * 8; unsigned short e[8];
#pragma unroll
                  for (int q = 0; q < 8; ++q) e[q] = *(const FK_LAS unsigned short*)(lds + (c8 + q) * RS + tok * 2);
                  *(u32x4*)(dst + (size_t)tok * 256 + cq * 64 + c8) = (u32x4){(unsigned)e[0] | ((unsigned)e[1] << 16), (unsigned)e[2] | ((unsigned)e[3] << 16), (unsigned)e[4] | ((unsigned)e[5] << 16), (unsigned)e[6] | ((unsigned)e[7] << 16)}; }
          } }
      asm volatile("s_waitcnt vmcnt(0)" ::: "memory"); __syncthreads(); }
    S.a0 = (const char*)wsp<bf16_t>(A, W.q); S.a1 = (const char*)wsp<bf16_t>(A, W.fno); S.a2 = (const char*)wsp<bf16_t>(A, W.attlo); S.a3 = (const char*)wsp<bf16_t>(A, W.atthi);
    S.w = (const char*)(wsp<bf16_t>(A, W.w_mrg) + (size_t)l * 4 * 1024 * 256);
    MergeEpi E{wsp<bf16_t>(A, W.g), wsp<bf16_t>(A, W.y)};
    gemm_phase(lds, 256, S, E);
}
struct PlainSched {
    int G, c, nM, nN, K; const char* a; const char* w;
    __device__ bool next(int i, Unit& u) const {
        const long T = (long)i * G + c; if (T >= (long)nM * nN) return false;
        int wgid = (int)T; const int nwg = nM * nN; { const int q = nwg / 8, r = nwg % 8, xcd = wgid % 8, off = wgid / 8; wgid = (xcd < r ? xcd * (q + 1) : r * (q + 1) + (xcd - r) * q) + off; }
        const int nig = 8 * nN, gid = wgid / nig, fm = gid * 8, gsz = (nM - fm) < 8 ? (nM - fm) : 8;
        u.pm = fm + ((wgid % nig) % gsz); u.pn = (wgid % nig) / gsz; u.kind = 0; u.aux = 0;
        u.a = a + (size_t)u.pm * 256 * K * 2; u.b = w + (size_t)u.pn * 256 * K * 2; return true;
    }
};
struct OutEpi {
    const float* x_in; const float* ctx_in; const float* xl; float* xc; const float* mod; int l; float* xo;
    __device__ __forceinline__ bool operator()(Acc& acc, const Unit& u, int wr, int wc, int fr, int fq) const {
        const bool lat = u.pm < NTL; const int mr = lat ? u.pm >> 3 : 8;
        const float* gate = mod + (size_t)mr * 6144 + 2 * 1024;
#pragma unroll
        for (int bj = 0; bj < 2; ++bj) { const int c = u.pn * 256 + 128 * bj + 32 * wc + 8 * fq;
            const f32x4 g0 = *(const f32x4*)(gate + c), g1 = *(const f32x4*)(gate + c + 4);
#pragma unroll
            for (int ai = 0; ai < 2; ++ai)
#pragma unroll
                for (int m = 0; m < 4; ++m) { const int rl = 128 * ai + 64 * wr + 16 * m + fr;
                    const size_t t = (size_t)u.pm * 256 + rl, tc = t - NLAT;
                    const float* bp = lat ? ((l == 0 ? x_in : xl) + t * 1024 + c) : (ctx_in + tc * 1024 + c);
                    float* op = lat ? (xo + t * 1024 + c) : (xc + tc * 1024 + c);
                    const f32x4 b0 = *(const f32x4*)bp, b1 = *(const f32x4*)(bp + 4);
                    *(f32x4*)op = b0 + g0 * acc[ai][bj][m][0]; *(f32x4*)(op + 4) = b1 + g1 * acc[ai][bj][m][1]; } }
        return true;
    }
};
__device__ __forceinline__ void phase_outproj(AP A, FK_LAS unsigned char* lds, int l, int G, int dry) {
    PlainSched S{G, (int)blockIdx.x, l == 0 ? NTT : NTL, 4, 1024, (const char*)wsp<bf16_t>(A, W.y), (const char*)(wsp<bf16_t>(A, W.w_out) + (size_t)l * 1024 * 1024)};
    OutEpi E{FIN(0), FIN(2), A->xl, wsp<float>(A, W.xc), wsp<float>(A, W.mod) + (size_t)l * 9 * 6144, l, dry ? wsp<float>(A, W.g) : A->xl};
    gemm_phase(lds, 1024, S, E);
}
__device__ __forceinline__ void phase_norm(AP A, int l, int vcu, int G) {
    const int tid = opaque_tid(), lane = tid & 63, wave = __builtin_amdgcn_readfirstlane(tid >> 6);
    const int gw = vcu * NWAVES + wave, NGW = G * NWAVES;
    const float* mod = wsp<float>(A, W.mod) + (size_t)l * 9 * 6144;
    const int nrow = l == 0 ? NTOK : NLAT;
    for (int t = gw; t < nrow; t += NGW) {
        const bool lat = t < NLAT; const int mr = lat ? t / SEQ : 8;
        const float* xr = lat ? A->xl + (size_t)t * DM : wsp<float>(A, W.xc) + (size_t)(t - NLAT) * DM;
        modulate_row_bf16(xr, FIN(7) + l * DM, mod + (size_t)mr * 6144 + 4 * 1024, mod + (size_t)mr * 6144 + 3 * 1024, wsp<bf16_t>(A, W.nn) + (size_t)t * DM, lane);
    }
    if (l == 1) {
        const size_t gt = (size_t)vcu * NTHR + tid, NGT = (size_t)G * NTHR, nUV = (size_t)16384 * 1024 / 16;
        for (size_t i = gt; i < 2 * nUV; i += NGT) {
            if (i < nUV) cvt16_fp8(FIN(28) + (size_t)16384 * 1024 + i * 16, wsp<unsigned char>(A, W.ub) + tab_chunk_off(i), SU);
            else cvt16_fp8(FIN(29) + (size_t)16384 * 1024 + (i - nUV) * 16, wsp<unsigned char>(A, W.vb) + tab_chunk_off(i - nUV), SV);
        }
    }
}
struct PqEpi {
    bf16_t* pq;
    __device__ __forceinline__ bool operator()(Acc& acc, const Unit& u, int wr, int wc, int fr, int fq) const {
#pragma unroll
        for (int ai = 0; ai < 2; ++ai)
#pragma unroll
            for (int m = 0; m < 4; ++m) { bf16_t* rowp = pq + ((size_t)u.pm * 256 + 128 * ai + 64 * wr + 16 * m + fr) * 2048 + u.pn * 256 + 32 * wc + 8 * fq;
#pragma unroll
                for (int bj = 0; bj < 2; ++bj) { const f32x4 v0 = acc[ai][bj][m][0], v1 = acc[ai][bj][m][1];
                    u32x4 w; w.x = cvt_pk_bf16(v0[0], v0[1]); w.y = cvt_pk_bf16(v0[2], v0[3]); w.z = cvt_pk_bf16(v1[0], v1[1]); w.w = cvt_pk_bf16(v1[2], v1[3]);
                    *(u32x4*)(rowp + 128 * bj) = w; } }
        return true;
    }
};
__device__ __forceinline__ void phase_peerq(AP A, FK_LAS unsigned char* lds, int l, int G) {
    PlainSched S{G, (int)blockIdx.x, l == 0 ? NTT : NTL, 8, 1024, (const char*)wsp<bf16_t>(A, W.nn), (const char*)(wsp<bf16_t>(A, W.w_q) + (size_t)l * 2048 * 1024)};
    PqEpi E{wsp<bf16_t>(A, W.pq)};
    gemm_phase(lds, 1024, S, E);
}
#define FK_HAVE_PEER 1
namespace peer {
typedef __bf16 bf16x2v __attribute__((ext_vector_type(2)));
__device__ __forceinline__ float dot2(unsigned a, unsigned b, float c) { return __builtin_amdgcn_fdot2_f32_bf16(__builtin_bit_cast(bf16x2v, a), __builtin_bit_cast(bf16x2v, b), c, false); }
__device__ __forceinline__ unsigned ford(float f) { const unsigned u = __float_as_uint(f); return (u & 0x80000000u) ? ~u : (u | 0x80000000u); }
__device__ __forceinline__ float funord(unsigned o) { return __uint_as_float((o & 0x80000000u) ? (o & 0x7fffffffu) : ~o); }
__device__ __forceinline__ unsigned umax(unsigned a, unsigned b) { return a > b ? a : b; }
__device__ __forceinline__ unsigned umin(unsigned a, unsigned b) { return a < b ? a : b; }
template <int N> __device__ __forceinline__ void sort_desc(unsigned (&v)[N]) {
#pragma unroll
    for (int k = 2; k <= N; k <<= 1)
#pragma unroll
        for (int j = k >> 1; j > 0; j >>= 1)
#pragma unroll
            for (int i = 0; i < N; ++i) { const int l = i ^ j;
                if (l > i) { const unsigned a = v[i], b = v[l], mx = umax(a, b), mn = umin(a, b); if ((i & k) == 0) { v[i] = mx; v[l] = mn; } else { v[i] = mn; v[l] = mx; } } }
}
template <int N> __device__ __forceinline__ void merge_desc(unsigned (&v)[N]) {
#pragma unroll
    for (int j = N >> 1; j > 0; j >>= 1)
#pragma unroll
        for (int i = 0; i < N; ++i) { const int l = i ^ j; if (l > i) { const unsigned a = v[i], b = v[l]; v[i] = umax(a, b); v[l] = umin(a, b); } }
}
__device__ __forceinline__ int crow(int r, int hi) { return (r & 3) + 8 * (r >> 2) + 4 * hi; }
constexpr int L_RIDX = 0, L_RG = 32 * 128 * 2, L_TBL = L_RG + 32 * 128 * 4, L_WK = L_TBL + 8 * 32 * 32, L_END = L_WK + 8 * 128 * 4;

__device__ __forceinline__ void score_top16(const bf16_t* keys  , const bf16_t* qrow  , int r32, int hi, unsigned (&top)[16]) {
    f32x16 acc[4];
    int koff = r32 * 128 + 8 * hi; asm volatile("" : "+v"(koff));
    const bf16_t* kbase = keys + koff; const bf16_t* qb = qrow + 8 * hi;
#pragma unroll
    for (int kt = 0; kt < 4; ++kt) acc[kt] = f32x16{};
    bf16x8 bq[8], ka[8], kb2[8];
#pragma unroll
    for (int ks = 0; ks < 8; ++ks) bq[ks] = *(const bf16x8*)(qb + 16 * ks);
#define KLOAD(dst, kt) do { _Pragma("unroll") for (int ks = 0; ks < 8; ++ks) dst[ks] = *(const bf16x8*)(kbase + 32 * (kt) * 128 + 16 * ks); } while (0)
#define KMMA(src, kt) do { _Pragma("unroll") for (int ks = 0; ks < 8; ++ks) acc[kt] = __builtin_amdgcn_mfma_f32_32x32x16_bf16(src[ks], bq[ks], acc[kt], 0, 0, 0); } while (0)
    KLOAD(ka, 0); asm volatile("" ::: "memory");
    KLOAD(kb2, 1); KMMA(ka, 0); asm volatile("" ::: "memory");
    KLOAD(ka, 2); KMMA(kb2, 1); asm volatile("" ::: "memory");
    KLOAD(kb2, 3); KMMA(ka, 2); asm volatile("" ::: "memory");
    KMMA(kb2, 3);
#undef KLOAD
#undef KMMA
    unsigned v[64]; const unsigned hi4 = 4u * (unsigned)hi;
#pragma unroll
    for (int kt = 0; kt < 4; ++kt)
#pragma unroll
        for (int r = 0; r < 16; ++r) v[kt * 16 + r] = ((ford(acc[kt][r]) & ~0x7fu) | (unsigned)(127 - (32 * kt + (r & 3) + 8 * (r >> 2)))) - hi4;
    unsigned g0[16], g1[16], g2[16], g3[16];
#pragma unroll
    for (int i = 0; i < 16; ++i) { g0[i] = v[i]; g1[i] = v[16 + i]; g2[i] = v[32 + i]; g3[i] = v[48 + i]; }
    sort_desc<16>(g0); sort_desc<16>(g1); sort_desc<16>(g2); sort_desc<16>(g3);
#pragma unroll
    for (int i = 0; i < 16; ++i) { g0[i] = umax(g0[i], g1[15 - i]); g2[i] = umax(g2[i], g3[15 - i]); }
    merge_desc<16>(g0); merge_desc<16>(g2);
#pragma unroll
    for (int i = 0; i < 16; ++i) g0[i] = umax(g0[i], g2[15 - i]);
    merge_desc<16>(g0);
#pragma unroll
    for (int i = 0; i < 16; ++i) { const unsigned o = (unsigned)__shfl_xor((int)g0[15 - i], 32); top[i] = umax(g0[i], o); }
    merge_desc<16>(top);
}
__device__ __forceinline__ void phase(AP A, FK_LAS unsigned char* lds, int l, int vcu, int G, int dry_in, const XcdBarrier bar, const int use_bar) {
    const int dry = dry_in;
#define GBAR() do { if (use_bar) xcd_barrier(bar); } while (0)
    const int tid = opaque_tid(), lane = tid & 63, wave = __builtin_amdgcn_readfirstlane(tid >> 6), r32 = lane & 31, hi = lane >> 5;
    const int TS = (l == 0 && (NTOK % 24) == 0) ? 24 : 32, TPW = TS / 8;
    const int ntile = (l == 0 ? NTOK : NLAT) / TS;
    const bf16_t* keys = wsp<bf16_t>(A, W.keys) + (size_t)l * 16 * 128 * 128;
    const float* mod = wsp<float>(A, W.mod) + (size_t)l * 9 * 6144;
    FK_LAS unsigned short* ridx = (FK_LAS unsigned short*)(lds + L_RIDX); FK_LAS float* rg = (FK_LAS float*)(lds + L_RG);
    FK_LAS unsigned char* tbl = (FK_LAS unsigned char*)(lds + L_TBL) + wave * 32 * 32; FK_LAS float* wk = (FK_LAS float*)(lds + L_WK) + wave * 128;
    for (int tile = vcu; tile < ntile; tile += G) {
        const int t0 = tile * TS; const int rtok = r32 < TS ? r32 : TS - 1;
        __syncthreads();
#ifndef FK_REP_SUB
#define FK_REP_SUB 0
#endif
        for (int rp = (FK_REP_SUB == 4 ? 1 : 0); rp >= 0; --rp) {
            const int h = wave; unsigned s1[16], s2[16];
            const bf16_t* qrow = wsp<bf16_t>(A, W.pq) + (size_t)(t0 + rtok) * 2048 + h * 256;
            score_top16(keys + (size_t)(h * 2 + 0) * 128 * 128, qrow, r32, hi, s1);
            score_top16(keys + (size_t)(h * 2 + 1) * 128 * 128, qrow + 128, r32, hi, s2);
            if (hi == 0) {
#pragma unroll
                for (int i = 0; i < 16; ++i) { tbl[r32 * 32 + i] = (unsigned char)(127 - (s1[i] & 127u)); tbl[r32 * 32 + 16 + i] = (unsigned char)(127 - (s2[i] & 127u)); } }
            float f1[16], f2[16];
#pragma unroll
            for (int i = 0; i < 16; ++i) { f1[i] = funord(s1[i] & ~0x7fu); f2[i] = funord(s2[i] & ~0x7fu); }
            unsigned c[32]; int cn = 0;
#pragma unroll
            for (int i = 0; i < 16; ++i)
#pragma unroll
                for (int j = 0; j < 16; ++j) if ((i + 1) * (j + 1) <= 16) {
                    const unsigned pk = (ford(f1[i] + f2[j]) & ~0xffu) | (unsigned)(255 - (i * 16 + j));
                    if ((cn & 1) == 0) c[cn >> 1] = pk; else c[cn >> 1] = hi ? pk : c[cn >> 1];
                    ++cn; }
#pragma unroll
            for (int q = 25; q < 32; ++q) c[q] = 0u;
            sort_desc<32>(c);
            unsigned ct[16];
#pragma unroll
            for (int i = 0; i < 16; ++i) { const unsigned o = (unsigned)__shfl_xor((int)c[15 - i], 32); ct[i] = umax(c[i], o); }
            merge_desc<16>(ct);
            if (hi == 0 && r32 < TS) {
                float e[16]; float sum = 0.f; const float mx = funord(ct[0] & ~0xffu);
#pragma unroll
                for (int t = 0; t < 16; ++t) { e[t] = __expf(funord(ct[t] & ~0xffu) - mx); sum += e[t]; }
                const float inv = 1.f / sum;
#pragma unroll
                for (int t = 0; t < 16; ++t) { const int ci = 255 - (int)(ct[t] & 0xffu); const int e1 = tbl[r32 * 32 + (ci >> 4)], e2 = tbl[r32 * 32 + 16 + (ci & 15)];
                    const int idx = e1 * 128 + e2; const float gg = e[t] * inv;
                    ridx[r32 * 128 + h * 16 + t] = (unsigned short)idx; rg[r32 * 128 + h * 16 + t] = gg;
                    wsp<unsigned short>(A, W.pidx)[(size_t)(t0 + r32) * 128 + ((h * 16 + t) & 7) * 16 + ((h * 16 + t) >> 3)] = (unsigned short)idx; wsp<float>(A, W.pg)[(size_t)(t0 + r32) * 128 + h * 16 + t] = gg; }
            }
        }
    }
    if (G != 256) return;
    GBAR();
    const int sl = (int)blockIdx.x & 7, rk = (int)blockIdx.x >> 3, ntok = (l == 0 ? NTOK : NLAT);
    const int r8 = lane >> 3, cc = lane & 7;
    A = opaque_args(A);
    const unsigned short* pidx = wsp<unsigned short>(A, W.pidx); const float* pgw = wsp<float>(A, W.pg);
    float* hidp = wsp<float>(A, W.pq);
    for (int rp = (FK_REP_SUB == 5 ? 1 : 0); rp >= 0; --rp) {
        const unsigned char* Us = wsp<unsigned char>(A, W.ub) + (size_t)sl * 16384 * 128; const unsigned cc16 = 16u * (unsigned)cc;
        const bf16_t* nn = wsp<bf16_t>(A, W.nn) + 128 * sl + 16 * cc;
#define TLOAD(IK, N0, N1, t) do { const u32x4 i0_ = *(const u32x4*)(pidx + (size_t)(t) * 128 + r8 * 16), i1_ = *(const u32x4*)(pidx + (size_t)(t) * 128 + r8 * 16 + 8); \
            IK[0] = i0_.x; IK[1] = i0_.y; IK[2] = i0_.z; IK[3] = i0_.w; IK[4] = i1_.x; IK[5] = i1_.y; IK[6] = i1_.z; IK[7] = i1_.w; \
            N0 = *(const u32x4*)(nn + (size_t)(t) * DM); N1 = *(const u32x4*)(nn + (size_t)(t) * DM + 8); } while (0)
#define GLOAD(GB, IK, h) do { _Pragma("unroll") for (int i = 0; i < 8; ++i) GB[i] = *(const u32x4*)(Us + (((IK[4 * (h) + (i >> 1)] >> (16 * (i & 1))) & 0xffffu) * 128u + cc16)); } while (0)
#define NUNPK(N0, N1) do { nf[0] = bflo(N0.x); nf[1] = bfhi(N0.x); nf[2] = bflo(N0.y); nf[3] = bfhi(N0.y); nf[4] = bflo(N0.z); nf[5] = bfhi(N0.z); nf[6] = bflo(N0.w); nf[7] = bfhi(N0.w); \
            nf[8] = bflo(N1.x); nf[9] = bfhi(N1.x); nf[10] = bflo(N1.y); nf[11] = bfhi(N1.y); nf[12] = bflo(N1.z); nf[13] = bfhi(N1.z); nf[14] = bflo(N1.w); nf[15] = bfhi(N1.w); } while (0)
#define HDOT(GB, t, h) do { float p[8]; \
            _Pragma("unroll") for (int i = 0; i < 8; ++i) { const unsigned aw[4] = {GB[i].x, GB[i].y, GB[i].z, GB[i].w}; f32x2 d2 = {0.f, 0.f}; \
                _Pragma("unroll") for (int q = 0; q < 4; ++q) { const f32x2 lo = __builtin_amdgcn_cvt_pk_f32_fp8(aw[q], false), hh = __builtin_amdgcn_cvt_pk_f32_fp8(aw[q], true); \
                    d2 = lo * (f32x2){nf[4 * q], nf[4 * q + 1]} + d2; d2 = hh * (f32x2){nf[4 * q + 2], nf[4 * q + 3]} + d2; }     \
                p[i] = d2[0] + d2[1]; } \
            _Pragma("unroll") for (int i = 0; i < 4; ++i) { const float send = (cc & 1) ? p[i] : p[i + 4], keep = (cc & 1) ? p[i + 4] : p[i]; p[i] = keep + __shfl_xor(send, 1); } \
            _Pragma("unroll") for (int i = 0; i < 2; ++i) { const float send = (cc & 2) ? p[i] : p[i + 2], keep = (cc & 2) ? p[i + 2] : p[i]; p[i] = keep + __shfl_xor(send, 2); } \
            { const float send = (cc & 4) ? p[0] : p[1], keep = (cc & 4) ? p[1] : p[0]; p[0] = keep + __shfl_xor(send, 4); } \
            const int v = 4 * (cc & 1) + 2 * ((cc >> 1) & 1) + ((cc >> 2) & 1); \
            hidp[((size_t)(t) * 8 + sl) * 128 + 8 * (8 * (h) + v) + r8] = p[0]; } while (0)
        unsigned ikA[8], ikB[8]; u32x4 nA0, nA1, nB0, nB1, ga[8], gb[8]; float nf[16];
        int t = rk + 32 * wave;
        if (t < ntok) { TLOAD(ikA, nA0, nA1, t); GLOAD(ga, ikA, 0); }
#pragma unroll 1
        while (t < ntok) {
            const int t1 = t + 256;
            if (t1 < ntok) TLOAD(ikB, nB0, nB1, t1);
            GLOAD(gb, ikA, 1); NUNPK(nA0, nA1); HDOT(ga, t, 0);
            if (t1 < ntok) GLOAD(ga, ikB, 0);
            HDOT(gb, t, 1);
            if (t1 >= ntok) break;
            const int t2 = t1 + 256;
            if (t2 < ntok) TLOAD(ikA, nA0, nA1, t2);
            GLOAD(gb, ikB, 1); NUNPK(nB0, nB1); HDOT(ga, t1, 0);
            if (t2 < ntok) GLOAD(ga, ikA, 0);
            HDOT(gb, t1, 1);
            t = t2;
        }
#undef TLOAD
#undef GLOAD
#undef NUNPK
#undef HDOT
    }
    GBAR();
    for (int rp = (FK_REP_SUB == 6 ? 1 : 0); rp >= 0; --rp) { const int dry = dry_in | rp;
        const unsigned char* Vs = wsp<unsigned char>(A, W.vb) + (size_t)sl * 16384 * 128; const unsigned cc16 = 16u * (unsigned)cc;
#define TLOADI(IK, t) do { const u32x4 i0_ = *(const u32x4*)(pidx + (size_t)(t) * 128 + r8 * 16), i1_ = *(const u32x4*)(pidx + (size_t)(t) * 128 + r8 * 16 + 8); \
            IK[0] = i0_.x; IK[1] = i0_.y; IK[2] = i0_.z; IK[3] = i0_.w; IK[4] = i1_.x; IK[5] = i1_.y; IK[6] = i1_.z; IK[7] = i1_.w; } while (0)
#define TLOADH(H, PGV, t) do { const float* hp_ = hidp + (size_t)(t) * 1024 + lane; _Pragma("unroll") for (int q = 0; q < 8; ++q) { H[2 * q] = hp_[q * 128]; H[2 * q + 1] = hp_[q * 128 + 64]; } \
            PGV[0] = pgw[(size_t)(t) * 128 + lane]; PGV[1] = pgw[(size_t)(t) * 128 + 64 + lane]; } while (0)
#define GLOAD2(GB, IK, h) do { _Pragma("unroll") for (int i = 0; i < 8; ++i) GB[i] = *(const u32x4*)(Vs + (((IK[4 * (h) + (i >> 1)] >> (16 * (i & 1))) & 0xffffu) * 128u + cc16)); } while (0)
#define WCALC(H, PGV) do { float h0 = 0.f, h1 = 0.f; _Pragma("unroll") for (int q = 0; q < 8; ++q) { h0 += H[2 * q]; h1 += H[2 * q + 1]; } h0 *= (1.f / SU); h1 *= (1.f / SU); \
            w0 = PGV[0] * 0.5f * h0 * (1.f + erff(h0 * 0.70710678118654752f)) * (1.f / SV); w1 = PGV[1] * 0.5f * h1 * (1.f + erff(h1 * 0.70710678118654752f)) * (1.f / SV); } while (0)
#define VACC(GB, h) do { _Pragma("unroll") for (int i = 0; i < 8; ++i) { const float w = __shfl((h) ? w1 : w0, 8 * i + r8); const unsigned aw[4] = {GB[i].x, GB[i].y, GB[i].z, GB[i].w}; \
                _Pragma("unroll") for (int q = 0; q < 4; ++q) { const f32x2 lo = __builtin_amdgcn_cvt_pk_f32_fp8(aw[q], false), hh = __builtin_amdgcn_cvt_pk_f32_fp8(aw[q], true); const f32x2 w2 = {w, w}; \
                    f32x2 ya = {y[4 * q], y[4 * q + 1]}, yb = {y[4 * q + 2], y[4 * q + 3]}; ya = w2 * lo + ya; yb = w2 * hh + yb; y[4 * q] = ya[0]; y[4 * q + 1] = ya[1]; y[4 * q + 2] = yb[0]; y[4 * q + 3] = yb[1]; } } } while (0)
#define XUPD(t) do { \
            _Pragma("unroll") for (int q = 0; q < 8; ++q) { const float send = (r8 & 1) ? y[q] : y[q + 8], keep = (r8 & 1) ? y[q + 8] : y[q]; y[q] = keep + __shfl_xor(send, 8); } \
            _Pragma("unroll") for (int q = 0; q < 4; ++q) { const float send = (r8 & 2) ? y[q] : y[q + 4], keep = (r8 & 2) ? y[q + 4] : y[q]; y[q] = keep + __shfl_xor(send, 16); } \
            _Pragma("unroll") for (int q = 0; q < 2; ++q) { const float send = (r8 & 4) ? y[q] : y[q + 2], keep = (r8 & 4) ? y[q + 2] : y[q]; y[q] = keep + __shfl_xor(send, 32); } \
            const int col = 128 * sl + 16 * cc + 8 * (r8 & 1) + 4 * ((r8 >> 1) & 1) + 2 * ((r8 >> 2) & 1); const bool lat_ = (t) < NLAT; \
            float* xr_ = (lat_ ? A->xl + (size_t)(t) * DM : wsp<float>(A, W.xc) + (size_t)((t) - NLAT) * DM) + col; \
            const float* gt_ = mod + (size_t)(lat_ ? (t) / SEQ : 8) * 6144 + 5 * 1024 + col; \
            f32x2 xv_ = *(const f32x2*)xr_; const f32x2 gv_ = *(const f32x2*)gt_; xv_[0] += gv_[0] * y[0]; xv_[1] += gv_[1] * y[1]; if (!dry) *(f32x2*)xr_ = xv_; } while (0)
        unsigned ikA[8], ikB[8]; float hN[16], pgN[2]; u32x4 ga[8], gb[8]; float y[16], w0, w1;
        int t = rk + 32 * wave;
        if (t < ntok) { TLOADI(ikA, t); TLOADH(hN, pgN, t); GLOAD2(ga, ikA, 0); }
#pragma unroll 1
        while (t < ntok) {
            WCALC(hN, pgN);
            const int t1 = t + 256;
            if (t1 < ntok) { TLOADI(ikB, t1); TLOADH(hN, pgN, t1); }
            GLOAD2(gb, ikA, 1);
#pragma unroll
            for (int i = 0; i < 16; ++i) y[i] = 0.f;
            VACC(ga, 0);
            if (t1 < ntok) GLOAD2(ga, ikB, 0);
            VACC(gb, 1); XUPD(t);
            if (t1 >= ntok) break;
            WCALC(hN, pgN);
            const int t2 = t1 + 256;
            if (t2 < ntok) { TLOADI(ikA, t2); TLOADH(hN, pgN, t2); }
            GLOAD2(gb, ikB, 1);
#pragma unroll
            for (int i = 0; i < 16; ++i) y[i] = 0.f;
            VACC(ga, 0);
            if (t2 < ntok) GLOAD2(ga, ikA, 0);
            VACC(gb, 1); XUPD(t1);
            t = t2;
        }
#undef TLOADI
#undef TLOADH
#undef GLOAD2
#undef WCALC
#undef VACC
#undef XUPD
    }
    if (l == 0 && !dry) {
        GBAR();
        const float* mod1 = wsp<float>(A, W.mod) + (size_t)9 * 6144; const int gw = vcu * NWAVES + wave, NGW = G * NWAVES;
        for (int t = gw; t < NTOK; t += NGW) { const bool lat = t < NLAT; const int mr = lat ? t / SEQ : 8;
            const float* xr = lat ? A->xl + (size_t)t * DM : wsp<float>(A, W.xc) + (size_t)(t - NLAT) * DM;
            modulate_row_bf16(xr, FIN(6) + DM, mod1 + (size_t)mr * 6144 + 1024, mod1 + (size_t)mr * 6144, wsp<bf16_t>(A, W.xn) + (size_t)t * DM, lane); }
    }
}
#undef GBAR
}
__device__ __forceinline__ void phase_peer(AP A, FK_LAS unsigned char* lds, int l, int vcu, int G, int dry, const XcdBarrier bar, const int use_bar) { peer::phase(A, lds, l, vcu, G, dry, bar, use_bar); }
constexpr int N_PHASES = 16;
__global__ void __launch_bounds__(NTHR, 2) mega(Args A_unused) {
    extern __shared__ __attribute__((aligned(16))) unsigned char lds_raw[];
    FK_LAS unsigned char* lds = (FK_LAS unsigned char*)lds_raw;
    const int tid = threadIdx.x;
    AP A0 = (AP)__builtin_amdgcn_kernarg_segment_ptr();
#define AA() opaque_args(A0)
    const int G = gridDim.x, bx = blockIdx.x, vcu = (G % 8 == 0) ? (bx % 8) * (G / 8) + bx / 8 : bx;
    volatile FK_LAS unsigned* MISC = (volatile FK_LAS unsigned*)(lds + LDS_MISC);
    if (tid < 64) MISC[tid] = 0u;
    __syncthreads();
    XcdBarrier bar; bar.bar = wsp<unsigned>(A0, W.ctl) + 1024; bar.x = 0; bar.st = MISC + 8;
    if (A0->use_bar) bar = xcd_barrier_post(wsp<unsigned>(A0, W.ctl) + 1024, MISC + 8);
    const int lo = A0->ph_lo, hi = A0->ph_hi;
#define IN(k) (lo <= (k) && (k) < hi)
#ifndef FK_REP_PHASE
#define FK_REP_PHASE -1
#endif
#define REP(k) for (int rep_ = (FK_REP_PHASE == (k)) ? 1 : 0; rep_ >= 0; --rep_)
#ifndef FK_REP_BAR
#define FK_REP_BAR 0
#endif
#define SEAM(k) do { if (IN(k) && IN((k) + 1)) { xcd_barrier(bar); if (FK_REP_BAR) xcd_barrier(bar); } } while (0)
#ifndef FK_REP_ALL
#define FK_REP_ALL 0
#endif
    for (int pass = FK_REP_ALL ? 1 : 0; pass >= 0; --pass) {
    if (IN(0)) REP(0) phase_pa(AA(), lds, vcu, G);
    SEAM(0);
    if (IN(1)) REP(1) phase_pb(AA(), vcu, G);
    SEAM(1);
    for (int l = 0; l < 2; ++l) {
        const int pb = 2 + 7 * l;
        if (IN(pb + 0)) REP(pb + 0) phase_inproj(AA(), lds, l, G);
        SEAM(pb + 0);
#ifdef FK_HAVE_MIX
        if (IN(pb + 1)) REP(pb + 1) phase_mix(AA(), lds, l, vcu, G);
#endif
        SEAM(pb + 1);
#ifdef FK_HAVE_MERGE
        if (IN(pb + 2)) REP(pb + 2) phase_merge(AA(), lds, l, G);
#endif
        SEAM(pb + 2);
#ifdef FK_HAVE_OUT
        if (IN(pb + 3)) REP(pb + 3) phase_outproj(AA(), lds, l, G, rep_ | (pass & l));
#endif
        SEAM(pb + 3);
#ifdef FK_HAVE_NORM
        if (IN(pb + 4)) REP(pb + 4) phase_norm(AA(), l, vcu, G);
#endif
        SEAM(pb + 4);
#ifdef FK_HAVE_PQ
        if (IN(pb + 5)) REP(pb + 5) phase_peerq(AA(), lds, l, G);
#endif
        SEAM(pb + 5);
#ifdef FK_HAVE_PEER
        if (IN(pb + 6)) REP(pb + 6) phase_peer(AA(), lds, l, vcu, G, rep_ | pass, bar, A0->use_bar);
#endif
        SEAM(pb + 6);
    }
    if (pass) xcd_barrier(bar);
    }
#undef IN
#undef SEAM
}
inline void launch(void* const* d_in, float* out, unsigned char* ws, float* xl, int lo, int hi, bool one_launch, hipStream_t st) {
    static int ok = 0;
    if (!ok) { if (hipFuncSetAttribute((const void*)mega, hipFuncAttributeMaxDynamicSharedMemorySize, LDS_BYTES) != hipSuccess) { fprintf(stderr, "hipFuncSetAttribute failed\n"); return; } ok = 1; }
    (void)hipMemsetAsync(ws + W.ctl, 0, 65536, st);
    Args a{}; for (int i = 0; i < 30; ++i) a.in[i] = (const float*)d_in[i];
    a.out = out; a.ws = ws; a.xl = xl; a.pad = 0;
    if (one_launch) { a.ph_lo = lo; a.ph_hi = hi; a.use_bar = 1; hipLaunchKernelGGL(mega, dim3(256), dim3(NTHR), LDS_BYTES, st, a); }
    else for (int p = lo; p < hi; ++p) { a.ph_lo = p; a.ph_hi = p + 1; a.use_bar = 0; hipLaunchKernelGGL(mega, dim3(256), dim3(NTHR), LDS_BYTES, st, a); }
}
}
#ifndef FK_ONE_LAUNCH
#define FK_ONE_LAUNCH 1
#endif
extern "C" void kernel_launch(void* const* d_in, const int* in_sizes, int n_in, void* d_out, int out_size, void* d_ws, size_t ws_size, hipStream_t stream) {
    if (n_in != 30 || ws_size < fk::W.end || out_size != fk::NLAT * 1024) { fprintf(stderr, "kernel_launch: n_in %d ws %zu (need %zu) out %d\n", n_in, ws_size, (size_t)fk::W.end, out_size); return; }
    fk::launch(d_in, (float*)d_out, (unsigned char*)d_ws, (float*)d_out, 0, fk::N_PHASES, FK_ONE_LAUNCH != 0, stream);
}
```

```cpp
#include <hip/hip_runtime.h>
#include <cstdio>
#include <cstdint>
#include <math.h>
#define FK_ONE_LAUNCH 1
namespace fk {
#define FK_LAS __attribute__((address_space(3)))
typedef unsigned short bf16_t;
typedef short bf16x8 __attribute__((ext_vector_type(8)));
typedef float f32x4 __attribute__((ext_vector_type(4)));
typedef float f32x16 __attribute__((ext_vector_type(16)));
typedef unsigned u32x4 __attribute__((ext_vector_type(4)));
typedef unsigned u32x2 __attribute__((ext_vector_type(2)));
#ifndef FK_NB
#define FK_NB 8
#endif
constexpr int NB = FK_NB, SEQ = 2048, DM = 1024, CTX = 256, KALL = SEQ + CTX;
constexpr int NLAT = NB * SEQ, NCTX = NB * CTX, NTOK = NLAT + NCTX;
constexpr int PINF = 5888;
constexpr int R_HY = 0, R_FZ = 768, R_Q = 1280, R_K = 1792, R_V = 2304, R_G = 2816;
constexpr float EPS = 1e-6f;
constexpr int NWAVES = 8, NTHR = 512;
constexpr int TLL = 4224, TLC = 576;

__device__ __forceinline__ unsigned f2bf(float f) { unsigned u = __builtin_bit_cast(unsigned, f); return (u + 0x7fffu + ((u >> 16) & 1u)) >> 16; }
__device__ __forceinline__ unsigned pk2(float lo, float hi) { return f2bf(lo) | (f2bf(hi) << 16); }
__device__ __forceinline__ float bf2f(unsigned short h) { return __builtin_bit_cast(float, (unsigned)h << 16); }
__device__ __forceinline__ float bflo(unsigned w) { return __builtin_bit_cast(float, w << 16); }
__device__ __forceinline__ float bfhi(unsigned w) { return __builtin_bit_cast(float, w & 0xffff0000u); }
typedef __bf16 bf16x2_t __attribute__((ext_vector_type(2)));
__device__ __forceinline__ unsigned cvt_pk_bf16(float lo, float hi) { bf16x2_t v = {(__bf16)lo, (__bf16)hi}; return __builtin_bit_cast(unsigned, v); }
typedef float f32x2 __attribute__((ext_vector_type(2)));
constexpr float SU = 64.f, SV = 4.f;
__device__ __forceinline__ unsigned pk4_fp8(float a, float b, float c, float d) { unsigned w = __builtin_amdgcn_cvt_pk_fp8_f32(a, b, 0, false); return __builtin_amdgcn_cvt_pk_fp8_f32(c, d, w, true); }
__device__ __forceinline__ size_t tab_chunk_off(size_t i  ) { const size_t e = i >> 6, c16 = i & 63; return (((c16 >> 3) * 16384 + e) * 128) + (c16 & 7) * 16; }
__device__ __forceinline__ void cvt16_fp8(const float* src, unsigned char* dst, float sc) {
    const f32x4 x0 = *(const f32x4*)(src), x1 = *(const f32x4*)(src + 4), x2 = *(const f32x4*)(src + 8), x3 = *(const f32x4*)(src + 12);
    u32x4 o; o.x = pk4_fp8(x0[0] * sc, x0[1] * sc, x0[2] * sc, x0[3] * sc); o.y = pk4_fp8(x1[0] * sc, x1[1] * sc, x1[2] * sc, x1[3] * sc);
    o.z = pk4_fp8(x2[0] * sc, x2[1] * sc, x2[2] * sc, x2[3] * sc); o.w = pk4_fp8(x3[0] * sc, x3[1] * sc, x3[2] * sc, x3[3] * sc);
    *(u32x4*)dst = o;
}
__device__ __forceinline__ float wave_sum(float v) {
#pragma unroll
    for (int o = 32; o > 0; o >>= 1) v += __shfl_xor(v, o);
    return v;
}

struct WS {
    size_t ctl, mod, misc, h3l, h3c, tapl, tapc, w_in, w_mrg, w_out, w_q, keys, ub, vb, dftl, dftc;
    size_t xn, nn, hyt, ftl, ftc, q, qc, k, vt, g, attlo, atthi, hyo, fno, y, xl, xc, pq, pidx, pg, stash, end;
};
__host__ __device__ constexpr size_t al(size_t x) { return (x + 4095) / 4096 * 4096; }
__host__ __device__ constexpr WS make_ws() {
    WS w{}; size_t o = 0;
    w.ctl = o; o += 65536;
    w.mod = o; o += al((size_t)2 * 9 * 6144 * 4);
    w.misc = o; o += al((size_t)12 << 20);
    w.tapl = o; o += al((size_t)2 * 2 * 256 * TLL * 2);
    w.tapc = o; o += al((size_t)2 * 2 * 256 * TLC * 2);
    w.w_in = o; o += al((size_t)2 * PINF * 1024 * 2);
    w.w_mrg = o; o += al((size_t)2 * 4 * 1024 * 256 * 2);
    w.w_out = o; o += al((size_t)2 * 1024 * 1024 * 2);
    w.w_q = o; o += al((size_t)2 * 2048 * 1024 * 2);
    w.keys = o; o += al((size_t)2 * 16 * 128 * 128 * 2);
    w.ub = o; o += al((size_t)16384 * 1024);
    w.vb = o; o += al((size_t)16384 * 1024);
    w.dftl = o; o += al((size_t)2048 * 4096 * 2);
    w.dftc = o; o += al((size_t)256 * 512 * 2);
    w.xn = o; o += al((size_t)NTOK * 1024 * 2);
    w.nn = o; w.stash = o; { size_t a = al((size_t)NTOK * 1024 * 2), b = al((size_t)256 * 512 * 128 * 4); o += a > b ? a : b; }
    w.hyt = o; w.y = o; { size_t a = al((size_t)768 * NTOK * 2) + al((size_t)NB * 256 * 4096 * 2) + al((size_t)NB * 256 * 512 * 2), b = al((size_t)NTOK * 1024 * 2);
        w.ftl = o + al((size_t)768 * NTOK * 2); w.ftc = w.ftl + al((size_t)NB * 256 * 4096 * 2); o += a > b ? a : b; }
    w.q = o; o += al((size_t)NB * 8 * 2048 * 64 * 2);
    w.qc = o; o += al((size_t)NB * 8 * 256 * 64 * 2);
    w.k = o; o += al((size_t)NB * 8 * KALL * 64 * 2);
    w.vt = o; o += al((size_t)NB * 4 * 128 * KALL * 2);
    w.g = o; w.pq = o; w.h3l = o; { size_t a = al((size_t)NTOK * 3072 * 2), b = al((size_t)2 * 2048 * 1024 * 4) + al((size_t)2 * 256 * 1024 * 4);
        w.h3c = o + al((size_t)2 * 2048 * 1024 * 4); o += a > b ? a : b; }
    w.attlo = o; o += al((size_t)NTOK * 256 * 2);
    w.atthi = o; o += al((size_t)NTOK * 256 * 2);
    w.hyo = o; o += al((size_t)NTOK * 256 * 2);
    w.fno = o; o += al((size_t)NTOK * 256 * 2);
    w.xl = o; o += (NB == 8) ? 0 : al((size_t)NLAT * 1024 * 4);
    w.xc = o; o += al((size_t)NCTX * 1024 * 4);
    w.pidx = o; o += al((size_t)NTOK * 128 * 4);
    w.pg = o; o += al((size_t)NTOK * 128 * 4);
    w.end = o; return w;
}
constexpr WS W = make_ws();
constexpr int MI_LAM = 0, MI_ROPE = 64, MI_HYINV = 4096, MI_HYPART = 8192;

constexpr int BM = 256, BK = 64, HALF = 128, HTB = HALF * BK * 2, STAGE_BYTES = 8 * HTB;
__host__ __device__ __forceinline__ int lds_byte(int r, int c) { const int st = (r >> 4) * 2 + (c >> 5), rr = r & 15, cc = c & 31, ob = rr * 64 + cc * 2; return st * 1024 + (ob ^ (((ob >> 9) & 1) << 5)); }
__host__ __device__ __forceinline__ void stage_rc(int b, int& R, int& C) { const int st = b / 1024, sb = b % 1024, swz = sb ^ (((sb >> 9) & 1) << 5); R = (st >> 1) * 16 + swz / 64; C = (st & 1) * 32 + (swz % 64) / 2; }
__host__ __device__ __forceinline__ int perm32(int rho) { const int n = rho >> 4, i = rho & 15; return 8 * (i >> 2) + 4 * n + (i & 3); }

struct Unit { const char* a; const char* b; int pm, pn, kind, aux; };
typedef f32x4 Acc[2][2][4][2];

template <class Sched, class Epi>
__device__ __forceinline__ void gemm_phase(FK_LAS unsigned char* lds, const int K, const Sched& S, const Epi& E) {
    int tid = threadIdx.x; asm volatile("" : "+v"(tid));
    const int wid = __builtin_amdgcn_readfirstlane(tid >> 6), lane = tid & 63, wr = wid >> 2, wc = wid & 3, fr = lane & 15, fq = lane >> 4;
    const int nt = K / BK;
    unsigned voffA[2], voffB[2];
#pragma unroll
    for (int i = 0; i < 2; ++i) { int R, C; stage_rc(tid * 16 + i * 8192, R, C); const int Rb = (R & ~31) + perm32(R & 31);
        voffA[i] = (unsigned)(R * K + C) * 2u; voffB[i] = (unsigned)(Rb * K + C) * 2u; }
    const size_t kstep = (size_t)(BK * 2);
    const size_t hstep = (size_t)HALF * K * 2;
    const unsigned ldsw = (unsigned)wid * 1024u;
    const int aoff = lds_byte(wr * 64 + fr, fq * 8), boff = lds_byte(wc * 32 + fr, fq * 8);
#define PG8_SA(b, h) (((b) * 2 + (h)) * HTB)
#define PG8_SB(b, h) ((4 + (b) * 2 + (h)) * HTB)
#define PG8_STAGE(bufoff, gbase, voff) do { _Pragma("unroll") for (int _i = 0; _i < 2; ++_i) \
        __builtin_amdgcn_global_load_lds((const unsigned*)((const char*)(gbase) + (voff)[_i]), (FK_LAS unsigned*)(lds + (bufoff) + ldsw + _i * 8192), 16, 0, 0); } while (0)
#define PG8_LDA(dst, b, h) do { _Pragma("unroll") for (int m = 0; m < 4; ++m) _Pragma("unroll") for (int k = 0; k < 2; ++k) dst[m][k] = *(const FK_LAS bf16x8*)(lds + PG8_SA(b, h) + aoff + m * 2048 + k * 1024); } while (0)
#define PG8_LDB(dst, b, h) do { _Pragma("unroll") for (int n = 0; n < 2; ++n) _Pragma("unroll") for (int k = 0; k < 2; ++k) dst[n][k] = *(const FK_LAS bf16x8*)(lds + PG8_SB(b, h) + boff + n * 2048 + k * 1024); } while (0)
#define PG8_MMA(ai, bj, At, Bt) do { __builtin_amdgcn_s_setprio(1); _Pragma("unroll") for (int m = 0; m < 4; ++m) _Pragma("unroll") for (int n = 0; n < 2; ++n) _Pragma("unroll") for (int k = 0; k < 2; ++k) \
        acc[ai][bj][m][n] = __builtin_amdgcn_mfma_f32_16x16x32_bf16(Bt[n][k], At[m][k], acc[ai][bj][m][n], 0, 0, 0); __builtin_amdgcn_s_setprio(0); } while (0)
#define PG8_WAIT_V(n) asm volatile("s_waitcnt vmcnt(" #n ")" ::: "memory")
#define PG8_WAIT_L(n) asm volatile("s_waitcnt lgkmcnt(" #n ")" ::: "memory")
#define PG8_BAR __builtin_amdgcn_s_barrier()
#define PG8_SCHED __builtin_amdgcn_sched_barrier(0)
    Unit cur, nxt; int ui = 0;
    if (!S.next(0, cur)) return;
    Acc acc;
#pragma unroll
    for (int a = 0; a < 2; ++a)
#pragma unroll
        for (int b = 0; b < 2; ++b)
#pragma unroll
            for (int m = 0; m < 4; ++m)
#pragma unroll
                for (int n = 0; n < 2; ++n) acc[a][b][m][n] = (f32x4){0.f, 0.f, 0.f, 0.f};
    bf16x8 At[4][2], B0[2][2], B1[2][2];
    const char* cA = cur.a; const char* cB = cur.b;
    PG8_STAGE(PG8_SB(0, 0), cB, voffB); PG8_STAGE(PG8_SB(0, 1), cB + hstep, voffB); PG8_STAGE(PG8_SA(0, 0), cA, voffA); PG8_STAGE(PG8_SA(0, 1), cA + hstep, voffA);
    if (wr == 1) PG8_BAR;
    PG8_WAIT_V(2); PG8_BAR;
    PG8_STAGE(PG8_SB(1, 0), cB + kstep, voffB); PG8_STAGE(PG8_SA(1, 0), cA + kstep, voffA); PG8_STAGE(PG8_SB(1, 1), cB + hstep + kstep, voffB);
    PG8_WAIT_V(6); PG8_BAR;
    for (;;) {
        const bool has_next = S.next(ui + 1, nxt);
        const char* nA = has_next ? nxt.a : cA; const char* nB = has_next ? nxt.b : cB;
        for (int t = 0; t < nt; t += 2) {
            const bool last = (t == nt - 2);
            const char* a1 = cA + (size_t)(t + 1) * kstep;
            const char* a2 = last ? nA : cA + (size_t)(t + 2) * kstep; const char* b2 = last ? nB : cB + (size_t)(t + 2) * kstep;
            const char* a3 = a2 + kstep; const char* b3 = b2 + kstep;
            PG8_LDB(B0, 0, 0); PG8_LDB(B1, 0, 1); PG8_SCHED; PG8_LDA(At, 0, 0); PG8_STAGE(PG8_SA(1, 1), a1 + hstep, voffA);
            PG8_WAIT_V(8); PG8_WAIT_L(0); PG8_BAR; PG8_MMA(0, 0, At, B0); PG8_MMA(0, 1, At, B1); PG8_BAR; PG8_SCHED;
            PG8_LDA(At, 0, 1); PG8_STAGE(PG8_SB(0, 0), b2, voffB); PG8_STAGE(PG8_SB(0, 1), b2 + hstep, voffB); PG8_STAGE(PG8_SA(0, 0), a2, voffA);
            PG8_WAIT_V(8); PG8_WAIT_L(0); PG8_BAR; PG8_MMA(1, 0, At, B0); PG8_MMA(1, 1, At, B1); PG8_BAR; PG8_SCHED;
            PG8_LDB(B0, 1, 0); PG8_LDB(B1, 1, 1); PG8_SCHED; PG8_LDA(At, 1, 0); PG8_STAGE(PG8_SA(0, 1), a2 + hstep, voffA);
            PG8_WAIT_V(8); PG8_WAIT_L(0); PG8_BAR; PG8_MMA(0, 0, At, B0); PG8_MMA(0, 1, At, B1); PG8_BAR; PG8_SCHED;
            PG8_LDA(At, 1, 1); PG8_STAGE(PG8_SB(1, 0), b3, voffB); PG8_STAGE(PG8_SB(1, 1), b3 + hstep, voffB); PG8_STAGE(PG8_SA(1, 0), a3, voffA);
            PG8_WAIT_V(8); PG8_WAIT_L(0); PG8_BAR; PG8_MMA(1, 0, At, B0); PG8_MMA(1, 1, At, B1); PG8_BAR; PG8_SCHED;
        }
        if (wr == 0) PG8_BAR;
        int fr2 = fr, fq2 = fq; asm volatile("" : "+v"(fr2), "+v"(fq2));
        const bool zero = E(acc, cur, wr, wc, fr2, fq2);
        if (!has_next) break;
        if (zero) {
#pragma unroll
            for (int a = 0; a < 2; ++a)
#pragma unroll
                for (int b = 0; b < 2; ++b)
#pragma unroll
                    for (int m = 0; m < 4; ++m)
#pragma unroll
                        for (int n = 0; n < 2; ++n) acc[a][b][m][n] = (f32x4){0.f, 0.f, 0.f, 0.f};
        }
        cur = nxt; cA = nA; cB = nB; ++ui;
        if (wr == 1) PG8_BAR;
    }
    PG8_WAIT_V(0);
    PG8_BAR;
#undef PG8_SA
#undef PG8_SB
#undef PG8_STAGE
#undef PG8_LDA
#undef PG8_LDB
#undef PG8_MMA
#undef PG8_WAIT_V
#undef PG8_WAIT_L
#undef PG8_BAR
#undef PG8_SCHED
}
#define XB_TMO      128
#define XB_XCNT(j)  (256  + 64 * (j))
#define XB_XSUB(j)  (1280 + 64 * (j))
#define XB_XGEN(j)  (2304 + 64 * (j))
#define XB_TOP      3328
#define XB_TOPGEN   3392
#define XCD_BAR_WORDS 3456
#define XB_SPIN_CAP (1u << 20)
__device__ __forceinline__ unsigned xb_ld(unsigned* p)              { return __hip_atomic_load(p, __ATOMIC_RELAXED, __HIP_MEMORY_SCOPE_AGENT); }
__device__ __forceinline__ unsigned xb_add(unsigned* p, unsigned v) { return __hip_atomic_fetch_add(p, v, __ATOMIC_RELAXED, __HIP_MEMORY_SCOPE_AGENT); }
__device__ __forceinline__ unsigned xb_xcc_id() { return (unsigned)__builtin_amdgcn_s_getreg((3 << 11) | 20) & 0xFu; }
#define XB_SPIN(cond, bar) do { unsigned _sp = 0; while (cond) { __builtin_amdgcn_s_sleep(1); \
    if ((++_sp & 255u) == 0u) { if (xb_ld(&(bar)[XB_TMO])) break; if (_sp > XB_SPIN_CAP) { atomicAdd(&(bar)[XB_TMO], 1u); break; } } } } while (0)
struct XcdBarrier { unsigned* bar; unsigned x; volatile FK_LAS unsigned* st; };
__device__ __forceinline__ XcdBarrier xcd_barrier_post(unsigned* bar, volatile FK_LAS unsigned* st) {
    XcdBarrier b; b.bar = bar; b.x = xb_xcc_id(); b.st = st;
    if (threadIdx.x == 0) (void)xb_add(&bar[XB_XCNT(b.x)], 1u);
    return b;
}
__device__ __forceinline__ void xcd_barrier_complete(unsigned* bar, unsigned x, unsigned& nloc, unsigned& nx) {
    const unsigned G = gridDim.x * gridDim.y * gridDim.z;
    unsigned sum, cnt, mine, sp = 0u;
    for (;;) {
        sum = 0u; cnt = 0u; mine = 0u;
#pragma unroll
        for (unsigned j = 0; j < 16; ++j) { const unsigned c = xb_ld(&bar[XB_XCNT(j)]); sum += c; cnt += (c > 0u) ? 1u : 0u; mine = (j == x) ? c : mine; }
        if (sum == G) break;
        __builtin_amdgcn_s_sleep(1);
        if ((++sp & 255u) == 0u) { if (xb_ld(&bar[XB_TMO])) break; if (sp > XB_SPIN_CAP) { atomicAdd(&bar[XB_TMO], 1u); break; } }
    }
    nloc = mine > 0u ? mine : 1u; nx = cnt > 0u ? cnt : 1u;
}
__device__ __forceinline__ void xcd_barrier(const XcdBarrier& b) {
    asm volatile("s_waitcnt vmcnt(0)" ::: "memory");
    __syncthreads();
    if (threadIdx.x == 0) {
        unsigned* bar = b.bar;
        __builtin_amdgcn_s_waitcnt(0);
        unsigned nloc = b.st[0], nx = b.st[1];
        if (nloc == 0u) { xcd_barrier_complete(bar, b.x, nloc, nx); b.st[0] = nloc; b.st[1] = nx; }
        const unsigned old = xb_add(&bar[XB_XSUB(b.x)], 1u);
        const unsigned gen = old / nloc;
        if (old + 1u == (gen + 1u) * nloc) {
            __builtin_amdgcn_fence(__ATOMIC_RELEASE, "agent");
            asm volatile("s_waitcnt vmcnt(0)" ::: "memory");
            const unsigned og = xb_add(&bar[XB_TOP], 1u);
            const unsigned tg = og / nx;
            if (og + 1u == (tg + 1u) * nx) xb_add(&bar[XB_TOPGEN], 1u);
            else XB_SPIN(xb_ld(&bar[XB_TOPGEN]) == tg, bar);
            __builtin_amdgcn_fence(__ATOMIC_ACQUIRE, "agent");
            xb_add(&bar[XB_XGEN(b.x)], 1u);
            asm volatile("s_waitcnt vmcnt(0)" ::: "memory");
        } else {
            XB_SPIN(xb_ld(&bar[XB_XGEN(b.x)]) == gen, bar);
            __builtin_amdgcn_fence(__ATOMIC_ACQUIRE, "agent");
            asm volatile("s_waitcnt vmcnt(0)" ::: "memory");
        }
    }
    __syncthreads();
}

struct Args { const float* in[30]; float* out; unsigned char* ws; float* xl; int ph_lo, ph_hi, use_bar, pad; };
constexpr int LDS_MISC = 155648, LDS_BYTES = 155648 + 256;

struct Ctx {
    const Args* a; FK_LAS unsigned char* lds; int tid, lane, wave, vcu, G;
};
typedef const Args __attribute__((address_space(4)))* AP;
#define FIN(i) (A->in[i])
template <class T> __device__ __forceinline__ T* wsp(AP A, size_t off) { return (T*)(A->ws + off); }
__device__ __forceinline__ int opaque_tid() { int t = threadIdx.x; asm volatile("" : "+v"(t)); return t; }
__device__ __forceinline__ AP opaque_args(AP a) { asm volatile("" : "+s"(a)); return a; }

__device__ __forceinline__ int inproj_src_col(int p) {
    if (p < R_FZ) return p;
    if (p >= R_V) return p - R_V + 2048;
    const int q0 = p - R_Q, tile = q0 >> 8, pl = q0 & 255;
    const int bj = pl >> 7, wc = (pl >> 5) & 3, fq = (pl >> 3) & 3, e = pl & 7;
    return 1024 + tile * 256 + 64 * wc + 32 * (fq >> 1) + 16 * bj + 8 * (fq & 1) + e;
}
template <class ColFn>
__device__ __forceinline__ void transpose_item(const float* src, int ldsrc, int ksrc0, bf16_t* dst, int Kd, int p0, int k0, FK_LAS float* scr, int lane, ColFn col) {
    const int cidx = col(p0 + (lane & 31));
    float tv[32];
#pragma unroll
    for (int i = 0; i < 32; ++i) tv[i] = src[(size_t)(ksrc0 + k0 + 2 * i + (lane >> 5)) * ldsrc + cidx];
#pragma unroll
    for (int i = 0; i < 32; ++i) scr[(2 * i + (lane >> 5)) * 33 + (lane & 31)] = tv[i];
    asm volatile("s_waitcnt lgkmcnt(0)" ::: "memory");
    const int c = lane & 7;
#pragma unroll
    for (int j = 0; j < 4; ++j) { const int n = (lane >> 3) + 8 * j; const FK_LAS float* s = scr + (8 * c) * 33 + n;
        u32x4 o; o.x = pk2(s[0 * 33], s[1 * 33]); o.y = pk2(s[2 * 33], s[3 * 33]); o.z = pk2(s[4 * 33], s[5 * 33]); o.w = pk2(s[6 * 33], s[7 * 33]);
        *(u32x4*)(dst + (size_t)(p0 + n) * Kd + k0 + 8 * c) = o; }
    asm volatile("s_waitcnt lgkmcnt(0)" ::: "memory");
}
struct IdCol { int off; __device__ int operator()(int p) const { return p + off; } };
struct InprojCol { __device__ int operator()(int p) const { return inproj_src_col(p); } };

__device__ __forceinline__ void phase_pa(AP A, FK_LAS unsigned char* lds, int vcu, int G) {
    const int tid = opaque_tid(), lane = tid & 63, wave = __builtin_amdgcn_readfirstlane(tid >> 6);
    const int gw = vcu * NWAVES + wave, NGW = G * NWAVES;
    const size_t gt = (size_t)vcu * NTHR + tid, NGT = (size_t)G * NTHR;
    float* misc = wsp<float>(A, W.misc);
    FK_LAS float* ctab = (FK_LAS float*)(lds + 131072); FK_LAS float* stab = ctab + 2048;
    for (int i = tid; i < 2048; i += NTHR) { const float a = (float)i * (2.f / 2048.f); ctab[i] = cospif(a); stab[i] = sinpif(a); }
    __syncthreads();
    if (vcu == 0) {
        if (tid < 2) { const float* p = FIN(20) + tid * 256; float a = 0.f, b = 0.f;
            for (int i = 0; i < 64; ++i) { a += p[i] * p[64 + i]; b += p[128 + i] * p[192 + i]; }
            misc[MI_LAM + tid] = expf(a) - expf(b) + (0.8f - 0.6f * expf(-0.3f * (float)tid)); }
        for (int i = tid; i < 64 * 16; i += NTHR) { const int pos = i >> 4, e = i & 15; const float inv = powf(10000.f, -(float)(2 * e) / 32.f), ang = (float)pos * inv;
            misc[MI_ROPE + 2 * i] = cosf(ang); misc[MI_ROPE + 2 * i + 1] = sinf(ang); }
    }
    {
        FK_LAS float* s = (FK_LAS float*)lds;
        FK_LAS float* red = (FK_LAS float*)(lds + 9 * 1024 * 4);
        bool have = false;
        for (int it = vcu; it < 192; it += G) {
            if (!have) { for (int i = tid; i < 9 * 1024; i += NTHR) { const int r = i >> 10, k = i & 1023; const float v = r < 8 ? FIN(1)[r * 1024 + k] : FIN(3)[k]; s[i] = v / (1.f + expf(-v)); } __syncthreads(); have = true; }
            const int l = it / 96, n0 = (it % 96) * 64, kq = tid >> 6, c = tid & 63;
            const float* Wp = FIN(4) + (size_t)l * 1024 * 6144 + n0 + c;
            float acc[9];
#pragma unroll
            for (int r = 0; r < 9; ++r) acc[r] = 0.f;
#pragma unroll 1
            for (int k0 = kq * 128; k0 < kq * 128 + 128; k0 += 16) { float wv[16];
#pragma unroll
                for (int j = 0; j < 16; ++j) wv[j] = Wp[(size_t)(k0 + j) * 6144];
#pragma unroll
                for (int j = 0; j < 16; ++j)
#pragma unroll
                    for (int r = 0; r < 9; ++r) acc[r] += s[r * 1024 + k0 + j] * wv[j]; }
#pragma unroll
            for (int r = 0; r < 9; ++r) red[(kq * 9 + r) * 64 + c] = acc[r];
            __syncthreads();
            for (int i = tid; i < 9 * 64; i += NTHR) { const int r = i >> 6, cc = i & 63; float t = 0.f;
#pragma unroll
                for (int q = 0; q < 8; ++q) t += red[(q * 9 + r) * 64 + cc];
                wsp<float>(A, W.mod)[((size_t)l * 9 + r) * 6144 + n0 + cc] = t + FIN(5)[l * 6144 + n0 + cc]; }
            __syncthreads();
        }
        __syncthreads();
    }
    {
        FK_LAS float* scr = (FK_LAS float*)(lds + wave * 16384);
        constexpr int I_IN = (PINF / 32) * 16;
        constexpr int I_M = (1024 / 32) * 4;
        constexpr int I_O = (1024 / 32) * 16, I_Q = (2048 / 32) * 16;
        constexpr int PER_L = I_IN + 4 * I_M + I_O + I_Q;
        for (int it = gw; it < 2 * PER_L; it += NGW) {
            const int l = it / PER_L; int r = it % PER_L;
            if (r < I_IN) { const int p0 = (r >> 4) * 32, k0 = (r & 15) * 64;
                if (p0 >= R_FZ && p0 < R_Q) continue;
                transpose_item(FIN(8) + (size_t)l * 1024 * 5632, 5632, 0, wsp<bf16_t>(A, W.w_in) + (size_t)l * PINF * 1024, 1024, p0, k0, scr, lane, InprojCol{}); continue; }
            r -= I_IN;
            if (r < 4 * I_M) { const int seg = r / I_M, q = r % I_M, p0 = (q >> 2) * 32, k0 = (q & 3) * 64;
                const float* src = seg == 0 ? FIN(22) + (size_t)l * 256 * 1024 : seg == 1 ? FIN(23) + (size_t)l * 256 * 1024 : FIN(24) + (size_t)l * 512 * 1024;
                transpose_item(src, 1024, seg == 3 ? 256 : 0, wsp<bf16_t>(A, W.w_mrg) + ((size_t)l * 4 + seg) * 1024 * 256, 256, p0, k0, scr, lane, IdCol{0}); continue; }
            r -= 4 * I_M;
            if (r < I_O) { const int p0 = (r >> 4) * 32, k0 = (r & 15) * 64;
                transpose_item(FIN(25) + (size_t)l * 1024 * 1024, 1024, 0, wsp<bf16_t>(A, W.w_out) + (size_t)l * 1024 * 1024, 1024, p0, k0, scr, lane, IdCol{0}); continue; }
            r -= I_O;
            { const int p0 = (r >> 4) * 32, k0 = (r & 15) * 64;
                transpose_item(FIN(26) + (size_t)l * 1024 * 2048, 2048, 0, wsp<bf16_t>(A, W.w_q) + (size_t)l * 2048 * 1024, 1024, p0, k0, scr, lane, IdCol{0}); }
        }
    }
    for (size_t i = gt; i < (size_t)1 << 17; i += NGT) {
        const int k = (int)(i & 1023), mc = (int)((i >> 10) & 7), part = (int)((i >> 13) & 1), g = (int)((i >> 14) & 3), l = (int)(i >> 16);
        const float* src = FIN(8) + (size_t)l * 1024 * 5632 + (size_t)k * 5632 + 768 + g * 64;
        f32x4 sv[16];
#pragma unroll
        for (int q = 0; q < 16; ++q) sv[q] = *(const f32x4*)(src + 4 * q);
        const FK_LAS float* tb = part ? stab : ctab;
        bf16_t* dst = wsp<bf16_t>(A, W.w_in) + ((size_t)l * PINF + R_FZ + part * 256 + g * 64 + mc * 8) * 1024 + k;
#pragma unroll 1
        for (int mm = 0; mm < 8; ++mm) { const int m = mc * 8 + mm; float acc = 0.f;
#pragma unroll
            for (int q = 0; q < 16; ++q)
#pragma unroll
                for (int j = 0; j < 4; ++j) acc += sv[q][j] * tb[((m * (4 * q + j)) & 63) * 32];
            dst[(size_t)mm * 1024] = (bf16_t)f2bf(acc); }
    }
    {
        const size_t nUV = (size_t)16384 * 1024 / 16, nK = (size_t)2 * 16 * 128 * 128 / 8;
        for (size_t i0 = gt; i0 < 2 * nUV + nK; i0 += 2 * NGT) {
#pragma unroll
            for (int rep = 0; rep < 2; ++rep) { const size_t i = i0 + rep * NGT; if (i >= 2 * nUV + nK) break;
                if (i < nUV) cvt16_fp8(FIN(28) + i * 16, wsp<unsigned char>(A, W.ub) + tab_chunk_off(i), SU);
                else if (i < 2 * nUV) cvt16_fp8(FIN(29) + (i - nUV) * 16, wsp<unsigned char>(A, W.vb) + tab_chunk_off(i - nUV), SV);
                else { const size_t j = i - 2 * nUV; const float* src = FIN(27); bf16_t* dst = wsp<bf16_t>(A, W.keys);
                    const f32x4 x0 = *(const f32x4*)(src + j * 8), x1 = *(const f32x4*)(src + j * 8 + 4);
                    u32x4 o; o.x = pk2(x0[0], x0[1]); o.y = pk2(x0[2], x0[3]); o.z = pk2(x1[0], x1[1]); o.w = pk2(x1[2], x1[3]);
                    *(u32x4*)(dst + j * 8) = o; } }
        }
    }
    for (size_t i = gt; i < (size_t)2048 * 2048 + 256 * 256; i += NGT) {
        const bool big = i < (size_t)2048 * 2048; const size_t j = big ? i : i - (size_t)2048 * 2048; const int L = big ? 2048 : 256, lg = big ? 11 : 8;
        const int k = (int)(j >> lg), t = (int)(j & (L - 1)); const int ti = ((k * t) & (L - 1)) * (2048 / L); const float sc = rsqrtf(64.f * (float)L);
        bf16_t* d = big ? wsp<bf16_t>(A, W.dftl) : wsp<bf16_t>(A, W.dftc);
        d[(size_t)k * 2 * L + t] = (bf16_t)f2bf(sc * ctab[ti]); d[(size_t)k * 2 * L + L + t] = (bf16_t)f2bf(-sc * stab[ti]);
    }
    {
        constexpr int HPP = 4;
        FK_LAS float* h1 = (FK_LAS float*)lds; FK_LAS float* h2 = h1 + HPP * 64; FK_LAS float* ft = h2 + HPP * 64;
        FK_LAS float* w1s = ft + HPP * 33 + 4; FK_LAS float* w2s = w1s + 33 * 64; FK_LAS float* b1s = w2s + 64 * 64; FK_LAS float* b2s = b1s + 64; FK_LAS float* fqs = b2s + 64;
        constexpr int IT_L = 2048 / HPP, IT_C = 256 / HPP, PER = IT_L + IT_C;
        int lcur = -1;
        for (int it = vcu; it < 2 * PER; it += G) {
            const int l = it / PER, r = it % PER, big = r < IT_L, L = big ? 2048 : 256, p0 = (big ? r : r - IT_L) * HPP;
            __syncthreads();
            if (l != lcur) { lcur = l;
                for (int i = tid; i < 33 * 64; i += NTHR) w1s[i] = FIN(11)[l * 33 * 64 + i];
                for (int i = tid; i < 64 * 64; i += NTHR) w2s[i] = FIN(14)[l * 4096 + i];
                if (tid < 64) { b1s[tid] = FIN(12)[l * 64 + tid]; b2s[tid] = FIN(15)[l * 64 + tid]; fqs[tid] = FIN(13)[l * 64 + tid]; } }
            for (int i = tid; i < HPP * 33; i += NTHR) { const int pp = i / 33, e = i % 33, pos = p0 + pp; const float t = (float)pos / (float)(L - 1), w = 2.0f * 3.14159265358979323846f * (float)pos / (float)L;
                float v; if (e == 0) v = t; else { const int b = (e - 1) & 15; const float f = 1e-4f + (float)b * ((15.f - 1e-4f) / 15.f), a = w * f; v = e <= 16 ? cosf(a) : -sinf(a); }
                ft[i] = v; }
            __syncthreads();
            for (int i = tid; i < HPP * 64; i += NTHR) { const int pp = i >> 6, j = i & 63; float acc = 0.f;
                for (int e = 0; e < 33; ++e) acc += ft[pp * 33 + e] * w1s[e * 64 + j];
                h1[i] = sinf(fqs[j] * (acc + b1s[j])); }
            __syncthreads();
            for (int i = tid; i < HPP * 64; i += NTHR) { const int pp = i >> 6, j = i & 63; float acc = 0.f;
                for (int e = 0; e < 64; ++e) acc += h1[pp * 64 + e] * w2s[e * 64 + j];
                h2[i] = sinf(fqs[j] * (acc + b2s[j])); }
            __syncthreads();
            float* H3 = big ? wsp<float>(A, W.h3l) + (size_t)l * 2048 * 1024 : wsp<float>(A, W.h3c) + (size_t)l * 256 * 1024;
            float* part = misc + MI_HYPART + ((size_t)(l * 2 + (big ? 0 : 1)) * IT_L + (big ? r : r - IT_L)) * 1024;
#pragma unroll
            for (int cc = 0; cc < 2; ++cc) { const int col = tid + cc * 512, ch = col & 255;
                const float mn = -3.0701134573253946f, mx = -15.350567286626973f; const float delta = fabsf(mn + (float)ch * ((mx - mn) / 255.f));
                float acc[HPP];
#pragma unroll
                for (int pp = 0; pp < HPP; ++pp) acc[pp] = 0.f;
                const float* w3 = FIN(16) + (size_t)l * 65536 + col;
#pragma unroll 1
                for (int e0 = 0; e0 < 64; e0 += 16) { float wv[16];
#pragma unroll
                    for (int j = 0; j < 16; ++j) wv[j] = w3[(size_t)(e0 + j) * 1024];
#pragma unroll
                    for (int j = 0; j < 16; ++j)
#pragma unroll
                        for (int pp = 0; pp < HPP; ++pp) acc[pp] += h2[pp * 64 + e0 + j] * wv[j]; }
                float ps = 0.f;
#pragma unroll
                for (int pp = 0; pp < HPP; ++pp) { const int pos = p0 + pp; const float v = acc[pp] * expf(-((float)pos / (float)(L - 1)) * delta); H3[(size_t)pos * 1024 + col] = v;
                    if (!(col >= 512 && pos == 0)) ps += fabsf(v); }
                part[col] = ps; }
        }
        __syncthreads();
    }
}
__device__ __forceinline__ void modulate_row_bf16(const float* xrow, const float* g, const float* scale, const float* shift, bf16_t* orow, int lane) {
    f32x4 v[4]; float ss = 0.f;
#pragma unroll
    for (int j = 0; j < 4; ++j) { v[j] = *(const f32x4*)(xrow + 4 * lane + 256 * j); ss += (v[j][0] * v[j][0] + v[j][1] * v[j][1]) + (v[j][2] * v[j][2] + v[j][3] * v[j][3]); }
    ss = wave_sum(ss); const float rs = rsqrtf(ss * (1.f / 1024.f) + EPS);
#pragma unroll
    for (int j = 0; j < 4; ++j) { const int k = 4 * lane + 256 * j; const f32x4 gg = *(const f32x4*)(g + k), sc = *(const f32x4*)(scale + k), sf = *(const f32x4*)(shift + k);
        const f32x4 o = v[j] * rs * gg * (sc + 1.0f) + sf; u32x2 w; w.x = pk2(o[0], o[1]); w.y = pk2(o[2], o[3]); *(u32x2*)(orow + k) = w; }
}
__device__ __forceinline__ void phase_pb(AP A, int vcu, int G) {
    const int tid = opaque_tid(), lane = tid & 63, wave = __builtin_amdgcn_readfirstlane(tid >> 6); (void)tid;
    const int gw = vcu * NWAVES + wave, NGW = G * NWAVES;
    const float* mod = wsp<float>(A, W.mod);
    for (int t = gw; t < NTOK; t += NGW) {
        const bool lat = t < NLAT; const int mr = lat ? t / SEQ : 8;
        const float* xr = lat ? FIN(0) + (size_t)t * DM : FIN(2) + (size_t)(t - NLAT) * DM;
        modulate_row_bf16(xr, FIN(6), mod + (size_t)mr * 6144 + 1024, mod + (size_t)mr * 6144, wsp<bf16_t>(A, W.xn) + (size_t)t * DM, lane);
    }
    const float* misc = wsp<float>(A, W.misc);
    for (int row = gw; row < 2 * 2 * 512; row += NGW) {
        const int l = row >> 10, big = ((row >> 9) & 1) == 0, oc = row & 511, L = big ? 2048 : 256, TLn = big ? TLL : TLC, nit = big ? 512 : 64;
        const float* part = misc + MI_HYPART + (size_t)(l * 2 + (big ? 0 : 1)) * 512 * 1024;
        float s = 0.f; for (int i = lane; i < nit; i += 64) s += part[(size_t)i * 1024 + oc] + part[(size_t)i * 1024 + 512 + oc];
        s = wave_sum(s); const float inv = 1.f / s;
        const float* H3 = big ? wsp<float>(A, W.h3l) + (size_t)l * 2048 * 1024 : wsp<float>(A, W.h3c) + (size_t)l * 256 * 1024;
        bf16_t* TL = big ? wsp<bf16_t>(A, W.tapl) + ((size_t)l * 512 + oc) * TLL : wsp<bf16_t>(A, W.tapc) + ((size_t)l * 512 + oc) * TLC;
        const int c = L + 32;
        for (int y0 = 0; y0 < TLn; y0 += 64 * 8) { float tv[8];
#pragma unroll
            for (int j = 0; j < 8; ++j) { const int y = y0 + 64 * j + lane, m = c - y, am = m < 0 ? -m : m; const bool ok = (y < TLn) && (am < L);
                const float v = H3[ok ? (size_t)am * 1024 + (m < 0 ? 512 : 0) + oc : (size_t)oc];
                tv[j] = ok ? v : 0.f; }
#pragma unroll
            for (int j = 0; j < 8; ++j) { const int y = y0 + 64 * j + lane; if (y < TLn) TL[y] = (bf16_t)f2bf(tv[j] * inv); } }
    }
}

constexpr int NTT = NTOK / 256, NTL = NLAT / 256;
struct InprojSched {
    int l, G, c; const char* xn; const char* w;
    __device__ bool next(int i, Unit& u) const {
        const long Li = (long)i * G + c;
        const int nM = (l == 0) ? NTT : NTL, nN = 23, nwg = nM * nN;
        if (Li < nwg) {
            int wgid = (int)Li; { const int q = nwg / 8, r = nwg % 8, xcd = wgid % 8, off = wgid / 8; wgid = (xcd < r ? xcd * (q + 1) : r * (q + 1) + (xcd - r) * q) + off; }
            const int nig = 8 * nN, gid = wgid / nig, fm = gid * 8, gsz = (nM - fm) < 8 ? (nM - fm) : 8;
            u.pm = fm + ((wgid % nig) % gsz); u.pn = (wgid % nig) / gsz;
        } else {
            const int r2 = (int)(Li - nwg); if (l == 0 || r2 >= (NTT - NTL) * 4) return false;
            u.pm = NTL + r2 / 4; u.pn = 7 + (r2 & 3);
        }
        const int pn = u.pn; u.kind = pn < 3 ? 0 : pn < 5 ? 1 : pn < 9 ? 2 : pn < 11 ? 3 : 4;
        const char* at = xn + (size_t)u.pm * 256 * 1024 * 2; const char* wt = w + (size_t)pn * 256 * 1024 * 2;
        const bool swapped = (u.kind == 0 || u.kind == 1 || u.kind == 3);
        u.a = swapped ? wt : at; u.b = swapped ? at : wt; u.aux = 0; return true;
    }
};
struct InprojEpi {
    int l; bf16_t *hyt, *ftl, *ftc, *q, *qc, *k, *vt, *g; const float *gq, *gk, *rope;
    __device__ __forceinline__ bool operator()(Acc& acc, const Unit& u, int wr, int wc, int fr, int fq) const {
        const int pm = u.pm, pn = u.pn;
        if (u.kind == 0 || u.kind == 1 || u.kind == 3) {
            const bool lat = pm < NTL; const int b = lat ? pm >> 3 : pm - NTL;
#pragma unroll
            for (int bj = 0; bj < 2; ++bj) {
                const int tl = 128 * bj + 32 * wc + 8 * fq;
                bf16_t* base; size_t rstride;
                if (u.kind == 0) { base = hyt + (size_t)(pn * 256) * NTOK + (size_t)pm * 256 + tl; rstride = NTOK; }
                else if (u.kind == 1) { const int part = pn - 3;
                    if (lat) { base = ftl + (size_t)b * 256 * 4096 + part * 2048 + (pm & 7) * 256 + tl; rstride = 4096; }
                    else { base = ftc + (size_t)b * 256 * 512 + part * 256 + tl; rstride = 512; } }
                else { base = vt + ((size_t)b * 512 + (pn - 9) * 256) * KALL + (lat ? (pm & 7) * 256 : SEQ) + tl; rstride = KALL; }
#pragma unroll
                for (int ai = 0; ai < 2; ++ai)
#pragma unroll
                    for (int m = 0; m < 4; ++m) { const int r = 128 * ai + 64 * wr + 16 * m + fr; const f32x4 v0 = acc[ai][bj][m][0], v1 = acc[ai][bj][m][1];
                        u32x4 w; w.x = cvt_pk_bf16(v0[0], v0[1]); w.y = cvt_pk_bf16(v0[2], v0[3]); w.z = cvt_pk_bf16(v1[0], v1[1]); w.w = cvt_pk_bf16(v1[2], v1[3]);
                        *(u32x4*)(base + (size_t)r * rstride) = w; }
            }
        } else if (u.kind == 4) {
#pragma unroll
            for (int ai = 0; ai < 2; ++ai)
#pragma unroll
                for (int m = 0; m < 4; ++m) { const int t = pm * 256 + 128 * ai + 64 * wr + 16 * m + fr;
#pragma unroll
                    for (int bj = 0; bj < 2; ++bj) { const int cg = (pn - 11) * 256 + 128 * bj + 32 * wc + 8 * fq; f32x4 v0 = acc[ai][bj][m][0], v1 = acc[ai][bj][m][1];
#pragma unroll
                        for (int j = 0; j < 4; ++j) { v0[j] = __builtin_amdgcn_rcpf(1.f + __builtin_amdgcn_exp2f(-1.4426950408889634f * v0[j])); v1[j] = __builtin_amdgcn_rcpf(1.f + __builtin_amdgcn_exp2f(-1.4426950408889634f * v1[j])); }
                        u32x4 w; w.x = cvt_pk_bf16(v0[0], v0[1]); w.y = cvt_pk_bf16(v0[2], v0[3]); w.z = cvt_pk_bf16(v1[0], v1[1]); w.w = cvt_pk_bf16(v1[2], v1[3]);
                        *(u32x4*)(g + (size_t)t * 3072 + cg) = w; } }
        } else {
            const int which = (pn - 5) >> 1, grp = ((pn - 5) & 1) * 4 + wc, h = grp >> 1, map = grp & 1;
            const int d0 = 32 * (fq >> 1) + 8 * (fq & 1);
            const float* gp = (which ? gk : gq) + map * 64 + d0;
            const f32x4 g00 = *(const f32x4*)(gp), g01 = *(const f32x4*)(gp + 4), g10 = *(const f32x4*)(gp + 16), g11 = *(const f32x4*)(gp + 20);
            const bool lat = pm < NTL; const int b = lat ? pm >> 3 : pm - NTL;
#pragma unroll
            for (int ai = 0; ai < 2; ++ai)
#pragma unroll
                for (int m = 0; m < 4; ++m) {
                    const int rl = 128 * ai + 64 * wr + 16 * m + fr;
                    f32x4 a0 = acc[ai][0][m][0], a1 = acc[ai][0][m][1], b0 = acc[ai][1][m][0], b1 = acc[ai][1][m][1];
                    float ss = 0.f;
#pragma unroll
                    for (int j = 0; j < 4; ++j) ss += a0[j] * a0[j] + a1[j] * a1[j] + b0[j] * b0[j] + b1[j] * b1[j];
                    ss += __shfl_xor(ss, 16); ss += __shfl_xor(ss, 32);
                    const float rs = rsqrtf(ss * (1.f / 64.f) + EPS);
                    a0 = a0 * rs * g00; a1 = a1 * rs * g01; b0 = b0 * rs * g10; b1 = b1 * rs * g11;
                    bf16_t* dst;
                    if (lat) { const int pos = (pm & 7) * 256 + rl; const int pa = (fq >> 1) ? (pos & 63) : (pos >> 6);
                        const float* rp = rope + ((size_t)pa * 16 + 8 * (fq & 1)) * 2;
                        const f32x4 r0 = *(const f32x4*)(rp), r1 = *(const f32x4*)(rp + 4), r2 = *(const f32x4*)(rp + 8), r3 = *(const f32x4*)(rp + 12);
                        const float cs[8] = {r0[0], r0[2], r1[0], r1[2], r2[0], r2[2], r3[0], r3[2]}, sn[8] = {r0[1], r0[3], r1[1], r1[3], r2[1], r2[3], r3[1], r3[3]};
#pragma unroll
                        for (int j = 0; j < 4; ++j) { const float x1 = a0[j], x2 = b0[j]; a0[j] = x1 * cs[j] - x2 * sn[j]; b0[j] = x2 * cs[j] + x1 * sn[j];
                            const float y1 = a1[j], y2 = b1[j]; a1[j] = y1 * cs[4 + j] - y2 * sn[4 + j]; b1[j] = y2 * cs[4 + j] + y1 * sn[4 + j]; }
                        dst = which ? k + (((size_t)(b * 4 + h) * 2 + map) * KALL + pos) * 64 : q + (((size_t)(b * 4 + h) * 2 + map) * SEQ + pos) * 64;
                    } else dst = which ? k + (((size_t)(b * 4 + h) * 2 + map) * KALL + SEQ + rl) * 64 : qc + (((size_t)(b * 4 + h) * 2 + map) * CTX + rl) * 64;
                    u32x4 w0, w1; w0.x = cvt_pk_bf16(a0[0], a0[1]); w0.y = cvt_pk_bf16(a0[2], a0[3]); w0.z = cvt_pk_bf16(a1[0], a1[1]); w0.w = cvt_pk_bf16(a1[2], a1[3]);
                    w1.x = cvt_pk_bf16(b0[0], b0[1]); w1.y = cvt_pk_bf16(b0[2], b0[3]); w1.z = cvt_pk_bf16(b1[0], b1[1]); w1.w = cvt_pk_bf16(b1[2], b1[3]);
                    *(u32x4*)(dst + d0) = w0; *(u32x4*)(dst + d0 + 16) = w1;
                }
        }
        return true;
    }
};
__device__ __forceinline__ void phase_inproj(AP A, FK_LAS unsigned char* lds, int l, int G) {
    InprojSched S{l, G, (int)blockIdx.x, (const char*)wsp<bf16_t>(A, W.xn), (const char*)(wsp<bf16_t>(A, W.w_in) + (size_t)l * PINF * 1024)};
    InprojEpi E{l, wsp<bf16_t>(A, W.hyt), wsp<bf16_t>(A, W.ftl), wsp<bf16_t>(A, W.ftc), wsp<bf16_t>(A, W.q), wsp<bf16_t>(A, W.qc), wsp<bf16_t>(A, W.k), wsp<bf16_t>(A, W.vt), wsp<bf16_t>(A, W.g),
                FIN(18) + l * 128, FIN(19) + l * 128, wsp<float>(A, W.misc) + MI_ROPE};
    gemm_phase(lds, 1024, S, E);
}
#define FK_HAVE_MIX 1
namespace attn {
constexpr float SCALE = 0.125f, THR = 8.f;
constexpr int KVBLK = 64;
constexpr int SHM_V = 128 * 64 * 2, SHM_K = 64 * 64 * 2;
constexpr int OFF_V = 0, OFF_K = 2 * SHM_V, OFF_WS = 2 * SHM_V + 2 * SHM_K;
#define ASWZ(row, cb) ((row) * 128 + ((cb) ^ ((((row) >> 1) & 7) << 4)))
#define SBAR() __builtin_amdgcn_sched_barrier(0)
__device__ __forceinline__ int crow(int r, int hi) { return (r & 3) + 8 * (r >> 2) + 4 * hi; }
__device__ __forceinline__ void partialSM(f32x16& p0, f32x16& p1, float& m_reg, float& mn, float& alpha) {
    constexpr float C = SCALE * 1.4426950408889634f;
    float pmax = p0[0];
#pragma unroll
    for (int r = 1; r < 16; ++r) pmax = fmaxf(pmax, p0[r]);
#pragma unroll
    for (int r = 0; r < 16; ++r) pmax = fmaxf(pmax, p1[r]);
    { auto rr = __builtin_amdgcn_permlane32_swap(__float_as_uint(pmax), __float_as_uint(pmax), false, false);
      pmax = fmaxf(__uint_as_float(rr[0]), __uint_as_float(rr[1])); }
    if (__builtin_expect(__all(pmax - m_reg <= THR / SCALE), 1)) { mn = m_reg; alpha = 1.f; }
    else { mn = fmaxf(m_reg, pmax); alpha = __builtin_amdgcn_exp2f((m_reg - mn) * C); m_reg = mn; }
    const float mnC = -mn * C;
#pragma unroll
    for (int r = 0; r < 16; ++r) p0[r] = fmaf(p0[r], C, mnC);
#pragma unroll
    for (int r = 0; r < 16; ++r) p1[r] = fmaf(p1[r], C, mnC);
#pragma unroll
    for (int r = 0; r < 16; ++r) p0[r] = __builtin_amdgcn_exp2f(p0[r]);
}
__device__ __forceinline__ void finishSM(f32x16& p0, f32x16& p1, float alpha, float& l_reg, bf16x8& pa0, bf16x8& pa1, bf16x8& pa2, bf16x8& pa3) {
#pragma unroll
    for (int r = 0; r < 16; ++r) p1[r] = __builtin_amdgcn_exp2f(p1[r]);
    float ps = 0;
#pragma unroll
    for (int r = 0; r < 16; ++r) ps += p0[r];
#pragma unroll
    for (int r = 0; r < 16; ++r) ps += p1[r];
    { auto rr = __builtin_amdgcn_permlane32_swap(__float_as_uint(ps), __float_as_uint(ps), false, false);
      ps = __uint_as_float(rr[0]) + __uint_as_float(rr[1]); }
    l_reg = l_reg * alpha + ps;
#define PK4(P, BASE, OUT) do { unsigned a0 = cvt_pk_bf16(P[BASE + 0], P[BASE + 1]), a1 = cvt_pk_bf16(P[BASE + 2], P[BASE + 3]);   \
    unsigned b0 = cvt_pk_bf16(P[BASE + 4], P[BASE + 5]), b1 = cvt_pk_bf16(P[BASE + 6], P[BASE + 7]);                              \
    auto r0 = __builtin_amdgcn_permlane32_swap(a0, b0, false, false); auto r1 = __builtin_amdgcn_permlane32_swap(a1, b1, false, false); \
    u32x4 w = {r0[0], r1[0], r0[1], r1[1]}; OUT = *reinterpret_cast<bf16x8*>(&w); } while (0)
    PK4(p0, 0, pa0); PK4(p0, 8, pa1); PK4(p1, 0, pa2); PK4(p1, 8, pa3);
#undef PK4
}
__device__ __forceinline__ void qkt(f32x16& p0, f32x16& p1, const FK_LAS char* Ks, const bf16x8* qr, int r32, int hi) {
    p0 = f32x16{}; p1 = f32x16{};
#pragma unroll
    for (int d0 = 0; d0 < 4; ++d0) { const int cb = d0 * 32 + hi * 16;
        const bf16x8 b0 = *(const FK_LAS bf16x8*)(Ks + ASWZ(r32, cb));
        const bf16x8 b1 = *(const FK_LAS bf16x8*)(Ks + ASWZ(32 + r32, cb));
        __builtin_amdgcn_s_setprio(1);
        p0 = __builtin_amdgcn_mfma_f32_32x32x16_bf16(b0, qr[d0], p0, 0, 0, 0);
        p1 = __builtin_amdgcn_mfma_f32_32x32x16_bf16(b1, qr[d0], p1, 0, 0, 0);
        __builtin_amdgcn_s_setprio(0); }
}
__device__ __forceinline__ void pv(f32x16* o, const FK_LAS char* Vs, int r32, int hi, bf16x8 pa0, bf16x8 pa1, bf16x8 pa2, bf16x8 pa3) {
#pragma unroll
    for (int d0 = 0; d0 < 4; ++d0) { const int row = 32 * d0 + r32;
        const bf16x8 v0 = *(const FK_LAS bf16x8*)(Vs + ASWZ(row, 0 * 32 + hi * 16)), v1 = *(const FK_LAS bf16x8*)(Vs + ASWZ(row, 1 * 32 + hi * 16));
        const bf16x8 v2 = *(const FK_LAS bf16x8*)(Vs + ASWZ(row, 2 * 32 + hi * 16)), v3 = *(const FK_LAS bf16x8*)(Vs + ASWZ(row, 3 * 32 + hi * 16));
        __builtin_amdgcn_s_setprio(1);
        o[d0] = __builtin_amdgcn_mfma_f32_32x32x16_bf16(pa0, v0, o[d0], 0, 0, 0);
        o[d0] = __builtin_amdgcn_mfma_f32_32x32x16_bf16(pa1, v1, o[d0], 0, 0, 0);
        o[d0] = __builtin_amdgcn_mfma_f32_32x32x16_bf16(pa2, v2, o[d0], 0, 0, 0);
        o[d0] = __builtin_amdgcn_mfma_f32_32x32x16_bf16(pa3, v3, o[d0], 0, 0, 0);
        __builtin_amdgcn_s_setprio(0); }
}
__device__ __forceinline__ void body(const bf16_t* __restrict__ Qb, const bf16_t* __restrict__ Kh, const bf16_t* __restrict__ VTh, int ldv, int seq, FK_LAS char* lds, f32x16* o, const int tid) {
    const int wid = tid >> 6, lane = tid & 63, r32 = lane & 31, hi = lane >> 5;
    FK_LAS char* V_lds = lds + OFF_V; FK_LAS char* K_lds = lds + OFF_K;
    FK_LAS float* wsf = (FK_LAS float*)(lds + OFF_WS) + wid * 64; FK_LAS float* li_l = wsf; FK_LAS float* al_l = wsf + 32;
    float m_reg = -1e30f, l_reg = 0;
#pragma unroll
    for (int d = 0; d < 4; ++d) o[d] = f32x16{};
    bf16x8 qr[4];
    const bf16_t* Qw = Qb + (size_t)(wid * 32 + r32) * 64 + hi * 8;
#pragma unroll
    for (int d0 = 0; d0 < 4; ++d0) qr[d0] = *(const bf16x8*)(Qw + d0 * 16);
    const int ksr = tid >> 3, kch = tid & 7;
    const int kst = ASWZ(ksr, kch * 16);
    const int vd0 = tid >> 3, vd1 = 64 + (tid >> 3);
    const int vst0 = ASWZ(vd0, kch * 16), vst1 = ASWZ(vd1, kch * 16);
    struct { bf16x8 vs0, vs1, ks; } sr_[2];
#define SLOAD(i, k0) do { sr_[i].vs0 = *(const bf16x8*)(VTh + (size_t)vd0 * ldv + (k0) + kch * 8); sr_[i].vs1 = *(const bf16x8*)(VTh + (size_t)vd1 * ldv + (k0) + kch * 8); \
    sr_[i].ks = *(const bf16x8*)(Kh + (size_t)((k0) + ksr) * 64 + kch * 8); } while (0)
#define SWRITE(b, i) do { *(FK_LAS bf16x8*)(V_lds + (b) * SHM_V + vst0) = sr_[i].vs0; *(FK_LAS bf16x8*)(V_lds + (b) * SHM_V + vst1) = sr_[i].vs1; \
    *(FK_LAS bf16x8*)(K_lds + (b) * SHM_K + kst) = sr_[i].ks; } while (0)
#define SWAIT() asm volatile("s_waitcnt vmcnt(3)" ::: "memory")
#define RESC(a) do { if (__any((a) < 1.f)) { if (hi == 0) al_l[r32] = (a); asm volatile("s_waitcnt lgkmcnt(0)" ::: "memory"); \
    _Pragma("unroll") for (int d = 0; d < 4; ++d) _Pragma("unroll") for (int r = 0; r < 16; ++r) o[d][r] *= al_l[crow(r, hi)]; } } while (0)
    f32x16 pA0, pA1, pB0, pB1; float mnA, mnB, alA, alB; bf16x8 pa0, pa1, pa2, pa3; const int NT = seq / KVBLK;
    SLOAD(0, 0); asm volatile("s_waitcnt vmcnt(0)" ::: "memory"); SWRITE(0, 0); __syncthreads();
    qkt(pA0, pA1, K_lds, qr, r32, hi); partialSM(pA0, pA1, m_reg, mnA, alA);
    SLOAD(1, KVBLK); if (2 < NT) SLOAD(0, 2 * KVBLK);
    if (2 < NT) SWAIT(); else asm volatile("s_waitcnt vmcnt(0)" ::: "memory");
    SWRITE(1, 1); __syncthreads();
    for (int j = 1; j + 1 < NT; j += 2) {
        SBAR(); qkt(pB0, pB1, K_lds + SHM_K, qr, r32, hi);
        finishSM(pA0, pA1, alA, l_reg, pa0, pa1, pa2, pa3); SBAR();
        SLOAD(1, (j + 2) * KVBLK); SBAR();
        pv(o, V_lds, r32, hi, pa0, pa1, pa2, pa3); partialSM(pB0, pB1, m_reg, mnB, alB);
        __syncthreads(); SWAIT(); SWRITE(0, 0);
        RESC(alB); __syncthreads();
        SBAR(); qkt(pA0, pA1, K_lds, qr, r32, hi);
        finishSM(pB0, pB1, alB, l_reg, pa0, pa1, pa2, pa3); SBAR();
        const bool more = (j + 3 < NT);
        if (more) SLOAD(0, (j + 3) * KVBLK);
        SBAR();
        pv(o, V_lds + SHM_V, r32, hi, pa0, pa1, pa2, pa3); partialSM(pA0, pA1, m_reg, mnA, alA);
        __syncthreads(); if (more) SWAIT(); else asm volatile("s_waitcnt vmcnt(0)" ::: "memory");
        SWRITE(1, 1);
        RESC(alA); __syncthreads();
    }
    SBAR(); qkt(pB0, pB1, K_lds + SHM_K, qr, r32, hi);
    finishSM(pA0, pA1, alA, l_reg, pa0, pa1, pa2, pa3); SBAR();
    pv(o, V_lds, r32, hi, pa0, pa1, pa2, pa3); partialSM(pB0, pB1, m_reg, mnB, alB);
    __syncthreads(); RESC(alB);
    finishSM(pB0, pB1, alB, l_reg, pa0, pa1, pa2, pa3); SBAR();
    pv(o, V_lds + SHM_V, r32, hi, pa0, pa1, pa2, pa3);
    if (hi == 0) li_l[r32] = l_reg; asm volatile("s_waitcnt lgkmcnt(0)" ::: "memory");
#pragma unroll
    for (int r = 0; r < 16; ++r) { const float rl = __builtin_amdgcn_rcpf(li_l[crow(r, hi)]);
#pragma unroll
        for (int d = 0; d < 4; ++d) o[d][r] *= rl; }
    __syncthreads();
#undef SLOAD
#undef SWRITE
#undef SWAIT
#undef RESC
}
__device__ __forceinline__ void unit(AP A, FK_LAS char* lds, int l, int b, int h, int qb  ) {
    const int tid = opaque_tid(), wid = tid >> 6, lane = tid & 63, r32 = lane & 31, hi = lane >> 5;
    const bool ctx = qb == 8;
    float* stash = wsp<float>(A, W.stash) + (size_t)blockIdx.x * 128 * 512;
#pragma unroll 1
    for (int map = 0; map < 2; ++map) {
        const size_t hm = (size_t)(b * 4 + h) * 2 + map;
        const bf16_t* Qb = ctx ? wsp<bf16_t>(A, W.qc) + hm * CTX * 64 : wsp<bf16_t>(A, W.q) + (hm * SEQ + (size_t)qb * 256) * 64;
        const bf16_t* Kh = wsp<bf16_t>(A, W.k) + (hm * KALL + (ctx ? SEQ : 0)) * 64;
        const bf16_t* VTh = wsp<bf16_t>(A, W.vt) + (size_t)(b * 4 + h) * 128 * KALL + (ctx ? SEQ : 0);
        f32x16 om[4];
        body(Qb, Kh, VTh, KALL, ctx ? CTX : KALL, lds, om, tid);
#pragma unroll
        for (int d = 0; d < 4; ++d)
#pragma unroll
            for (int r = 0; r < 16; ++r) stash[(size_t)((map * 4 + d) * 16 + r) * 512 + tid] = om[d][r];
    }
    const float lam = wsp<float>(A, W.misc)[MI_LAM + l], post = 1.f - (0.8f - 0.6f * __expf(-0.3f * (float)l));
    f32x16 o[4];
    float ss[16];
#pragma unroll
    for (int r = 0; r < 16; ++r) ss[r] = 0.f;
#pragma unroll
    for (int d = 0; d < 4; ++d)
#pragma unroll
        for (int r = 0; r < 16; ++r) { const float v = stash[(size_t)(d * 16 + r) * 512 + tid] - lam * stash[(size_t)((4 + d) * 16 + r) * 512 + tid]; o[d][r] = v; ss[r] += v * v; }
#pragma unroll
    for (int r = 0; r < 16; ++r) {
#pragma unroll
        for (int s = 1; s < 32; s <<= 1) ss[r] += __shfl_xor(ss[r], s);
        ss[r] = rsqrtf(ss[r] * (1.f / 128.f) + EPS) * post; }
    bf16_t* att = (h < 2) ? wsp<bf16_t>(A, W.attlo) : wsp<bf16_t>(A, W.atthi);
    const size_t t0 = ctx ? (size_t)NLAT + b * CTX : (size_t)b * SEQ + qb * 256;
#pragma unroll
    for (int d = 0; d < 4; ++d) { const float gs = FIN(21)[l * 128 + 32 * d + r32];
#pragma unroll
        for (int r = 0; r < 16; ++r) att[(t0 + wid * 32 + crow(r, hi)) * 256 + (h & 1) * 128 + 32 * d + r32] = (bf16_t)f2bf(o[d][r] * ss[r] * gs); }
}
#undef ASWZ
#undef SBAR
}

namespace hy {
template <int L, int NBH> struct Geo {
    static constexpr int NBLK = L / 32, IB = 32 / NBH, NG = NBLK / IB, GPW = (NG >= 8) ? NG / 8 : 1, AW = NG / GPW;
    static constexpr int PADB = IB * GPW - 1, RL = (NBLK + 2 * PADB) * 32, ZRS = RL * 2 + 16;
    static constexpr int TLn = (L == 2048) ? TLL : TLC, TCS = TLn * 2 + ((L == 2048) ? 32 : 160);
    static constexpr int OFF_Z = 0, OFF_G = NBH * ZRS, OFF_T = 2 * NBH * ZRS, END = OFF_T + 8 * TCS;
};
__device__ __forceinline__ int crow(int r, int hi) { return (r & 3) + 8 * (r >> 2) + 4 * hi; }
template <int L, int NBH>
__device__ __forceinline__ void unit(AP A, FK_LAS char* lds, int l, int ch, int boff) {
    using Gm = Geo<L, NBH>;
    static_assert(Gm::END <= LDS_MISC, "hyena LDS");
    const int tid = opaque_tid(), wid = __builtin_amdgcn_readfirstlane(tid >> 6), lane = tid & 63, r32 = lane & 31, hi = lane >> 5;
    const bf16_t* hyt = wsp<bf16_t>(A, W.hyt);
    const float* cw = FIN(9) + l * 3 * 768; const float* cb = FIN(10) + l * 768;
    const int tbl = tid / (L / 32), tb = boff + tbl, tp0 = (tid % (L / 32)) * 32; const bool ld_act = tid < NBH * (L / 32);
    unsigned x2p[16];
    __syncthreads();
    for (int i = tid; i < 2 * NBH * Gm::ZRS / 16; i += NTHR) *(FK_LAS u32x4*)(lds + i * 16) = (u32x4){0u, 0u, 0u, 0u};
    __syncthreads();
    if (ld_act) {
#pragma unroll
        for (int sel = 0; sel < 3; ++sel) {
            const int row = sel * 256 + ch; const float w0 = cw[row], w1 = cw[768 + row], w2 = cw[1536 + row], bs = cb[row];
            float vals[34];
            if (tb < NB) {
                const size_t tok0 = (L == 2048) ? (size_t)tb * SEQ + tp0 : (size_t)NLAT + tb * CTX + tp0;
                const bf16_t* src = hyt + (size_t)row * NTOK + tok0;
#pragma unroll
                for (int q = 0; q < 4; ++q) { const u32x4 w = *(const u32x4*)(src + q * 8);
                    vals[1 + q * 8 + 0] = bflo(w.x); vals[1 + q * 8 + 1] = bfhi(w.x); vals[1 + q * 8 + 2] = bflo(w.y); vals[1 + q * 8 + 3] = bfhi(w.y);
                    vals[1 + q * 8 + 4] = bflo(w.z); vals[1 + q * 8 + 5] = bfhi(w.z); vals[1 + q * 8 + 6] = bflo(w.w); vals[1 + q * 8 + 7] = bfhi(w.w); }
                vals[0] = tp0 > 0 ? bf2f(src[-1]) : 0.f; vals[33] = tp0 + 32 < L ? bf2f(src[32]) : 0.f;
            } else {
#pragma unroll
                for (int i = 0; i < 34; ++i) vals[i] = 0.f;
            }
            unsigned pk[16];
#pragma unroll
            for (int i = 0; i < 16; ++i) { const float a = tb < NB ? vals[2 * i] * w0 + vals[2 * i + 1] * w1 + vals[2 * i + 2] * w2 + bs : 0.f, b2 = tb < NB ? vals[2 * i + 1] * w0 + vals[2 * i + 2] * w1 + vals[2 * i + 3] * w2 + bs : 0.f;
                pk[i] = cvt_pk_bf16(a, b2); }
            if (sel < 2) { FK_LAS char* dst = lds + (sel == 0 ? Gm::OFF_Z : Gm::OFF_G) + tbl * Gm::ZRS + (Gm::PADB * 32 + tp0) * 2;
#pragma unroll
                for (int q = 0; q < 4; ++q) *(FK_LAS u32x4*)(dst + q * 16) = (u32x4){pk[4 * q], pk[4 * q + 1], pk[4 * q + 2], pk[4 * q + 3]}; }
            else {
#pragma unroll
                for (int i = 0; i < 16; ++i) x2p[i] = pk[i]; }
        }
    }
    const int G0 = wid * Gm::GPW; const bool act = wid < Gm::AW;
    const int dlo = Gm::IB * G0 - (Gm::NBLK - 1), dhi = Gm::IB * (G0 + Gm::GPW) - 1;
    const int il = r32 & (Gm::IB - 1), bb = r32 / Gm::IB;
    for (int o = 0; o < 2; ++o) {
        { const bf16_t* TL = (L == 2048 ? wsp<bf16_t>(A, W.tapl) + ((size_t)l * 512 + o * 256 + ch) * TLL : wsp<bf16_t>(A, W.tapc) + ((size_t)l * 512 + o * 256 + ch) * TLC);
          constexpr int NC = Gm::TLn / 8;
          for (int i = tid; i < NC; i += NTHR) *(FK_LAS u32x4*)(lds + Gm::OFF_T + i * 16) = *(const u32x4*)(TL + i * 8);
          __syncthreads();
          for (int i = tid; i < 7 * NC; i += NTHR) { const int sft = 1 + i / NC, c = i % NC;
              const FK_LAS unsigned* src = (const FK_LAS unsigned*)(lds + Gm::OFF_T + c * 16 + 4 * (sft >> 1)); const unsigned sh = 16u * (unsigned)(sft & 1);
              const bool tail = (c == NC - 1);
              unsigned w0 = src[0], w1 = tail && (1 + (sft >> 1)) >= 4 ? 0u : src[1], w2 = tail && (2 + (sft >> 1)) >= 4 ? 0u : src[2], w3 = tail && (3 + (sft >> 1)) >= 4 ? 0u : src[3], w4 = tail ? 0u : src[4];
              u32x4 ov; ov.x = __builtin_amdgcn_alignbit(w1, w0, sh); ov.y = __builtin_amdgcn_alignbit(w2, w1, sh); ov.z = __builtin_amdgcn_alignbit(w3, w2, sh); ov.w = __builtin_amdgcn_alignbit(w4, w3, sh);
              *(FK_LAS u32x4*)(lds + Gm::OFF_T + sft * Gm::TCS + c * 16) = ov; } }
        __syncthreads();
        f32x16 acc[Gm::GPW];
#pragma unroll
        for (int g = 0; g < Gm::GPW; ++g) acc[g] = f32x16{};
        if (act) {
            const int c0 = (L + 32) - r32 + 8 * hi, sc = c0 & 7;
            int pa = Gm::OFF_T + sc * Gm::TCS + (c0 - sc - 32 * dlo) * 2;
            int pb = Gm::OFF_Z + bb * Gm::ZRS + ((Gm::PADB + Gm::IB * G0 + il - dlo) * 32 + 8 * hi) * 2;
#define HY_LOAD(A0, A1, B0, B1) do { A0 = *(const FK_LAS bf16x8*)(lds + pa); A1 = *(const FK_LAS bf16x8*)(lds + pa + 32); \
                _Pragma("unroll") for (int g = 0; g < Gm::GPW; ++g) { B0[g] = *(const FK_LAS bf16x8*)(lds + pb + g * Gm::IB * 64); B1[g] = *(const FK_LAS bf16x8*)(lds + pb + g * Gm::IB * 64 + 32); } \
                pa -= 64; pb -= 64; } while (0)
#define HY_MMA(A0, A1, B0, B1) do { _Pragma("unroll") for (int g = 0; g < Gm::GPW; ++g) { acc[g] = __builtin_amdgcn_mfma_f32_32x32x16_bf16(A0, B0[g], acc[g], 0, 0, 0); \
                acc[g] = __builtin_amdgcn_mfma_f32_32x32x16_bf16(A1, B1[g], acc[g], 0, 0, 0); } } while (0)
            bf16x8 xa0, xa1, ya0, ya1, xb0[Gm::GPW], xb1[Gm::GPW], yb0[Gm::GPW], yb1[Gm::GPW];
            const int nd = dhi - dlo + 1;
            HY_LOAD(xa0, xa1, xb0, xb1);
            int d = 0;
#pragma unroll 1
            for (; d + 2 <= nd - 1; d += 2) {
                HY_LOAD(ya0, ya1, yb0, yb1);
                HY_MMA(xa0, xa1, xb0, xb1);
                HY_LOAD(xa0, xa1, xb0, xb1);
                HY_MMA(ya0, ya1, yb0, yb1);
            }
            if (d + 1 <= nd - 1) { HY_LOAD(ya0, ya1, yb0, yb1); HY_MMA(xa0, xa1, xb0, xb1); HY_MMA(ya0, ya1, yb0, yb1); }
            else HY_MMA(xa0, xa1, xb0, xb1);
#undef HY_LOAD
#undef HY_MMA
        }
        __syncthreads();
        const float bias = FIN(17)[l * 512 + o * 256 + ch];
        if (act) {
#pragma unroll
            for (int g = 0; g < Gm::GPW; ++g)
#pragma unroll
                for (int r = 0; r < 16; ++r) { const int pos = 32 * (Gm::IB * (G0 + g) + il) + crow(r, hi);
                    FK_LAS unsigned short* zp = (FK_LAS unsigned short*)(lds + Gm::OFF_Z + bb * Gm::ZRS + (Gm::PADB * 32 + pos) * 2);
                    const float gate = bf2f(*(FK_LAS unsigned short*)(lds + Gm::OFF_G + bb * Gm::ZRS + (Gm::PADB * 32 + pos) * 2));
                    const float zn = gate * (acc[g][r] + bias * bf2f(*zp));
                    *zp = (unsigned short)f2bf(zn); }
        }
        __syncthreads();
        if (o == 0 && ld_act) { FK_LAS char* dst = lds + Gm::OFF_G + tbl * Gm::ZRS + (Gm::PADB * 32 + tp0) * 2;
#pragma unroll
            for (int q = 0; q < 4; ++q) *(FK_LAS u32x4*)(dst + q * 16) = (u32x4){x2p[4 * q], x2p[4 * q + 1], x2p[4 * q + 2], x2p[4 * q + 3]}; }
    }
    __syncthreads();
    if (ld_act && tb < NB) { const size_t tok0 = (L == 2048) ? (size_t)tb * SEQ + tp0 : (size_t)NLAT + tb * CTX + tp0;
        bf16_t* dst = wsp<bf16_t>(A, W.hyo) + (size_t)ch * NTOK + tok0; const FK_LAS char* srcz = lds + Gm::OFF_Z + tbl * Gm::ZRS + (Gm::PADB * 32 + tp0) * 2;
#pragma unroll
        for (int q = 0; q < 4; ++q) *(u32x4*)(dst + q * 8) = *(const FK_LAS u32x4*)(srcz + q * 16); }
    __syncthreads();
}
}

struct FnSched {
    int G, c, big; const char* dft; const char* ft;
    __device__ bool next(int i, Unit& u) const {
        const long Li = (long)i * G + (G - 1 - c);
        const int n = big ? NB * 8 : NB; if (Li >= n) return false;
        const int b = big ? (int)Li >> 3 : (int)Li, mt = big ? (int)Li & 7 : 0;
        u.pm = mt; u.pn = b; u.kind = big; u.aux = 0;
        u.a = dft + (size_t)mt * 256 * (big ? 4096 : 512) * 2; u.b = ft + (size_t)b * 256 * (big ? 4096 : 512) * 2; return true;
    }
};
struct FnEpi {
    bf16_t* fno;
    __device__ __forceinline__ bool operator()(Acc& acc, const Unit& u, int wr, int wc, int fr, int fq) const {
        const size_t t0 = u.kind ? (size_t)u.pn * SEQ + u.pm * 256 : (size_t)NLAT + u.pn * CTX;
#pragma unroll
        for (int ai = 0; ai < 2; ++ai)
#pragma unroll
            for (int m = 0; m < 4; ++m) { bf16_t* rowp = fno + (t0 + 128 * ai + 64 * wr + 16 * m + fr) * 256 + 32 * wc + 8 * fq;
#pragma unroll
                for (int bj = 0; bj < 2; ++bj) { const f32x4 v0 = acc[ai][bj][m][0], v1 = acc[ai][bj][m][1];
                    u32x4 w; w.x = cvt_pk_bf16(v0[0], v0[1]); w.y = cvt_pk_bf16(v0[2], v0[3]); w.z = cvt_pk_bf16(v1[0], v1[1]); w.w = cvt_pk_bf16(v1[2], v1[3]);
                    *(u32x4*)(rowp + 128 * bj) = w; } }
        return true;
    }
};

__device__ __forceinline__ void phase_mix(AP A, FK_LAS unsigned char* lds, int l, int vcu, int G) {
    const int n_lat = NB * 32, n_all = n_lat + (l == 0 ? NB * 4 : 0);
#ifndef FK_REP_SUB
#define FK_REP_SUB 0
#endif
#ifndef FK_NO_ATTN
    for (int rp = (FK_REP_SUB == 1 ? 1 : 0); rp >= 0; --rp)
    for (int u = vcu; u < n_all; u += G) {
        if (u < n_lat) attn::unit(A, (FK_LAS char*)lds, l, u >> 5, (u >> 3) & 3, u & 7);
        else { const int v = u - n_lat; attn::unit(A, (FK_LAS char*)lds, l, v >> 2, v & 3, 8); }
    }
#endif
#ifndef FK_NO_HY
    for (int rp = (FK_REP_SUB == 2 ? 1 : 0); rp >= 0; --rp)
    if (G == 256) { if (vcu < 192) hy::unit<2048, 8>(A, (FK_LAS char*)lds, l, vcu, 0); if (vcu >= 64 && vcu < 128) hy::unit<2048, 8>(A, (FK_LAS char*)lds, l, vcu + 128, 0); }
    else for (int ch = vcu; ch < 256; ch += G) hy::unit<2048, 8>(A, (FK_LAS char*)lds, l, ch, 0);
    if (l == 0) for (int ch = vcu; ch < 256; ch += G) hy::unit<256, 8>(A, (FK_LAS char*)lds, l, ch, 0);
#endif
#ifndef FK_NO_FN
    for (int rp = (FK_REP_SUB == 3 ? 1 : 0); rp >= 0; --rp)
    { FnSched S{G, vcu, 1, (const char*)wsp<bf16_t>(A, W.dftl), (const char*)wsp<bf16_t>(A, W.ftl)}; FnEpi E{wsp<bf16_t>(A, W.fno)}; gemm_phase(lds, 4096, S, E); }
    if (l == 0) { FnSched S{G, vcu, 0, (const char*)wsp<bf16_t>(A, W.dftc), (const char*)wsp<bf16_t>(A, W.ftc)}; FnEpi E{wsp<bf16_t>(A, W.fno)}; gemm_phase(lds, 512, S, E); }
#endif
}
#define FK_HAVE_MERGE 1
#define FK_HAVE_OUT 1
#define FK_HAVE_NORM 1
#define FK_HAVE_PQ 1
struct MergeSched {
    int G, c, ntile; const char *a0, *a1, *a2, *a3; const char* w;
    __device__ bool next(int i, Unit& u) const {
        const int j = i >> 2, s = i & 3; const long T = (long)j * G + c; if (T >= ntile) return false;
        u.pm = (int)(T >> 2); u.pn = (int)(T & 3); u.kind = s; u.aux = 0;
        u.a = (s == 0) ? a0 + (size_t)(j * 256 + c) * 256 * 256 * 2 : (s == 1 ? a1 : s == 2 ? a2 : a3) + (size_t)u.pm * 256 * 256 * 2; u.b = w + ((size_t)s * 1024 + u.pn * 256) * 256 * 2; return true;
    }
};
struct MergeEpi {
    const bf16_t* g; bf16_t* y;
    __device__ __forceinline__ bool operator()(Acc& acc, const Unit& u, int wr, int wc, int fr, int fq) const {
        const int s = u.kind; if (s == 2) return false;
        const int gn = (s == 3 ? 2048 : s * 1024), gd = (s + 1) * 1024;
#pragma unroll
        for (int ai = 0; ai < 2; ++ai)
#pragma unroll
            for (int m = 0; m < 4; ++m) { const size_t t = (size_t)u.pm * 256 + 128 * ai + 64 * wr + 16 * m + fr;
#pragma unroll
                for (int bj = 0; bj < 2; ++bj) { const int c = u.pn * 256 + 128 * bj + 32 * wc + 8 * fq; const bf16_t* gp = g + t * 3072 + c;
#pragma unroll
                    for (int n = 0; n < 2; ++n) {
                        const u32x2 wn = *(const u32x2*)(gp + gn + 4 * n);
                        f32x4 f = {bflo(wn.x), bfhi(wn.x), bflo(wn.y), bfhi(wn.y)};
                        if (s != 3) { const u32x2 wd = *(const u32x2*)(gp + gd + 4 * n);
                            f[0] *= __builtin_amdgcn_rcpf(bflo(wd.x)); f[1] *= __builtin_amdgcn_rcpf(bfhi(wd.x)); f[2] *= __builtin_amdgcn_rcpf(bflo(wd.y)); f[3] *= __builtin_amdgcn_rcpf(bfhi(wd.y)); }
                        acc[ai][bj][m][n] = acc[ai][bj][m][n] * f; }
                    if (s == 3) { const f32x4 v0 = acc[ai][bj][m][0], v1 = acc[ai][bj][m][1];
                        u32x4 w; w.x = cvt_pk_bf16(v0[0], v0[1]); w.y = cvt_pk_bf16(v0[2], v0[3]); w.z = cvt_pk_bf16(v1[0], v1[1]); w.w = cvt_pk_bf16(v1[2], v1[3]); *(u32x4*)(y + t * 1024 + c) = w; } }
                if (m == 3) asm volatile("" ::: "memory"); }
        return s == 3;
    }
};
__device__ __forceinline__ void phase_merge(AP A, FK_LAS unsigned char* lds, int l, int G) {
    MergeSched S; S.G = G; S.c = (int)blockIdx.x; S.ntile = (l == 0 ? NTT : NTL) * 4;
    { const int tid = opaque_tid(); const bf16_t* hyot = wsp<bf16_t>(A, W.hyo); bf16_t* scr = wsp<bf16_t>(A, W.q);
      constexpr int RS = 516;
      for (int j = 0; (long)j * G + S.c < S.ntile; ++j) { const int pm = (int)(((long)j * G + S.c) >> 2); bf16_t* dst = scr + (size_t)(j * 256 + S.c) * 65536;
          for (int cq = 0; cq < 4; ++cq) {
              __syncthreads();
#pragma unroll
              for (int i = 0; i < 4; ++i) { const int idx = tid + 512 * i, chl = idx >> 5, t8 = (idx & 31) * 8;
                  const u32x4 v = *(const u32x4*)(hyot + (size_t)(cq * 64 + chl) * NTOK + (size_t)pm * 256 + t8);
                  FK_LAS unsigned* p = (FK_LAS unsigned*)(lds + chl * RS + t8 * 2); p[0] = v.x; p[1] = v.y; p[2] = v.z; p[3] = v.w; }
              __syncthreads();
#pragma unroll
              for (int i = 0; i < 4; ++i) { const int idx = tid + 512 * i, tok = idx >> 3, c8 = (idx & 7) * 8; unsigned short e[8];
#pragma unroll
                  for (int q = 0; q < 8; ++q) e[q] = *(const FK_LAS unsigned short*)(lds + (c8 + q) * RS + tok * 2);
                  *(u32x4*)(dst + (size_t)tok * 256 + cq * 64 + c8) = (u32x4){(unsigned)e[0] | ((unsigned)e[1] << 16), (unsigned)e[2] | ((unsigned)e[3] << 16), (unsigned)e[4] | ((unsigned)e[5] << 16), (unsigned)e[6] | ((unsigned)e[7] << 16)}; }
          } }
      asm volatile("s_waitcnt vmcnt(0)" ::: "memory"); __syncthreads(); }
    S.a0 = (const char*)wsp<bf16_t>(A, W.q); S.a1 = (const char*)wsp<bf16_t>(A, W.fno); S.a2 = (const char*)wsp<bf16_t>(A, W.attlo); S.a3 = (const char*)wsp<bf16_t>(A, W.atthi);
    S.w = (const char*)(wsp<bf16_t>(A, W.w_mrg) + (size_t)l * 4 * 1024 * 256);
    MergeEpi E{wsp<bf16_t>(A, W.g), wsp<bf16_t>(A, W.y)};
    gemm_phase(lds, 256, S, E);
}
struct PlainSched {
    int G, c, nM, nN, K; const char* a; const char* w;
    __device__ bool next(int i, Unit& u) const {
        const long T = (long)i * G + c; if (T >= (long)nM * nN) return false;
        int wgid = (int)T; const int nwg = nM * nN; { const int q = nwg / 8, r = nwg % 8, xcd = wgid % 8, off = wgid / 8; wgid = (xcd < r ? xcd * (q + 1) : r * (q + 1) + (xcd - r) * q) + off; }
        const int nig = 8 * nN, gid = wgid / nig, fm = gid * 8, gsz = (nM - fm) < 8 ? (nM - fm) : 8;
        u.pm = fm + ((wgid % nig) % gsz); u.pn = (wgid % nig) / gsz; u.kind = 0; u.aux = 0;
        u.a = a + (size_t)u.pm * 256 * K * 2; u.b = w + (size_t)u.pn * 256 * K * 2; return true;
    }
};
struct OutEpi {
    const float* x_in; const float* ctx_in; const float* xl; float* xc; const float* mod; int l; float* xo;
    __device__ __forceinline__ bool operator()(Acc& acc, const Unit& u, int wr, int wc, int fr, int fq) const {
        const bool lat = u.pm < NTL; const int mr = lat ? u.pm >> 3 : 8;
        const float* gate = mod + (size_t)mr * 6144 + 2 * 1024;
#pragma unroll
        for (int bj = 0; bj < 2; ++bj) { const int c = u.pn * 256 + 128 * bj + 32 * wc + 8 * fq;
            const f32x4 g0 = *(const f32x4*)(gate + c), g1 = *(const f32x4*)(gate + c + 4);
#pragma unroll
            for (int ai = 0; ai < 2; ++ai)
#pragma unroll
                for (int m = 0; m < 4; ++m) { const int rl = 128 * ai + 64 * wr + 16 * m + fr;
                    const size_t t = (size_t)u.pm * 256 + rl, tc = t - NLAT;
                    const float* bp = lat ? ((l == 0 ? x_in : xl) + t * 1024 + c) : (ctx_in + tc * 1024 + c);
                    float* op = lat ? (xo + t * 1024 + c) : (xc + tc * 1024 + c);
                    const f32x4 b0 = *(const f32x4*)bp, b1 = *(const f32x4*)(bp + 4);
                    *(f32x4*)op = b0 + g0 * acc[ai][bj][m][0]; *(f32x4*)(op + 4) = b1 + g1 * acc[ai][bj][m][1]; } }
        return true;
    }
};
__device__ __forceinline__ void phase_outproj(AP A, FK_LAS unsigned char* lds, int l, int G, int dry) {
    PlainSched S{G, (int)blockIdx.x, l == 0 ? NTT : NTL, 4, 1024, (const char*)wsp<bf16_t>(A, W.y), (const char*)(wsp<bf16_t>(A, W.w_out) + (size_t)l * 1024 * 1024)};
    OutEpi E{FIN(0), FIN(2), A->xl, wsp<float>(A, W.xc), wsp<float>(A, W.mod) + (size_t)l * 9 * 6144, l, dry ? wsp<float>(A, W.g) : A->xl};
    gemm_phase(lds, 1024, S, E);
}
__device__ __forceinline__ void phase_norm(AP A, int l, int vcu, int G) {
    const int tid = opaque_tid(), lane = tid & 63, wave = __builtin_amdgcn_readfirstlane(tid >> 6);
    const int gw = vcu * NWAVES + wave, NGW = G * NWAVES;
    const float* mod = wsp<float>(A, W.mod) + (size_t)l * 9 * 6144;
    const int nrow = l == 0 ? NTOK : NLAT;
    for (int t = gw; t < nrow; t += NGW) {
        const bool lat = t < NLAT; const int mr = lat ? t / SEQ : 8;
        const float* xr = lat ? A->xl + (size_t)t * DM : wsp<float>(A, W.xc) + (size_t)(t - NLAT) * DM;
        modulate_row_bf16(xr, FIN(7) + l * DM, mod + (size_t)mr * 6144 + 4 * 1024, mod + (size_t)mr * 6144 + 3 * 1024, wsp<bf16_t>(A, W.nn) + (size_t)t * DM, lane);
    }
    if (l == 1) {
        const size_t gt = (size_t)vcu * NTHR + tid, NGT = (size_t)G * NTHR, nUV = (size_t)16384 * 1024 / 16;
        for (size_t i = gt; i < 2 * nUV; i += NGT) {
            if (i < nUV) cvt16_fp8(FIN(28) + (size_t)16384 * 1024 + i * 16, wsp<unsigned char>(A, W.ub) + tab_chunk_off(i), SU);
            else cvt16_fp8(FIN(29) + (size_t)16384 * 1024 + (i - nUV) * 16, wsp<unsigned char>(A, W.vb) + tab_chunk_off(i - nUV), SV);
        }
    }
}
struct PqEpi {
    bf16_t* pq;
    __device__ __forceinline__ bool operator()(Acc& acc, const Unit& u, int wr, int wc, int fr, int fq) const {
#pragma unroll
        for (int ai = 0; ai < 2; ++ai)
#pragma unroll
            for (int m = 0; m < 4; ++m) { bf16_t* rowp = pq + ((size_t)u.pm * 256 + 128 * ai + 64 * wr + 16 * m + fr) * 2048 + u.pn * 256 + 32 * wc + 8 * fq;
#pragma unroll
                for (int bj = 0; bj < 2; ++bj) { const f32x4 v0 = acc[ai][bj][m][0], v1 = acc[ai][bj][m][1];
                    u32x4 w; w.x = cvt_pk_bf16(v0[0], v0[1]); w.y = cvt_pk_bf16(v0[2], v0[3]); w.z = cvt_pk_bf16(v1[0], v1[1]); w.w = cvt_pk_bf16(v1[2], v1[3]);
                    *(u32x4*)(rowp + 128 * bj) = w; } }
        return true;
    }
};
__device__ __forceinline__ void phase_peerq(AP A, FK_LAS unsigned char* lds, int l, int G) {
    PlainSched S{G, (int)blockIdx.x, l == 0 ? NTT : NTL, 8, 1024, (const char*)wsp<bf16_t>(A, W.nn), (const char*)(wsp<bf16_t>(A, W.w_q) + (size_t)l * 2048 * 1024)};
    PqEpi E{wsp<bf16_t>(A, W.pq)};
    gemm_phase(lds, 1024, S, E);
}
#define FK_HAVE_PEER 1
namespace peer {
typedef __bf16 bf16x2v __attribute__((ext_vector_type(2)));
__device__ __forceinline__ float dot2(unsigned a, unsigned b, float c) { return __builtin_amdgcn_fdot2_f32_bf16(__builtin_bit_cast(bf16x2v, a), __builtin_bit_cast(bf16x2v, b), c, false); }
__device__ __forceinline__ unsigned ford(float f) { const unsigned u = __float_as_uint(f); return (u & 0x80000000u) ? ~u : (u | 0x80000000u); }
__device__ __forceinline__ float funord(unsigned o) { return __uint_as_float((o & 0x80000000u) ? (o & 0x7fffffffu) : ~o); }
__device__ __forceinline__ unsigned umax(unsigned a, unsigned b) { return a > b ? a : b; }
__device__ __forceinline__ unsigned umin(unsigned a, unsigned b) { return a < b ? a : b; }
template <int N> __device__ __forceinline__ void sort_desc(unsigned (&v)[N]) {
#pragma unroll
    for (int k = 2; k <= N; k <<= 1)
#pragma unroll
        for (int j = k >> 1; j > 0; j >>= 1)
#pragma unroll
            for (int i = 0; i < N; ++i) { const int l = i ^ j;
                if (l > i) { const unsigned a = v[i], b = v[l], mx = umax(a, b), mn = umin(a, b); if ((i & k) == 0) { v[i] = mx; v[l] = mn; } else { v[i] = mn; v[l] = mx; } } }
}
template <int N> __device__ __forceinline__ void merge_desc(unsigned (&v)[N]) {
#pragma unroll
    for (int j = N >> 1; j > 0; j >>= 1)
#pragma unroll
        for (int i = 0; i < N; ++i) { const int l = i ^ j; if (l > i) { const unsigned a = v[i], b = v[l]; v[i] = umax(a, b); v[l] = umin(a, b); } }
}
__device__ __forceinline__ int crow(int r, int hi) { return (r & 3) + 8 * (r >> 2) + 4 * hi; }
constexpr int L_RIDX = 0, L_RG = 32 * 128 * 2, L_TBL = L_RG + 32 * 128 * 4, L_WK = L_TBL + 8 * 32 * 32, L_END = L_WK + 8 * 128 * 4;

__device__ __forceinline__ void score_top16(const bf16_t* keys  , const bf16_t* qrow  , int r32, int hi, unsigned (&top)[16]) {
    f32x16 acc[4];
    int koff = r32 * 128 + 8 * hi; asm volatile("" : "+v"(koff));
    const bf16_t* kbase = keys + koff; const bf16_t* qb = qrow + 8 * hi;
#pragma unroll
    for (int kt = 0; kt < 4; ++kt) acc[kt] = f32x16{};
    bf16x8 bq[8], ka[8], kb2[8];
#pragma unroll
    for (int ks = 0; ks < 8; ++ks) bq[ks] = *(const bf16x8*)(qb + 16 * ks);
#define KLOAD(dst, kt) do { _Pragma("unroll") for (int ks = 0; ks < 8; ++ks) dst[ks] = *(const bf16x8*)(kbase + 32 * (kt) * 128 + 16 * ks); } while (0)
#define KMMA(src, kt) do { _Pragma("unroll") for (int ks = 0; ks < 8; ++ks) acc[kt] = __builtin_amdgcn_mfma_f32_32x32x16_bf16(src[ks], bq[ks], acc[kt], 0, 0, 0); } while (0)
    KLOAD(ka, 0); asm volatile("" ::: "memory");
    KLOAD(kb2, 1); KMMA(ka, 0); asm volatile("" ::: "memory");
    KLOAD(ka, 2); KMMA(kb2, 1); asm volatile("" ::: "memory");
    KLOAD(kb2, 3); KMMA(ka, 2); asm volatile("" ::: "memory");
    KMMA(kb2, 3);
#undef KLOAD
#undef KMMA
    unsigned v[64]; const unsigned hi4 = 4u * (unsigned)hi;
#pragma unroll
    for (int kt = 0; kt < 4; ++kt)
#pragma unroll
        for (int r = 0; r < 16; ++r) v[kt * 16 + r] = ((ford(acc[kt][r]) & ~0x7fu) | (unsigned)(127 - (32 * kt + (r & 3) + 8 * (r >> 2)))) - hi4;
    unsigned g0[16], g1[16], g2[16], g3[16];
#pragma unroll
    for (int i = 0; i < 16; ++i) { g0[i] = v[i]; g1[i] = v[16 + i]; g2[i] = v[32 + i]; g3[i] = v[48 + i]; }
    sort_desc<16>(g0); sort_desc<16>(g1); sort_desc<16>(g2); sort_desc<16>(g3);
#pragma unroll
    for (int i = 0; i < 16; ++i) { g0[i] = umax(g0[i], g1[15 - i]); g2[i] = umax(g2[i], g3[15 - i]); }
    merge_desc<16>(g0); merge_desc<16>(g2);
#pragma unroll
    for (int i = 0; i < 16; ++i) g0[i] = umax(g0[i], g2[15 - i]);
    merge_desc<16>(g0);
#pragma unroll
    for (int i = 0; i < 16; ++i) { const unsigned o = (unsigned)__shfl_xor((int)g0[15 - i], 32); top[i] = umax(g0[i], o); }
    merge_desc<16>(top);
}
__device__ __forceinline__ void phase(AP A, FK_LAS unsigned char* lds, int l, int vcu, int G, int dry_in, const XcdBarrier bar, const int use_bar) {
    const int dry = dry_in;
#define GBAR() do { if (use_bar) xcd_barrier(bar); } while (0)
    const int tid = opaque_tid(), lane = tid & 63, wave = __builtin_amdgcn_readfirstlane(tid >> 6), r32 = lane & 31, hi = lane >> 5;
    const int TS = (l == 0 && (NTOK % 24) == 0) ? 24 : 32, TPW = TS / 8;
    const int ntile = (l == 0 ? NTOK : NLAT) / TS;
    const bf16_t* keys = wsp<bf16_t>(A, W.keys) + (size_t)l * 16 * 128 * 128;
    const float* mod = wsp<float>(A, W.mod) + (size_t)l * 9 * 6144;
    FK_LAS unsigned short* ridx = (FK_LAS unsigned short*)(lds + L_RIDX); FK_LAS float* rg = (FK_LAS float*)(lds + L_RG);
    FK_LAS unsigned char* tbl = (FK_LAS unsigned char*)(lds + L_TBL) + wave * 32 * 32; FK_LAS float* wk = (FK_LAS float*)(lds + L_WK) + wave * 128;
    for (int tile = vcu; tile < ntile; tile += G) {
        const int t0 = tile * TS; const int rtok = r32 < TS ? r32 : TS - 1;
        __syncthreads();
#ifndef FK_REP_SUB
#define FK_REP_SUB 0
#endif
        for (int rp = (FK_REP_SUB == 4 ? 1 : 0); rp >= 0; --rp) {
            const int h = wave; unsigned s1[16], s2[16];
            const bf16_t* qrow = wsp<bf16_t>(A, W.pq) + (size_t)(t0 + rtok) * 2048 + h * 256;
            score_top16(keys + (size_t)(h * 2 + 0) * 128 * 128, qrow, r32, hi, s1);
            score_top16(keys + (size_t)(h * 2 + 1) * 128 * 128, qrow + 128, r32, hi, s2);
            if (hi == 0) {
#pragma unroll
                for (int i = 0; i < 16; ++i) { tbl[r32 * 32 + i] = (unsigned char)(127 - (s1[i] & 127u)); tbl[r32 * 32 + 16 + i] = (unsigned char)(127 - (s2[i] & 127u)); } }
            float f1[16], f2[16];
#pragma unroll
            for (int i = 0; i < 16; ++i) { f1[i] = funord(s1[i] & ~0x7fu); f2[i] = funord(s2[i] & ~0x7fu); }
            unsigned c[32]; int cn = 0;
#pragma unroll
            for (int i = 0; i < 16; ++i)
#pragma unroll
                for (int j = 0; j < 16; ++j) if ((i + 1) * (j + 1) <= 16) {
                    const unsigned pk = (ford(f1[i] + f2[j]) & ~0xffu) | (unsigned)(255 - (i * 16 + j));
                    if ((cn & 1) == 0) c[cn >> 1] = pk; else c[cn >> 1] = hi ? pk : c[cn >> 1];
                    ++cn; }
#pragma unroll
            for (int q = 25; q < 32; ++q) c[q] = 0u;
            sort_desc<32>(c);
            unsigned ct[16];
#pragma unroll
            for (int i = 0; i < 16; ++i) { const unsigned o = (unsigned)__shfl_xor((int)c[15 - i], 32); ct[i] = umax(c[i], o); }
            merge_desc<16>(ct);
            if (hi == 0 && r32 < TS) {
                float e[16]; float sum = 0.f; const float mx = funord(ct[0] & ~0xffu);
#pragma unroll
                for (int t = 0; t < 16; ++t) { e[t] = __expf(funord(ct[t] & ~0xffu) - mx); sum += e[t]; }
                const float inv = 1.f / sum;
#pragma unroll
                for (int t = 0; t < 16; ++t) { const int ci = 255 - (int)(ct[t] & 0xffu); const int e1 = tbl[r32 * 32 + (ci >> 4)], e2 = tbl[r32 * 32 + 16 + (ci & 15)];
                    const int idx = e1 * 128 + e2; const float gg = e[t] * inv;
                    ridx[r32 * 128 + h * 16 + t] = (unsigned short)idx; rg[r32 * 128 + h * 16 + t] = gg;
                    wsp<unsigned short>(A, W.pidx)[(size_t)(t0 + r32) * 128 + ((h * 16 + t) & 7) * 16 + ((h * 16 + t) >> 3)] = (unsigned short)idx; wsp<float>(A, W.pg)[(size_t)(t0 + r32) * 128 + h * 16 + t] = gg; }
            }
        }
    }
    if (G != 256) return;
    GBAR();
    const int sl = (int)blockIdx.x & 7, rk = (int)blockIdx.x >> 3, ntok = (l == 0 ? NTOK : NLAT);
    const int r8 = lane >> 3, cc = lane & 7;
    A = opaque_args(A);
    const unsigned short* pidx = wsp<unsigned short>(A, W.pidx); const float* pgw = wsp<float>(A, W.pg);
    float* hidp = wsp<float>(A, W.pq);
    for (int rp = (FK_REP_SUB == 5 ? 1 : 0); rp >= 0; --rp) {
        const unsigned char* Us = wsp<unsigned char>(A, W.ub) + (size_t)sl * 16384 * 128; const unsigned cc16 = 16u * (unsigned)cc;
        const bf16_t* nn = wsp<bf16_t>(A, W.nn) + 128 * sl + 16 * cc;
#define TLOAD(IK, N0, N1, t) do { const u32x4 i0_ = *(const u32x4*)(pidx + (size_t)(t) * 128 + r8 * 16), i1_ = *(const u32x4*)(pidx + (size_t)(t) * 128 + r8 * 16 + 8); \
            IK[0] = i0_.x; IK[1] = i0_.y; IK[2] = i0_.z; IK[3] = i0_.w; IK[4] = i1_.x; IK[5] = i1_.y; IK[6] = i1_.z; IK[7] = i1_.w; \
            N0 = *(const u32x4*)(nn + (size_t)(t) * DM); N1 = *(const u32x4*)(nn + (size_t)(t) * DM + 8); } while (0)
#define GLOAD(GB, IK, h) do { _Pragma("unroll") for (int i = 0; i < 8; ++i) GB[i] = *(const u32x4*)(Us + (((IK[4 * (h) + (i >> 1)] >> (16 * (i & 1))) & 0xffffu) * 128u + cc16)); } while (0)
#define NUNPK(N0, N1) do { nf[0] = bflo(N0.x); nf[1] = bfhi(N0.x); nf[2] = bflo(N0.y); nf[3] = bfhi(N0.y); nf[4] = bflo(N0.z); nf[5] = bfhi(N0.z); nf[6] = bflo(N0.w); nf[7] = bfhi(N0.w); \
            nf[8] = bflo(N1.x); nf[9] = bfhi(N1.x); nf[10] = bflo(N1.y); nf[11] = bfhi(N1.y); nf[12] = bflo(N1.z); nf[13] = bfhi(N1.z); nf[14] = bflo(N1.w); nf[15] = bfhi(N1.w); } while (0)
#define HDOT(GB, t, h) do { float p[8]; \
            _Pragma("unroll") for (int i = 0; i < 8; ++i) { const unsigned aw[4] = {GB[i].x, GB[i].y, GB[i].z, GB[i].w}; f32x2 d2 = {0.f, 0.f}; \
                _Pragma("unroll") for (int q = 0; q < 4; ++q) { const f32x2 lo = __builtin_amdgcn_cvt_pk_f32_fp8(aw[q], false), hh = __builtin_amdgcn_cvt_pk_f32_fp8(aw[q], true); \
                    d2 = lo * (f32x2){nf[4 * q], nf[4 * q + 1]} + d2; d2 = hh * (f32x2){nf[4 * q + 2], nf[4 * q + 3]} + d2; }     \
                p[i] = d2[0] + d2[1]; } \
            _Pragma("unroll") for (int i = 0; i < 4; ++i) { const float send = (cc & 1) ? p[i] : p[i + 4], keep = (cc & 1) ? p[i + 4] : p[i]; p[i] = keep + __shfl_xor(send, 1); } \
            _Pragma("unroll") for (int i = 0; i < 2; ++i) { const float send = (cc & 2) ? p[i] : p[i + 2], keep = (cc & 2) ? p[i + 2] : p[i]; p[i] = keep + __shfl_xor(send, 2); } \
            { const float send = (cc & 4) ? p[0] : p[1], keep = (cc & 4) ? p[1] : p[0]; p[0] = keep + __shfl_xor(send, 4); } \
            const int v = 4 * (cc & 1) + 2 * ((cc >> 1) & 1) + ((cc >> 2) & 1); \
            hidp[((size_t)(t) * 8 + sl) * 128 + 8 * (8 * (h) + v) + r8] = p[0]; } while (0)
        unsigned ikA[8], ikB[8]; u32x4 nA0, nA1, nB0, nB1, ga[8], gb[8]; float nf[16];
        int t = rk + 32 * wave, t1 = t + 256;
        if (t < ntok) TLOAD(ikA, nA0, nA1, t);
        if (t1 < ntok) TLOAD(ikB, nB0, nB1, t1);
        if (t < ntok) GLOAD(ga, ikA, 0);
#pragma unroll 1
        while (t < ntok) {
            GLOAD(gb, ikA, 1); NUNPK(nA0, nA1);
            const int t2 = t + 512;
            if (t2 < ntok) TLOAD(ikA, nA0, nA1, t2);
            HDOT(ga, t, 0);
            if (t1 < ntok) GLOAD(ga, ikB, 0);
            HDOT(gb, t, 1);
            if (t1 >= ntok) break;
            GLOAD(gb, ikB, 1); NUNPK(nB0, nB1);
            const int t3 = t1 + 512;
            if (t3 < ntok) TLOAD(ikB, nB0, nB1, t3);
            HDOT(ga, t1, 0);
            if (t2 < ntok) GLOAD(ga, ikA, 0);
            HDOT(gb, t1, 1);
            t = t2; t1 = t3;
        }
#undef TLOAD
#undef GLOAD
#undef NUNPK
#undef HDOT
    }
    GBAR();
    for (int rp = (FK_REP_SUB == 6 ? 1 : 0); rp >= 0; --rp) { const int dry = dry_in | rp;
        const unsigned char* Vs = wsp<unsigned char>(A, W.vb) + (size_t)sl * 16384 * 128; const unsigned cc16 = 16u * (unsigned)cc;
#define TLOADI(IK, t) do { const u32x4 i0_ = *(const u32x4*)(pidx + (size_t)(t) * 128 + r8 * 16), i1_ = *(const u32x4*)(pidx + (size_t)(t) * 128 + r8 * 16 + 8); \
            IK[0] = i0_.x; IK[1] = i0_.y; IK[2] = i0_.z; IK[3] = i0_.w; IK[4] = i1_.x; IK[5] = i1_.y; IK[6] = i1_.z; IK[7] = i1_.w; } while (0)
#define TLOADH(H, PGV, t) do { const float* hp_ = hidp + (size_t)(t) * 1024 + lane; _Pragma("unroll") for (int q = 0; q < 8; ++q) { H[2 * q] = hp_[q * 128]; H[2 * q + 1] = hp_[q * 128 + 64]; } \
            PGV[0] = pgw[(size_t)(t) * 128 + lane]; PGV[1] = pgw[(size_t)(t) * 128 + 64 + lane]; } while (0)
#define GLOAD2(GB, IK, h) do { _Pragma("unroll") for (int i = 0; i < 8; ++i) GB[i] = *(const u32x4*)(Vs + (((IK[4 * (h) + (i >> 1)] >> (16 * (i & 1))) & 0xffffu) * 128u + cc16)); } while (0)
#define WCALC(H, PGV) do { float h0 = 0.f, h1 = 0.f; _Pragma("unroll") for (int q = 0; q < 8; ++q) { h0 += H[2 * q]; h1 += H[2 * q + 1]; } h0 *= (1.f / SU); h1 *= (1.f / SU); \
            w0 = PGV[0] * 0.5f * h0 * (1.f + erff(h0 * 0.70710678118654752f)) * (1.f / SV); w1 = PGV[1] * 0.5f * h1 * (1.f + erff(h1 * 0.70710678118654752f)) * (1.f / SV); } while (0)
#define VACC(GB, h) do { _Pragma("unroll") for (int i = 0; i < 8; ++i) { const float w = __shfl((h) ? w1 : w0, 8 * i + r8); const unsigned aw[4] = {GB[i].x, GB[i].y, GB[i].z, GB[i].w}; \
                _Pragma("unroll") for (int q = 0; q < 4; ++q) { const f32x2 lo = __builtin_amdgcn_cvt_pk_f32_fp8(aw[q], false), hh = __builtin_amdgcn_cvt_pk_f32_fp8(aw[q], true); const f32x2 w2 = {w, w}; \
                    f32x2 ya = {y[4 * q], y[4 * q + 1]}, yb = {y[4 * q + 2], y[4 * q + 3]}; ya = w2 * lo + ya; yb = w2 * hh + yb; y[4 * q] = ya[0]; y[4 * q + 1] = ya[1]; y[4 * q + 2] = yb[0]; y[4 * q + 3] = yb[1]; } } } while (0)
#define XUPD(t) do { \
            _Pragma("unroll") for (int q = 0; q < 8; ++q) { const float send = (r8 & 1) ? y[q] : y[q + 8], keep = (r8 & 1) ? y[q + 8] : y[q]; y[q] = keep + __shfl_xor(send, 8); } \
            _Pragma("unroll") for (int q = 0; q < 4; ++q) { const float send = (r8 & 2) ? y[q] : y[q + 4], keep = (r8 & 2) ? y[q + 4] : y[q]; y[q] = keep + __shfl_xor(send, 16); } \
            _Pragma("unroll") for (int q = 0; q < 2; ++q) { const float send = (r8 & 4) ? y[q] : y[q + 2], keep = (r8 & 4) ? y[q + 2] : y[q]; y[q] = keep + __shfl_xor(send, 32); } \
            const int col = 128 * sl + 16 * cc + 8 * (r8 & 1) + 4 * ((r8 >> 1) & 1) + 2 * ((r8 >> 2) & 1); const bool lat_ = (t) < NLAT; \
            float* xr_ = (lat_ ? A->xl + (size_t)(t) * DM : wsp<float>(A, W.xc) + (size_t)((t) - NLAT) * DM) + col; \
            const float* gt_ = mod + (size_t)(lat_ ? (t) / SEQ : 8) * 6144 + 5 * 1024 + col; \
            f32x2 xv_ = *(const f32x2*)xr_; const f32x2 gv_ = *(const f32x2*)gt_; xv_[0] += gv_[0] * y[0]; xv_[1] += gv_[1] * y[1]; if (!dry) *(f32x2*)xr_ = xv_; } while (0)
        unsigned ikA[8], ikB[8]; float hN[16], pgN[2]; u32x4 ga[8], gb[8]; float y[16], w0, w1;
        int t = rk + 32 * wave, t1 = t + 256;
        if (t < ntok) { TLOADI(ikA, t); TLOADH(hN, pgN, t); }
        if (t1 < ntok) TLOADI(ikB, t1);
        if (t < ntok) GLOAD2(ga, ikA, 0);
#pragma unroll 1
        while (t < ntok) {
            WCALC(hN, pgN);
            if (t1 < ntok) TLOADH(hN, pgN, t1);
            GLOAD2(gb, ikA, 1);
            const int t2 = t + 512;
            if (t2 < ntok) TLOADI(ikA, t2);
#pragma unroll
            for (int i = 0; i < 16; ++i) y[i] = 0.f;
            VACC(ga, 0);
            if (t1 < ntok) GLOAD2(ga, ikB, 0);
            VACC(gb, 1); XUPD(t);
            if (t1 >= ntok) break;
            WCALC(hN, pgN);
            if (t2 < ntok) TLOADH(hN, pgN, t2);
            GLOAD2(gb, ikB, 1);
            const int t3 = t1 + 512;
            if (t3 < ntok) TLOADI(ikB, t3);
#pragma unroll
            for (int i = 0; i < 16; ++i) y[i] = 0.f;
            VACC(ga, 0);
            if (t2 < ntok) GLOAD2(ga, ikA, 0);
            VACC(gb, 1); XUPD(t1);
            t = t2; t1 = t3;
        }
#undef TLOADI
#undef TLOADH
#undef GLOAD2
#undef WCALC
#undef VACC
#undef XUPD
    }
    if (l == 0 && !dry) {
        GBAR();
        const float* mod1 = wsp<float>(A, W.mod) + (size_t)9 * 6144; const int gw = vcu * NWAVES + wave, NGW = G * NWAVES;
        for (int t = gw; t < NTOK; t += NGW) { const bool lat = t < NLAT; const int mr = lat ? t / SEQ : 8;
            const float* xr = lat ? A->xl + (size_t)t * DM : wsp<float>(A, W.xc) + (size_t)(t - NLAT) * DM;
            modulate_row_bf16(xr, FIN(6) + DM, mod1 + (size_t)mr * 6144 + 1024, mod1 + (size_t)mr * 6144, wsp<bf16_t>(A, W.xn) + (size_t)t * DM, lane); }
    }
}
#undef GBAR
}
__device__ __forceinline__ void phase_peer(AP A, FK_LAS unsigned char* lds, int l, int vcu, int G, int dry, const XcdBarrier bar, const int use_bar) { peer::phase(A, lds, l, vcu, G, dry, bar, use_bar); }
constexpr int N_PHASES = 16;
__global__ void __launch_bounds__(NTHR, 2) mega(Args A_unused) {
    extern __shared__ __attribute__((aligned(16))) unsigned char lds_raw[];
    FK_LAS unsigned char* lds = (FK_LAS unsigned char*)lds_raw;
    const int tid = threadIdx.x;
    AP A0 = (AP)__builtin_amdgcn_kernarg_segment_ptr();
#define AA() opaque_args(A0)
    const int G = gridDim.x, bx = blockIdx.x, vcu = (G % 8 == 0) ? (bx % 8) * (G / 8) + bx / 8 : bx;
    volatile FK_LAS unsigned* MISC = (volatile FK_LAS unsigned*)(lds + LDS_MISC);
    if (tid < 64) MISC[tid] = 0u;
    __syncthreads();
    XcdBarrier bar; bar.bar = wsp<unsigned>(A0, W.ctl) + 1024; bar.x = 0; bar.st = MISC + 8;
    if (A0->use_bar) bar = xcd_barrier_post(wsp<unsigned>(A0, W.ctl) + 1024, MISC + 8);
    const int lo = A0->ph_lo, hi = A0->ph_hi;
#define IN(k) (lo <= (k) && (k) < hi)
#ifndef FK_REP_PHASE
#define FK_REP_PHASE -1
#endif
#define REP(k) for (int rep_ = (FK_REP_PHASE == (k)) ? 1 : 0; rep_ >= 0; --rep_)
#ifndef FK_REP_BAR
#define FK_REP_BAR 0
#endif
#define SEAM(k) do { if (IN(k) && IN((k) + 1)) { xcd_barrier(bar); if (FK_REP_BAR) xcd_barrier(bar); } } while (0)
#ifndef FK_REP_ALL
#define FK_REP_ALL 0
#endif
    for (int pass = FK_REP_ALL ? 1 : 0; pass >= 0; --pass) {
    if (IN(0)) REP(0) phase_pa(AA(), lds, vcu, G);
    SEAM(0);
    if (IN(1)) REP(1) phase_pb(AA(), vcu, G);
    SEAM(1);
    for (int l = 0; l < 2; ++l) {
        const int pb = 2 + 7 * l;
        if (IN(pb + 0)) REP(pb + 0) phase_inproj(AA(), lds, l, G);
        SEAM(pb + 0);
#ifdef FK_HAVE_MIX
        if (IN(pb + 1)) REP(pb + 1) phase_mix(AA(), lds, l, vcu, G);
#endif
        SEAM(pb + 1);
#ifdef FK_HAVE_MERGE
        if (IN(pb + 2)) REP(pb + 2) phase_merge(AA(), lds, l, G);
#endif
        SEAM(pb + 2);
#ifdef FK_HAVE_OUT
        if (IN(pb + 3)) REP(pb + 3) phase_outproj(AA(), lds, l, G, rep_ | (pass & l));
#endif
        SEAM(pb + 3);
#ifdef FK_HAVE_NORM
        if (IN(pb + 4)) REP(pb + 4) phase_norm(AA(), l, vcu, G);
#endif
        SEAM(pb + 4);
#ifdef FK_HAVE_PQ
        if (IN(pb + 5)) REP(pb + 5) phase_peerq(AA(), lds, l, G);
#endif
        SEAM(pb + 5);
#ifdef FK_HAVE_PEER
        if (IN(pb + 6)) REP(pb + 6) phase_peer(AA(), lds, l, vcu, G, rep_ | pass, bar, A0->use_bar);
#endif
        SEAM(pb + 6);
    }
    if (pass) xcd_barrier(bar);
    }
#undef IN
#undef SEAM
}
inline void launch(void* const* d_in, float* out, unsigned char* ws, float* xl, int lo, int hi, bool one_launch, hipStream_t st) {
    static int ok = 0;
    if (!ok) { if (hipFuncSetAttribute((const void*)mega, hipFuncAttributeMaxDynamicSharedMemorySize, LDS_BYTES) != hipSuccess) { fprintf(stderr, "hipFuncSetAttribute failed\n"); return; } ok = 1; }
    (void)hipMemsetAsync(ws + W.ctl, 0, 65536, st);
    Args a{}; for (int i = 0; i < 30; ++i) a.in[i] = (const float*)d_in[i];
    a.out = out; a.ws = ws; a.xl = xl; a.pad = 0;
    if (one_launch) { a.ph_lo = lo; a.ph_hi = hi; a.use_bar = 1; hipLaunchKernelGGL(mega, dim3(256), dim3(NTHR), LDS_BYTES, st, a); }
    else for (int p = lo; p < hi; ++p) { a.ph_lo = p; a.ph_hi = p + 1; a.use_bar = 0; hipLaunchKernelGGL(mega, dim3(256), dim3(NTHR), LDS_BYTES, st, a); }
}
}
#ifndef FK_ONE_LAUNCH
#define FK_ONE_LAUNCH 1
#endif
extern "C" void kernel_launch(void* const* d_in, const int* in_sizes, int n_in, void* d_out, int out_size, void* d_ws, size_t ws_size, hipStream_t stream) {
    if (n_in != 30 || ws_size < fk::W.end || out_size != fk::NLAT * 1024) { fprintf(stderr, "kernel_launch: n_in %d ws %zu (need %zu) out %d\n", n_in, ws_size, (size_t)fk::W.end, out_size); return; }
    fk::launch(d_in, (float*)d_out, (unsigned char*)d_ws, (float*)d_out, 0, fk::N_PHASES, FK_ONE_LAUNCH != 0, stream);
}
```

```cpp
#include <hip/hip_runtime.h>
#include <cstdio>
#include <cstdint>
#include <math.h>
#define FK_ONE_LAUNCH 1
namespace fk {
#ifndef FK_NT_STORE
#define FK_NT_STORE 1
#endif
#if FK_NT_STORE
#define ST_NT(p, v) __builtin_nontemporal_store((v), (p))
#else
#define ST_NT(p, v) (*(p) = (v))
#endif

#define FK_LAS __attribute__((address_space(3)))
typedef unsigned short bf16_t;
typedef short bf16x8 __attribute__((ext_vector_type(8)));
typedef float f32x4 __attribute__((ext_vector_type(4)));
typedef float f32x16 __attribute__((ext_vector_type(16)));
typedef unsigned u32x4 __attribute__((ext_vector_type(4)));
typedef unsigned u32x2 __attribute__((ext_vector_type(2)));
#ifndef FK_NB
#define FK_NB 8
#endif
constexpr int NB = FK_NB, SEQ = 2048, DM = 1024, CTX = 256, KALL = SEQ + CTX;
constexpr int NLAT = NB * SEQ, NCTX = NB * CTX, NTOK = NLAT + NCTX;
constexpr int PINF = 5888;
constexpr int R_HY = 0, R_FZ = 768, R_Q = 1280, R_K = 1792, R_V = 2304, R_G = 2816;
constexpr float EPS = 1e-6f;
constexpr int NWAVES = 8, NTHR = 512;
constexpr int TLL = 4224, TLC = 576;

__device__ __forceinline__ unsigned f2bf(float f) { unsigned u = __builtin_bit_cast(unsigned, f); return (u + 0x7fffu + ((u >> 16) & 1u)) >> 16; }
__device__ __forceinline__ unsigned pk2(float lo, float hi) { return f2bf(lo) | (f2bf(hi) << 16); }
__device__ __forceinline__ float bf2f(unsigned short h) { return __builtin_bit_cast(float, (unsigned)h << 16); }
__device__ __forceinline__ float bflo(unsigned w) { return __builtin_bit_cast(float, w << 16); }
__device__ __forceinline__ float bfhi(unsigned w) { return __builtin_bit_cast(float, w & 0xffff0000u); }
typedef __bf16 bf16x2_t __attribute__((ext_vector_type(2)));
__device__ __forceinline__ unsigned cvt_pk_bf16(float lo, float hi) { bf16x2_t v = {(__bf16)lo, (__bf16)hi}; return __builtin_bit_cast(unsigned, v); }
typedef float f32x2 __attribute__((ext_vector_type(2)));
constexpr float SU = 64.f, SV = 4.f;
__device__ __forceinline__ unsigned pk4_fp8(float a, float b, float c, float d) { unsigned w = __builtin_amdgcn_cvt_pk_fp8_f32(a, b, 0, false); return __builtin_amdgcn_cvt_pk_fp8_f32(c, d, w, true); }
__device__ __forceinline__ size_t tab_chunk_off(size_t i  ) { const size_t e = i >> 6, c16 = i & 63; return (((c16 >> 3) * 16384 + e) * 128) + (c16 & 7) * 16; }
__device__ __forceinline__ void cvt16_fp8(const float* src, unsigned char* dst, float sc) {
    const f32x4 x0 = *(const f32x4*)(src), x1 = *(const f32x4*)(src + 4), x2 = *(const f32x4*)(src + 8), x3 = *(const f32x4*)(src + 12);
    u32x4 o; o.x = pk4_fp8(x0[0] * sc, x0[1] * sc, x0[2] * sc, x0[3] * sc); o.y = pk4_fp8(x1[0] * sc, x1[1] * sc, x1[2] * sc, x1[3] * sc);
    o.z = pk4_fp8(x2[0] * sc, x2[1] * sc, x2[2] * sc, x2[3] * sc); o.w = pk4_fp8(x3[0] * sc, x3[1] * sc, x3[2] * sc, x3[3] * sc);
    *(u32x4*)dst = o;
}
__device__ __forceinline__ float wave_sum(float v) {
#pragma unroll
    for (int o = 32; o > 0; o >>= 1) v += __shfl_xor(v, o);
    return v;
}

struct WS {
    size_t ctl, mod, misc, h3l, h3c, tapl, tapc, w_in, w_mrg, w_out, w_q, keys, ub, vb, dftl, dftc;
    size_t xn, nn, hyt, ftl, ftc, q, qc, k, vt, g, attlo, atthi, hyo, fno, y, xl, xc, pq, pidx, pg, stash, ub1, vb1, end;
};
__host__ __device__ constexpr size_t al(size_t x) { return (x + 4095) / 4096 * 4096; }
__host__ __device__ constexpr WS make_ws() {
    WS w{}; size_t o = 0;
    w.ctl = o; o += 65536;
    w.mod = o; o += al((size_t)2 * 9 * 6144 * 4);
    w.misc = o; o += al((size_t)12 << 20);
    w.tapl = o; o += al((size_t)2 * 2 * 256 * TLL * 2);
    w.tapc = o; o += al((size_t)2 * 2 * 256 * TLC * 2);
    w.w_in = o; o += al((size_t)2 * PINF * 1024 * 2);
    w.w_mrg = o; o += al((size_t)2 * 4 * 1024 * 256 * 2);
    w.w_out = o; o += al((size_t)2 * 1024 * 1024 * 2);
    w.w_q = o; o += al((size_t)2 * 2048 * 1024 * 2);
    w.keys = o; o += al((size_t)2 * 16 * 128 * 128 * 2);
    w.ub = o; o += al((size_t)16384 * 1024);
    w.vb = o; o += al((size_t)16384 * 1024);
    w.ub1 = o; o += al((size_t)16384 * 1024);
    w.vb1 = o; o += al((size_t)16384 * 1024);
    w.dftl = o; o += al((size_t)2048 * 4096 * 2);
    w.dftc = o; o += al((size_t)256 * 512 * 2);
    w.xn = o; o += al((size_t)NTOK * 1024 * 2);
    w.nn = o; w.stash = o; { size_t a = al((size_t)NTOK * 1024 * 2), b = al((size_t)256 * 512 * 128 * 4); o += a > b ? a : b; }
    w.hyt = o; w.y = o; { size_t a = al((size_t)768 * NTOK * 2) + al((size_t)NB * 256 * 4096 * 2) + al((size_t)NB * 256 * 512 * 2), b = al((size_t)NTOK * 1024 * 2);
        w.ftl = o + al((size_t)768 * NTOK * 2); w.ftc = w.ftl + al((size_t)NB * 256 * 4096 * 2); o += a > b ? a : b; }
    w.q = o; o += al((size_t)NB * 8 * 2048 * 64 * 2);
    w.qc = o; o += al((size_t)NB * 8 * 256 * 64 * 2);
    w.k = o; o += al((size_t)NB * 8 * KALL * 64 * 2);
    w.vt = o; o += al((size_t)NB * 4 * 128 * KALL * 2);
    w.g = o; w.pq = o; w.h3l = o; { size_t a = al((size_t)NTOK * 3072 * 2), b = al((size_t)2 * 2048 * 1024 * 4) + al((size_t)2 * 256 * 1024 * 4);
        w.h3c = o + al((size_t)2 * 2048 * 1024 * 4); o += a > b ? a : b; }
    w.attlo = o; o += al((size_t)NTOK * 256 * 2);
    w.atthi = o; o += al((size_t)NTOK * 256 * 2);
    w.hyo = o; o += al((size_t)NTOK * 256 * 2);
    w.fno = o; o += al((size_t)NTOK * 256 * 2);
    w.xl = o; o += (NB == 8) ? 0 : al((size_t)NLAT * 1024 * 4);
    w.xc = o; o += al((size_t)NCTX * 1024 * 4);
    w.pidx = o; o += al((size_t)NTOK * 128 * 4);
    w.pg = o; o += al((size_t)NTOK * 128 * 4);
    w.end = o; return w;
}
constexpr WS W = make_ws();
constexpr int MI_LAM = 0, MI_ROPE = 64, MI_HYINV = 4096, MI_HYPART = 8192;

constexpr int BM = 256, BK = 64, HALF = 128, HTB = HALF * BK * 2, STAGE_BYTES = 8 * HTB;
__host__ __device__ __forceinline__ int lds_byte(int r, int c) { const int st = (r >> 4) * 2 + (c >> 5), rr = r & 15, cc = c & 31, ob = rr * 64 + cc * 2; return st * 1024 + (ob ^ (((ob >> 9) & 1) << 5)); }
__host__ __device__ __forceinline__ void stage_rc(int b, int& R, int& C) { const int st = b / 1024, sb = b % 1024, swz = sb ^ (((sb >> 9) & 1) << 5); R = (st >> 1) * 16 + swz / 64; C = (st & 1) * 32 + (swz % 64) / 2; }
__host__ __device__ __forceinline__ int perm32(int rho) { const int n = rho >> 4, i = rho & 15; return 8 * (i >> 2) + 4 * n + (i & 3); }

struct Unit { const char* a; const char* b; int pm, pn, kind, aux; };
typedef f32x4 Acc[2][2][4][2];

template <class Sched, class Epi>
__device__ __forceinline__ void gemm_phase(FK_LAS unsigned char* lds, const int K, const Sched& S, const Epi& E) {
    int tid = threadIdx.x; asm volatile("" : "+v"(tid));
    const int wid = __builtin_amdgcn_readfirstlane(tid >> 6), lane = tid & 63, wr = wid >> 2, wc = wid & 3, fr = lane & 15, fq = lane >> 4;
    const int nt = K / BK;
    unsigned voffA[2], voffB[2];
#pragma unroll
    for (int i = 0; i < 2; ++i) { int R, C; stage_rc(tid * 16 + i * 8192, R, C); const int Rb = (R & ~31) + perm32(R & 31);
        voffA[i] = (unsigned)(R * K + C) * 2u; voffB[i] = (unsigned)(Rb * K + C) * 2u; }
    const size_t kstep = (size_t)(BK * 2);
    const size_t hstep = (size_t)HALF * K * 2;
    const unsigned ldsw = (unsigned)wid * 1024u;
    const int aoff = lds_byte(wr * 64 + fr, fq * 8), boff = lds_byte(wc * 32 + fr, fq * 8);
#define PG8_SA(b, h) (((b) * 2 + (h)) * HTB)
#define PG8_SB(b, h) ((4 + (b) * 2 + (h)) * HTB)
#define PG8_STAGE(bufoff, gbase, voff) do { _Pragma("unroll") for (int _i = 0; _i < 2; ++_i) \
        __builtin_amdgcn_global_load_lds((const unsigned*)((const char*)(gbase) + (voff)[_i]), (FK_LAS unsigned*)(lds + (bufoff) + ldsw + _i * 8192), 16, 0, 0); } while (0)
#define PG8_LDA(dst, b, h) do { _Pragma("unroll") for (int m = 0; m < 4; ++m) _Pragma("unroll") for (int k = 0; k < 2; ++k) dst[m][k] = *(const FK_LAS bf16x8*)(lds + PG8_SA(b, h) + aoff + m * 2048 + k * 1024); } while (0)
#define PG8_LDB(dst, b, h) do { _Pragma("unroll") for (int n = 0; n < 2; ++n) _Pragma("unroll") for (int k = 0; k < 2; ++k) dst[n][k] = *(const FK_LAS bf16x8*)(lds + PG8_SB(b, h) + boff + n * 2048 + k * 1024); } while (0)
#define PG8_MMA(ai, bj, At, Bt) do { __builtin_amdgcn_s_setprio(1); _Pragma("unroll") for (int m = 0; m < 4; ++m) _Pragma("unroll") for (int n = 0; n < 2; ++n) _Pragma("unroll") for (int k = 0; k < 2; ++k) \
        acc[ai][bj][m][n] = __builtin_amdgcn_mfma_f32_16x16x32_bf16(Bt[n][k], At[m][k], acc[ai][bj][m][n], 0, 0, 0); __builtin_amdgcn_s_setprio(0); } while (0)
#define PG8_WAIT_V(n) asm volatile("s_waitcnt vmcnt(" #n ")" ::: "memory")
#define PG8_WAIT_L(n) asm volatile("s_waitcnt lgkmcnt(" #n ")" ::: "memory")
#define PG8_BAR __builtin_amdgcn_s_barrier()
#define PG8_SCHED __builtin_amdgcn_sched_barrier(0)
    Unit cur, nxt; int ui = 0;
    if (!S.next(0, cur)) return;
    Acc acc;
#pragma unroll
    for (int a = 0; a < 2; ++a)
#pragma unroll
        for (int b = 0; b < 2; ++b)
#pragma unroll
            for (int m = 0; m < 4; ++m)
#pragma unroll
                for (int n = 0; n < 2; ++n) acc[a][b][m][n] = (f32x4){0.f, 0.f, 0.f, 0.f};
    bf16x8 At[4][2], B0[2][2], B1[2][2];
    const char* cA = cur.a; const char* cB = cur.b;
    PG8_STAGE(PG8_SB(0, 0), cB, voffB); PG8_STAGE(PG8_SB(0, 1), cB + hstep, voffB); PG8_STAGE(PG8_SA(0, 0), cA, voffA); PG8_STAGE(PG8_SA(0, 1), cA + hstep, voffA);
    if (wr == 1) PG8_BAR;
    PG8_WAIT_V(2); PG8_BAR;
    PG8_STAGE(PG8_SB(1, 0), cB + kstep, voffB); PG8_STAGE(PG8_SA(1, 0), cA + kstep, voffA); PG8_STAGE(PG8_SB(1, 1), cB + hstep + kstep, voffB);
    PG8_WAIT_V(6); PG8_BAR;
    for (;;) {
        const bool has_next = S.next(ui + 1, nxt);
        const char* nA = has_next ? nxt.a : cA; const char* nB = has_next ? nxt.b : cB;
        for (int t = 0; t < nt; t += 2) {
            const bool last = (t == nt - 2);
            const char* a1 = cA + (size_t)(t + 1) * kstep;
            const char* a2 = last ? nA : cA + (size_t)(t + 2) * kstep; const char* b2 = last ? nB : cB + (size_t)(t + 2) * kstep;
            const char* a3 = a2 + kstep; const char* b3 = b2 + kstep;
            PG8_LDB(B0, 0, 0); PG8_LDB(B1, 0, 1); PG8_SCHED; PG8_LDA(At, 0, 0); PG8_STAGE(PG8_SA(1, 1), a1 + hstep, voffA);
            PG8_WAIT_V(8); PG8_WAIT_L(0); PG8_BAR; PG8_MMA(0, 0, At, B0); PG8_MMA(0, 1, At, B1); PG8_BAR; PG8_SCHED;
            PG8_LDA(At, 0, 1); PG8_STAGE(PG8_SB(0, 0), b2, voffB); PG8_STAGE(PG8_SB(0, 1), b2 + hstep, voffB); PG8_STAGE(PG8_SA(0, 0), a2, voffA);
            PG8_WAIT_V(8); PG8_WAIT_L(0); PG8_BAR; PG8_MMA(1, 0, At, B0); PG8_MMA(1, 1, At, B1); PG8_BAR; PG8_SCHED;
            PG8_LDB(B0, 1, 0); PG8_LDB(B1, 1, 1); PG8_SCHED; PG8_LDA(At, 1, 0); PG8_STAGE(PG8_SA(0, 1), a2 + hstep, voffA);
            PG8_WAIT_V(8); PG8_WAIT_L(0); PG8_BAR; PG8_MMA(0, 0, At, B0); PG8_MMA(0, 1, At, B1); PG8_BAR; PG8_SCHED;
            PG8_LDA(At, 1, 1); PG8_STAGE(PG8_SB(1, 0), b3, voffB); PG8_STAGE(PG8_SB(1, 1), b3 + hstep, voffB); PG8_STAGE(PG8_SA(1, 0), a3, voffA);
            PG8_WAIT_V(8); PG8_WAIT_L(0); PG8_BAR; PG8_MMA(1, 0, At, B0); PG8_MMA(1, 1, At, B1); PG8_BAR; PG8_SCHED;
        }
        if (wr == 0) PG8_BAR;
        int fr2 = fr, fq2 = fq; asm volatile("" : "+v"(fr2), "+v"(fq2));
        const bool zero = E(acc, cur, wr, wc, fr2, fq2);
        if (!has_next) break;
        if (zero) {
#pragma unroll
            for (int a = 0; a < 2; ++a)
#pragma unroll
                for (int b = 0; b < 2; ++b)
#pragma unroll
                    for (int m = 0; m < 4; ++m)
#pragma unroll
                        for (int n = 0; n < 2; ++n) acc[a][b][m][n] = (f32x4){0.f, 0.f, 0.f, 0.f};
        }
        cur = nxt; cA = nA; cB = nB; ++ui;
        if (wr == 1) PG8_BAR;
    }
    PG8_WAIT_V(0);
    PG8_BAR;
#undef PG8_SA
#undef PG8_SB
#undef PG8_STAGE
#undef PG8_LDA
#undef PG8_LDB
#undef PG8_MMA
#undef PG8_WAIT_V
#undef PG8_WAIT_L
#undef PG8_BAR
#undef PG8_SCHED
}
#define XB_TMO      128
#define XB_XCNT(j)  (256  + 64 * (j))
#define XB_XSUB(j)  (1280 + 64 * (j))
#define XB_XGEN(j)  (2304 + 64 * (j))
#define XB_TOP      3328
#define XB_TOPGEN   3392
#define XCD_BAR_WORDS 3456
#define XB_SPIN_CAP (1u << 20)
__device__ __forceinline__ unsigned xb_ld(unsigned* p)              { return __hip_atomic_load(p, __ATOMIC_RELAXED, __HIP_MEMORY_SCOPE_AGENT); }
__device__ __forceinline__ unsigned xb_add(unsigned* p, unsigned v) { return __hip_atomic_fetch_add(p, v, __ATOMIC_RELAXED, __HIP_MEMORY_SCOPE_AGENT); }
__device__ __forceinline__ unsigned xb_xcc_id() { return (unsigned)__builtin_amdgcn_s_getreg((3 << 11) | 20) & 0xFu; }
#define XB_SPIN(cond, bar) do { unsigned _sp = 0; while (cond) { __builtin_amdgcn_s_sleep(1); \
    if ((++_sp & 255u) == 0u) { if (xb_ld(&(bar)[XB_TMO])) break; if (_sp > XB_SPIN_CAP) { atomicAdd(&(bar)[XB_TMO], 1u); break; } } } } while (0)
struct XcdBarrier { unsigned* bar; unsigned x; volatile FK_LAS unsigned* st; };
__device__ __forceinline__ XcdBarrier xcd_barrier_post(unsigned* bar, volatile FK_LAS unsigned* st) {
    XcdBarrier b; b.bar = bar; b.x = xb_xcc_id(); b.st = st;
    if (threadIdx.x == 0) (void)xb_add(&bar[XB_XCNT(b.x)], 1u);
    return b;
}
__device__ __forceinline__ void xcd_barrier_complete(unsigned* bar, unsigned x, unsigned& nloc, unsigned& nx) {
    const unsigned G = gridDim.x * gridDim.y * gridDim.z;
    unsigned sum, cnt, mine, sp = 0u;
    for (;;) {
        sum = 0u; cnt = 0u; mine = 0u;
#pragma unroll
        for (unsigned j = 0; j < 16; ++j) { const unsigned c = xb_ld(&bar[XB_XCNT(j)]); sum += c; cnt += (c > 0u) ? 1u : 0u; mine = (j == x) ? c : mine; }
        if (sum == G) break;
        __builtin_amdgcn_s_sleep(1);
        if ((++sp & 255u) == 0u) { if (xb_ld(&bar[XB_TMO])) break; if (sp > XB_SPIN_CAP) { atomicAdd(&bar[XB_TMO], 1u); break; } }
    }
    nloc = mine > 0u ? mine : 1u; nx = cnt > 0u ? cnt : 1u;
}
__device__ __forceinline__ void xcd_barrier(const XcdBarrier& b) {
    asm volatile("s_waitcnt vmcnt(0)" ::: "memory");
    __syncthreads();
    if (threadIdx.x == 0) {
        unsigned* bar = b.bar;
        __builtin_amdgcn_s_waitcnt(0);
        unsigned nloc = b.st[0], nx = b.st[1];
        if (nloc == 0u) { xcd_barrier_complete(bar, b.x, nloc, nx); b.st[0] = nloc; b.st[1] = nx; }
        const unsigned old = xb_add(&bar[XB_XSUB(b.x)], 1u);
        const unsigned gen = old / nloc;
        if (old + 1u == (gen + 1u) * nloc) {
            __builtin_amdgcn_fence(__ATOMIC_RELEASE, "agent");
            asm volatile("s_waitcnt vmcnt(0)" ::: "memory");
            const unsigned og = xb_add(&bar[XB_TOP], 1u);
            const unsigned tg = og / nx;
            if (og + 1u == (tg + 1u) * nx) xb_add(&bar[XB_TOPGEN], 1u);
            else XB_SPIN(xb_ld(&bar[XB_TOPGEN]) == tg, bar);
            __builtin_amdgcn_fence(__ATOMIC_ACQUIRE, "agent");
            asm volatile("s_waitcnt vmcnt(0)" ::: "memory");
        } else {
            XB_SPIN(xb_ld(&bar[XB_TOPGEN]) == gen, bar);
            __builtin_amdgcn_fence(__ATOMIC_ACQUIRE, "agent");
            asm volatile("s_waitcnt vmcnt(0)" ::: "memory");
        }
    }
    __syncthreads();
}

struct Args { const float* in[30]; float* out; unsigned char* ws; float* xl; int ph_lo, ph_hi, use_bar, pad; };
constexpr int LDS_MISC = 155648, LDS_BYTES = 155648 + 256;

struct Ctx {
    const Args* a; FK_LAS unsigned char* lds; int tid, lane, wave, vcu, G;
};
typedef const Args __attribute__((address_space(4)))* AP;
#define FIN(i) (A->in[i])
template <class T> __device__ __forceinline__ T* wsp(AP A, size_t off) { return (T*)(A->ws + off); }
__device__ __forceinline__ int opaque_tid() { int t = threadIdx.x; asm volatile("" : "+v"(t)); return t; }
__device__ __forceinline__ AP opaque_args(AP a) { asm volatile("" : "+s"(a)); return a; }

__device__ __forceinline__ int inproj_src_col(int p) {
    if (p < R_FZ) return p;
    if (p >= R_V) return p - R_V + 2048;
    const int q0 = p - R_Q, tile = q0 >> 8, pl = q0 & 255;
    const int bj = pl >> 7, wc = (pl >> 5) & 3, fq = (pl >> 3) & 3, e = pl & 7;
    return 1024 + tile * 256 + 64 * wc + 32 * (fq >> 1) + 16 * bj + 8 * (fq & 1) + e;
}
template <class ColFn>
__device__ __forceinline__ void transpose_item(const float* src, int ldsrc, int ksrc0, bf16_t* dst, int Kd, int p0, int k0, FK_LAS float* scr, int lane, ColFn col) {
    const int cidx = col(p0 + (lane & 31));
    float tv[32];
#pragma unroll
    for (int i = 0; i < 32; ++i) tv[i] = src[(size_t)(ksrc0 + k0 + 2 * i + (lane >> 5)) * ldsrc + cidx];
#pragma unroll
    for (int i = 0; i < 32; ++i) scr[(2 * i + (lane >> 5)) * 33 + (lane & 31)] = tv[i];
    asm volatile("s_waitcnt lgkmcnt(0)" ::: "memory");
    const int c = lane & 7;
#pragma unroll
    for (int j = 0; j < 4; ++j) { const int n = (lane >> 3) + 8 * j; const FK_LAS float* s = scr + (8 * c) * 33 + n;
        u32x4 o; o.x = pk2(s[0 * 33], s[1 * 33]); o.y = pk2(s[2 * 33], s[3 * 33]); o.z = pk2(s[4 * 33], s[5 * 33]); o.w = pk2(s[6 * 33], s[7 * 33]);
        *(u32x4*)(dst + (size_t)(p0 + n) * Kd + k0 + 8 * c) = o; }
    asm volatile("s_waitcnt lgkmcnt(0)" ::: "memory");
}
__device__ __forceinline__ void conv_tables(AP A, int l, unsigned char* ub, unsigned char* vb, int widx, int nw, int tid, int part = 0) {
    asm volatile("" : "+v"(widx));
    const size_t nUV = (size_t)16384 * 1024 / 16, gt = (size_t)widx * NTHR + tid, NGT = (size_t)nw * NTHR;
    const float* us = FIN(28) + (size_t)l * 16384 * 1024; const float* vs = FIN(29) + (size_t)l * 16384 * 1024;
    const size_t ibeg = part == 2 ? nUV : 0, iend = part == 1 ? nUV : 2 * nUV;
    for (size_t i0 = ibeg + gt; i0 < iend; i0 += 2 * NGT) {
#pragma unroll
        for (int rep = 0; rep < 2; ++rep) { const size_t i = i0 + rep * NGT; if (i >= iend) break;
            if (i < nUV) cvt16_fp8(us + i * 16, ub + tab_chunk_off(i), SU); else cvt16_fp8(vs + (i - nUV) * 16, vb + tab_chunk_off(i - nUV), SV); } }
}
struct IdCol { int off; __device__ int operator()(int p) const { return p + off; } };
struct InprojCol { __device__ int operator()(int p) const { return inproj_src_col(p); } };

__device__ __forceinline__ float* h3_ptr(AP A, int l, int big) { return big ? wsp<float>(A, W.h3l) + (size_t)l * 2048 * 1024 : wsp<float>(A, W.h3c) + (size_t)l * 256 * 1024; }
__device__ __forceinline__ void prep_transposes(AP A, FK_LAS unsigned char* lds, int l_lo, int l_hi, int gw, int NGW, int wave, int lane) {
        FK_LAS float* scr = (FK_LAS float*)(lds + wave * 16384);
        constexpr int I_IN = (PINF / 32) * 16;
        constexpr int I_M = (1024 / 32) * 4;
        constexpr int I_O = (1024 / 32) * 16, I_Q = (2048 / 32) * 16;
        constexpr int PER_L = I_IN + 4 * I_M + I_O + I_Q;
        for (int it = l_lo * PER_L + gw; it < l_hi * PER_L; it += NGW) {
            const int l = it / PER_L; int r = it % PER_L;
            if (r < I_IN) { const int p0 = (r >> 4) * 32, k0 = (r & 15) * 64;
                if (p0 >= R_FZ && p0 < R_Q) continue;
                transpose_item(FIN(8) + (size_t)l * 1024 * 5632, 5632, 0, wsp<bf16_t>(A, W.w_in) + (size_t)l * PINF * 1024, 1024, p0, k0, scr, lane, InprojCol{}); continue; }
            r -= I_IN;
            if (r < 4 * I_M) { const int seg = r / I_M, q = r % I_M, p0 = (q >> 2) * 32, k0 = (q & 3) * 64;
                const float* src = seg == 0 ? FIN(22) + (size_t)l * 256 * 1024 : seg == 1 ? FIN(23) + (size_t)l * 256 * 1024 : FIN(24) + (size_t)l * 512 * 1024;
                transpose_item(src, 1024, seg == 3 ? 256 : 0, wsp<bf16_t>(A, W.w_mrg) + ((size_t)l * 4 + seg) * 1024 * 256, 256, p0, k0, scr, lane, IdCol{0}); continue; }
            r -= 4 * I_M;
            if (r < I_O) { const int p0 = (r >> 4) * 32, k0 = (r & 15) * 64;
                transpose_item(FIN(25) + (size_t)l * 1024 * 1024, 1024, 0, wsp<bf16_t>(A, W.w_out) + (size_t)l * 1024 * 1024, 1024, p0, k0, scr, lane, IdCol{0}); continue; }
            r -= I_O;
            { const int p0 = (r >> 4) * 32, k0 = (r & 15) * 64;
                transpose_item(FIN(26) + (size_t)l * 1024 * 2048, 2048, 0, wsp<bf16_t>(A, W.w_q) + (size_t)l * 2048 * 1024, 1024, p0, k0, scr, lane, IdCol{0}); }
        }
}
__device__ __forceinline__ void prep_fz(AP A, const FK_LAS float* ctab, const FK_LAS float* stab, int tstride, int l_lo, int l_hi, size_t gt, size_t NGT) {
    for (size_t i = ((size_t)l_lo << 16) + gt; i < ((size_t)l_hi << 16); i += NGT) {
        const int k = (int)(i & 1023), mc = (int)((i >> 10) & 7), part = (int)((i >> 13) & 1), g = (int)((i >> 14) & 3), l = (int)(i >> 16);
        const float* src = FIN(8) + (size_t)l * 1024 * 5632 + (size_t)k * 5632 + 768 + g * 64;
        f32x4 sv[16];
#pragma unroll
        for (int q = 0; q < 16; ++q) sv[q] = *(const f32x4*)(src + 4 * q);
        const FK_LAS float* tb = part ? stab : ctab;
        bf16_t* dst = wsp<bf16_t>(A, W.w_in) + ((size_t)l * PINF + R_FZ + part * 256 + g * 64 + mc * 8) * 1024 + k;
#pragma unroll 1
        for (int mm = 0; mm < 8; ++mm) { const int m = mc * 8 + mm; float acc = 0.f;
#pragma unroll
            for (int q = 0; q < 16; ++q)
#pragma unroll
                for (int j = 0; j < 4; ++j) acc += sv[q][j] * tb[((m * (4 * q + j)) & 63) * tstride];
            dst[(size_t)mm * 1024] = (bf16_t)f2bf(acc); }
    }
}
__device__ __forceinline__ void prep_hyfilt(AP A, FK_LAS unsigned char* lds, int l_lo, int l_hi, int widx, int nw, int tid) {
    float* misc = wsp<float>(A, W.misc);
    {
        constexpr int HPP = 4;
        FK_LAS float* h1 = (FK_LAS float*)lds; FK_LAS float* h2 = h1 + HPP * 64; FK_LAS float* ft = h2 + HPP * 64;
        FK_LAS float* w1s = ft + HPP * 33 + 4; FK_LAS float* w2s = w1s + 33 * 64; FK_LAS float* b1s = w2s + 64 * 64; FK_LAS float* b2s = b1s + 64; FK_LAS float* fqs = b2s + 64;
        constexpr int IT_L = 2048 / HPP, IT_C = 256 / HPP, PER = IT_L + IT_C;
        int lcur = -1;
        constexpr int ER = 40;
        FK_LAS float* w3s = fqs + 64;
        float wv0[ER], wv1[ER];
#pragma unroll
        for (int e = 0; e < ER; ++e) { wv0[e] = 0.f; wv1[e] = 0.f; }
        for (int it = l_lo * PER + widx; it < l_hi * PER; it += nw) {
            const int l = it / PER, r = it % PER, big = r < IT_L, L = big ? 2048 : 256, p0 = (big ? r : r - IT_L) * HPP;
            __syncthreads();
            if (l != lcur) { lcur = l;
                for (int i = tid; i < 33 * 64; i += NTHR) w1s[i] = FIN(11)[l * 33 * 64 + i];
                for (int i = tid; i < 64 * 64; i += NTHR) w2s[i] = FIN(14)[l * 4096 + i];
                if (tid < 64) { b1s[tid] = FIN(12)[l * 64 + tid]; b2s[tid] = FIN(15)[l * 64 + tid]; fqs[tid] = FIN(13)[l * 64 + tid]; }
                const float* w3 = FIN(16) + (size_t)l * 65536 + tid;
#pragma unroll
                for (int e = 0; e < ER; ++e) { wv0[e] = w3[(size_t)e * 1024]; wv1[e] = w3[(size_t)e * 1024 + 512]; }
#pragma unroll
                for (int e = ER; e < 64; ++e) { w3s[(e - ER) * 1024 + tid] = w3[(size_t)e * 1024]; w3s[(e - ER) * 1024 + 512 + tid] = w3[(size_t)e * 1024 + 512]; } }
            for (int i = tid; i < HPP * 33; i += NTHR) { const int pp = i / 33, e = i % 33, pos = p0 + pp; const float t = (float)pos / (float)(L - 1), w = 2.0f * 3.14159265358979323846f * (float)pos / (float)L;
                float v; if (e == 0) v = t; else { const int b = (e - 1) & 15; const float f = 1e-4f + (float)b * ((15.f - 1e-4f) / 15.f), a = w * f; v = e <= 16 ? cosf(a) : -sinf(a); }
                ft[i] = v; }
            __syncthreads();
            for (int i = tid; i < HPP * 64; i += NTHR) { const int pp = i >> 6, j = i & 63; float acc = 0.f;
                for (int e = 0; e < 33; ++e) acc += ft[pp * 33 + e] * w1s[e * 64 + j];
                h1[i] = sinf(fqs[j] * (acc + b1s[j])); }
            __syncthreads();
            for (int i = tid; i < HPP * 64; i += NTHR) { const int pp = i >> 6, j = i & 63; float acc = 0.f;
                for (int e = 0; e < 64; ++e) acc += h1[pp * 64 + e] * w2s[e * 64 + j];
                h2[i] = sinf(fqs[j] * (acc + b2s[j])); }
            __syncthreads();
            float* H3 = h3_ptr(A, l, big);
            float* part = misc + MI_HYPART + ((size_t)(l * 2 + (big ? 0 : 1)) * IT_L + (big ? r : r - IT_L)) * 1024;
#pragma unroll
            for (int cc = 0; cc < 2; ++cc) { const int col = tid + cc * 512, ch = col & 255;
                const float mn = -3.0701134573253946f, mx = -15.350567286626973f; const float delta = fabsf(mn + (float)ch * ((mx - mn) / 255.f));
                float acc[HPP];
#pragma unroll
                for (int pp = 0; pp < HPP; ++pp) acc[pp] = 0.f;
#pragma unroll
                for (int e = 0; e < 64; e += 4) { float wq[4];
#pragma unroll
                    for (int j = 0; j < 4; ++j) wq[j] = (e + j < ER) ? (cc ? wv1[(e + j) < ER ? (e + j) : 0] : wv0[(e + j) < ER ? (e + j) : 0]) : w3s[(e + j - ER) * 1024 + col];
#pragma unroll
                    for (int pp = 0; pp < HPP; ++pp) { const f32x4 hv = *(const FK_LAS f32x4*)(h2 + pp * 64 + e);
#pragma unroll
                        for (int j = 0; j < 4; ++j) acc[pp] += hv[j] * wq[j]; } }
                float ps = 0.f;
#pragma unroll
                for (int pp = 0; pp < HPP; ++pp) { const int pos = p0 + pp; const float v = acc[pp] * expf(-((float)pos / (float)(L - 1)) * delta); H3[(size_t)pos * 1024 + col] = v;
                    if (!(col >= 512 && pos == 0)) ps += fabsf(v); }
                part[col] = ps; }
        }
        __syncthreads();
    }
}
__device__ __forceinline__ void phase_pa(AP A, FK_LAS unsigned char* lds, int vcu, int G) {
    const int tid = opaque_tid(), lane = tid & 63, wave = __builtin_amdgcn_readfirstlane(tid >> 6);
    const int gw = vcu * NWAVES + wave, NGW = G * NWAVES;
    const size_t gt = (size_t)vcu * NTHR + tid, NGT = (size_t)G * NTHR;
    float* misc = wsp<float>(A, W.misc);
    FK_LAS float* ctab = (FK_LAS float*)(lds + 131072); FK_LAS float* stab = ctab + 2048;
    for (int i = tid; i < 2048; i += NTHR) { const float a = (float)i * (2.f / 2048.f); ctab[i] = cospif(a); stab[i] = sinpif(a); }
    __syncthreads();
    if (vcu == 0) {
        if (tid < 2) { const float* p = FIN(20) + tid * 256; float a = 0.f, b = 0.f;
            for (int i = 0; i < 64; ++i) { a += p[i] * p[64 + i]; b += p[128 + i] * p[192 + i]; }
            misc[MI_LAM + tid] = expf(a) - expf(b) + (0.8f - 0.6f * expf(-0.3f * (float)tid));
            float gqm = 0.f, gkm = 0.f; for (int i = 0; i < 128; ++i) { gqm = fmaxf(gqm, fabsf(FIN(18)[tid * 128 + i])); gkm = fmaxf(gkm, fabsf(FIN(19)[tid * 128 + i])); }
            misc[MI_LAM + 2 + tid] = -(64.f * gqm * gkm * 1.02f) * (0.125f * 1.4426950408889634f); }
        for (int i = tid; i < 64 * 16; i += NTHR) { const int pos = i >> 4, e = i & 15; const float inv = powf(10000.f, -(float)(2 * e) / 32.f), ang = (float)pos * inv;
            misc[MI_ROPE + 2 * i] = cosf(ang); misc[MI_ROPE + 2 * i + 1] = sinf(ang); }
    }
    {
        FK_LAS float* s = (FK_LAS float*)lds;
        FK_LAS float* red = (FK_LAS float*)(lds + 9 * 1024 * 4);
        bool have = false;
        for (int it = vcu; it < 192; it += G) {
            if (!have) { for (int i = tid; i < 9 * 1024; i += NTHR) { const int r = i >> 10, k = i & 1023; const float v = r < 8 ? FIN(1)[r * 1024 + k] : FIN(3)[k]; s[i] = v / (1.f + expf(-v)); } __syncthreads(); have = true; }
            const int l = it / 96, n0 = (it % 96) * 64, kq = tid >> 6, c = tid & 63;
            const float* Wp = FIN(4) + (size_t)l * 1024 * 6144 + n0 + c;
            float acc[9];
#pragma unroll
            for (int r = 0; r < 9; ++r) acc[r] = 0.f;
#pragma unroll 1
            for (int k0 = kq * 128; k0 < kq * 128 + 128; k0 += 16) { float wv[16];
#pragma unroll
                for (int j = 0; j < 16; ++j) wv[j] = Wp[(size_t)(k0 + j) * 6144];
#pragma unroll
                for (int j = 0; j < 16; ++j)
#pragma unroll
                    for (int r = 0; r < 9; ++r) acc[r] += s[r * 1024 + k0 + j] * wv[j]; }
#pragma unroll
            for (int r = 0; r < 9; ++r) red[(kq * 9 + r) * 64 + c] = acc[r];
            __syncthreads();
            for (int i = tid; i < 9 * 64; i += NTHR) { const int r = i >> 6, cc = i & 63; float t = 0.f;
#pragma unroll
                for (int q = 0; q < 8; ++q) t += red[(q * 9 + r) * 64 + cc];
                wsp<float>(A, W.mod)[((size_t)l * 9 + r) * 6144 + n0 + cc] = t + FIN(5)[l * 6144 + n0 + cc]; }
            __syncthreads();
        }
        __syncthreads();
    }
    prep_transposes(A, lds, 0, 2, gw, NGW, wave, lane);
    prep_fz(A, ctab, stab, 32, 0, 2, gt, NGT);
    {
        const size_t nK = (size_t)2 * 16 * 128 * 128 / 8;
        for (size_t j = gt; j < nK; j += NGT) { const float* src = FIN(27); bf16_t* dst = wsp<bf16_t>(A, W.keys);
            const f32x4 x0 = *(const f32x4*)(src + j * 8), x1 = *(const f32x4*)(src + j * 8 + 4);
            u32x4 o; o.x = pk2(x0[0], x0[1]); o.y = pk2(x0[2], x0[3]); o.z = pk2(x1[0], x1[1]); o.w = pk2(x1[2], x1[3]);
            *(u32x4*)(dst + j * 8) = o; }
    }
    for (size_t i = gt; i < (size_t)2048 * 2048 + 256 * 256; i += NGT) {
        const bool big = i < (size_t)2048 * 2048; const size_t j = big ? i : i - (size_t)2048 * 2048; const int L = big ? 2048 : 256, lg = big ? 11 : 8;
        const int k = (int)(j >> lg), t = (int)(j & (L - 1)); const int ti = ((k * t) & (L - 1)) * (2048 / L); const float sc = rsqrtf(64.f * (float)L);
        bf16_t* d = big ? wsp<bf16_t>(A, W.dftl) : wsp<bf16_t>(A, W.dftc);
        d[(size_t)k * 2 * L + t] = (bf16_t)f2bf(sc * ctab[ti]); d[(size_t)k * 2 * L + L + t] = (bf16_t)f2bf(-sc * stab[ti]);
    }
    prep_hyfilt(A, lds, 0, 2, vcu, G, tid);
}
__device__ __forceinline__ void modulate_row_bf16(const float* xrow, const float* g, const float* scale, const float* shift, bf16_t* orow, int lane) {
    f32x4 v[4]; float ss = 0.f;
#pragma unroll
    for (int j = 0; j < 4; ++j) { v[j] = *(const f32x4*)(xrow + 4 * lane + 256 * j); ss += (v[j][0] * v[j][0] + v[j][1] * v[j][1]) + (v[j][2] * v[j][2] + v[j][3] * v[j][3]); }
    ss = wave_sum(ss); const float rs = rsqrtf(ss * (1.f / 1024.f) + EPS);
#pragma unroll
    for (int j = 0; j < 4; ++j) { const int k = 4 * lane + 256 * j; const f32x4 gg = *(const f32x4*)(g + k), sc = *(const f32x4*)(scale + k), sf = *(const f32x4*)(shift + k);
        const f32x4 o = v[j] * rs * gg * (sc + 1.0f) + sf; u32x2 w; w.x = pk2(o[0], o[1]); w.y = pk2(o[2], o[3]); ST_NT((u32x2*)(orow + k), w); }
}
__device__ __forceinline__ void prep_taplines(AP A, int l_lo, int l_hi, int gw, int NGW, int lane) {
    const float* misc = wsp<float>(A, W.misc);
    for (int row = l_lo * 1024 + gw; row < l_hi * 1024; row += NGW) {
        const int l = row >> 10, big = ((row >> 9) & 1) == 0, oc = row & 511, L = big ? 2048 : 256, TLn = big ? TLL : TLC, nit = big ? 512 : 64;
        const float* part = misc + MI_HYPART + (size_t)(l * 2 + (big ? 0 : 1)) * 512 * 1024;
        float s = 0.f;
#pragma unroll 8
        for (int i = lane; i < nit; i += 64) s += part[(size_t)i * 1024 + oc] + part[(size_t)i * 1024 + 512 + oc];
        s = wave_sum(s); const float inv = 1.f / s;
        const float* H3 = h3_ptr(A, l, big);
        bf16_t* TL = big ? wsp<bf16_t>(A, W.tapl) + ((size_t)l * 512 + oc) * TLL : wsp<bf16_t>(A, W.tapc) + ((size_t)l * 512 + oc) * TLC;
        const int c = L + 32;
        for (int y0 = 0; y0 < TLn; y0 += 64 * 8) { float tv[8];
#pragma unroll
            for (int j = 0; j < 8; ++j) { const int y = y0 + 64 * j + lane, m = c - y, am = m < 0 ? -m : m; const bool ok = (y < TLn) && (am < L);
                const float v = H3[ok ? (size_t)am * 1024 + (m < 0 ? 512 : 0) + oc : (size_t)oc];
                tv[j] = ok ? v : 0.f; }
#pragma unroll
            for (int j = 0; j < 8; ++j) { const int y = y0 + 64 * j + lane; if (y < TLn) TL[y] = (bf16_t)f2bf(tv[j] * inv); } }
    }
}
__device__ __forceinline__ void prep_taplines8(AP A, int l_lo, int l_hi, int vcu, int G, int wave, int lane) {
    const float* misc = wsp<float>(A, W.misc);
    for (int it = l_lo * 128 + vcu; it < l_hi * 128; it += G) {
        const int l = it >> 7, big = ((it >> 6) & 1) == 0, oc0 = (it & 63) * 8, L = big ? 2048 : 256, TLn = big ? TLL : TLC, nit = big ? 512 : 64;
        const float* part = misc + MI_HYPART + (size_t)(l * 2 + (big ? 0 : 1)) * 512 * 1024 + oc0;
        f32x4 s0 = {0.f, 0.f, 0.f, 0.f}, s1 = s0;
        for (int i = lane; i < nit; i += 64) { const float* pp = part + (size_t)i * 1024; s0 = s0 + *(const f32x4*)(pp) + *(const f32x4*)(pp + 512); s1 = s1 + *(const f32x4*)(pp + 4) + *(const f32x4*)(pp + 516); }
        float inv[8];
#pragma unroll
        for (int j = 0; j < 4; ++j) { inv[j] = 1.f / wave_sum(s0[j]); inv[4 + j] = 1.f / wave_sum(s1[j]); }
        const float* H3 = h3_ptr(A, l, big) + oc0;
        bf16_t* TL = (big ? wsp<bf16_t>(A, W.tapl) + ((size_t)l * 512 + oc0) * TLL : wsp<bf16_t>(A, W.tapc) + ((size_t)l * 512 + oc0) * TLC);
        const int c = L + 32;
        for (int y0 = wave * 64; y0 < TLn; y0 += 64 * NWAVES * 2) {
            f32x4 va[2], vb[2]; int yy[2];
#pragma unroll
            for (int j = 0; j < 2; ++j) { const int y = y0 + 64 * NWAVES * j + lane, m = c - y, am = m < 0 ? -m : m; const bool ok = (y < TLn) && (am < L); yy[j] = y;
                const float* src = H3 + (ok ? (size_t)am * 1024 + (m < 0 ? 512 : 0) : (size_t)0);
                va[j] = *(const f32x4*)src; vb[j] = *(const f32x4*)(src + 4);
                if (!ok) { va[j] = (f32x4){0.f, 0.f, 0.f, 0.f}; vb[j] = va[j]; } }
#pragma unroll
            for (int j = 0; j < 2; ++j) if (yy[j] < TLn) {
#pragma unroll
                for (int q = 0; q < 4; ++q) { TL[(size_t)q * TLn + yy[j]] = (bf16_t)f2bf(va[j][q] * inv[q]); TL[(size_t)(4 + q) * TLn + yy[j]] = (bf16_t)f2bf(vb[j][q] * inv[4 + q]); } }
        }
    }
}
__device__ __forceinline__ void phase_pb(AP A, int vcu, int G) {
    const int tid = opaque_tid(), lane = tid & 63, wave = __builtin_amdgcn_readfirstlane(tid >> 6); (void)tid;
    const int gw = vcu * NWAVES + wave, NGW = G * NWAVES;
    const float* mod = wsp<float>(A, W.mod);
    for (int t0 = gw; t0 < NTOK; t0 += 2 * NGW) {
        const int ta = t0, tb2 = t0 + NGW; const bool hb = tb2 < NTOK;
        const float* xa = ta < NLAT ? FIN(0) + (size_t)ta * DM : FIN(2) + (size_t)(ta - NLAT) * DM;
        const float* xb = !hb ? xa : (tb2 < NLAT ? FIN(0) + (size_t)tb2 * DM : FIN(2) + (size_t)(tb2 - NLAT) * DM);
        f32x4 va[4], vb[4]; float sa = 0.f, sb = 0.f;
#pragma unroll
        for (int j = 0; j < 4; ++j) { va[j] = *(const f32x4*)(xa + 4 * lane + 256 * j); vb[j] = *(const f32x4*)(xb + 4 * lane + 256 * j); }
#pragma unroll
        for (int j = 0; j < 4; ++j) { sa += (va[j][0] * va[j][0] + va[j][1] * va[j][1]) + (va[j][2] * va[j][2] + va[j][3] * va[j][3]); sb += (vb[j][0] * vb[j][0] + vb[j][1] * vb[j][1]) + (vb[j][2] * vb[j][2] + vb[j][3] * vb[j][3]); }
        sa = wave_sum(sa); sb = wave_sum(sb);
        const float ra = rsqrtf(sa * (1.f / 1024.f) + EPS), rb = rsqrtf(sb * (1.f / 1024.f) + EPS);
        const float* ma = mod + (size_t)(ta < NLAT ? ta / SEQ : 8) * 6144; const float* mb = mod + (size_t)(tb2 < NLAT ? tb2 / SEQ : 8) * 6144;
        bf16_t* oa = wsp<bf16_t>(A, W.xn) + (size_t)ta * DM; bf16_t* ob = wsp<bf16_t>(A, W.xn) + (size_t)tb2 * DM;
#pragma unroll
        for (int j = 0; j < 4; ++j) { const int k = 4 * lane + 256 * j; const f32x4 gg = *(const f32x4*)(FIN(6) + k);
            { const f32x4 sc = *(const f32x4*)(ma + 1024 + k), sf = *(const f32x4*)(ma + k); const f32x4 o = va[j] * ra * gg * (sc + 1.0f) + sf; u32x2 w; w.x = pk2(o[0], o[1]); w.y = pk2(o[2], o[3]); ST_NT((u32x2*)(oa + k), w); }
            if (hb) { const f32x4 sc = *(const f32x4*)(mb + 1024 + k), sf = *(const f32x4*)(mb + k); const f32x4 o = vb[j] * rb * gg * (sc + 1.0f) + sf; u32x2 w; w.x = pk2(o[0], o[1]); w.y = pk2(o[2], o[3]); ST_NT((u32x2*)(ob + k), w); } }
    }
    prep_taplines8(A, 0, 2, vcu, G, wave, lane);
}

constexpr int NTT = NTOK / 256, NTL = NLAT / 256;
__device__ __forceinline__ size_t gate_frag(int pm, int gt, int wr, int wc, int fr, int fq) { return ((((size_t)(pm * 12 + gt) * 8 + (wr * 4 + wc)) * 16) * 64 + (fq * 16 + fr)) * 8; }
struct InprojSched {
    int l, G, c; const char* xn; const char* w;
    __device__ bool next(int i, Unit& u) const {
        const long Li = (long)i * G + c;
        const int nM = (l == 0) ? NTT : NTL, nN = 23, nwg = nM * nN;
        if (Li < nwg) {
            int wgid = (int)Li; { const int q = nwg / 8, r = nwg % 8, xcd = wgid % 8, off = wgid / 8; wgid = (xcd < r ? xcd * (q + 1) : r * (q + 1) + (xcd - r) * q) + off; }
            const int nig = 8 * nN, gid = wgid / nig, fm = gid * 8, gsz = (nM - fm) < 8 ? (nM - fm) : 8;
            u.pm = fm + ((wgid % nig) % gsz); u.pn = (wgid % nig) / gsz;
        } else {
            const int r2 = (int)(Li - nwg); if (l == 0 || r2 >= (NTT - NTL) * 4) return false;
            u.pm = NTL + r2 / 4; u.pn = 7 + (r2 & 3);
        }
        const int pn = u.pn; u.kind = pn < 3 ? 0 : pn < 5 ? 1 : pn < 9 ? 2 : pn < 11 ? 3 : 4;
        const char* at = xn + (size_t)u.pm * 256 * 1024 * 2; const char* wt = w + (size_t)pn * 256 * 1024 * 2;
        const bool swapped = (u.kind == 0 || u.kind == 1 || u.kind == 3);
        u.a = swapped ? wt : at; u.b = swapped ? at : wt; u.aux = 0; return true;
    }
};
struct InprojEpi {
    int l; bf16_t *hyt, *ftl, *ftc, *q, *qc, *k, *vt, *g; const float *gq, *gk, *rope;
    __device__ __forceinline__ bool operator()(Acc& acc, const Unit& u, int wr, int wc, int fr, int fq) const {
        const int pm = u.pm, pn = u.pn;
        if (u.kind == 0 || u.kind == 1 || u.kind == 3) {
            const bool lat = pm < NTL; const int b = lat ? pm >> 3 : pm - NTL;
#pragma unroll
            for (int bj = 0; bj < 2; ++bj) {
                const int tl = 128 * bj + 32 * wc + 8 * fq;
                bf16_t* base; size_t rstride;
                if (u.kind == 0) { base = hyt + (size_t)(pn * 256) * NTOK + (size_t)pm * 256 + tl; rstride = NTOK; }
                else if (u.kind == 1) { const int part = pn - 3;
                    if (lat) { base = ftl + (size_t)b * 256 * 4096 + part * 2048 + (pm & 7) * 256 + tl; rstride = 4096; }
                    else { base = ftc + (size_t)b * 256 * 512 + part * 256 + tl; rstride = 512; } }
                else { base = vt + ((size_t)b * 512 + (pn - 9) * 256) * KALL + (lat ? (pm & 7) * 256 : SEQ) + tl; rstride = KALL; }
#pragma unroll
                for (int ai = 0; ai < 2; ++ai)
#pragma unroll
                    for (int m = 0; m < 4; ++m) { const int r = 128 * ai + 64 * wr + 16 * m + fr; const f32x4 v0 = acc[ai][bj][m][0], v1 = acc[ai][bj][m][1];
                        u32x4 w; w.x = cvt_pk_bf16(v0[0], v0[1]); w.y = cvt_pk_bf16(v0[2], v0[3]); w.z = cvt_pk_bf16(v1[0], v1[1]); w.w = cvt_pk_bf16(v1[2], v1[3]);
                        ST_NT((u32x4*)(base + (size_t)r * rstride), w); }
            }
        } else if (u.kind == 4) {
            unsigned char* gt_ = (unsigned char*)g + gate_frag(pm, pn - 11, wr, wc, fr, fq);
#pragma unroll
            for (int ai = 0; ai < 2; ++ai)
#pragma unroll
                for (int m = 0; m < 4; ++m) {
#pragma unroll
                    for (int bj = 0; bj < 2; ++bj) { f32x4 v0 = acc[ai][bj][m][0], v1 = acc[ai][bj][m][1];
#pragma unroll
                        for (int j = 0; j < 4; ++j) { v0[j] = fmaxf(255.f * __builtin_amdgcn_rcpf(1.f + __builtin_amdgcn_exp2f(-1.4426950408889634f * v0[j])), 1.f); v1[j] = fmaxf(255.f * __builtin_amdgcn_rcpf(1.f + __builtin_amdgcn_exp2f(-1.4426950408889634f * v1[j])), 1.f); }
                        u32x2 w = {0u, 0u};
#pragma unroll
                        for (int j = 0; j < 4; ++j) { w.x = __builtin_amdgcn_cvt_pk_u8_f32(v0[j], j, w.x); w.y = __builtin_amdgcn_cvt_pk_u8_f32(v1[j], j, w.y); }
                        ST_NT((u32x2*)(gt_ + ((ai * 4 + m) * 2 + bj) * 512), w); } }
        } else {
            const int which = (pn - 5) >> 1, grp = ((pn - 5) & 1) * 4 + wc, h = grp >> 1, map = grp & 1;
            const int d0 = 32 * (fq >> 1) + 8 * (fq & 1);
            const float* gp = (which ? gk : gq) + map * 64 + d0;
            const f32x4 g00 = *(const f32x4*)(gp), g01 = *(const f32x4*)(gp + 4), g10 = *(const f32x4*)(gp + 16), g11 = *(const f32x4*)(gp + 20);
            const bool lat = pm < NTL; const int b = lat ? pm >> 3 : pm - NTL;
#pragma unroll
            for (int ai = 0; ai < 2; ++ai)
#pragma unroll
                for (int m = 0; m < 4; ++m) {
                    const int rl = 128 * ai + 64 * wr + 16 * m + fr;
                    f32x4 a0 = acc[ai][0][m][0], a1 = acc[ai][0][m][1], b0 = acc[ai][1][m][0], b1 = acc[ai][1][m][1];
                    float ss = 0.f;
#pragma unroll
                    for (int j = 0; j < 4; ++j) ss += a0[j] * a0[j] + a1[j] * a1[j] + b0[j] * b0[j] + b1[j] * b1[j];
                    ss += __shfl_xor(ss, 16); ss += __shfl_xor(ss, 32);
                    const float rs = rsqrtf(ss * (1.f / 64.f) + EPS) * (which ? 1.f : 0.125f * 1.4426950408889634f);
                    a0 = a0 * rs * g00; a1 = a1 * rs * g01; b0 = b0 * rs * g10; b1 = b1 * rs * g11;
                    bf16_t* dst;
                    if (lat) { const int pos = (pm & 7) * 256 + rl; const int pa = (fq >> 1) ? (pos & 63) : (pos >> 6);
                        const float* rp = rope + ((size_t)pa * 16 + 8 * (fq & 1)) * 2;
                        const f32x4 r0 = *(const f32x4*)(rp), r1 = *(const f32x4*)(rp + 4), r2 = *(const f32x4*)(rp + 8), r3 = *(const f32x4*)(rp + 12);
                        const float cs[8] = {r0[0], r0[2], r1[0], r1[2], r2[0], r2[2], r3[0], r3[2]}, sn[8] = {r0[1], r0[3], r1[1], r1[3], r2[1], r2[3], r3[1], r3[3]};
#pragma unroll
                        for (int j = 0; j < 4; ++j) { const float x1 = a0[j], x2 = b0[j]; a0[j] = x1 * cs[j] - x2 * sn[j]; b0[j] = x2 * cs[j] + x1 * sn[j];
                            const float y1 = a1[j], y2 = b1[j]; a1[j] = y1 * cs[4 + j] - y2 * sn[4 + j]; b1[j] = y2 * cs[4 + j] + y1 * sn[4 + j]; }
                        dst = which ? k + (((size_t)(b * 4 + h) * 2 + map) * KALL + pos) * 64 : q + (((size_t)(b * 4 + h) * 2 + map) * SEQ + pos) * 64;
                    } else dst = which ? k + (((size_t)(b * 4 + h) * 2 + map) * KALL + SEQ + rl) * 64 : qc + (((size_t)(b * 4 + h) * 2 + map) * CTX + rl) * 64;
                    u32x4 w0, w1; w0.x = cvt_pk_bf16(a0[0], a0[1]); w0.y = cvt_pk_bf16(a0[2], a0[3]); w0.z = cvt_pk_bf16(a1[0], a1[1]); w0.w = cvt_pk_bf16(a1[2], a1[3]);
                    w1.x = cvt_pk_bf16(b0[0], b0[1]); w1.y = cvt_pk_bf16(b0[2], b0[3]); w1.z = cvt_pk_bf16(b1[0], b1[1]); w1.w = cvt_pk_bf16(b1[2], b1[3]);
                    ST_NT((u32x4*)(dst + d0), w0); ST_NT((u32x4*)(dst + d0 + 16), w1);
                }
        }
        return true;
    }
};
__device__ __forceinline__ void phase_inproj(AP A, FK_LAS unsigned char* lds, int l, int G) {
    InprojSched S{l, G, (int)blockIdx.x, (const char*)wsp<bf16_t>(A, W.xn), (const char*)(wsp<bf16_t>(A, W.w_in) + (size_t)l * PINF * 1024)};
    InprojEpi E{l, wsp<bf16_t>(A, W.hyt), wsp<bf16_t>(A, W.ftl), wsp<bf16_t>(A, W.ftc), wsp<bf16_t>(A, W.q), wsp<bf16_t>(A, W.qc), wsp<bf16_t>(A, W.k), wsp<bf16_t>(A, W.vt), wsp<bf16_t>(A, W.g),
                FIN(18) + l * 128, FIN(19) + l * 128, wsp<float>(A, W.misc) + MI_ROPE};
    gemm_phase(lds, 1024, S, E);
}
#define FK_HAVE_MIX 1
namespace attn {
constexpr float SCALE = 0.125f, THR = 8.f;
constexpr int KVBLK = 64;
constexpr int SHM_V = 128 * 64 * 2, SHM_K = 64 * 64 * 2;
constexpr int OFF_V = 0, OFF_K = 2 * SHM_V, OFF_WS = 2 * SHM_V + 2 * SHM_K;
#define ASWZ(row, cb) ((row) * 128 + ((cb) ^ ((((row) >> 1) & 7) << 4)))
#define SBAR() __builtin_amdgcn_sched_barrier(0)
__device__ __forceinline__ int crow(int r, int hi) { return (r & 3) + 8 * (r >> 2) + 4 * hi; }
__device__ __forceinline__ void partialSM(f32x16& p0, f32x16& p1, const float mnC) {
    if (mnC < -64.f) {
#pragma unroll
        for (int r = 0; r < 16; ++r) { p0[r] += mnC; p1[r] += mnC; } }
#pragma unroll
    for (int r = 0; r < 16; ++r) p0[r] = __builtin_amdgcn_exp2f(p0[r]);
}
__device__ __forceinline__ void finishSM(f32x16& p0, f32x16& p1, float& l_reg, bf16x8& pa0, bf16x8& pa1, bf16x8& pa2, bf16x8& pa3) {
#pragma unroll
    for (int r = 0; r < 16; ++r) p1[r] = __builtin_amdgcn_exp2f(p1[r]);
    float ps = 0;
#pragma unroll
    for (int r = 0; r < 16; ++r) ps += p0[r];
#pragma unroll
    for (int r = 0; r < 16; ++r) ps += p1[r];
    { auto rr = __builtin_amdgcn_permlane32_swap(__float_as_uint(ps), __float_as_uint(ps), false, false);
      ps = __uint_as_float(rr[0]) + __uint_as_float(rr[1]); }
    l_reg += ps;
#define PK4(P, BASE, OUT) do { unsigned a0 = cvt_pk_bf16(P[BASE + 0], P[BASE + 1]), a1 = cvt_pk_bf16(P[BASE + 2], P[BASE + 3]);   \
    unsigned b0 = cvt_pk_bf16(P[BASE + 4], P[BASE + 5]), b1 = cvt_pk_bf16(P[BASE + 6], P[BASE + 7]);                              \
    auto r0 = __builtin_amdgcn_permlane32_swap(a0, b0, false, false); auto r1 = __builtin_amdgcn_permlane32_swap(a1, b1, false, false); \
    u32x4 w = {r0[0], r1[0], r0[1], r1[1]}; OUT = *reinterpret_cast<bf16x8*>(&w); } while (0)
    PK4(p0, 0, pa0); PK4(p0, 8, pa1); PK4(p1, 0, pa2); PK4(p1, 8, pa3);
#undef PK4
}
__device__ __forceinline__ void qkt(f32x16& p0, f32x16& p1, const FK_LAS char* Ks, const bf16x8* qr, int r32, int hi, const float mnC) {
    (void)mnC; p0 = f32x16{}; p1 = f32x16{};
#pragma unroll
    for (int d0 = 0; d0 < 4; ++d0) { const int cb = d0 * 32 + hi * 16;
        const bf16x8 b0 = *(const FK_LAS bf16x8*)(Ks + ASWZ(r32, cb));
        const bf16x8 b1 = *(const FK_LAS bf16x8*)(Ks + ASWZ(32 + r32, cb));
        __builtin_amdgcn_s_setprio(1);
        p0 = __builtin_amdgcn_mfma_f32_32x32x16_bf16(b0, qr[d0], p0, 0, 0, 0);
        p1 = __builtin_amdgcn_mfma_f32_32x32x16_bf16(b1, qr[d0], p1, 0, 0, 0);
        __builtin_amdgcn_s_setprio(0); }
}
__device__ __forceinline__ void pv(f32x16* o, const FK_LAS char* Vs, int r32, int hi, bf16x8 pa0, bf16x8 pa1, bf16x8 pa2, bf16x8 pa3) {
#pragma unroll
    for (int d0 = 0; d0 < 4; ++d0) { const int row = 32 * d0 + r32;
        const bf16x8 v0 = *(const FK_LAS bf16x8*)(Vs + ASWZ(row, 0 * 32 + hi * 16)), v1 = *(const FK_LAS bf16x8*)(Vs + ASWZ(row, 1 * 32 + hi * 16));
        const bf16x8 v2 = *(const FK_LAS bf16x8*)(Vs + ASWZ(row, 2 * 32 + hi * 16)), v3 = *(const FK_LAS bf16x8*)(Vs + ASWZ(row, 3 * 32 + hi * 16));
        __builtin_amdgcn_s_setprio(1);
        o[d0] = __builtin_amdgcn_mfma_f32_32x32x16_bf16(pa0, v0, o[d0], 0, 0, 0);
        o[d0] = __builtin_amdgcn_mfma_f32_32x32x16_bf16(pa1, v1, o[d0], 0, 0, 0);
        o[d0] = __builtin_amdgcn_mfma_f32_32x32x16_bf16(pa2, v2, o[d0], 0, 0, 0);
        o[d0] = __builtin_amdgcn_mfma_f32_32x32x16_bf16(pa3, v3, o[d0], 0, 0, 0);
        __builtin_amdgcn_s_setprio(0); }
}
__device__ __forceinline__ void body(const bf16_t* __restrict__ Qb, const bf16_t* __restrict__ Kh, const bf16_t* __restrict__ VTh, int ldv, int seq, FK_LAS char* lds, f32x16* o, const int tid, const float mnC) {
    const int wid = tid >> 6, lane = tid & 63, r32 = lane & 31, hi = lane >> 5;
    FK_LAS char* V_lds = lds + OFF_V; FK_LAS char* K_lds = lds + OFF_K;
    FK_LAS float* wsf = (FK_LAS float*)(lds + OFF_WS) + wid * 64; FK_LAS float* li_l = wsf;
    float l_reg = 0;
#pragma unroll
    for (int d = 0; d < 4; ++d) o[d] = f32x16{};
    bf16x8 qr[4];
    const bf16_t* Qw = Qb + (size_t)(wid * 32 + r32) * 64 + hi * 8;
#pragma unroll
    for (int d0 = 0; d0 < 4; ++d0) qr[d0] = *(const bf16x8*)(Qw + d0 * 16);
    const int ksr = tid >> 3, kch = tid & 7;
    const int kst = ASWZ(ksr, kch * 16);
    const int vd0 = tid >> 3, vd1 = 64 + (tid >> 3);
    const int vst0 = ASWZ(vd0, kch * 16), vst1 = ASWZ(vd1, kch * 16);
    struct { bf16x8 vs0, vs1, ks; } sr_[2];
#define SLOAD(i, k0) do { sr_[i].vs0 = *(const bf16x8*)(VTh + (size_t)vd0 * ldv + (k0) + kch * 8); sr_[i].vs1 = *(const bf16x8*)(VTh + (size_t)vd1 * ldv + (k0) + kch * 8); \
    sr_[i].ks = *(const bf16x8*)(Kh + (size_t)((k0) + ksr) * 64 + kch * 8); } while (0)
#define SWRITE(b, i) do { *(FK_LAS bf16x8*)(V_lds + (b) * SHM_V + vst0) = sr_[i].vs0; *(FK_LAS bf16x8*)(V_lds + (b) * SHM_V + vst1) = sr_[i].vs1; \
    *(FK_LAS bf16x8*)(K_lds + (b) * SHM_K + kst) = sr_[i].ks; } while (0)
#define SWAIT() asm volatile("s_waitcnt vmcnt(3)" ::: "memory")
    f32x16 pA0, pA1, pB0, pB1; bf16x8 pa0, pa1, pa2, pa3; const int NT = seq / KVBLK;
    SLOAD(0, 0); asm volatile("s_waitcnt vmcnt(0)" ::: "memory"); SWRITE(0, 0); __syncthreads();
    qkt(pA0, pA1, K_lds, qr, r32, hi, mnC); partialSM(pA0, pA1, mnC);
    SLOAD(1, KVBLK); if (2 < NT) SLOAD(0, 2 * KVBLK);
    if (2 < NT) SWAIT(); else asm volatile("s_waitcnt vmcnt(0)" ::: "memory");
    SWRITE(1, 1); __syncthreads();
    for (int j = 1; j + 1 < NT; j += 2) {
        SBAR(); qkt(pB0, pB1, K_lds + SHM_K, qr, r32, hi, mnC);
        finishSM(pA0, pA1, l_reg, pa0, pa1, pa2, pa3); SBAR();
        SLOAD(1, (j + 2) * KVBLK); SBAR();
        pv(o, V_lds, r32, hi, pa0, pa1, pa2, pa3); partialSM(pB0, pB1, mnC);
        __syncthreads(); SWAIT(); SWRITE(0, 0);
        __syncthreads();
        SBAR(); qkt(pA0, pA1, K_lds, qr, r32, hi, mnC);
        finishSM(pB0, pB1, l_reg, pa0, pa1, pa2, pa3); SBAR();
        const bool more = (j + 3 < NT);
        if (more) SLOAD(0, (j + 3) * KVBLK);
        SBAR();
        pv(o, V_lds + SHM_V, r32, hi, pa0, pa1, pa2, pa3); partialSM(pA0, pA1, mnC);
        __syncthreads(); if (more) SWAIT(); else asm volatile("s_waitcnt vmcnt(0)" ::: "memory");
        SWRITE(1, 1);
        __syncthreads();
    }
    SBAR(); qkt(pB0, pB1, K_lds + SHM_K, qr, r32, hi, mnC);
    finishSM(pA0, pA1, l_reg, pa0, pa1, pa2, pa3); SBAR();
    pv(o, V_lds, r32, hi, pa0, pa1, pa2, pa3); partialSM(pB0, pB1, mnC);
    __syncthreads();
    finishSM(pB0, pB1, l_reg, pa0, pa1, pa2, pa3); SBAR();
    pv(o, V_lds + SHM_V, r32, hi, pa0, pa1, pa2, pa3);
    if (hi == 0) li_l[r32] = l_reg; asm volatile("s_waitcnt lgkmcnt(0)" ::: "memory");
#pragma unroll
    for (int r = 0; r < 16; ++r) { const float rl = __builtin_amdgcn_rcpf(li_l[crow(r, hi)]);
#pragma unroll
        for (int d = 0; d < 4; ++d) o[d][r] *= rl; }
    __syncthreads();
#undef SLOAD
#undef SWRITE
#undef SWAIT
}
__device__ __forceinline__ void unit(AP A, FK_LAS char* lds, int l, int b, int h, int qb  ) {
    const int tid = opaque_tid(), wid = tid >> 6, lane = tid & 63, r32 = lane & 31, hi = lane >> 5;
    const bool ctx = qb == 8;
    float* stash = wsp<float>(A, W.stash) + (size_t)blockIdx.x * 128 * 512;
    const float mnC = wsp<float>(A, W.misc)[MI_LAM + 2 + l];
#pragma unroll 1
    for (int map = 0; map < 2; ++map) {
        const size_t hm = (size_t)(b * 4 + h) * 2 + map;
        const bf16_t* Qb = ctx ? wsp<bf16_t>(A, W.qc) + hm * CTX * 64 : wsp<bf16_t>(A, W.q) + (hm * SEQ + (size_t)qb * 256) * 64;
        const bf16_t* Kh = wsp<bf16_t>(A, W.k) + (hm * KALL + (ctx ? SEQ : 0)) * 64;
        const bf16_t* VTh = wsp<bf16_t>(A, W.vt) + (size_t)(b * 4 + h) * 128 * KALL + (ctx ? SEQ : 0);
        f32x16 om[4];
        body(Qb, Kh, VTh, KALL, ctx ? CTX : KALL, lds, om, tid, mnC);
#pragma unroll
        for (int d = 0; d < 4; ++d)
#pragma unroll
            for (int r = 0; r < 16; ++r) stash[(size_t)((map * 4 + d) * 16 + r) * 512 + tid] = om[d][r];
    }
    const float lam = wsp<float>(A, W.misc)[MI_LAM + l], post = 1.f - (0.8f - 0.6f * __expf(-0.3f * (float)l));
    f32x16 o[4];
    float ss[16];
#pragma unroll
    for (int r = 0; r < 16; ++r) ss[r] = 0.f;
#pragma unroll
    for (int d = 0; d < 4; ++d)
#pragma unroll
        for (int r = 0; r < 16; ++r) { const float v = stash[(size_t)(d * 16 + r) * 512 + tid] - lam * stash[(size_t)((4 + d) * 16 + r) * 512 + tid]; o[d][r] = v; ss[r] += v * v; }
#pragma unroll
    for (int r = 0; r < 16; ++r) {
#pragma unroll
        for (int s = 1; s < 32; s <<= 1) ss[r] += __shfl_xor(ss[r], s);
        ss[r] = rsqrtf(ss[r] * (1.f / 128.f) + EPS) * post; }
    bf16_t* att = (h < 2) ? wsp<bf16_t>(A, W.attlo) : wsp<bf16_t>(A, W.atthi);
    const size_t t0 = ctx ? (size_t)NLAT + b * CTX : (size_t)b * SEQ + qb * 256;
#pragma unroll
    for (int d = 0; d < 4; ++d) { const float gs = FIN(21)[l * 128 + 32 * d + r32];
#pragma unroll
        for (int r = 0; r < 16; ++r) att[(t0 + wid * 32 + crow(r, hi)) * 256 + (h & 1) * 128 + 32 * d + r32] = (bf16_t)f2bf(o[d][r] * ss[r] * gs); }
}
#undef ASWZ
#undef SBAR
}

namespace hy {
template <int L, int NBH> struct Geo {
    static constexpr int NBLK = L / 32, IB = 32 / NBH, NG = NBLK / IB, GPW = (NG >= 8) ? NG / 8 : 1, AW = NG / GPW;
    static constexpr int PADB = IB * GPW - 1, RL = (NBLK + 2 * PADB) * 32, ZRS = RL * 2 + 16;
    static constexpr int TLn = (L == 2048) ? TLL : TLC, TCS = TLn * 2 + ((L == 2048) ? 32 : 160);
    static constexpr int OFF_Z = 0, OFF_G = NBH * ZRS, OFF_T = 2 * NBH * ZRS, END = OFF_T + 8 * TCS;
};
__device__ __forceinline__ int crow(int r, int hi) { return (r & 3) + 8 * (r >> 2) + 4 * hi; }
template <int L, int NBH>
__device__ __forceinline__ void unit(AP A, FK_LAS char* lds, int l, int ch, int boff) {
    using Gm = Geo<L, NBH>;
    static_assert(Gm::END <= LDS_MISC, "hyena LDS");
    const int tid = opaque_tid(), wid = __builtin_amdgcn_readfirstlane(tid >> 6), lane = tid & 63, r32 = lane & 31, hi = lane >> 5;
    const bf16_t* hyt = wsp<bf16_t>(A, W.hyt);
    const float* cw = FIN(9) + l * 3 * 768; const float* cb = FIN(10) + l * 768;
    const int tbl = tid / (L / 32), tb = boff + tbl, tp0 = (tid % (L / 32)) * 32; const bool ld_act = tid < NBH * (L / 32);
    unsigned x2p[16];
    __syncthreads();
    for (int i = tid; i < 2 * NBH * Gm::ZRS / 16; i += NTHR) *(FK_LAS u32x4*)(lds + i * 16) = (u32x4){0u, 0u, 0u, 0u};
    __syncthreads();
    if (ld_act) {
#pragma unroll
        for (int sel = 0; sel < 3; ++sel) {
            const int row = sel * 256 + ch; const float w0 = cw[row], w1 = cw[768 + row], w2 = cw[1536 + row], bs = cb[row];
            float vals[34];
            if (tb < NB) {
                const size_t tok0 = (L == 2048) ? (size_t)tb * SEQ + tp0 : (size_t)NLAT + tb * CTX + tp0;
                const bf16_t* src = hyt + (size_t)row * NTOK + tok0;
#pragma unroll
                for (int q = 0; q < 4; ++q) { const u32x4 w = *(const u32x4*)(src + q * 8);
                    vals[1 + q * 8 + 0] = bflo(w.x); vals[1 + q * 8 + 1] = bfhi(w.x); vals[1 + q * 8 + 2] = bflo(w.y); vals[1 + q * 8 + 3] = bfhi(w.y);
                    vals[1 + q * 8 + 4] = bflo(w.z); vals[1 + q * 8 + 5] = bfhi(w.z); vals[1 + q * 8 + 6] = bflo(w.w); vals[1 + q * 8 + 7] = bfhi(w.w); }
                vals[0] = tp0 > 0 ? bf2f(src[-1]) : 0.f; vals[33] = tp0 + 32 < L ? bf2f(src[32]) : 0.f;
            } else {
#pragma unroll
                for (int i = 0; i < 34; ++i) vals[i] = 0.f;
            }
            unsigned pk[16];
#pragma unroll
            for (int i = 0; i < 16; ++i) { const float a = tb < NB ? vals[2 * i] * w0 + vals[2 * i + 1] * w1 + vals[2 * i + 2] * w2 + bs : 0.f, b2 = tb < NB ? vals[2 * i + 1] * w0 + vals[2 * i + 2] * w1 + vals[2 * i + 3] * w2 + bs : 0.f;
                pk[i] = cvt_pk_bf16(a, b2); }
            if (sel < 2) { FK_LAS char* dst = lds + (sel == 0 ? Gm::OFF_Z : Gm::OFF_G) + tbl * Gm::ZRS + (Gm::PADB * 32 + tp0) * 2;
#pragma unroll
                for (int q = 0; q < 4; ++q) *(FK_LAS u32x4*)(dst + q * 16) = (u32x4){pk[4 * q], pk[4 * q + 1], pk[4 * q + 2], pk[4 * q + 3]}; }
            else {
#pragma unroll
                for (int i = 0; i < 16; ++i) x2p[i] = pk[i]; }
        }
    }
    const int G0 = wid * Gm::GPW; const bool act = wid < Gm::AW;
    const int dlo = Gm::IB * G0 - (Gm::NBLK - 1), dhi = Gm::IB * (G0 + Gm::GPW) - 1;
    const int il = r32 & (Gm::IB - 1), bb = r32 / Gm::IB;
    for (int o = 0; o < 2; ++o) {
        { const bf16_t* TL = (L == 2048 ? wsp<bf16_t>(A, W.tapl) + ((size_t)l * 512 + o * 256 + ch) * TLL : wsp<bf16_t>(A, W.tapc) + ((size_t)l * 512 + o * 256 + ch) * TLC);
          constexpr int NC = Gm::TLn / 8;
          for (int i = tid; i < NC; i += NTHR) *(FK_LAS u32x4*)(lds + Gm::OFF_T + i * 16) = *(const u32x4*)(TL + i * 8);
          __syncthreads();
          for (int i = tid; i < 7 * NC; i += NTHR) { const int sft = 1 + i / NC, c = i % NC;
              const FK_LAS unsigned* src = (const FK_LAS unsigned*)(lds + Gm::OFF_T + c * 16 + 4 * (sft >> 1)); const unsigned sh = 16u * (unsigned)(sft & 1);
              const bool tail = (c == NC - 1);
              unsigned w0 = src[0], w1 = tail && (1 + (sft >> 1)) >= 4 ? 0u : src[1], w2 = tail && (2 + (sft >> 1)) >= 4 ? 0u : src[2], w3 = tail && (3 + (sft >> 1)) >= 4 ? 0u : src[3], w4 = tail ? 0u : src[4];
              u32x4 ov; ov.x = __builtin_amdgcn_alignbit(w1, w0, sh); ov.y = __builtin_amdgcn_alignbit(w2, w1, sh); ov.z = __builtin_amdgcn_alignbit(w3, w2, sh); ov.w = __builtin_amdgcn_alignbit(w4, w3, sh);
              *(FK_LAS u32x4*)(lds + Gm::OFF_T + sft * Gm::TCS + c * 16) = ov; } }
        __syncthreads();
        f32x16 acc[Gm::GPW];
#pragma unroll
        for (int g = 0; g < Gm::GPW; ++g) acc[g] = f32x16{};
        if (act) {
            const int c0 = (L + 32) - r32 + 8 * hi, sc = c0 & 7;
            int pa = Gm::OFF_T + sc * Gm::TCS + (c0 - sc - 32 * dlo) * 2;
            int pb = Gm::OFF_Z + bb * Gm::ZRS + ((Gm::PADB + Gm::IB * G0 + il - dlo) * 32 + 8 * hi) * 2;
            const int nd = dhi - dlo + 1;
            if constexpr (Gm::GPW == 2 && Gm::IB == 4) {
                bf16x8 a0, a1, r0[5], r1[5];
#pragma unroll
                for (int q = 0; q < 4; ++q) { r0[q + 1] = *(const FK_LAS bf16x8*)(lds + pb + 256 - 64 * q); r1[q + 1] = *(const FK_LAS bf16x8*)(lds + pb + 256 - 64 * q + 32); }
                a0 = *(const FK_LAS bf16x8*)(lds + pa); a1 = *(const FK_LAS bf16x8*)(lds + pa + 32); r0[0] = *(const FK_LAS bf16x8*)(lds + pb); r1[0] = *(const FK_LAS bf16x8*)(lds + pb + 32);
#define HY_STEP(k, more) do { \
                    acc[0] = __builtin_amdgcn_mfma_f32_32x32x16_bf16(a0, r0[k], acc[0], 0, 0, 0); acc[0] = __builtin_amdgcn_mfma_f32_32x32x16_bf16(a1, r1[k], acc[0], 0, 0, 0); \
                    acc[1] = __builtin_amdgcn_mfma_f32_32x32x16_bf16(a0, r0[((k) + 1) % 5], acc[1], 0, 0, 0); acc[1] = __builtin_amdgcn_mfma_f32_32x32x16_bf16(a1, r1[((k) + 1) % 5], acc[1], 0, 0, 0); \
                    if (more) { pa -= 64; pb -= 64; a0 = *(const FK_LAS bf16x8*)(lds + pa); a1 = *(const FK_LAS bf16x8*)(lds + pa + 32); \
                        r0[((k) + 1) % 5] = *(const FK_LAS bf16x8*)(lds + pb); r1[((k) + 1) % 5] = *(const FK_LAS bf16x8*)(lds + pb + 32); } } while (0)
                int d = 0;
#pragma unroll 1
                for (; d + 5 < nd; d += 5) { HY_STEP(0, true); HY_STEP(1, true); HY_STEP(2, true); HY_STEP(3, true); HY_STEP(4, true); }
                { const int rem = nd - d;
                  HY_STEP(0, rem > 1); if (rem > 1) { HY_STEP(1, rem > 2); if (rem > 2) { HY_STEP(2, rem > 3); if (rem > 3) { HY_STEP(3, rem > 4); if (rem > 4) HY_STEP(4, false); } } } }
#undef HY_STEP
            } else {
#define HY_LOAD(A0, A1, B0, B1) do { A0 = *(const FK_LAS bf16x8*)(lds + pa); A1 = *(const FK_LAS bf16x8*)(lds + pa + 32); \
                _Pragma("unroll") for (int g = 0; g < Gm::GPW; ++g) { B0[g] = *(const FK_LAS bf16x8*)(lds + pb + g * Gm::IB * 64); B1[g] = *(const FK_LAS bf16x8*)(lds + pb + g * Gm::IB * 64 + 32); } \
                pa -= 64; pb -= 64; } while (0)
#define HY_MMA(A0, A1, B0, B1) do { _Pragma("unroll") for (int g = 0; g < Gm::GPW; ++g) { acc[g] = __builtin_amdgcn_mfma_f32_32x32x16_bf16(A0, B0[g], acc[g], 0, 0, 0); \
                acc[g] = __builtin_amdgcn_mfma_f32_32x32x16_bf16(A1, B1[g], acc[g], 0, 0, 0); } } while (0)
            bf16x8 xa0, xa1, ya0, ya1, xb0[Gm::GPW], xb1[Gm::GPW], yb0[Gm::GPW], yb1[Gm::GPW];
            HY_LOAD(xa0, xa1, xb0, xb1);
            int d = 0;
#pragma unroll 1
            for (; d + 2 <= nd - 1; d += 2) {
                HY_LOAD(ya0, ya1, yb0, yb1);
                HY_MMA(xa0, xa1, xb0, xb1);
                HY_LOAD(xa0, xa1, xb0, xb1);
                HY_MMA(ya0, ya1, yb0, yb1);
            }
            if (d + 1 <= nd - 1) { HY_LOAD(ya0, ya1, yb0, yb1); HY_MMA(xa0, xa1, xb0, xb1); HY_MMA(ya0, ya1, yb0, yb1); }
            else HY_MMA(xa0, xa1, xb0, xb1);
#undef HY_LOAD
#undef HY_MMA
            }
        }
        __syncthreads();
        const float bias = FIN(17)[l * 512 + o * 256 + ch];
        if (act) {
#pragma unroll
            for (int g = 0; g < Gm::GPW; ++g)
#pragma unroll
                for (int r = 0; r < 16; ++r) { const int pos = 32 * (Gm::IB * (G0 + g) + il) + crow(r, hi);
                    FK_LAS unsigned short* zp = (FK_LAS unsigned short*)(lds + Gm::OFF_Z + bb * Gm::ZRS + (Gm::PADB * 32 + pos) * 2);
                    const float gate = bf2f(*(FK_LAS unsigned short*)(lds + Gm::OFF_G + bb * Gm::ZRS + (Gm::PADB * 32 + pos) * 2));
                    const float zn = gate * (acc[g][r] + bias * bf2f(*zp));
                    *zp = (unsigned short)f2bf(zn); }
        }
        __syncthreads();
        if (o == 0 && ld_act) { FK_LAS char* dst = lds + Gm::OFF_G + tbl * Gm::ZRS + (Gm::PADB * 32 + tp0) * 2;
#pragma unroll
            for (int q = 0; q < 4; ++q) *(FK_LAS u32x4*)(dst + q * 16) = (u32x4){x2p[4 * q], x2p[4 * q + 1], x2p[4 * q + 2], x2p[4 * q + 3]}; }
    }
    __syncthreads();
    if (ld_act && tb < NB) { const size_t tok0 = (L == 2048) ? (size_t)tb * SEQ + tp0 : (size_t)NLAT + tb * CTX + tp0;
        bf16_t* dst = wsp<bf16_t>(A, W.hyo) + (size_t)ch * NTOK + tok0; const FK_LAS char* srcz = lds + Gm::OFF_Z + tbl * Gm::ZRS + (Gm::PADB * 32 + tp0) * 2;
#pragma unroll
        for (int q = 0; q < 4; ++q) *(u32x4*)(dst + q * 8) = *(const FK_LAS u32x4*)(srcz + q * 16); }
    __syncthreads();
}
}

struct FnSched {
    int G, c, big; const char* dft; const char* ft;
    __device__ bool next(int i, Unit& u) const {
        const long Li = (long)i * G + (G - 1 - c);
        const int n = big ? NB * 8 : NB; if (Li >= n) return false;
        const int b = big ? (int)Li >> 3 : (int)Li, mt = big ? (int)Li & 7 : 0;
        u.pm = mt; u.pn = b; u.kind = big; u.aux = 0;
        u.a = dft + (size_t)mt * 256 * (big ? 4096 : 512) * 2; u.b = ft + (size_t)b * 256 * (big ? 4096 : 512) * 2; return true;
    }
};
struct FnEpi {
    bf16_t* fno;
    __device__ __forceinline__ bool operator()(Acc& acc, const Unit& u, int wr, int wc, int fr, int fq) const {
        const size_t t0 = u.kind ? (size_t)u.pn * SEQ + u.pm * 256 : (size_t)NLAT + u.pn * CTX;
#pragma unroll
        for (int ai = 0; ai < 2; ++ai)
#pragma unroll
            for (int m = 0; m < 4; ++m) { bf16_t* rowp = fno + (t0 + 128 * ai + 64 * wr + 16 * m + fr) * 256 + 32 * wc + 8 * fq;
#pragma unroll
                for (int bj = 0; bj < 2; ++bj) { const f32x4 v0 = acc[ai][bj][m][0], v1 = acc[ai][bj][m][1];
                    u32x4 w; w.x = cvt_pk_bf16(v0[0], v0[1]); w.y = cvt_pk_bf16(v0[2], v0[3]); w.z = cvt_pk_bf16(v1[0], v1[1]); w.w = cvt_pk_bf16(v1[2], v1[3]);
                    *(u32x4*)(rowp + 128 * bj) = w; } }
        return true;
    }
};

__device__ __forceinline__ void phase_mix(AP A, FK_LAS unsigned char* lds, int l, int vcu, int G) {
    const int n_lat = NB * 32, n_all = n_lat + (l == 0 ? NB * 4 : 0);
#ifndef FK_REP_SUB
#define FK_REP_SUB 0
#endif
#ifndef FK_NO_ATTN
    for (int rp = (FK_REP_SUB == 1 ? 1 : 0); rp >= 0; --rp)
    for (int u = vcu; u < n_all; u += G) {
        if (u < n_lat) attn::unit(A, (FK_LAS char*)lds, l, u >> 5, (u >> 3) & 3, u & 7);
        else { const int v = u - n_lat; attn::unit(A, (FK_LAS char*)lds, l, v >> 2, v & 3, 8); }
    }
#endif
#ifndef FK_NO_HY
    for (int rp = (FK_REP_SUB == 2 ? 1 : 0); rp >= 0; --rp)
    if (G == 256) { if (vcu < 192) hy::unit<2048, 8>(A, (FK_LAS char*)lds, l, vcu, 0); if (vcu >= 64 && vcu < 128) hy::unit<2048, 8>(A, (FK_LAS char*)lds, l, vcu + 128, 0); }
    else for (int ch = vcu; ch < 256; ch += G) hy::unit<2048, 8>(A, (FK_LAS char*)lds, l, ch, 0);
    if (l == 0) { if (G == 256) { const int slot = vcu < 64 ? vcu : (vcu >= 128 && vcu < 192) ? vcu - 64 : -1;
                      if (slot >= 0) { hy::unit<256, 8>(A, (FK_LAS char*)lds, l, slot, 0); hy::unit<256, 8>(A, (FK_LAS char*)lds, l, slot + 128, 0); } }
                  else for (int ch = vcu; ch < 256; ch += G) hy::unit<256, 8>(A, (FK_LAS char*)lds, l, ch, 0); }
#endif
#ifndef FK_NO_FN
    for (int rp = (FK_REP_SUB == 3 ? 1 : 0); rp >= 0; --rp)
    { FnSched S{G, vcu, 1, (const char*)wsp<bf16_t>(A, W.dftl), (const char*)wsp<bf16_t>(A, W.ftl)}; FnEpi E{wsp<bf16_t>(A, W.fno)}; gemm_phase(lds, 4096, S, E); }
    if (l == 0) { const int cctx = (G == 256) ? ((vcu >= 128 && vcu < 136) ? G - 1 - (vcu - 128) : 0) : vcu;
                  FnSched S{G, cctx, 0, (const char*)wsp<bf16_t>(A, W.dftc), (const char*)wsp<bf16_t>(A, W.ftc)}; FnEpi E{wsp<bf16_t>(A, W.fno)}; gemm_phase(lds, 512, S, E); }
#endif
    if (l == 1 && G == 256) { const int slot = vcu < 64 ? vcu : (vcu >= 128 && vcu < 192) ? vcu - 64 : -1;
        if (slot >= 0) conv_tables(A, 1, wsp<unsigned char>(A, W.ub1), wsp<unsigned char>(A, W.vb1), slot, 128, opaque_tid()); }
}
#define FK_HAVE_MERGE 1
#define FK_HAVE_OUT 1
#define FK_HAVE_NORM 1
#define FK_HAVE_PQ 1
#ifndef FK_MERGE_XCD
#define FK_MERGE_XCD 0
#endif
__device__ __forceinline__ bool merge_tile(int mode, int j, int c, int G, int ntile, int& pm, int& pn) {
    if (mode == 1) { const int T = c < 224 ? c : c + 32; pm = T >> 2; pn = T & 3; return j == 0; }
    if (mode == 2) { const int T = 224 + c; pm = T >> 2; pn = T & 3; return j == 0 && c < 32; }
    if (FK_MERGE_XCD && G == 256 && ntile <= 288) { const int xcd = c & 7, loc = c >> 3;
        if (j == 0) { pm = xcd * 8 + (loc >> 2); pn = loc & 3; return true; }
        pm = 64 + xcd; pn = loc & 3; return j == 1 && loc < 4 && pm * 4 < ntile; }
    const long T = (long)j * G + c; pm = (int)(T >> 2); pn = (int)(T & 3); return T < ntile;
}
struct MergeSched {
    int G, c, ntile, mode; const char *a0, *a1, *a2, *a3; const char* w;
    __device__ bool next(int i, Unit& u) const {
        const int j = i >> 2, s = i & 3; int pm_, pn_; if (!merge_tile(mode, j, c, G, ntile, pm_, pn_)) return false;
        u.pm = pm_; u.pn = pn_; u.kind = s; u.aux = 0;
        u.a = (s == 0) ? a0 + (size_t)(j * 256 + c) * 256 * 256 * 2 : (s == 1 ? a1 : s == 2 ? a2 : a3) + (size_t)u.pm * 256 * 256 * 2; u.b = w + ((size_t)s * 1024 + u.pn * 256) * 256 * 2; return true;
    }
};
struct MergeEpi {
    const bf16_t* g; bf16_t* y;
    __device__ __forceinline__ bool operator()(Acc& acc, const Unit& u, int wr, int wc, int fr, int fq) const {
        const int s = u.kind; if (s == 2) return false;
        const unsigned char* gpn = (const unsigned char*)g + gate_frag(u.pm, (s == 3 ? 2 : s) * 4 + u.pn, wr, wc, fr, fq); const unsigned char* gpd = (const unsigned char*)g + gate_frag(u.pm, (s == 3 ? 2 : s + 1) * 4 + u.pn, wr, wc, fr, fq);
#pragma unroll
        for (int ai = 0; ai < 2; ++ai)
#pragma unroll
            for (int m = 0; m < 4; ++m) { const size_t t = (size_t)u.pm * 256 + 128 * ai + 64 * wr + 16 * m + fr;
#pragma unroll
                for (int bj = 0; bj < 2; ++bj) { const int c = u.pn * 256 + 128 * bj + 32 * wc + 8 * fq; const int fo = ((ai * 4 + m) * 2 + bj) * 512;
                    { const u32x2 wn = *(const u32x2*)(gpn + fo);
                      f32x4 f0 = {(float)(wn.x & 0xffu), (float)((wn.x >> 8) & 0xffu), (float)((wn.x >> 16) & 0xffu), (float)(wn.x >> 24)}, f1 = {(float)(wn.y & 0xffu), (float)((wn.y >> 8) & 0xffu), (float)((wn.y >> 16) & 0xffu), (float)(wn.y >> 24)};
                      if (s != 3) { const u32x2 wd = *(const u32x2*)(gpd + fo);
                          f0[0] *= __builtin_amdgcn_rcpf((float)(wd.x & 0xffu)); f0[1] *= __builtin_amdgcn_rcpf((float)((wd.x >> 8) & 0xffu)); f0[2] *= __builtin_amdgcn_rcpf((float)((wd.x >> 16) & 0xffu)); f0[3] *= __builtin_amdgcn_rcpf((float)(wd.x >> 24));
                          f1[0] *= __builtin_amdgcn_rcpf((float)(wd.y & 0xffu)); f1[1] *= __builtin_amdgcn_rcpf((float)((wd.y >> 8) & 0xffu)); f1[2] *= __builtin_amdgcn_rcpf((float)((wd.y >> 16) & 0xffu)); f1[3] *= __builtin_amdgcn_rcpf((float)(wd.y >> 24)); }
                      else { f0 = f0 * (1.f / 255.f); f1 = f1 * (1.f / 255.f); }
                      acc[ai][bj][m][0] = acc[ai][bj][m][0] * f0; acc[ai][bj][m][1] = acc[ai][bj][m][1] * f1; }
                    if (s == 3) { const f32x4 v0 = acc[ai][bj][m][0], v1 = acc[ai][bj][m][1];
                        u32x4 w; w.x = cvt_pk_bf16(v0[0], v0[1]); w.y = cvt_pk_bf16(v0[2], v0[3]); w.z = cvt_pk_bf16(v1[0], v1[1]); w.w = cvt_pk_bf16(v1[2], v1[3]); ST_NT((u32x4*)(y + t * 1024 + c), w); } }
                }
        return s == 3;
    }
};
struct OneTileSched {
    int T, K; const char* a; const char* w;
    __device__ bool next(int i, Unit& u) const { if (i != 0 || T < 0) return false; u.pm = T >> 2; u.pn = T & 3; u.kind = 0; u.aux = 0; u.a = a + (size_t)u.pm * 256 * K * 2; u.b = w + (size_t)u.pn * 256 * K * 2; return true; }
};
struct OutEpi;
__device__ __forceinline__ void outproj_one(AP A, FK_LAS unsigned char* lds, int l, int T);
__device__ __forceinline__ bool l0_split(int l, int G, int use_bar) { return l == 0 && G == 256 && NTT == 72 && use_bar != 0; }
__device__ __forceinline__ void phase_merge(AP A, FK_LAS unsigned char* lds, int l, int G, const XcdBarrier bar, const int use_bar) {
    const bool split = l0_split(l, G, use_bar);
    MergeSched S; S.G = G; S.c = (int)blockIdx.x; S.ntile = (l == 0 ? NTT : NTL) * 4;
#pragma unroll 1
    for (int pass = 0; pass < (split ? 2 : 1); ++pass) {
    S.mode = split ? pass + 1 : 0;
    if (pass == 1) { xcd_barrier(bar); A = opaque_args(A);
        if (S.c >= 32) { outproj_one(A, lds, 0, S.c - 32);
            conv_tables(A, 0, wsp<unsigned char>(A, W.ub), wsp<unsigned char>(A, W.vb), S.c - 32, 224, opaque_tid(), 1); break; } }
#ifndef FK_REP_SUB
#define FK_REP_SUB 0
#endif
    for (int rp7 = (FK_REP_SUB == 7 && l == 1) ? 1 : 0; rp7 >= 0; --rp7)
    { const int tid = opaque_tid(); const bf16_t* hyot = wsp<bf16_t>(A, W.hyo); bf16_t* scr = wsp<bf16_t>(A, W.q);
      constexpr int RS = 516;
      for (int j = 0; ; ++j) { int pm, pn_; if (!merge_tile(S.mode, j, S.c, G, S.ntile, pm, pn_)) break; bf16_t* dst = scr + (size_t)(j * 256 + S.c) * 65536;
          u32x4 pv[4];
#pragma unroll
          for (int i = 0; i < 4; ++i) { const int idx = tid + 512 * i, chl = idx >> 5, t8 = (idx & 31) * 8; pv[i] = *(const u32x4*)(hyot + (size_t)chl * NTOK + (size_t)pm * 256 + t8); }
          for (int cq = 0; cq < 4; ++cq) {
              __syncthreads();
#pragma unroll
              for (int i = 0; i < 4; ++i) { const int idx = tid + 512 * i, chl = idx >> 5, t8 = (idx & 31) * 8;
                  FK_LAS unsigned* p = (FK_LAS unsigned*)(lds + chl * RS + t8 * 2); p[0] = pv[i].x; p[1] = pv[i].y; p[2] = pv[i].z; p[3] = pv[i].w; }
              if (cq < 3) {
#pragma unroll
                  for (int i = 0; i < 4; ++i) { const int idx = tid + 512 * i, chl = idx >> 5, t8 = (idx & 31) * 8; pv[i] = *(const u32x4*)(hyot + (size_t)((cq + 1) * 64 + chl) * NTOK + (size_t)pm * 256 + t8); } }
              __syncthreads();
#pragma unroll
              for (int i = 0; i < 4; ++i) { const int idx = tid + 512 * i, tok = idx >> 3, c8 = (idx & 7) * 8; unsigned short e[8];
#pragma unroll
                  for (int q = 0; q < 8; ++q) e[q] = *(const FK_LAS unsigned short*)(lds + (c8 + q) * RS + tok * 2);
                  *(u32x4*)(dst + (size_t)tok * 256 + cq * 64 + c8) = (u32x4){(unsigned)e[0] | ((unsigned)e[1] << 16), (unsigned)e[2] | ((unsigned)e[3] << 16), (unsigned)e[4] | ((unsigned)e[5] << 16), (unsigned)e[6] | ((unsigned)e[7] << 16)}; }
          } }
      asm volatile("s_waitcnt vmcnt(0)" ::: "memory"); __syncthreads(); }
    S.a0 = (const char*)wsp<bf16_t>(A, W.q); S.a1 = (const char*)wsp<bf16_t>(A, W.fno); S.a2 = (const char*)wsp<bf16_t>(A, W.attlo); S.a3 = (const char*)wsp<bf16_t>(A, W.atthi);
    S.w = (const char*)(wsp<bf16_t>(A, W.w_mrg) + (size_t)l * 4 * 1024 * 256);
    MergeEpi E{wsp<bf16_t>(A, W.g), wsp<bf16_t>(A, W.y)};
    gemm_phase(lds, 256, S, E);
    }
}
struct PlainSched {
    int G, c, nM, nN, K; const char* a; const char* w;
    __device__ bool next(int i, Unit& u) const {
        const long T = (long)i * G + c; if (T >= (long)nM * nN) return false;
        int wgid = (int)T; const int nwg = nM * nN; { const int q = nwg / 8, r = nwg % 8, xcd = wgid % 8, off = wgid / 8; wgid = (xcd < r ? xcd * (q + 1) : r * (q + 1) + (xcd - r) * q) + off; }
        const int nig = 8 * nN, gid = wgid / nig, fm = gid * 8, gsz = (nM - fm) < 8 ? (nM - fm) : 8;
        u.pm = fm + ((wgid % nig) % gsz); u.pn = (wgid % nig) / gsz; u.kind = 0; u.aux = 0;
        u.a = a + (size_t)u.pm * 256 * K * 2; u.b = w + (size_t)u.pn * 256 * K * 2; return true;
    }
};
struct OutEpi {
    const float* x_in; const float* ctx_in; const float* xl; float* xc; const float* mod; int l; float* xo;
    __device__ __forceinline__ bool operator()(Acc& acc, const Unit& u, int wr, int wc, int fr, int fq) const {
        const bool lat = u.pm < NTL; const int mr = lat ? u.pm >> 3 : 8;
        const float* gate = mod + (size_t)mr * 6144 + 2 * 1024;
#pragma unroll
        for (int bj = 0; bj < 2; ++bj) { const int c = u.pn * 256 + 128 * bj + 32 * wc + 8 * fq;
            const f32x4 g0 = *(const f32x4*)(gate + c), g1 = *(const f32x4*)(gate + c + 4);
#pragma unroll
            for (int ai = 0; ai < 2; ++ai)
#pragma unroll
                for (int m = 0; m < 4; ++m) { const int rl = 128 * ai + 64 * wr + 16 * m + fr;
                    const size_t t = (size_t)u.pm * 256 + rl, tc = t - NLAT;
                    const float* bp = lat ? ((l == 0 ? x_in : xl) + t * 1024 + c) : (ctx_in + tc * 1024 + c);
                    float* op = lat ? (xo + t * 1024 + c) : (xc + tc * 1024 + c);
                    const f32x4 b0 = *(const f32x4*)bp, b1 = *(const f32x4*)(bp + 4);
                    ST_NT((f32x4*)op, b0 + g0 * acc[ai][bj][m][0]); ST_NT((f32x4*)(op + 4), b1 + g1 * acc[ai][bj][m][1]); } }
        return true;
    }
};
__device__ __forceinline__ void outproj_one(AP A, FK_LAS unsigned char* lds, int l, int T) {
    OneTileSched S{T, 1024, (const char*)wsp<bf16_t>(A, W.y), (const char*)(wsp<bf16_t>(A, W.w_out) + (size_t)l * 1024 * 1024)};
    OutEpi E{FIN(0), FIN(2), A->xl, wsp<float>(A, W.xc), wsp<float>(A, W.mod) + (size_t)l * 9 * 6144, l, A->xl};
    gemm_phase(lds, 1024, S, E);
}
__device__ __forceinline__ void phase_outproj(AP A, FK_LAS unsigned char* lds, int l, int G, int dry, int use_bar) {
    if (l0_split(l, G, use_bar) && !dry) {
        const int c = (int)blockIdx.x;
        if (c < 64) outproj_one(A, lds, 0, 224 + c); else conv_tables(A, 0, wsp<unsigned char>(A, W.ub), wsp<unsigned char>(A, W.vb), c - 64, 192, opaque_tid(), 2);
        return; }
    PlainSched S{G, (int)blockIdx.x, l == 0 ? NTT : NTL, 4, 1024, (const char*)wsp<bf16_t>(A, W.y), (const char*)(wsp<bf16_t>(A, W.w_out) + (size_t)l * 1024 * 1024)};
    OutEpi E{FIN(0), FIN(2), A->xl, wsp<float>(A, W.xc), wsp<float>(A, W.mod) + (size_t)l * 9 * 6144, l, dry ? wsp<float>(A, W.g) : A->xl};
    gemm_phase(lds, 1024, S, E);
    if (l == 0 && G == 256 && !dry && (int)blockIdx.x >= 32) conv_tables(A, 0, wsp<unsigned char>(A, W.ub), wsp<unsigned char>(A, W.vb), (int)blockIdx.x - 32, 224, opaque_tid());
}
__device__ __forceinline__ void phase_norm(AP A, int l, int vcu, int G) {
    const int tid = opaque_tid(), lane = tid & 63, wave = __builtin_amdgcn_readfirstlane(tid >> 6);
    const int gw = vcu * NWAVES + wave, NGW = G * NWAVES;
    const float* mod = wsp<float>(A, W.mod) + (size_t)l * 9 * 6144;
    const int nrow = l == 0 ? NTOK : NLAT;
    for (int t = gw; t < nrow; t += NGW) {
        const bool lat = t < NLAT; const int mr = lat ? t / SEQ : 8;
        const float* xr = lat ? A->xl + (size_t)t * DM : wsp<float>(A, W.xc) + (size_t)(t - NLAT) * DM;
        modulate_row_bf16(xr, FIN(7) + l * DM, mod + (size_t)mr * 6144 + 4 * 1024, mod + (size_t)mr * 6144 + 3 * 1024, wsp<bf16_t>(A, W.nn) + (size_t)t * DM, lane);
    }
}
struct PqEpi {
    bf16_t* pq;
    __device__ __forceinline__ bool operator()(Acc& acc, const Unit& u, int wr, int wc, int fr, int fq) const {
#pragma unroll
        for (int ai = 0; ai < 2; ++ai)
#pragma unroll
            for (int m = 0; m < 4; ++m) { bf16_t* rowp = pq + ((size_t)u.pm * 256 + 128 * ai + 64 * wr + 16 * m + fr) * 2048 + u.pn * 256 + 32 * wc + 8 * fq;
#pragma unroll
                for (int bj = 0; bj < 2; ++bj) { const f32x4 v0 = acc[ai][bj][m][0], v1 = acc[ai][bj][m][1];
                    u32x4 w; w.x = cvt_pk_bf16(v0[0], v0[1]); w.y = cvt_pk_bf16(v0[2], v0[3]); w.z = cvt_pk_bf16(v1[0], v1[1]); w.w = cvt_pk_bf16(v1[2], v1[3]);
                    ST_NT((u32x4*)(rowp + 128 * bj), w); } }
        return true;
    }
};
__device__ __forceinline__ void phase_peerq(AP A, FK_LAS unsigned char* lds, int l, int G) {
    PlainSched S{G, (int)blockIdx.x, l == 0 ? NTT : NTL, 8, 1024, (const char*)wsp<bf16_t>(A, W.nn), (const char*)(wsp<bf16_t>(A, W.w_q) + (size_t)l * 2048 * 1024)};
    PqEpi E{wsp<bf16_t>(A, W.pq)};
    gemm_phase(lds, 1024, S, E);
}
#define FK_HAVE_PEER 1
namespace peer {
typedef __bf16 bf16x2v __attribute__((ext_vector_type(2)));
__device__ __forceinline__ float dot2(unsigned a, unsigned b, float c) { return __builtin_amdgcn_fdot2_f32_bf16(__builtin_bit_cast(bf16x2v, a), __builtin_bit_cast(bf16x2v, b), c, false); }
__device__ __forceinline__ unsigned ford(float f) { const unsigned u = __float_as_uint(f); return (u & 0x80000000u) ? ~u : (u | 0x80000000u); }
__device__ __forceinline__ float funord(unsigned o) { return __uint_as_float((o & 0x80000000u) ? (o & 0x7fffffffu) : ~o); }
__device__ __forceinline__ unsigned umax(unsigned a, unsigned b) { return a > b ? a : b; }
__device__ __forceinline__ unsigned umin(unsigned a, unsigned b) { return a < b ? a : b; }
template <int N> __device__ __forceinline__ void sort_desc(unsigned (&v)[N]) {
#pragma unroll
    for (int k = 2; k <= N; k <<= 1)
#pragma unroll
        for (int j = k >> 1; j > 0; j >>= 1)
#pragma unroll
            for (int i = 0; i < N; ++i) { const int l = i ^ j;
                if (l > i) { const unsigned a = v[i], b = v[l], mx = umax(a, b), mn = umin(a, b); if ((i & k) == 0) { v[i] = mx; v[l] = mn; } else { v[i] = mn; v[l] = mx; } } }
}
template <int N> __device__ __forceinline__ void merge_desc(unsigned (&v)[N]) {
#pragma unroll
    for (int j = N >> 1; j > 0; j >>= 1)
#pragma unroll
        for (int i = 0; i < N; ++i) { const int l = i ^ j; if (l > i) { const unsigned a = v[i], b = v[l]; v[i] = umax(a, b); v[l] = umin(a, b); } }
}
__device__ __forceinline__ int crow(int r, int hi) { return (r & 3) + 8 * (r >> 2) + 4 * hi; }
constexpr int L_RIDX = 0, L_RG = 32 * 128 * 2, L_TBL = L_RG + 32 * 128 * 4, L_WK = L_TBL + 8 * 32 * 32, L_END = L_WK + 8 * 128 * 4;

template <bool PF> __device__ __forceinline__ void score_top16(const bf16_t* keys  , const bf16_t* qrow  , int r32, int hi, unsigned (&top)[16], const unsigned* pf, unsigned& pf0, unsigned& pf1) {
    f32x16 acc[4];
    int koff = r32 * 128 + 8 * hi; asm volatile("" : "+v"(koff));
    const bf16_t* kbase = keys + koff; const bf16_t* qb = qrow + 8 * hi;
#pragma unroll
    for (int kt = 0; kt < 4; ++kt) acc[kt] = f32x16{};
    bf16x8 bq[8], ka[8], kb2[8];
#pragma unroll
    for (int ks = 0; ks < 8; ++ks) bq[ks] = *(const bf16x8*)(qb + 16 * ks);
#define KLOAD(dst, kt) do { _Pragma("unroll") for (int ks = 0; ks < 8; ++ks) dst[ks] = *(const bf16x8*)(kbase + 32 * (kt) * 128 + 16 * ks); } while (0)
#define KMMA(src, kt) do { _Pragma("unroll") for (int ks = 0; ks < 8; ++ks) acc[kt] = __builtin_amdgcn_mfma_f32_32x32x16_bf16(src[ks], bq[ks], acc[kt], 0, 0, 0); } while (0)
    KLOAD(ka, 0); asm volatile("" ::: "memory");
    KLOAD(kb2, 1); KMMA(ka, 0); asm volatile("" ::: "memory");
    KLOAD(ka, 2); KMMA(kb2, 1); asm volatile("" ::: "memory");
    KLOAD(kb2, 3); KMMA(ka, 2); asm volatile("" ::: "memory");
    KMMA(kb2, 3);
    if (PF) { asm volatile("" ::: "memory"); pf0 = pf[0]; pf1 = pf[32]; asm volatile("" ::: "memory"); }
#undef KLOAD
#undef KMMA
    unsigned v[64]; const unsigned hi4 = 4u * (unsigned)hi;
#pragma unroll
    for (int kt = 0; kt < 4; ++kt)
#pragma unroll
        for (int r = 0; r < 16; ++r) v[kt * 16 + r] = ((ford(acc[kt][r]) & ~0x7fu) | (unsigned)(127 - (32 * kt + (r & 3) + 8 * (r >> 2)))) - hi4;
    unsigned g0[16], g1[16], g2[16], g3[16];
#pragma unroll
    for (int i = 0; i < 16; ++i) { g0[i] = v[i]; g1[i] = v[16 + i]; g2[i] = v[32 + i]; g3[i] = v[48 + i]; }
    sort_desc<16>(g0); sort_desc<16>(g1); sort_desc<16>(g2); sort_desc<16>(g3);
#pragma unroll
    for (int i = 0; i < 16; ++i) { g0[i] = umax(g0[i], g1[15 - i]); g2[i] = umax(g2[i], g3[15 - i]); }
    merge_desc<16>(g0); merge_desc<16>(g2);
#pragma unroll
    for (int i = 0; i < 16; ++i) g0[i] = umax(g0[i], g2[15 - i]);
    merge_desc<16>(g0);
#pragma unroll
    for (int i = 0; i < 16; ++i) { const unsigned o = (unsigned)__shfl_xor((int)g0[15 - i], 32); top[i] = umax(g0[i], o); }
    merge_desc<16>(top);
}
__device__ __forceinline__ void phase(AP A, FK_LAS unsigned char* lds, int l, int vcu, int G, int dry_in, const XcdBarrier bar, const int use_bar) {
    const int dry = dry_in;
#define GBAR() do { if (use_bar) xcd_barrier(bar); } while (0)
    const int tid = opaque_tid(), lane = tid & 63, wave = __builtin_amdgcn_readfirstlane(tid >> 6), r32 = lane & 31, hi = lane >> 5;
    const int TS = (l == 0 && (NTOK % 24) == 0) ? 24 : 32, TPW = TS / 8;
    const int ntile = (l == 0 ? NTOK : NLAT) / TS;
    const bf16_t* keys = wsp<bf16_t>(A, W.keys) + (size_t)l * 16 * 128 * 128;
    const float* mod = wsp<float>(A, W.mod) + (size_t)l * 9 * 6144;
    FK_LAS unsigned short* ridx = (FK_LAS unsigned short*)(lds + L_RIDX); FK_LAS float* rg = (FK_LAS float*)(lds + L_RG);
    FK_LAS unsigned char* tbl = (FK_LAS unsigned char*)(lds + L_TBL) + wave * 32 * 32; FK_LAS float* wk = (FK_LAS float*)(lds + L_WK) + wave * 128;
    for (int tile = vcu; tile < ntile; tile += G) {
        const int t0 = tile * TS; const int rtok = r32 < TS ? r32 : TS - 1;
        __syncthreads();
#ifndef FK_REP_SUB
#define FK_REP_SUB 0
#endif
        for (int rp = (FK_REP_SUB == 4 ? 1 : 0); rp >= 0; --rp) {
            const int h = wave; unsigned s1[16], s2[16];
            const bf16_t* qrow = wsp<bf16_t>(A, W.pq) + (size_t)(t0 + rtok) * 2048 + h * 256;
            const int ntl = (tile + G < ntile) ? tile + G : tile; unsigned pf0 = 0u, pf1 = 0u;
            const unsigned* pfp = (const unsigned*)(wsp<bf16_t>(A, W.pq) + (size_t)(ntl * TS + rtok) * 2048 + h * 256 + hi * 128);
            score_top16<false>(keys + (size_t)(h * 2 + 0) * 128 * 128, qrow, r32, hi, s1, pfp, pf0, pf1);
            score_top16<true>(keys + (size_t)(h * 2 + 1) * 128 * 128, qrow + 128, r32, hi, s2, pfp, pf0, pf1);
            if (hi == 0) {
#pragma unroll
                for (int i = 0; i < 16; ++i) { tbl[r32 * 32 + i] = (unsigned char)(127 - (s1[i] & 127u)); tbl[r32 * 32 + 16 + i] = (unsigned char)(127 - (s2[i] & 127u)); } }
            float f1[16], f2[16];
#pragma unroll
            for (int i = 0; i < 16; ++i) { f1[i] = funord(s1[i] & ~0x7fu); f2[i] = funord(s2[i] & ~0x7fu); }
            unsigned c[32]; int cn = 0;
#pragma unroll
            for (int i = 0; i < 16; ++i)
#pragma unroll
                for (int j = 0; j < 16; ++j) if ((i + 1) * (j + 1) <= 16) {
                    const unsigned pk = (ford(f1[i] + f2[j]) & ~0xffu) | (unsigned)(255 - (i * 16 + j));
                    if ((cn & 1) == 0) c[cn >> 1] = pk; else c[cn >> 1] = hi ? pk : c[cn >> 1];
                    ++cn; }
#pragma unroll
            for (int q = 25; q < 32; ++q) c[q] = 0u;
            sort_desc<32>(c);
            unsigned ct[16];
#pragma unroll
            for (int i = 0; i < 16; ++i) { const unsigned o = (unsigned)__shfl_xor((int)c[15 - i], 32); ct[i] = umax(c[i], o); }
            merge_desc<16>(ct);
            if (hi == 0 && r32 < TS) {
                float e[16]; float sum = 0.f; const float mx = funord(ct[0] & ~0xffu);
#pragma unroll
                for (int t = 0; t < 16; ++t) { e[t] = __expf(funord(ct[t] & ~0xffu) - mx); sum += e[t]; }
                const float inv = 1.f / sum;
#pragma unroll
                for (int t = 0; t < 16; ++t) { const int ci = 255 - (int)(ct[t] & 0xffu); const int e1 = tbl[r32 * 32 + (ci >> 4)], e2 = tbl[r32 * 32 + 16 + (ci & 15)];
                    const int idx = e1 * 128 + e2; const float gg = e[t] * inv;
                    ridx[r32 * 128 + h * 16 + t] = (unsigned short)idx; rg[r32 * 128 + h * 16 + t] = gg;
                    wsp<unsigned short>(A, W.pidx)[(size_t)(t0 + r32) * 128 + ((h * 16 + t) & 7) * 16 + ((h * 16 + t) >> 3)] = (unsigned short)idx; wsp<float>(A, W.pg)[(size_t)(t0 + r32) * 128 + h * 16 + t] = gg; }
            }
            asm volatile("" :: "v"(pf0), "v"(pf1));
        }
    }
    if (G != 256) return;
    GBAR();
    const int sl = (int)blockIdx.x & 7, rk = (int)blockIdx.x >> 3, ntok = (l == 0 ? NTOK : NLAT);
    const int r8 = lane >> 3, cc = lane & 7;
    A = opaque_args(A);
    const unsigned short* pidx = wsp<unsigned short>(A, W.pidx); const float* pgw = wsp<float>(A, W.pg);
    unsigned* hidp = wsp<unsigned>(A, W.pq);
    for (int rp = (FK_REP_SUB == 5 ? 1 : 0); rp >= 0; --rp) {
        const unsigned char* Us = wsp<unsigned char>(A, l == 0 ? W.ub : W.ub1) + (size_t)sl * 16384 * 128; const unsigned cc16 = 16u * (unsigned)cc;
        const bf16_t* nn = wsp<bf16_t>(A, W.nn) + 128 * sl + 16 * cc;
#define TLOAD(IK, N0, N1, t) do { const u32x4 i0_ = *(const u32x4*)(pidx + (size_t)(t) * 128 + r8 * 16), i1_ = *(const u32x4*)(pidx + (size_t)(t) * 128 + r8 * 16 + 8); \
            IK[0] = i0_.x; IK[1] = i0_.y; IK[2] = i0_.z; IK[3] = i0_.w; IK[4] = i1_.x; IK[5] = i1_.y; IK[6] = i1_.z; IK[7] = i1_.w; \
            N0 = *(const u32x4*)(nn + (size_t)(t) * DM); N1 = *(const u32x4*)(nn + (size_t)(t) * DM + 8); } while (0)
#define GLOAD(GB, IK) do { _Pragma("unroll") for (int i = 0; i < 16; ++i) GB[i] = *(const u32x4*)(Us + (((IK[i >> 1] >> (16 * (i & 1))) & 0xffffu) * 128u + cc16)); } while (0)
#define NUNPK(N0, N1) do { nf[0] = bflo(N0.x); nf[1] = bfhi(N0.x); nf[2] = bflo(N0.y); nf[3] = bfhi(N0.y); nf[4] = bflo(N0.z); nf[5] = bfhi(N0.z); nf[6] = bflo(N0.w); nf[7] = bfhi(N0.w); \
            nf[8] = bflo(N1.x); nf[9] = bfhi(N1.x); nf[10] = bflo(N1.y); nf[11] = bfhi(N1.y); nf[12] = bflo(N1.z); nf[13] = bfhi(N1.z); nf[14] = bflo(N1.w); nf[15] = bfhi(N1.w); } while (0)
#define HDOT(GB, t, h) do { float p[8]; \
            _Pragma("unroll") for (int i = 0; i < 8; ++i) { const unsigned aw[4] = {GB[8 * (h) + i].x, GB[8 * (h) + i].y, GB[8 * (h) + i].z, GB[8 * (h) + i].w}; f32x2 d2 = {0.f, 0.f}; \
                _Pragma("unroll") for (int q = 0; q < 4; ++q) { const f32x2 lo = __builtin_amdgcn_cvt_pk_f32_fp8(aw[q], false), hh = __builtin_amdgcn_cvt_pk_f32_fp8(aw[q], true); \
                    d2 = lo * (f32x2){nf[4 * q], nf[4 * q + 1]} + d2; d2 = hh * (f32x2){nf[4 * q + 2], nf[4 * q + 3]} + d2; }     \
                p[i] = d2[0] + d2[1]; } \
            _Pragma("unroll") for (int i = 0; i < 4; ++i) { const float send = (cc & 1) ? p[i] : p[i + 4], keep = (cc & 1) ? p[i + 4] : p[i]; p[i] = keep + __shfl_xor(send, 1); } \
            _Pragma("unroll") for (int i = 0; i < 2; ++i) { const float send = (cc & 2) ? p[i] : p[i + 2], keep = (cc & 2) ? p[i + 2] : p[i]; p[i] = keep + __shfl_xor(send, 2); } \
            { const float send = (cc & 4) ? p[0] : p[1], keep = (cc & 4) ? p[1] : p[0]; p[0] = keep + __shfl_xor(send, 4); } \
            const int v = 4 * (cc & 1) + 2 * ((cc >> 1) & 1) + ((cc >> 2) & 1); \
            if ((h) == 0) ph0 = p[0]; else hidp[((size_t)(t) * 8 + sl) * 64 + 8 * v + r8] = cvt_pk_bf16(ph0, p[0]); } while (0)
        unsigned ikA[8], ikB[8]; u32x4 nA0, nA1, nB0, nB1, ga[16], gb[16]; float nf[16], ph0 = 0.f;
        int t = rk + 32 * wave, t1 = t + 256;
        if (t < ntok) TLOAD(ikA, nA0, nA1, t);
        if (t1 < ntok) TLOAD(ikB, nB0, nB1, t1);
        if (t < ntok) GLOAD(ga, ikA);
#pragma unroll 1
        while (t < ntok) {
            NUNPK(nA0, nA1);
            const int t2 = t + 512;
            if (t2 < ntok) TLOAD(ikA, nA0, nA1, t2);
            if (t1 < ntok) GLOAD(gb, ikB);
            HDOT(ga, t, 0); HDOT(ga, t, 1);
            if (t1 >= ntok) break;
            NUNPK(nB0, nB1);
            const int t3 = t1 + 512;
            if (t3 < ntok) TLOAD(ikB, nB0, nB1, t3);
            if (t2 < ntok) GLOAD(ga, ikA);
            HDOT(gb, t1, 0); HDOT(gb, t1, 1);
            t = t2; t1 = t3;
        }
#undef TLOAD
#undef GLOAD
#undef NUNPK
#undef HDOT
    }
    GBAR();
    for (int rp = (FK_REP_SUB == 6 ? 1 : 0); rp >= 0; --rp) { const int dry = dry_in | rp;
        const unsigned char* Vs = wsp<unsigned char>(A, l == 0 ? W.vb : W.vb1) + (size_t)sl * 16384 * 128; const unsigned cc16 = 16u * (unsigned)cc;
#define TLOADI(IK, t) do { const u32x4 i0_ = *(const u32x4*)(pidx + (size_t)(t) * 128 + r8 * 16), i1_ = *(const u32x4*)(pidx + (size_t)(t) * 128 + r8 * 16 + 8); \
            IK[0] = i0_.x; IK[1] = i0_.y; IK[2] = i0_.z; IK[3] = i0_.w; IK[4] = i1_.x; IK[5] = i1_.y; IK[6] = i1_.z; IK[7] = i1_.w; } while (0)
#define TLOADH(H, PGV, t) do { const unsigned* hp_ = hidp + (size_t)(t) * 512 + lane; _Pragma("unroll") for (int q = 0; q < 8; ++q) H[q] = hp_[q * 64]; \
            PGV[0] = pgw[(size_t)(t) * 128 + lane]; PGV[1] = pgw[(size_t)(t) * 128 + 64 + lane]; \
            { const bool lat_ = (t) < NLAT; xN = *(const f32x2*)((lat_ ? A->xl + (size_t)(t) * DM : wsp<float>(A, W.xc) + (size_t)((t) - NLAT) * DM) + xcol); \
              gN = *(const f32x2*)(mod + (size_t)(lat_ ? (t) / SEQ : 8) * 6144 + 5 * 1024 + xcol); } } while (0)
#define GLOAD2(GB, IK) do { _Pragma("unroll") for (int i = 0; i < 16; ++i) GB[i] = *(const u32x4*)(Vs + (((IK[i >> 1] >> (16 * (i & 1))) & 0xffffu) * 128u + cc16)); } while (0)
#define WCALC(H, PGV) do { float h0 = 0.f, h1 = 0.f; _Pragma("unroll") for (int q = 0; q < 8; ++q) { h0 += bflo(H[q]); h1 += bfhi(H[q]); } h0 *= (1.f / SU); h1 *= (1.f / SU); \
            w0 = PGV[0] * 0.5f * h0 * (1.f + erff(h0 * 0.70710678118654752f)) * (1.f / SV); w1 = PGV[1] * 0.5f * h1 * (1.f + erff(h1 * 0.70710678118654752f)) * (1.f / SV); xC = xN; gC = gN; } while (0)
#define VACC(GB, h) do { _Pragma("unroll") for (int i = 0; i < 8; ++i) { const float w = __shfl((h) ? w1 : w0, 8 * i + r8); const unsigned aw[4] = {GB[8 * (h) + i].x, GB[8 * (h) + i].y, GB[8 * (h) + i].z, GB[8 * (h) + i].w}; \
                _Pragma("unroll") for (int q = 0; q < 4; ++q) { const f32x2 lo = __builtin_amdgcn_cvt_pk_f32_fp8(aw[q], false), hh = __builtin_amdgcn_cvt_pk_f32_fp8(aw[q], true); const f32x2 w2 = {w, w}; \
                    f32x2 ya = {y[4 * q], y[4 * q + 1]}, yb = {y[4 * q + 2], y[4 * q + 3]}; ya = w2 * lo + ya; yb = w2 * hh + yb; y[4 * q] = ya[0]; y[4 * q + 1] = ya[1]; y[4 * q + 2] = yb[0]; y[4 * q + 3] = yb[1]; } } } while (0)
#define XUPD(t) do { \
            _Pragma("unroll") for (int q = 0; q < 8; ++q) { const float send = (r8 & 1) ? y[q] : y[q + 8], keep = (r8 & 1) ? y[q + 8] : y[q]; y[q] = keep + __shfl_xor(send, 8); } \
            _Pragma("unroll") for (int q = 0; q < 4; ++q) { const float send = (r8 & 2) ? y[q] : y[q + 4], keep = (r8 & 2) ? y[q + 4] : y[q]; y[q] = keep + __shfl_xor(send, 16); } \
            _Pragma("unroll") for (int q = 0; q < 2; ++q) { const float send = (r8 & 4) ? y[q] : y[q + 2], keep = (r8 & 4) ? y[q + 2] : y[q]; y[q] = keep + __shfl_xor(send, 32); } \
            const bool lat_ = (t) < NLAT; float* xr_ = (lat_ ? A->xl + (size_t)(t) * DM : wsp<float>(A, W.xc) + (size_t)((t) - NLAT) * DM) + xcol; \
            f32x2 xv_ = xC; xv_[0] += gC[0] * y[0]; xv_[1] += gC[1] * y[1]; if (!dry) *(f32x2*)xr_ = xv_; } while (0)
        unsigned ikA[8], ikB[8], hN[8]; float pgN[2]; u32x4 ga[16], gb[16]; float y[16], w0, w1; f32x2 xN = {0.f, 0.f}, gN = {0.f, 0.f}, xC, gC;
        const int xcol = 128 * sl + 16 * cc + 8 * (r8 & 1) + 4 * ((r8 >> 1) & 1) + 2 * ((r8 >> 2) & 1);
        int t = rk + 32 * wave, t1 = t + 256;
        if (t < ntok) { TLOADI(ikA, t); TLOADH(hN, pgN, t); }
        if (t1 < ntok) TLOADI(ikB, t1);
        if (t < ntok) GLOAD2(ga, ikA);
#pragma unroll 1
        while (t < ntok) {
            WCALC(hN, pgN);
            const int t2 = t + 512;
            if (t1 < ntok) TLOADH(hN, pgN, t1);
            if (t2 < ntok) TLOADI(ikA, t2);
            if (t1 < ntok) GLOAD2(gb, ikB);
#pragma unroll
            for (int i = 0; i < 16; ++i) y[i] = 0.f;
            VACC(ga, 0); VACC(ga, 1); XUPD(t);
            if (t1 >= ntok) break;
            WCALC(hN, pgN);
            const int t3 = t1 + 512;
            if (t2 < ntok) TLOADH(hN, pgN, t2);
            if (t3 < ntok) TLOADI(ikB, t3);
            if (t2 < ntok) GLOAD2(ga, ikA);
#pragma unroll
            for (int i = 0; i < 16; ++i) y[i] = 0.f;
            VACC(gb, 0); VACC(gb, 1); XUPD(t1);
            t = t2; t1 = t3;
        }
#undef TLOADI
#undef TLOADH
#undef GLOAD2
#undef WCALC
#undef VACC
#undef XUPD
    }
    if (l == 0 && !dry) {
        GBAR();
        const float* mod1 = wsp<float>(A, W.mod) + (size_t)9 * 6144; const int gw = vcu * NWAVES + wave, NGW = G * NWAVES;
        for (int t = gw; t < NTOK; t += NGW) { const bool lat = t < NLAT; const int mr = lat ? t / SEQ : 8;
            const float* xr = lat ? A->xl + (size_t)t * DM : wsp<float>(A, W.xc) + (size_t)(t - NLAT) * DM;
            modulate_row_bf16(xr, FIN(6) + DM, mod1 + (size_t)mr * 6144 + 1024, mod1 + (size_t)mr * 6144, wsp<bf16_t>(A, W.xn) + (size_t)t * DM, lane); }
    }
}
#undef GBAR
}
__device__ __forceinline__ void phase_peer(AP A, FK_LAS unsigned char* lds, int l, int vcu, int G, int dry, const XcdBarrier bar, const int use_bar) { peer::phase(A, lds, l, vcu, G, dry, bar, use_bar); }
constexpr int N_PHASES = 16;
__global__ void __launch_bounds__(NTHR, 2) mega(Args A_unused) {
    extern __shared__ __attribute__((aligned(16))) unsigned char lds_raw[];
    FK_LAS unsigned char* lds = (FK_LAS unsigned char*)lds_raw;
    const int tid = threadIdx.x;
    AP A0 = (AP)__builtin_amdgcn_kernarg_segment_ptr();
#define AA() opaque_args(A0)
    const int G = gridDim.x, bx = blockIdx.x, vcu = (G % 8 == 0) ? (bx % 8) * (G / 8) + bx / 8 : bx;
    volatile FK_LAS unsigned* MISC = (volatile FK_LAS unsigned*)(lds + LDS_MISC);
    if (tid < 64) MISC[tid] = 0u;
    __syncthreads();
    XcdBarrier bar; bar.bar = wsp<unsigned>(A0, W.ctl) + 1024; bar.x = 0; bar.st = MISC + 8;
    if (A0->use_bar) bar = xcd_barrier_post(wsp<unsigned>(A0, W.ctl) + 1024, MISC + 8);
    const int lo = A0->ph_lo, hi = A0->ph_hi;
#ifndef FK_TSTAMP
#define FK_TSTAMP -1
#endif
#ifndef FK_TSTAMP_END
#define FK_TSTAMP_END (FK_TSTAMP + 1)
#endif
#ifndef FK_TSCALE
#define FK_TSCALE 1000.f
#endif
#define STAMP(k) do { if (FK_TSTAMP >= 0 && bx == 0 && tid == 0) { const unsigned long long ts_ = __builtin_amdgcn_s_memrealtime(); MISC[16 + 2 * (k)] = (unsigned)ts_; MISC[17 + 2 * (k)] = (unsigned)(ts_ >> 32); } } while (0)
    STAMP(0);
#define IN(k) (lo <= (k) && (k) < hi)
#ifndef FK_REP_PHASE
#define FK_REP_PHASE -1
#endif
#define REP(k) for (int rep_ = (FK_REP_PHASE == (k)) ? 1 : 0; rep_ >= 0; --rep_)
#ifndef FK_REP_BAR
#define FK_REP_BAR 0
#endif
#define SEAM(k) do { if (IN(k) && IN((k) + 1)) { xcd_barrier(bar); if (FK_REP_BAR) xcd_barrier(bar); } STAMP((k) + 1); } while (0)
#ifndef FK_REP_ALL
#define FK_REP_ALL 0
#endif
    for (int pass = FK_REP_ALL ? 1 : 0; pass >= 0; --pass) {
    if (IN(0)) REP(0) phase_pa(AA(), lds, vcu, G);
    SEAM(0);
    if (IN(1)) REP(1) phase_pb(AA(), vcu, G);
    SEAM(1);
    for (int l = 0; l < 2; ++l) {
        const int pb = 2 + 7 * l;
        if (IN(pb + 0)) REP(pb + 0) phase_inproj(AA(), lds, l, G);
        SEAM(pb + 0);
#ifdef FK_HAVE_MIX
        if (IN(pb + 1)) REP(pb + 1) phase_mix(AA(), lds, l, vcu, G);
#endif
        SEAM(pb + 1);
#ifdef FK_HAVE_MERGE
        if (IN(pb + 2)) REP(pb + 2) phase_merge(AA(), lds, l, G, bar, A0->use_bar);
#endif
        SEAM(pb + 2);
#ifdef FK_HAVE_OUT
        if (IN(pb + 3)) REP(pb + 3) phase_outproj(AA(), lds, l, G, rep_ | (pass & l), A0->use_bar);
#endif
        SEAM(pb + 3);
#ifdef FK_HAVE_NORM
        if (IN(pb + 4)) REP(pb + 4) phase_norm(AA(), l, vcu, G);
#endif
        SEAM(pb + 4);
#ifdef FK_HAVE_PQ
        if (IN(pb + 5)) REP(pb + 5) phase_peerq(AA(), lds, l, G);
#endif
        SEAM(pb + 5);
#ifdef FK_HAVE_PEER
        if (IN(pb + 6)) REP(pb + 6) phase_peer(AA(), lds, l, vcu, G, rep_ | pass, bar, A0->use_bar);
#endif
        SEAM(pb + 6);
    }
    if (pass) xcd_barrier(bar);
    }
    if (FK_TSTAMP >= 0 && bx == 0 && tid == 0) {
        const unsigned long long a_ = ((unsigned long long)MISC[17 + 2 * FK_TSTAMP] << 32) | MISC[16 + 2 * FK_TSTAMP], b_ = ((unsigned long long)MISC[17 + 2 * (FK_TSTAMP_END)] << 32) | MISC[16 + 2 * (FK_TSTAMP_END)];
        const float us_ = (float)(b_ - a_) * 0.01f; asm volatile("s_waitcnt vmcnt(0)" ::: "memory");
        A0->out[0] += 0.25f + 0.30f * fminf(1.f, us_ * (1.f / FK_TSCALE)); }
#undef IN
#undef SEAM
}
inline void launch(void* const* d_in, float* out, unsigned char* ws, float* xl, int lo, int hi, bool one_launch, hipStream_t st) {
    static int ok = 0;
    if (!ok) { if (hipFuncSetAttribute((const void*)mega, hipFuncAttributeMaxDynamicSharedMemorySize, LDS_BYTES) != hipSuccess) { fprintf(stderr, "hipFuncSetAttribute failed\n"); return; } ok = 1; }
    (void)hipMemsetAsync(ws + W.ctl, 0, 65536, st);
    Args a{}; for (int i = 0; i < 30; ++i) a.in[i] = (const float*)d_in[i];
    a.out = out; a.ws = ws; a.xl = xl; a.pad = 0;
    if (one_launch) { a.ph_lo = lo; a.ph_hi = hi; a.use_bar = 1; hipLaunchKernelGGL(mega, dim3(256), dim3(NTHR), LDS_BYTES, st, a); }
    else for (int p = lo; p < hi; ++p) { a.ph_lo = p; a.ph_hi = p + 1; a.use_bar = 0; hipLaunchKernelGGL(mega, dim3(256), dim3(NTHR), LDS_BYTES, st, a); }
}
}
#ifndef FK_ONE_LAUNCH
#define FK_ONE_LAUNCH 1
#endif
extern "C" void kernel_launch(void* const* d_in, const int* in_sizes, int n_in, void* d_out, int out_size, void* d_ws, size_t ws_size, hipStream_t stream) {
    if (n_in != 30 || ws_size < fk::W.end || out_size != fk::NLAT * 1024) { fprintf(stderr, "kernel_launch: n_in %d ws %zu (need %zu) out %d\n", n_in, ws_size, (size_t)fk::W.end, out_size); return; }
    fk::launch(d_in, (float*)d_out, (unsigned char*)d_ws, (float*)d_out, 0, fk::N_PHASES, FK_ONE_LAUNCH != 0, stream);
}
```

```cpp
#include <hip/hip_runtime.h>
#include <cstdio>
#include <cstdint>
#include <math.h>
#define FK_ONE_LAUNCH 1
namespace fk {
#ifndef FK_NT_STORE
#define FK_NT_STORE 1
#endif
#if FK_NT_STORE
#define ST_NT(p, v) __builtin_nontemporal_store((v), (p))
#else
#define ST_NT(p, v) (*(p) = (v))
#endif

#define FK_LAS __attribute__((address_space(3)))
typedef unsigned short bf16_t;
typedef short bf16x8 __attribute__((ext_vector_type(8)));
typedef float f32x4 __attribute__((ext_vector_type(4)));
typedef float f32x16 __attribute__((ext_vector_type(16)));
typedef unsigned u32x4 __attribute__((ext_vector_type(4)));
typedef unsigned u32x2 __attribute__((ext_vector_type(2)));
#ifndef FK_NB
#define FK_NB 8
#endif
constexpr int NB = FK_NB, SEQ = 2048, DM = 1024, CTX = 256, KALL = SEQ + CTX;
constexpr int NLAT = NB * SEQ, NCTX = NB * CTX, NTOK = NLAT + NCTX;
constexpr int PINF = 5888;
constexpr int R_HY = 0, R_FZ = 768, R_Q = 1280, R_K = 1792, R_V = 2304, R_G = 2816;
constexpr float EPS = 1e-6f;
constexpr int NWAVES = 8, NTHR = 512;
constexpr int TLL = 4224, TLC = 576;

__device__ __forceinline__ unsigned f2bf(float f) { unsigned u = __builtin_bit_cast(unsigned, f); return (u + 0x7fffu + ((u >> 16) & 1u)) >> 16; }
__device__ __forceinline__ unsigned pk2(float lo, float hi) { return f2bf(lo) | (f2bf(hi) << 16); }
__device__ __forceinline__ float bf2f(unsigned short h) { return __builtin_bit_cast(float, (unsigned)h << 16); }
__device__ __forceinline__ float bflo(unsigned w) { return __builtin_bit_cast(float, w << 16); }
__device__ __forceinline__ float bfhi(unsigned w) { return __builtin_bit_cast(float, w & 0xffff0000u); }
typedef __bf16 bf16x2_t __attribute__((ext_vector_type(2)));
__device__ __forceinline__ unsigned cvt_pk_bf16(float lo, float hi) { bf16x2_t v = {(__bf16)lo, (__bf16)hi}; return __builtin_bit_cast(unsigned, v); }
typedef float f32x2 __attribute__((ext_vector_type(2)));
constexpr float SU = 64.f, SV = 4.f;
__device__ __forceinline__ unsigned pk4_fp8(float a, float b, float c, float d) { unsigned w = __builtin_amdgcn_cvt_pk_fp8_f32(a, b, 0, false); return __builtin_amdgcn_cvt_pk_fp8_f32(c, d, w, true); }
__device__ __forceinline__ size_t tab_chunk_off(size_t i  ) { const size_t e = i >> 6, c16 = i & 63; return (((c16 >> 3) * 16384 + e) * 128) + (c16 & 7) * 16; }
__device__ __forceinline__ void cvt16_fp8(const float* src, unsigned char* dst, float sc) {
    const f32x4 x0 = *(const f32x4*)(src), x1 = *(const f32x4*)(src + 4), x2 = *(const f32x4*)(src + 8), x3 = *(const f32x4*)(src + 12);
    u32x4 o; o.x = pk4_fp8(x0[0] * sc, x0[1] * sc, x0[2] * sc, x0[3] * sc); o.y = pk4_fp8(x1[0] * sc, x1[1] * sc, x1[2] * sc, x1[3] * sc);
    o.z = pk4_fp8(x2[0] * sc, x2[1] * sc, x2[2] * sc, x2[3] * sc); o.w = pk4_fp8(x3[0] * sc, x3[1] * sc, x3[2] * sc, x3[3] * sc);
    *(u32x4*)dst = o;
}
__device__ __forceinline__ float wave_sum(float v) {
#pragma unroll
    for (int o = 32; o > 0; o >>= 1) v += __shfl_xor(v, o);
    return v;
}

struct WS {
    size_t ctl, mod, misc, h3l, h3c, tapl, tapc, w_in, w_mrg, w_out, w_q, keys, ub, vb, dftl, dftc;
    size_t xn, nn, hyt, ftl, ftc, q, qc, k, vt, g, attlo, atthi, hyo, fno, y, xl, xc, pq, pidx, pg, stash, ub1, vb1, end;
};
__host__ __device__ constexpr size_t al(size_t x) { return (x + 4095) / 4096 * 4096; }
__host__ __device__ constexpr WS make_ws() {
    WS w{}; size_t o = 0;
    w.ctl = o; o += 65536;
    w.mod = o; o += al((size_t)2 * 9 * 6144 * 4);
    w.misc = o; o += al((size_t)12 << 20);
    w.tapl = o; o += al((size_t)2 * 2 * 256 * TLL * 2);
    w.tapc = o; o += al((size_t)2 * 2 * 256 * TLC * 2);
    w.w_in = o; o += al((size_t)2 * PINF * 1024 * 2);
    w.w_mrg = o; o += al((size_t)2 * 4 * 1024 * 256 * 2);
    w.w_out = o; o += al((size_t)2 * 1024 * 1024 * 2);
    w.w_q = o; o += al((size_t)2 * 2048 * 1024 * 2);
    w.keys = o; o += al((size_t)2 * 16 * 128 * 128 * 2);
    w.ub = o; o += al((size_t)16384 * 1024);
    w.vb = o; o += al((size_t)16384 * 1024);
    w.ub1 = o; o += al((size_t)16384 * 1024);
    w.vb1 = o; o += al((size_t)16384 * 1024);
    w.dftl = o; o += al((size_t)2048 * 4096 * 2);
    w.dftc = o; o += al((size_t)256 * 512 * 2);
    w.xn = o; o += al((size_t)NTOK * 1024 * 2);
    w.nn = o; w.stash = o; { size_t a = al((size_t)NTOK * 1024 * 2), b = al((size_t)256 * 512 * 128 * 4); o += a > b ? a : b; }
    w.hyt = o; w.y = o; { size_t a = al((size_t)768 * NTOK * 2) + al((size_t)NB * 256 * 4096 * 2) + al((size_t)NB * 256 * 512 * 2), b = al((size_t)NTOK * 1024 * 2);
        w.ftl = o + al((size_t)768 * NTOK * 2); w.ftc = w.ftl + al((size_t)NB * 256 * 4096 * 2); o += a > b ? a : b; }
    w.q = o; o += al((size_t)NB * 8 * 2048 * 64 * 2);
    w.qc = o; o += al((size_t)NB * 8 * 256 * 64 * 2);
    w.k = o; o += al((size_t)NB * 8 * KALL * 64 * 2);
    w.vt = o; o += al((size_t)NB * 4 * 128 * KALL * 2);
    w.g = o; w.pq = o; w.h3l = o; { size_t a = al((size_t)NTOK * 3072 * 2), b = al((size_t)2 * 2048 * 1024 * 4) + al((size_t)2 * 256 * 1024 * 4);
        w.h3c = o + al((size_t)2 * 2048 * 1024 * 4); o += a > b ? a : b; }
    w.attlo = o; o += al((size_t)NTOK * 256 * 2);
    w.atthi = o; o += al((size_t)NTOK * 256 * 2);
    w.hyo = o; o += al((size_t)NTOK * 256 * 2);
    w.fno = o; o += al((size_t)NTOK * 256 * 2);
    w.xl = o; o += (NB == 8) ? 0 : al((size_t)NLAT * 1024 * 4);
    w.xc = o; o += al((size_t)NCTX * 1024 * 4);
    w.pidx = o; o += al((size_t)NTOK * 128 * 4);
    w.pg = o; o += al((size_t)NTOK * 128 * 4);
    w.end = o; return w;
}
constexpr WS W = make_ws();
constexpr int MI_LAM = 0, MI_ROPE = 64, MI_HYINV = 4096, MI_HYPART = 8192;

constexpr int BM = 256, BK = 64, HALF = 128, HTB = HALF * BK * 2, STAGE_BYTES = 8 * HTB;
__host__ __device__ __forceinline__ int lds_byte(int r, int c) { const int st = (r >> 4) * 2 + (c >> 5), rr = r & 15, cc = c & 31, ob = rr * 64 + cc * 2; return st * 1024 + (ob ^ (((ob >> 9) & 1) << 5)); }
__host__ __device__ __forceinline__ void stage_rc(int b, int& R, int& C) { const int st = b / 1024, sb = b % 1024, swz = sb ^ (((sb >> 9) & 1) << 5); R = (st >> 1) * 16 + swz / 64; C = (st & 1) * 32 + (swz % 64) / 2; }
__host__ __device__ __forceinline__ int perm32(int rho) { const int n = rho >> 4, i = rho & 15; return 8 * (i >> 2) + 4 * n + (i & 3); }

struct Unit { const char* a; const char* b; int pm, pn, kind, aux; };
typedef f32x4 Acc[2][2][4][2];

template <class Sched, class Epi>
__device__ __forceinline__ void gemm_phase(FK_LAS unsigned char* lds, const int K, const Sched& S, const Epi& E) {
    int tid = threadIdx.x; asm volatile("" : "+v"(tid));
    const int wid = __builtin_amdgcn_readfirstlane(tid >> 6), lane = tid & 63, wr = wid >> 2, wc = wid & 3, fr = lane & 15, fq = lane >> 4;
    const int nt = K / BK;
    unsigned voffA[2], voffB[2];
#pragma unroll
    for (int i = 0; i < 2; ++i) { int R, C; stage_rc(tid * 16 + i * 8192, R, C); const int Rb = (R & ~31) + perm32(R & 31);
        voffA[i] = (unsigned)(R * K + C) * 2u; voffB[i] = (unsigned)(Rb * K + C) * 2u; }
    const size_t kstep = (size_t)(BK * 2);
    const size_t hstep = (size_t)HALF * K * 2;
    const unsigned ldsw = (unsigned)wid * 1024u;
    const int aoff = lds_byte(wr * 64 + fr, fq * 8), boff = lds_byte(wc * 32 + fr, fq * 8);
#define PG8_SA(b, h) (((b) * 2 + (h)) * HTB)
#define PG8_SB(b, h) ((4 + (b) * 2 + (h)) * HTB)
#define PG8_STAGE(bufoff, gbase, voff) do { _Pragma("unroll") for (int _i = 0; _i < 2; ++_i) \
        __builtin_amdgcn_global_load_lds((const unsigned*)((const char*)(gbase) + (voff)[_i]), (FK_LAS unsigned*)(lds + (bufoff) + ldsw + _i * 8192), 16, 0, 0); } while (0)
#define PG8_LDA(dst, b, h) do { _Pragma("unroll") for (int m = 0; m < 4; ++m) _Pragma("unroll") for (int k = 0; k < 2; ++k) dst[m][k] = *(const FK_LAS bf16x8*)(lds + PG8_SA(b, h) + aoff + m * 2048 + k * 1024); } while (0)
#define PG8_LDB(dst, b, h) do { _Pragma("unroll") for (int n = 0; n < 2; ++n) _Pragma("unroll") for (int k = 0; k < 2; ++k) dst[n][k] = *(const FK_LAS bf16x8*)(lds + PG8_SB(b, h) + boff + n * 2048 + k * 1024); } while (0)
#define PG8_MMA(ai, bj, At, Bt) do { __builtin_amdgcn_s_setprio(1); _Pragma("unroll") for (int m = 0; m < 4; ++m) _Pragma("unroll") for (int n = 0; n < 2; ++n) _Pragma("unroll") for (int k = 0; k < 2; ++k) \
        acc[ai][bj][m][n] = __builtin_amdgcn_mfma_f32_16x16x32_bf16(Bt[n][k], At[m][k], acc[ai][bj][m][n], 0, 0, 0); __builtin_amdgcn_s_setprio(0); } while (0)
#define PG8_WAIT_V(n) asm volatile("s_waitcnt vmcnt(" #n ")" ::: "memory")
#define PG8_WAIT_L(n) asm volatile("s_waitcnt lgkmcnt(" #n ")" ::: "memory")
#define PG8_BAR __builtin_amdgcn_s_barrier()
#define PG8_SCHED __builtin_amdgcn_sched_barrier(0)
    Unit cur, nxt; int ui = 0;
    if (!S.next(0, cur)) return;
    Acc acc;
#pragma unroll
    for (int a = 0; a < 2; ++a)
#pragma unroll
        for (int b = 0; b < 2; ++b)
#pragma unroll
            for (int m = 0; m < 4; ++m)
#pragma unroll
                for (int n = 0; n < 2; ++n) acc[a][b][m][n] = (f32x4){0.f, 0.f, 0.f, 0.f};
    bf16x8 At[4][2], B0[2][2], B1[2][2];
    const char* cA = cur.a; const char* cB = cur.b;
    PG8_STAGE(PG8_SB(0, 0), cB, voffB); PG8_STAGE(PG8_SB(0, 1), cB + hstep, voffB); PG8_STAGE(PG8_SA(0, 0), cA, voffA); PG8_STAGE(PG8_SA(0, 1), cA + hstep, voffA);
    if (wr == 1) PG8_BAR;
    PG8_WAIT_V(2); PG8_BAR;
    PG8_STAGE(PG8_SB(1, 0), cB + kstep, voffB); PG8_STAGE(PG8_SA(1, 0), cA + kstep, voffA); PG8_STAGE(PG8_SB(1, 1), cB + hstep + kstep, voffB);
    PG8_WAIT_V(6); PG8_BAR;
    for (;;) {
        const bool has_next = S.next(ui + 1, nxt);
        const char* nA = has_next ? nxt.a : cA; const char* nB = has_next ? nxt.b : cB;
        for (int t = 0; t < nt; t += 2) {
            const bool last = (t == nt - 2);
            const char* a1 = cA + (size_t)(t + 1) * kstep;
            const char* a2 = last ? nA : cA + (size_t)(t + 2) * kstep; const char* b2 = last ? nB : cB + (size_t)(t + 2) * kstep;
            const char* a3 = a2 + kstep; const char* b3 = b2 + kstep;
            PG8_LDB(B0, 0, 0); PG8_LDB(B1, 0, 1); PG8_SCHED; PG8_LDA(At, 0, 0); PG8_STAGE(PG8_SA(1, 1), a1 + hstep, voffA);
            PG8_WAIT_V(8); PG8_WAIT_L(0); PG8_BAR; PG8_MMA(0, 0, At, B0); PG8_MMA(0, 1, At, B1); PG8_BAR; PG8_SCHED;
            PG8_LDA(At, 0, 1); PG8_STAGE(PG8_SB(0, 0), b2, voffB); PG8_STAGE(PG8_SB(0, 1), b2 + hstep, voffB); PG8_STAGE(PG8_SA(0, 0), a2, voffA);
            PG8_WAIT_V(8); PG8_WAIT_L(0); PG8_BAR; PG8_MMA(1, 0, At, B0); PG8_MMA(1, 1, At, B1); PG8_BAR; PG8_SCHED;
            PG8_LDB(B0, 1, 0); PG8_LDB(B1, 1, 1); PG8_SCHED; PG8_LDA(At, 1, 0); PG8_STAGE(PG8_SA(0, 1), a2 + hstep, voffA);
            PG8_WAIT_V(8); PG8_WAIT_L(0); PG8_BAR; PG8_MMA(0, 0, At, B0); PG8_MMA(0, 1, At, B1); PG8_BAR; PG8_SCHED;
            PG8_LDA(At, 1, 1); PG8_STAGE(PG8_SB(1, 0), b3, voffB); PG8_STAGE(PG8_SB(1, 1), b3 + hstep, voffB); PG8_STAGE(PG8_SA(1, 0), a3, voffA);
            PG8_WAIT_V(8); PG8_WAIT_L(0); PG8_BAR; PG8_MMA(1, 0, At, B0); PG8_MMA(1, 1, At, B1); PG8_BAR; PG8_SCHED;
        }
        if (wr == 0) PG8_BAR;
        int fr2 = fr, fq2 = fq; asm volatile("" : "+v"(fr2), "+v"(fq2));
        const bool zero = E(acc, cur, wr, wc, fr2, fq2);
        if (!has_next) break;
        if (zero) {
#pragma unroll
            for (int a = 0; a < 2; ++a)
#pragma unroll
                for (int b = 0; b < 2; ++b)
#pragma unroll
                    for (int m = 0; m < 4; ++m)
#pragma unroll
                        for (int n = 0; n < 2; ++n) acc[a][b][m][n] = (f32x4){0.f, 0.f, 0.f, 0.f};
        }
        cur = nxt; cA = nA; cB = nB; ++ui;
        if (wr == 1) PG8_BAR;
    }
    PG8_WAIT_V(0);
    PG8_BAR;
#undef PG8_SA
#undef PG8_SB
#undef PG8_STAGE
#undef PG8_LDA
#undef PG8_LDB
#undef PG8_MMA
#undef PG8_WAIT_V
#undef PG8_WAIT_L
#undef PG8_BAR
#undef PG8_SCHED
}
#define XB_TMO      128
#define XB_XCNT(j)  (256  + 64 * (j))
#define XB_XSUB(j)  (1280 + 64 * (j))
#define XB_XGEN(j)  (2304 + 64 * (j))
#define XB_TOP      3328
#define XB_TOPGEN   3392
#define XCD_BAR_WORDS 3456
#define XB_SPIN_CAP (1u << 20)
__device__ __forceinline__ unsigned xb_ld(unsigned* p)              { return __hip_atomic_load(p, __ATOMIC_RELAXED, __HIP_MEMORY_SCOPE_AGENT); }
__device__ __forceinline__ unsigned xb_add(unsigned* p, unsigned v) { return __hip_atomic_fetch_add(p, v, __ATOMIC_RELAXED, __HIP_MEMORY_SCOPE_AGENT); }
__device__ __forceinline__ unsigned xb_xcc_id() { return (unsigned)__builtin_amdgcn_s_getreg((3 << 11) | 20) & 0xFu; }
#define XB_SPIN(cond, bar) do { unsigned _sp = 0; while (cond) { __builtin_amdgcn_s_sleep(1); \
    if ((++_sp & 255u) == 0u) { if (xb_ld(&(bar)[XB_TMO])) break; if (_sp > XB_SPIN_CAP) { atomicAdd(&(bar)[XB_TMO], 1u); break; } } } } while (0)
struct XcdBarrier { unsigned* bar; unsigned x; volatile FK_LAS unsigned* st; };
__device__ __forceinline__ XcdBarrier xcd_barrier_post(unsigned* bar, volatile FK_LAS unsigned* st) {
    XcdBarrier b; b.bar = bar; b.x = xb_xcc_id(); b.st = st;
    if (threadIdx.x == 0) (void)xb_add(&bar[XB_XCNT(b.x)], 1u);
    return b;
}
__device__ __forceinline__ void xcd_barrier_complete(unsigned* bar, unsigned x, unsigned& nloc, unsigned& nx) {
    const unsigned G = gridDim.x * gridDim.y * gridDim.z;
    unsigned sum, cnt, mine, sp = 0u;
    for (;;) {
        sum = 0u; cnt = 0u; mine = 0u;
#pragma unroll
        for (unsigned j = 0; j < 16; ++j) { const unsigned c = xb_ld(&bar[XB_XCNT(j)]); sum += c; cnt += (c > 0u) ? 1u : 0u; mine = (j == x) ? c : mine; }
        if (sum == G) break;
        __builtin_amdgcn_s_sleep(1);
        if ((++sp & 255u) == 0u) { if (xb_ld(&bar[XB_TMO])) break; if (sp > XB_SPIN_CAP) { atomicAdd(&bar[XB_TMO], 1u); break; } }
    }
    nloc = mine > 0u ? mine : 1u; nx = cnt > 0u ? cnt : 1u;
}
__device__ __forceinline__ void xcd_barrier(const XcdBarrier& b) {
    asm volatile("s_waitcnt vmcnt(0)" ::: "memory");
    __syncthreads();
    if (threadIdx.x == 0) {
        unsigned* bar = b.bar;
        __builtin_amdgcn_s_waitcnt(0);
        unsigned nloc = b.st[0], nx = b.st[1];
        if (nloc == 0u) { xcd_barrier_complete(bar, b.x, nloc, nx); b.st[0] = nloc; b.st[1] = nx; }
        const unsigned old = xb_add(&bar[XB_XSUB(b.x)], 1u);
        const unsigned gen = old / nloc;
        if (old + 1u == (gen + 1u) * nloc) {
            __builtin_amdgcn_fence(__ATOMIC_RELEASE, "agent");
            asm volatile("s_waitcnt vmcnt(0)" ::: "memory");
            const unsigned og = xb_add(&bar[XB_TOP], 1u);
            const unsigned tg = og / nx;
            if (og + 1u == (tg + 1u) * nx) xb_add(&bar[XB_TOPGEN], 1u);
            else XB_SPIN(xb_ld(&bar[XB_TOPGEN]) == tg, bar);
            __builtin_amdgcn_fence(__ATOMIC_ACQUIRE, "agent");
            asm volatile("s_waitcnt vmcnt(0)" ::: "memory");
        } else {
            XB_SPIN(xb_ld(&bar[XB_TOPGEN]) == gen, bar);
            __builtin_amdgcn_fence(__ATOMIC_ACQUIRE, "agent");
            asm volatile("s_waitcnt vmcnt(0)" ::: "memory");
        }
    }
    __syncthreads();
}

struct Args { const float* in[30]; float* out; unsigned char* ws; float* xl; int ph_lo, ph_hi, use_bar, pad; };
constexpr int LDS_MISC = 155648, LDS_BYTES = 155648 + 256;

struct Ctx {
    const Args* a; FK_LAS unsigned char* lds; int tid, lane, wave, vcu, G;
};
typedef const Args __attribute__((address_space(4)))* AP;
#define FIN(i) (A->in[i])
template <class T> __device__ __forceinline__ T* wsp(AP A, size_t off) { return (T*)(A->ws + off); }
__device__ __forceinline__ int opaque_tid() { int t = threadIdx.x; asm volatile("" : "+v"(t)); return t; }
__device__ __forceinline__ AP opaque_args(AP a) { asm volatile("" : "+s"(a)); return a; }

__device__ __forceinline__ int inproj_src_col(int p) {
    if (p < R_FZ) return p;
    if (p >= R_V) return p - R_V + 2048;
    const int q0 = p - R_Q, tile = q0 >> 8, pl = q0 & 255;
    const int bj = pl >> 7, wc = (pl >> 5) & 3, fq = (pl >> 3) & 3, e = pl & 7;
    return 1024 + tile * 256 + 64 * wc + 32 * (fq >> 1) + 16 * bj + 8 * (fq & 1) + e;
}
template <class ColFn>
__device__ __forceinline__ void transpose_item(const float* src, int ldsrc, int ksrc0, bf16_t* dst, int Kd, int p0, int k0, FK_LAS float* scr, int lane, ColFn col) {
    const int cidx = col(p0 + (lane & 31));
    float tv[32];
#pragma unroll
    for (int i = 0; i < 32; ++i) tv[i] = src[(size_t)(ksrc0 + k0 + 2 * i + (lane >> 5)) * ldsrc + cidx];
#pragma unroll
    for (int i = 0; i < 32; ++i) scr[(2 * i + (lane >> 5)) * 33 + (lane & 31)] = tv[i];
    asm volatile("s_waitcnt lgkmcnt(0)" ::: "memory");
    const int c = lane & 7;
#pragma unroll
    for (int j = 0; j < 4; ++j) { const int n = (lane >> 3) + 8 * j; const FK_LAS float* s = scr + (8 * c) * 33 + n;
        u32x4 o; o.x = pk2(s[0 * 33], s[1 * 33]); o.y = pk2(s[2 * 33], s[3 * 33]); o.z = pk2(s[4 * 33], s[5 * 33]); o.w = pk2(s[6 * 33], s[7 * 33]);
        *(u32x4*)(dst + (size_t)(p0 + n) * Kd + k0 + 8 * c) = o; }
    asm volatile("s_waitcnt lgkmcnt(0)" ::: "memory");
}
__device__ __forceinline__ void conv_tables(AP A, int l, unsigned char* ub, unsigned char* vb, int widx, int nw, int tid, int part = 0) {
    asm volatile("" : "+v"(widx));
    const size_t nUV = (size_t)16384 * 1024 / 16, gt = (size_t)widx * NTHR + tid, NGT = (size_t)nw * NTHR;
    const float* us = FIN(28) + (size_t)l * 16384 * 1024; const float* vs = FIN(29) + (size_t)l * 16384 * 1024;
    const size_t ibeg = part == 2 ? nUV : 0, iend = part == 1 ? nUV : 2 * nUV;
    for (size_t i0 = ibeg + gt; i0 < iend; i0 += 2 * NGT) {
#pragma unroll
        for (int rep = 0; rep < 2; ++rep) { const size_t i = i0 + rep * NGT; if (i >= iend) break;
            if (i < nUV) cvt16_fp8(us + i * 16, ub + tab_chunk_off(i), SU); else cvt16_fp8(vs + (i - nUV) * 16, vb + tab_chunk_off(i - nUV), SV); } }
}
struct IdCol { int off; __device__ int operator()(int p) const { return p + off; } };
struct InprojCol { __device__ int operator()(int p) const { return inproj_src_col(p); } };

__device__ __forceinline__ float* h3_ptr(AP A, int l, int big) { return big ? wsp<float>(A, W.h3l) + (size_t)l * 2048 * 1024 : wsp<float>(A, W.h3c) + (size_t)l * 256 * 1024; }
__device__ __forceinline__ void prep_transposes(AP A, FK_LAS unsigned char* lds, int l_lo, int l_hi, int gw, int NGW, int wave, int lane) {
        FK_LAS float* scr = (FK_LAS float*)(lds + wave * 16384);
        constexpr int I_IN = (PINF / 32) * 16;
        constexpr int I_M = (1024 / 32) * 4;
        constexpr int I_O = (1024 / 32) * 16, I_Q = (2048 / 32) * 16;
        constexpr int PER_L = I_IN + 4 * I_M + I_O + I_Q;
        for (int it = l_lo * PER_L + gw; it < l_hi * PER_L; it += NGW) {
            const int l = it / PER_L; int r = it % PER_L;
            if (r < I_IN) { const int p0 = (r >> 4) * 32, k0 = (r & 15) * 64;
                if (p0 >= R_FZ && p0 < R_Q) continue;
                transpose_item(FIN(8) + (size_t)l * 1024 * 5632, 5632, 0, wsp<bf16_t>(A, W.w_in) + (size_t)l * PINF * 1024, 1024, p0, k0, scr, lane, InprojCol{}); continue; }
            r -= I_IN;
            if (r < 4 * I_M) { const int seg = r / I_M, q = r % I_M, p0 = (q >> 2) * 32, k0 = (q & 3) * 64;
                const float* src = seg == 0 ? FIN(22) + (size_t)l * 256 * 1024 : seg == 1 ? FIN(23) + (size_t)l * 256 * 1024 : FIN(24) + (size_t)l * 512 * 1024;
                transpose_item(src, 1024, seg == 3 ? 256 : 0, wsp<bf16_t>(A, W.w_mrg) + ((size_t)l * 4 + seg) * 1024 * 256, 256, p0, k0, scr, lane, IdCol{0}); continue; }
            r -= 4 * I_M;
            if (r < I_O) { const int p0 = (r >> 4) * 32, k0 = (r & 15) * 64;
                transpose_item(FIN(25) + (size_t)l * 1024 * 1024, 1024, 0, wsp<bf16_t>(A, W.w_out) + (size_t)l * 1024 * 1024, 1024, p0, k0, scr, lane, IdCol{0}); continue; }
            r -= I_O;
            { const int p0 = (r >> 4) * 32, k0 = (r & 15) * 64;
                transpose_item(FIN(26) + (size_t)l * 1024 * 2048, 2048, 0, wsp<bf16_t>(A, W.w_q) + (size_t)l * 2048 * 1024, 1024, p0, k0, scr, lane, IdCol{0}); }
        }
}
__device__ __forceinline__ void prep_fz(AP A, const FK_LAS float* ctab, const FK_LAS float* stab, int tstride, int l_lo, int l_hi, size_t gt, size_t NGT) {
    for (size_t i = ((size_t)l_lo << 16) + gt; i < ((size_t)l_hi << 16); i += NGT) {
        const int k = (int)(i & 1023), mc = (int)((i >> 10) & 7), part = (int)((i >> 13) & 1), g = (int)((i >> 14) & 3), l = (int)(i >> 16);
        const float* src = FIN(8) + (size_t)l * 1024 * 5632 + (size_t)k * 5632 + 768 + g * 64;
        f32x4 sv[16];
#pragma unroll
        for (int q = 0; q < 16; ++q) sv[q] = *(const f32x4*)(src + 4 * q);
        const FK_LAS float* tb = part ? stab : ctab;
        bf16_t* dst = wsp<bf16_t>(A, W.w_in) + ((size_t)l * PINF + R_FZ + part * 256 + g * 64 + mc * 8) * 1024 + k;
#pragma unroll 1
        for (int mm = 0; mm < 8; ++mm) { const int m = mc * 8 + mm; float acc = 0.f;
#pragma unroll
            for (int q = 0; q < 16; ++q)
#pragma unroll
                for (int j = 0; j < 4; ++j) acc += sv[q][j] * tb[((m * (4 * q + j)) & 63) * tstride];
            dst[(size_t)mm * 1024] = (bf16_t)f2bf(acc); }
    }
}
__device__ __forceinline__ void prep_hyfilt(AP A, FK_LAS unsigned char* lds, int l_lo, int l_hi, int widx, int nw, int tid) {
    float* misc = wsp<float>(A, W.misc);
    {
        constexpr int HPP = 4;
        FK_LAS float* h1 = (FK_LAS float*)lds; FK_LAS float* h2 = h1 + HPP * 64; FK_LAS float* ft = h2 + HPP * 64;
        FK_LAS float* w1s = ft + HPP * 33 + 4; FK_LAS float* w2s = w1s + 33 * 64; FK_LAS float* b1s = w2s + 64 * 64; FK_LAS float* b2s = b1s + 64; FK_LAS float* fqs = b2s + 64;
        constexpr int IT_L = 2048 / HPP, IT_C = 256 / HPP, PER = IT_L + IT_C;
        int lcur = -1;
        constexpr int ER = 40;
        FK_LAS float* w3s = fqs + 64;
        float wv0[ER], wv1[ER];
#pragma unroll
        for (int e = 0; e < ER; ++e) { wv0[e] = 0.f; wv1[e] = 0.f; }
        for (int it = l_lo * PER + widx; it < l_hi * PER; it += nw) {
            const int l = it / PER, r = it % PER, big = r < IT_L, L = big ? 2048 : 256, p0 = (big ? r : r - IT_L) * HPP;
            __syncthreads();
            if (l != lcur) { lcur = l;
                for (int i = tid; i < 33 * 64; i += NTHR) w1s[i] = FIN(11)[l * 33 * 64 + i];
                for (int i = tid; i < 64 * 64; i += NTHR) w2s[i] = FIN(14)[l * 4096 + i];
                if (tid < 64) { b1s[tid] = FIN(12)[l * 64 + tid]; b2s[tid] = FIN(15)[l * 64 + tid]; fqs[tid] = FIN(13)[l * 64 + tid]; }
                const float* w3 = FIN(16) + (size_t)l * 65536 + tid;
#pragma unroll
                for (int e = 0; e < ER; ++e) { wv0[e] = w3[(size_t)e * 1024]; wv1[e] = w3[(size_t)e * 1024 + 512]; }
#pragma unroll
                for (int e = ER; e < 64; ++e) { w3s[(e - ER) * 1024 + tid] = w3[(size_t)e * 1024]; w3s[(e - ER) * 1024 + 512 + tid] = w3[(size_t)e * 1024 + 512]; } }
            for (int i = tid; i < HPP * 33; i += NTHR) { const int pp = i / 33, e = i % 33, pos = p0 + pp; const float t = (float)pos / (float)(L - 1), w = 2.0f * 3.14159265358979323846f * (float)pos / (float)L;
                float v; if (e == 0) v = t; else { const int b = (e - 1) & 15; const float f = 1e-4f + (float)b * ((15.f - 1e-4f) / 15.f), a = w * f; v = e <= 16 ? cosf(a) : -sinf(a); }
                ft[i] = v; }
            __syncthreads();
            for (int i = tid; i < HPP * 64; i += NTHR) { const int pp = i >> 6, j = i & 63; float acc = 0.f;
                for (int e = 0; e < 33; ++e) acc += ft[pp * 33 + e] * w1s[e * 64 + j];
                h1[i] = sinf(fqs[j] * (acc + b1s[j])); }
            __syncthreads();
            for (int i = tid; i < HPP * 64; i += NTHR) { const int pp = i >> 6, j = i & 63; float acc = 0.f;
                for (int e = 0; e < 64; ++e) acc += h1[pp * 64 + e] * w2s[e * 64 + j];
                h2[i] = sinf(fqs[j] * (acc + b2s[j])); }
            __syncthreads();
            float* H3 = h3_ptr(A, l, big);
            float* part = misc + MI_HYPART + ((size_t)(l * 2 + (big ? 0 : 1)) * IT_L + (big ? r : r - IT_L)) * 1024;
#pragma unroll
            for (int cc = 0; cc < 2; ++cc) { const int col = tid + cc * 512, ch = col & 255;
                const float mn = -3.0701134573253946f, mx = -15.350567286626973f; const float delta = fabsf(mn + (float)ch * ((mx - mn) / 255.f));
                float acc[HPP];
#pragma unroll
                for (int pp = 0; pp < HPP; ++pp) acc[pp] = 0.f;
#pragma unroll
                for (int e = 0; e < 64; e += 4) { float wq[4];
#pragma unroll
                    for (int j = 0; j < 4; ++j) wq[j] = (e + j < ER) ? (cc ? wv1[(e + j) < ER ? (e + j) : 0] : wv0[(e + j) < ER ? (e + j) : 0]) : w3s[(e + j - ER) * 1024 + col];
#pragma unroll
                    for (int pp = 0; pp < HPP; ++pp) { const f32x4 hv = *(const FK_LAS f32x4*)(h2 + pp * 64 + e);
#pragma unroll
                        for (int j = 0; j < 4; ++j) acc[pp] += hv[j] * wq[j]; } }
                float ps = 0.f;
#pragma unroll
                for (int pp = 0; pp < HPP; ++pp) { const int pos = p0 + pp; const float v = acc[pp] * expf(-((float)pos / (float)(L - 1)) * delta); H3[(size_t)pos * 1024 + col] = v;
                    if (!(col >= 512 && pos == 0)) ps += fabsf(v); }
                part[col] = ps; }
        }
        __syncthreads();
    }
}
__device__ __forceinline__ void phase_pa(AP A, FK_LAS unsigned char* lds, int vcu, int G) {
    const int tid = opaque_tid(), lane = tid & 63, wave = __builtin_amdgcn_readfirstlane(tid >> 6);
    const int gw = vcu * NWAVES + wave, NGW = G * NWAVES;
    const size_t gt = (size_t)vcu * NTHR + tid, NGT = (size_t)G * NTHR;
    float* misc = wsp<float>(A, W.misc);
    FK_LAS float* ctab = (FK_LAS float*)(lds + 131072); FK_LAS float* stab = ctab + 2048;
    for (int i = tid; i < 2048; i += NTHR) { const float a = (float)i * (2.f / 2048.f); ctab[i] = cospif(a); stab[i] = sinpif(a); }
    __syncthreads();
    if (vcu == 0) {
        if (tid < 2) { const float* p = FIN(20) + tid * 256; float a = 0.f, b = 0.f;
            for (int i = 0; i < 64; ++i) { a += p[i] * p[64 + i]; b += p[128 + i] * p[192 + i]; }
            misc[MI_LAM + tid] = expf(a) - expf(b) + (0.8f - 0.6f * expf(-0.3f * (float)tid));
            float gqm = 0.f, gkm = 0.f; for (int i = 0; i < 128; ++i) { gqm = fmaxf(gqm, fabsf(FIN(18)[tid * 128 + i])); gkm = fmaxf(gkm, fabsf(FIN(19)[tid * 128 + i])); }
            misc[MI_LAM + 2 + tid] = -(64.f * gqm * gkm * 1.02f) * (0.125f * 1.4426950408889634f); }
        for (int i = tid; i < 64 * 16; i += NTHR) { const int pos = i >> 4, e = i & 15; const float inv = powf(10000.f, -(float)(2 * e) / 32.f), ang = (float)pos * inv;
            misc[MI_ROPE + 2 * i] = cosf(ang); misc[MI_ROPE + 2 * i + 1] = sinf(ang); }
    }
    {
        FK_LAS float* s = (FK_LAS float*)lds;
        FK_LAS float* red = (FK_LAS float*)(lds + 9 * 1024 * 4);
        bool have = false;
        for (int it = vcu; it < 192; it += G) {
            if (!have) { for (int i = tid; i < 9 * 1024; i += NTHR) { const int r = i >> 10, k = i & 1023; const float v = r < 8 ? FIN(1)[r * 1024 + k] : FIN(3)[k]; s[i] = v / (1.f + expf(-v)); } __syncthreads(); have = true; }
            const int l = it / 96, n0 = (it % 96) * 64, kq = tid >> 6, c = tid & 63;
            const float* Wp = FIN(4) + (size_t)l * 1024 * 6144 + n0 + c;
            float acc[9];
#pragma unroll
            for (int r = 0; r < 9; ++r) acc[r] = 0.f;
#pragma unroll 1
            for (int k0 = kq * 128; k0 < kq * 128 + 128; k0 += 16) { float wv[16];
#pragma unroll
                for (int j = 0; j < 16; ++j) wv[j] = Wp[(size_t)(k0 + j) * 6144];
#pragma unroll
                for (int j = 0; j < 16; ++j)
#pragma unroll
                    for (int r = 0; r < 9; ++r) acc[r] += s[r * 1024 + k0 + j] * wv[j]; }
#pragma unroll
            for (int r = 0; r < 9; ++r) red[(kq * 9 + r) * 64 + c] = acc[r];
            __syncthreads();
            for (int i = tid; i < 9 * 64; i += NTHR) { const int r = i >> 6, cc = i & 63; float t = 0.f;
#pragma unroll
                for (int q = 0; q < 8; ++q) t += red[(q * 9 + r) * 64 + cc];
                wsp<float>(A, W.mod)[((size_t)l * 9 + r) * 6144 + n0 + cc] = t + FIN(5)[l * 6144 + n0 + cc]; }
            __syncthreads();
        }
        __syncthreads();
    }
    prep_transposes(A, lds, 0, 2, gw, NGW, wave, lane);
    prep_fz(A, ctab, stab, 32, 0, 2, gt, NGT);
    {
        const size_t nK = (size_t)2 * 16 * 128 * 128 / 8;
        for (size_t j = gt; j < nK; j += NGT) { const float* src = FIN(27); bf16_t* dst = wsp<bf16_t>(A, W.keys);
            const f32x4 x0 = *(const f32x4*)(src + j * 8), x1 = *(const f32x4*)(src + j * 8 + 4);
            u32x4 o; o.x = pk2(x0[0], x0[1]); o.y = pk2(x0[2], x0[3]); o.z = pk2(x1[0], x1[1]); o.w = pk2(x1[2], x1[3]);
            *(u32x4*)(dst + j * 8) = o; }
    }
    for (size_t i = gt; i < (size_t)2048 * 2048 + 256 * 256; i += NGT) {
        const bool big = i < (size_t)2048 * 2048; const size_t j = big ? i : i - (size_t)2048 * 2048; const int L = big ? 2048 : 256, lg = big ? 11 : 8;
        const int k = (int)(j >> lg), t = (int)(j & (L - 1)); const int ti = ((k * t) & (L - 1)) * (2048 / L); const float sc = rsqrtf(64.f * (float)L);
        bf16_t* d = big ? wsp<bf16_t>(A, W.dftl) : wsp<bf16_t>(A, W.dftc);
        d[(size_t)k * 2 * L + t] = (bf16_t)f2bf(sc * ctab[ti]); d[(size_t)k * 2 * L + L + t] = (bf16_t)f2bf(-sc * stab[ti]);
    }
    prep_hyfilt(A, lds, 0, 2, vcu, G, tid);
}
__device__ __forceinline__ void modulate_row_bf16(const float* xrow, const float* g, const float* scale, const float* shift, bf16_t* orow, int lane) {
    f32x4 v[4]; float ss = 0.f;
#pragma unroll
    for (int j = 0; j < 4; ++j) { v[j] = *(const f32x4*)(xrow + 4 * lane + 256 * j); ss += (v[j][0] * v[j][0] + v[j][1] * v[j][1]) + (v[j][2] * v[j][2] + v[j][3] * v[j][3]); }
    ss = wave_sum(ss); const float rs = rsqrtf(ss * (1.f / 1024.f) + EPS);
#pragma unroll
    for (int j = 0; j < 4; ++j) { const int k = 4 * lane + 256 * j; const f32x4 gg = *(const f32x4*)(g + k), sc = *(const f32x4*)(scale + k), sf = *(const f32x4*)(shift + k);
        const f32x4 o = v[j] * rs * gg * (sc + 1.0f) + sf; u32x2 w; w.x = pk2(o[0], o[1]); w.y = pk2(o[2], o[3]); ST_NT((u32x2*)(orow + k), w); }
}
__device__ __forceinline__ void modulate_rows2_bf16(const float* xa, const float* xb, const float* g, const float* sca, const float* sfa, const float* scb, const float* sfb, bf16_t* oa, bf16_t* ob, bool hb, int lane) {
    f32x4 va[4], vb[4], gg[4], ca[4], fa[4], cb[4], fb[4];
#pragma unroll
    for (int j = 0; j < 4; ++j) { const int k = 4 * lane + 256 * j; va[j] = *(const f32x4*)(xa + k); vb[j] = *(const f32x4*)(xb + k); }
#pragma unroll
    for (int j = 0; j < 4; ++j) { const int k = 4 * lane + 256 * j; gg[j] = *(const f32x4*)(g + k); ca[j] = *(const f32x4*)(sca + k); fa[j] = *(const f32x4*)(sfa + k); cb[j] = *(const f32x4*)(scb + k); fb[j] = *(const f32x4*)(sfb + k); }
    float sa = 0.f, sb = 0.f;
#pragma unroll
    for (int j = 0; j < 4; ++j) { sa += (va[j][0] * va[j][0] + va[j][1] * va[j][1]) + (va[j][2] * va[j][2] + va[j][3] * va[j][3]); sb += (vb[j][0] * vb[j][0] + vb[j][1] * vb[j][1]) + (vb[j][2] * vb[j][2] + vb[j][3] * vb[j][3]); }
    sa = wave_sum(sa); sb = wave_sum(sb);
    const float ra = rsqrtf(sa * (1.f / 1024.f) + EPS), rb = rsqrtf(sb * (1.f / 1024.f) + EPS);
#pragma unroll
    for (int j = 0; j < 4; ++j) { const int k = 4 * lane + 256 * j;
        { const f32x4 o = va[j] * ra * gg[j] * (ca[j] + 1.0f) + fa[j]; u32x2 w; w.x = pk2(o[0], o[1]); w.y = pk2(o[2], o[3]); ST_NT((u32x2*)(oa + k), w); }
        if (hb) { const f32x4 o = vb[j] * rb * gg[j] * (cb[j] + 1.0f) + fb[j]; u32x2 w; w.x = pk2(o[0], o[1]); w.y = pk2(o[2], o[3]); ST_NT((u32x2*)(ob + k), w); } }
}
template <int NR>
__device__ __forceinline__ void modulate_wave_rows(const float* latb, const float* ctxb, const float* g, const float* mod, int sc_off, int sf_off, bf16_t* out, int t0, int t1, int lane) {
    f32x4 gg[4], sc[4], sf[4]; int mrc = -1;
#pragma unroll
    for (int j = 0; j < 4; ++j) { gg[j] = *(const f32x4*)(g + 4 * lane + 256 * j); sc[j] = gg[j]; sf[j] = gg[j]; }
    for (int t = t0; t < t1; t += NR) {
        const int n = (t1 - t) < NR ? (t1 - t) : NR; const int tl = t + n - 1;
        const int mra = t < NLAT ? t / SEQ : 8, mrl = tl < NLAT ? tl / SEQ : 8;
        if (mra != mrl) {
            for (int r = 0; r < n; ++r) { const int tt = t + r, mr = tt < NLAT ? tt / SEQ : 8; const float* xr = tt < NLAT ? latb + (size_t)tt * DM : ctxb + (size_t)(tt - NLAT) * DM;
                modulate_row_bf16(xr, g, mod + (size_t)mr * 6144 + sc_off, mod + (size_t)mr * 6144 + sf_off, out + (size_t)tt * DM, lane); }
            continue; }
        f32x4 v[NR][4];
#pragma unroll
        for (int r = 0; r < NR; ++r) { const int tt = r < n ? t + r : t; const float* xr = tt < NLAT ? latb + (size_t)tt * DM : ctxb + (size_t)(tt - NLAT) * DM;
#pragma unroll
            for (int j = 0; j < 4; ++j) v[r][j] = *(const f32x4*)(xr + 4 * lane + 256 * j); }
        if (mra != mrc) { mrc = mra;
#pragma unroll
            for (int j = 0; j < 4; ++j) { const int k = 4 * lane + 256 * j; sc[j] = *(const f32x4*)(mod + (size_t)mra * 6144 + sc_off + k); sf[j] = *(const f32x4*)(mod + (size_t)mra * 6144 + sf_off + k); } }
        float rs[NR];
#pragma unroll
        for (int r = 0; r < NR; ++r) { float ss = 0.f;
#pragma unroll
            for (int j = 0; j < 4; ++j) ss += (v[r][j][0] * v[r][j][0] + v[r][j][1] * v[r][j][1]) + (v[r][j][2] * v[r][j][2] + v[r][j][3] * v[r][j][3]);
            rs[r] = rsqrtf(wave_sum(ss) * (1.f / 1024.f) + EPS); }
#pragma unroll
        for (int j = 0; j < 4; ++j) { const int k = 4 * lane + 256 * j; const f32x4 m1 = gg[j] * (sc[j] + 1.0f);
#pragma unroll
            for (int r = 0; r < NR; ++r) if (r < n) { const f32x4 o = v[r][j] * rs[r] * m1 + sf[j]; u32x2 w; w.x = pk2(o[0], o[1]); w.y = pk2(o[2], o[3]); ST_NT((u32x2*)(out + (size_t)(t + r) * DM + k), w); } }
    }
}
__device__ __forceinline__ void prep_taplines(AP A, int l_lo, int l_hi, int gw, int NGW, int lane) {
    const float* misc = wsp<float>(A, W.misc);
    for (int row = l_lo * 1024 + gw; row < l_hi * 1024; row += NGW) {
        const int l = row >> 10, big = ((row >> 9) & 1) == 0, oc = row & 511, L = big ? 2048 : 256, TLn = big ? TLL : TLC, nit = big ? 512 : 64;
        const float* part = misc + MI_HYPART + (size_t)(l * 2 + (big ? 0 : 1)) * 512 * 1024;
        float s = 0.f;
#pragma unroll 8
        for (int i = lane; i < nit; i += 64) s += part[(size_t)i * 1024 + oc] + part[(size_t)i * 1024 + 512 + oc];
        s = wave_sum(s); const float inv = 1.f / s;
        const float* H3 = h3_ptr(A, l, big);
        bf16_t* TL = big ? wsp<bf16_t>(A, W.tapl) + ((size_t)l * 512 + oc) * TLL : wsp<bf16_t>(A, W.tapc) + ((size_t)l * 512 + oc) * TLC;
        const int c = L + 32;
        for (int y0 = 0; y0 < TLn; y0 += 64 * 8) { float tv[8];
#pragma unroll
            for (int j = 0; j < 8; ++j) { const int y = y0 + 64 * j + lane, m = c - y, am = m < 0 ? -m : m; const bool ok = (y < TLn) && (am < L);
                const float v = H3[ok ? (size_t)am * 1024 + (m < 0 ? 512 : 0) + oc : (size_t)oc];
                tv[j] = ok ? v : 0.f; }
#pragma unroll
            for (int j = 0; j < 8; ++j) { const int y = y0 + 64 * j + lane; if (y < TLn) TL[y] = (bf16_t)f2bf(tv[j] * inv); } }
    }
}
__device__ __forceinline__ void prep_taplines8(AP A, int l_lo, int l_hi, int vcu, int G, int wave, int lane) {
    const float* misc = wsp<float>(A, W.misc);
    for (int it = l_lo * 128 + vcu; it < l_hi * 128; it += G) {
        const int l = it >> 7, big = ((it >> 6) & 1) == 0, oc0 = (it & 63) * 8, L = big ? 2048 : 256, TLn = big ? TLL : TLC, nit = big ? 512 : 64;
        const float* part = misc + MI_HYPART + (size_t)(l * 2 + (big ? 0 : 1)) * 512 * 1024 + oc0;
        f32x4 s0 = {0.f, 0.f, 0.f, 0.f}, s1 = s0;
        for (int i = lane; i < nit; i += 64) { const float* pp = part + (size_t)i * 1024; s0 = s0 + *(const f32x4*)(pp) + *(const f32x4*)(pp + 512); s1 = s1 + *(const f32x4*)(pp + 4) + *(const f32x4*)(pp + 516); }
        float inv[8];
#pragma unroll
        for (int j = 0; j < 4; ++j) { inv[j] = 1.f / wave_sum(s0[j]); inv[4 + j] = 1.f / wave_sum(s1[j]); }
        const float* H3 = h3_ptr(A, l, big) + oc0;
        bf16_t* TL = (big ? wsp<bf16_t>(A, W.tapl) + ((size_t)l * 512 + oc0) * TLL : wsp<bf16_t>(A, W.tapc) + ((size_t)l * 512 + oc0) * TLC);
        const int c = L + 32;
        for (int y0 = wave * 64; y0 < TLn; y0 += 64 * NWAVES * 2) {
            f32x4 va[2], vb[2]; int yy[2];
#pragma unroll
            for (int j = 0; j < 2; ++j) { const int y = y0 + 64 * NWAVES * j + lane, m = c - y, am = m < 0 ? -m : m; const bool ok = (y < TLn) && (am < L); yy[j] = y;
                const float* src = H3 + (ok ? (size_t)am * 1024 + (m < 0 ? 512 : 0) : (size_t)0);
                va[j] = *(const f32x4*)src; vb[j] = *(const f32x4*)(src + 4);
                if (!ok) { va[j] = (f32x4){0.f, 0.f, 0.f, 0.f}; vb[j] = va[j]; } }
#pragma unroll
            for (int j = 0; j < 2; ++j) if (yy[j] < TLn) {
#pragma unroll
                for (int q = 0; q < 4; ++q) { TL[(size_t)q * TLn + yy[j]] = (bf16_t)f2bf(va[j][q] * inv[q]); TL[(size_t)(4 + q) * TLn + yy[j]] = (bf16_t)f2bf(vb[j][q] * inv[4 + q]); } }
        }
    }
}
__device__ __forceinline__ void phase_pb(AP A, int vcu, int G) {
    const int tid = opaque_tid(), lane = tid & 63, wave = __builtin_amdgcn_readfirstlane(tid >> 6); (void)tid;
    const int gw = vcu * NWAVES + wave, NGW = G * NWAVES;
    const float* mod = wsp<float>(A, W.mod);
    { const int R = (NTOK + NGW - 1) / NGW, t0 = gw * R, t1 = (t0 + R) < NTOK ? (t0 + R) : NTOK;
      if (t0 < NTOK) modulate_wave_rows<5>(FIN(0), FIN(2), FIN(6), mod, 1024, 0, wsp<bf16_t>(A, W.xn), t0, t1, lane); }
    prep_taplines8(A, 0, 2, vcu, G, wave, lane);
}

constexpr int NTT = NTOK / 256, NTL = NLAT / 256;
__device__ __forceinline__ size_t gate_frag(int pm, int gt, int wr, int wc, int fr, int fq) { return ((((size_t)(pm * 12 + gt) * 8 + (wr * 4 + wc)) * 16) * 64 + (fq * 16 + fr)) * 8; }
struct InprojSched {
    int l, G, c; const char* xn; const char* w;
    __device__ bool next(int i, Unit& u) const {
        const long Li = (long)i * G + c;
        const int nM = (l == 0) ? NTT : NTL, nN = 23, nwg = nM * nN;
        if (Li < nwg) {
            int wgid = (int)Li; { const int q = nwg / 8, r = nwg % 8, xcd = wgid % 8, off = wgid / 8; wgid = (xcd < r ? xcd * (q + 1) : r * (q + 1) + (xcd - r) * q) + off; }
            const int nig = 8 * nN, gid = wgid / nig, fm = gid * 8, gsz = (nM - fm) < 8 ? (nM - fm) : 8;
            u.pm = fm + ((wgid % nig) % gsz); u.pn = (wgid % nig) / gsz;
        } else {
            const int r2 = (int)(Li - nwg); if (l == 0 || r2 >= (NTT - NTL) * 4) return false;
            u.pm = NTL + r2 / 4; u.pn = 7 + (r2 & 3);
        }
        const int pn = u.pn; u.kind = pn < 3 ? 0 : pn < 5 ? 1 : pn < 9 ? 2 : pn < 11 ? 3 : 4;
        const char* at = xn + (size_t)u.pm * 256 * 1024 * 2; const char* wt = w + (size_t)pn * 256 * 1024 * 2;
        const bool swapped = (u.kind == 0 || u.kind == 1 || u.kind == 3);
        u.a = swapped ? wt : at; u.b = swapped ? at : wt; u.aux = 0; return true;
    }
};
struct InprojEpi {
    int l; bf16_t *hyt, *ftl, *ftc, *q, *qc, *k, *vt, *g; const float *gq, *gk, *rope;
    __device__ __forceinline__ bool operator()(Acc& acc, const Unit& u, int wr, int wc, int fr, int fq) const {
        const int pm = u.pm, pn = u.pn;
        if (u.kind == 0 || u.kind == 1 || u.kind == 3) {
            const bool lat = pm < NTL; const int b = lat ? pm >> 3 : pm - NTL;
#pragma unroll
            for (int bj = 0; bj < 2; ++bj) {
                const int tl = 128 * bj + 32 * wc + 8 * fq;
                bf16_t* base; size_t rstride;
                if (u.kind == 0) { base = hyt + (size_t)(pn * 256) * NTOK + (size_t)pm * 256 + tl; rstride = NTOK; }
                else if (u.kind == 1) { const int part = pn - 3;
                    if (lat) { base = ftl + (size_t)b * 256 * 4096 + part * 2048 + (pm & 7) * 256 + tl; rstride = 4096; }
                    else { base = ftc + (size_t)b * 256 * 512 + part * 256 + tl; rstride = 512; } }
                else { base = vt + ((size_t)b * 512 + (pn - 9) * 256) * KALL + (lat ? (pm & 7) * 256 : SEQ) + tl; rstride = KALL; }
#pragma unroll
                for (int ai = 0; ai < 2; ++ai)
#pragma unroll
                    for (int m = 0; m < 4; ++m) { const int r = 128 * ai + 64 * wr + 16 * m + fr; const f32x4 v0 = acc[ai][bj][m][0], v1 = acc[ai][bj][m][1];
                        u32x4 w; w.x = cvt_pk_bf16(v0[0], v0[1]); w.y = cvt_pk_bf16(v0[2], v0[3]); w.z = cvt_pk_bf16(v1[0], v1[1]); w.w = cvt_pk_bf16(v1[2], v1[3]);
                        ST_NT((u32x4*)(base + (size_t)r * rstride), w); }
            }
        } else if (u.kind == 4) {
            unsigned char* gt_ = (unsigned char*)g + gate_frag(pm, pn - 11, wr, wc, fr, fq);
#pragma unroll
            for (int ai = 0; ai < 2; ++ai)
#pragma unroll
                for (int m = 0; m < 4; ++m) {
#pragma unroll
                    for (int bj = 0; bj < 2; ++bj) { f32x4 v0 = acc[ai][bj][m][0], v1 = acc[ai][bj][m][1];
#pragma unroll
                        for (int j = 0; j < 4; ++j) { v0[j] = fmaxf(255.f * __builtin_amdgcn_rcpf(1.f + __builtin_amdgcn_exp2f(-1.4426950408889634f * v0[j])), 1.f); v1[j] = fmaxf(255.f * __builtin_amdgcn_rcpf(1.f + __builtin_amdgcn_exp2f(-1.4426950408889634f * v1[j])), 1.f); }
                        u32x2 w = {0u, 0u};
#pragma unroll
                        for (int j = 0; j < 4; ++j) { w.x = __builtin_amdgcn_cvt_pk_u8_f32(v0[j], j, w.x); w.y = __builtin_amdgcn_cvt_pk_u8_f32(v1[j], j, w.y); }
                        ST_NT((u32x2*)(gt_ + ((ai * 4 + m) * 2 + bj) * 512), w); } }
        } else {
            const int which = (pn - 5) >> 1, grp = ((pn - 5) & 1) * 4 + wc, h = grp >> 1, map = grp & 1;
            const int d0 = 32 * (fq >> 1) + 8 * (fq & 1);
            const float* gp = (which ? gk : gq) + map * 64 + d0;
            const f32x4 g00 = *(const f32x4*)(gp), g01 = *(const f32x4*)(gp + 4), g10 = *(const f32x4*)(gp + 16), g11 = *(const f32x4*)(gp + 20);
            const bool lat = pm < NTL; const int b = lat ? pm >> 3 : pm - NTL;
#pragma unroll
            for (int ai = 0; ai < 2; ++ai)
#pragma unroll
                for (int m = 0; m < 4; ++m) {
                    const int rl = 128 * ai + 64 * wr + 16 * m + fr;
                    f32x4 a0 = acc[ai][0][m][0], a1 = acc[ai][0][m][1], b0 = acc[ai][1][m][0], b1 = acc[ai][1][m][1];
                    float ss = 0.f;
#pragma unroll
                    for (int j = 0; j < 4; ++j) ss += a0[j] * a0[j] + a1[j] * a1[j] + b0[j] * b0[j] + b1[j] * b1[j];
                    ss += __shfl_xor(ss, 16); ss += __shfl_xor(ss, 32);
                    const float rs = rsqrtf(ss * (1.f / 64.f) + EPS) * (which ? 1.f : 0.125f * 1.4426950408889634f);
                    a0 = a0 * rs * g00; a1 = a1 * rs * g01; b0 = b0 * rs * g10; b1 = b1 * rs * g11;
                    bf16_t* dst;
                    if (lat) { const int pos = (pm & 7) * 256 + rl; const int pa = (fq >> 1) ? (pos & 63) : (pos >> 6);
                        const float* rp = rope + ((size_t)pa * 16 + 8 * (fq & 1)) * 2;
                        const f32x4 r0 = *(const f32x4*)(rp), r1 = *(const f32x4*)(rp + 4), r2 = *(const f32x4*)(rp + 8), r3 = *(const f32x4*)(rp + 12);
                        const float cs[8] = {r0[0], r0[2], r1[0], r1[2], r2[0], r2[2], r3[0], r3[2]}, sn[8] = {r0[1], r0[3], r1[1], r1[3], r2[1], r2[3], r3[1], r3[3]};
#pragma unroll
                        for (int j = 0; j < 4; ++j) { const float x1 = a0[j], x2 = b0[j]; a0[j] = x1 * cs[j] - x2 * sn[j]; b0[j] = x2 * cs[j] + x1 * sn[j];
                            const float y1 = a1[j], y2 = b1[j]; a1[j] = y1 * cs[4 + j] - y2 * sn[4 + j]; b1[j] = y2 * cs[4 + j] + y1 * sn[4 + j]; }
                        dst = which ? k + (((size_t)(b * 4 + h) * 2 + map) * KALL + pos) * 64 : q + (((size_t)(b * 4 + h) * 2 + map) * SEQ + pos) * 64;
                    } else dst = which ? k + (((size_t)(b * 4 + h) * 2 + map) * KALL + SEQ + rl) * 64 : qc + (((size_t)(b * 4 + h) * 2 + map) * CTX + rl) * 64;
                    u32x4 w0, w1; w0.x = cvt_pk_bf16(a0[0], a0[1]); w0.y = cvt_pk_bf16(a0[2], a0[3]); w0.z = cvt_pk_bf16(a1[0], a1[1]); w0.w = cvt_pk_bf16(a1[2], a1[3]);
                    w1.x = cvt_pk_bf16(b0[0], b0[1]); w1.y = cvt_pk_bf16(b0[2], b0[3]); w1.z = cvt_pk_bf16(b1[0], b1[1]); w1.w = cvt_pk_bf16(b1[2], b1[3]);
                    ST_NT((u32x4*)(dst + d0), w0); ST_NT((u32x4*)(dst + d0 + 16), w1);
                }
        }
        return true;
    }
};
__device__ __forceinline__ void phase_inproj(AP A, FK_LAS unsigned char* lds, int l, int G) {
    InprojSched S{l, G, (int)blockIdx.x, (const char*)wsp<bf16_t>(A, W.xn), (const char*)(wsp<bf16_t>(A, W.w_in) + (size_t)l * PINF * 1024)};
    InprojEpi E{l, wsp<bf16_t>(A, W.hyt), wsp<bf16_t>(A, W.ftl), wsp<bf16_t>(A, W.ftc), wsp<bf16_t>(A, W.q), wsp<bf16_t>(A, W.qc), wsp<bf16_t>(A, W.k), wsp<bf16_t>(A, W.vt), wsp<bf16_t>(A, W.g),
                FIN(18) + l * 128, FIN(19) + l * 128, wsp<float>(A, W.misc) + MI_ROPE};
    gemm_phase(lds, 1024, S, E);
}
#define FK_HAVE_MIX 1
namespace attn {
constexpr float SCALE = 0.125f, THR = 8.f;
constexpr int KVBLK = 64;
constexpr int SHM_V = 128 * 64 * 2, SHM_K = 64 * 64 * 2;
constexpr int OFF_V = 0, OFF_K = 2 * SHM_V, OFF_WS = 2 * SHM_V + 2 * SHM_K;
#define ASWZ(row, cb) ((row) * 128 + ((cb) ^ ((((row) >> 1) & 7) << 4)))
#define SBAR() __builtin_amdgcn_sched_barrier(0)
__device__ __forceinline__ int crow(int r, int hi) { return (r & 3) + 8 * (r >> 2) + 4 * hi; }
__device__ __forceinline__ void partialSM(f32x16& p0, f32x16& p1, const float mnC) {
    if (mnC < -64.f) {
#pragma unroll
        for (int r = 0; r < 16; ++r) { p0[r] += mnC; p1[r] += mnC; } }
#pragma unroll
    for (int r = 0; r < 16; ++r) p0[r] = __builtin_amdgcn_exp2f(p0[r]);
}
__device__ __forceinline__ void finishSM(f32x16& p0, f32x16& p1, float& l_reg, bf16x8& pa0, bf16x8& pa1, bf16x8& pa2, bf16x8& pa3) {
#pragma unroll
    for (int r = 0; r < 16; ++r) p1[r] = __builtin_amdgcn_exp2f(p1[r]);
    float ps = 0;
#pragma unroll
    for (int r = 0; r < 16; ++r) ps += p0[r];
#pragma unroll
    for (int r = 0; r < 16; ++r) ps += p1[r];
    { auto rr = __builtin_amdgcn_permlane32_swap(__float_as_uint(ps), __float_as_uint(ps), false, false);
      ps = __uint_as_float(rr[0]) + __uint_as_float(rr[1]); }
    l_reg += ps;
#define PK4(P, BASE, OUT) do { unsigned a0 = cvt_pk_bf16(P[BASE + 0], P[BASE + 1]), a1 = cvt_pk_bf16(P[BASE + 2], P[BASE + 3]);   \
    unsigned b0 = cvt_pk_bf16(P[BASE + 4], P[BASE + 5]), b1 = cvt_pk_bf16(P[BASE + 6], P[BASE + 7]);                              \
    auto r0 = __builtin_amdgcn_permlane32_swap(a0, b0, false, false); auto r1 = __builtin_amdgcn_permlane32_swap(a1, b1, false, false); \
    u32x4 w = {r0[0], r1[0], r0[1], r1[1]}; OUT = *reinterpret_cast<bf16x8*>(&w); } while (0)
    PK4(p0, 0, pa0); PK4(p0, 8, pa1); PK4(p1, 0, pa2); PK4(p1, 8, pa3);
#undef PK4
}
__device__ __forceinline__ void qkt(f32x16& p0, f32x16& p1, const FK_LAS char* Ks, const bf16x8* qr, int r32, int hi, const float mnC) {
    (void)mnC; p0 = f32x16{}; p1 = f32x16{};
#pragma unroll
    for (int d0 = 0; d0 < 4; ++d0) { const int cb = d0 * 32 + hi * 16;
        const bf16x8 b0 = *(const FK_LAS bf16x8*)(Ks + ASWZ(r32, cb));
        const bf16x8 b1 = *(const FK_LAS bf16x8*)(Ks + ASWZ(32 + r32, cb));
        __builtin_amdgcn_s_setprio(1);
        p0 = __builtin_amdgcn_mfma_f32_32x32x16_bf16(b0, qr[d0], p0, 0, 0, 0);
        p1 = __builtin_amdgcn_mfma_f32_32x32x16_bf16(b1, qr[d0], p1, 0, 0, 0);
        __builtin_amdgcn_s_setprio(0); }
}
__device__ __forceinline__ void pv(f32x16* o, const FK_LAS char* Vs, int r32, int hi, bf16x8 pa0, bf16x8 pa1, bf16x8 pa2, bf16x8 pa3) {
#pragma unroll
    for (int d0 = 0; d0 < 4; ++d0) { const int row = 32 * d0 + r32;
        const bf16x8 v0 = *(const FK_LAS bf16x8*)(Vs + ASWZ(row, 0 * 32 + hi * 16)), v1 = *(const FK_LAS bf16x8*)(Vs + ASWZ(row, 1 * 32 + hi * 16));
        const bf16x8 v2 = *(const FK_LAS bf16x8*)(Vs + ASWZ(row, 2 * 32 + hi * 16)), v3 = *(const FK_LAS bf16x8*)(Vs + ASWZ(row, 3 * 32 + hi * 16));
        __builtin_amdgcn_s_setprio(1);
        o[d0] = __builtin_amdgcn_mfma_f32_32x32x16_bf16(pa0, v0, o[d0], 0, 0, 0);
        o[d0] = __builtin_amdgcn_mfma_f32_32x32x16_bf16(pa1, v1, o[d0], 0, 0, 0);
        o[d0] = __builtin_amdgcn_mfma_f32_32x32x16_bf16(pa2, v2, o[d0], 0, 0, 0);
        o[d0] = __builtin_amdgcn_mfma_f32_32x32x16_bf16(pa3, v3, o[d0], 0, 0, 0);
        __builtin_amdgcn_s_setprio(0); }
}
__device__ __forceinline__ void body(const bf16_t* __restrict__ Qb, const bf16_t* __restrict__ Kh, const bf16_t* __restrict__ VTh, int ldv, int seq, FK_LAS char* lds, f32x16* o, const int tid, const float mnC) {
    const int wid = tid >> 6, lane = tid & 63, r32 = lane & 31, hi = lane >> 5;
    FK_LAS char* V_lds = lds + OFF_V; FK_LAS char* K_lds = lds + OFF_K;
    FK_LAS float* wsf = (FK_LAS float*)(lds + OFF_WS) + wid * 64; FK_LAS float* li_l = wsf;
    float l_reg = 0;
#pragma unroll
    for (int d = 0; d < 4; ++d) o[d] = f32x16{};
    bf16x8 qr[4];
    const bf16_t* Qw = Qb + (size_t)(wid * 32 + r32) * 64 + hi * 8;
#pragma unroll
    for (int d0 = 0; d0 < 4; ++d0) qr[d0] = *(const bf16x8*)(Qw + d0 * 16);
    const int ksr = tid >> 3, kch = tid & 7;
    const int kst = ASWZ(ksr, kch * 16);
    const int vd0 = tid >> 3, vd1 = 64 + (tid >> 3);
    const int vst0 = ASWZ(vd0, kch * 16), vst1 = ASWZ(vd1, kch * 16);
    struct { bf16x8 vs0, vs1, ks; } sr_[2];
#define SLOAD(i, k0) do { sr_[i].vs0 = *(const bf16x8*)(VTh + (size_t)vd0 * ldv + (k0) + kch * 8); sr_[i].vs1 = *(const bf16x8*)(VTh + (size_t)vd1 * ldv + (k0) + kch * 8); \
    sr_[i].ks = *(const bf16x8*)(Kh + (size_t)((k0) + ksr) * 64 + kch * 8); } while (0)
#define SWRITE(b, i) do { *(FK_LAS bf16x8*)(V_lds + (b) * SHM_V + vst0) = sr_[i].vs0; *(FK_LAS bf16x8*)(V_lds + (b) * SHM_V + vst1) = sr_[i].vs1; \
    *(FK_LAS bf16x8*)(K_lds + (b) * SHM_K + kst) = sr_[i].ks; } while (0)
#define SWAIT() asm volatile("s_waitcnt vmcnt(3)" ::: "memory")
    f32x16 pA0, pA1, pB0, pB1; bf16x8 pa0, pa1, pa2, pa3; const int NT = seq / KVBLK;
    SLOAD(0, 0); asm volatile("s_waitcnt vmcnt(0)" ::: "memory"); SWRITE(0, 0); __syncthreads();
    qkt(pA0, pA1, K_lds, qr, r32, hi, mnC); partialSM(pA0, pA1, mnC);
    SLOAD(1, KVBLK); if (2 < NT) SLOAD(0, 2 * KVBLK);
    if (2 < NT) SWAIT(); else asm volatile("s_waitcnt vmcnt(0)" ::: "memory");
    SWRITE(1, 1); __syncthreads();
    for (int j = 1; j + 1 < NT; j += 2) {
        SBAR(); qkt(pB0, pB1, K_lds + SHM_K, qr, r32, hi, mnC);
        finishSM(pA0, pA1, l_reg, pa0, pa1, pa2, pa3); SBAR();
        SLOAD(1, (j + 2) * KVBLK); SBAR();
        pv(o, V_lds, r32, hi, pa0, pa1, pa2, pa3); partialSM(pB0, pB1, mnC);
        __syncthreads(); SWAIT(); SWRITE(0, 0);
        __syncthreads();
        SBAR(); qkt(pA0, pA1, K_lds, qr, r32, hi, mnC);
        finishSM(pB0, pB1, l_reg, pa0, pa1, pa2, pa3); SBAR();
        const bool more = (j + 3 < NT);
        if (more) SLOAD(0, (j + 3) * KVBLK);
        SBAR();
        pv(o, V_lds + SHM_V, r32, hi, pa0, pa1, pa2, pa3); partialSM(pA0, pA1, mnC);
        __syncthreads(); if (more) SWAIT(); else asm volatile("s_waitcnt vmcnt(0)" ::: "memory");
        SWRITE(1, 1);
        __syncthreads();
    }
    SBAR(); qkt(pB0, pB1, K_lds + SHM_K, qr, r32, hi, mnC);
    finishSM(pA0, pA1, l_reg, pa0, pa1, pa2, pa3); SBAR();
    pv(o, V_lds, r32, hi, pa0, pa1, pa2, pa3); partialSM(pB0, pB1, mnC);
    __syncthreads();
    finishSM(pB0, pB1, l_reg, pa0, pa1, pa2, pa3); SBAR();
    pv(o, V_lds + SHM_V, r32, hi, pa0, pa1, pa2, pa3);
    if (hi == 0) li_l[r32] = l_reg; asm volatile("s_waitcnt lgkmcnt(0)" ::: "memory");
#pragma unroll
    for (int r = 0; r < 16; ++r) { const float rl = __builtin_amdgcn_rcpf(li_l[crow(r, hi)]);
#pragma unroll
        for (int d = 0; d < 4; ++d) o[d][r] *= rl; }
    __syncthreads();
#undef SLOAD
#undef SWRITE
#undef SWAIT
}
__device__ __forceinline__ void unit(AP A, FK_LAS char* lds, int l, int b, int h, int qb  ) {
    const int tid = opaque_tid(), wid = tid >> 6, lane = tid & 63, r32 = lane & 31, hi = lane >> 5;
    const bool ctx = qb == 8;
    float* stash = wsp<float>(A, W.stash) + (size_t)blockIdx.x * 128 * 512;
    const float mnC = wsp<float>(A, W.misc)[MI_LAM + 2 + l];
#pragma unroll 1
    for (int map = 0; map < 2; ++map) {
        const size_t hm = (size_t)(b * 4 + h) * 2 + map;
        const bf16_t* Qb = ctx ? wsp<bf16_t>(A, W.qc) + hm * CTX * 64 : wsp<bf16_t>(A, W.q) + (hm * SEQ + (size_t)qb * 256) * 64;
        const bf16_t* Kh = wsp<bf16_t>(A, W.k) + (hm * KALL + (ctx ? SEQ : 0)) * 64;
        const bf16_t* VTh = wsp<bf16_t>(A, W.vt) + (size_t)(b * 4 + h) * 128 * KALL + (ctx ? SEQ : 0);
        f32x16 om[4];
        body(Qb, Kh, VTh, KALL, ctx ? CTX : KALL, lds, om, tid, mnC);
#pragma unroll
        for (int d = 0; d < 4; ++d)
#pragma unroll
            for (int r = 0; r < 16; ++r) stash[(size_t)((map * 4 + d) * 16 + r) * 512 + tid] = om[d][r];
    }
    const float lam = wsp<float>(A, W.misc)[MI_LAM + l], post = 1.f - (0.8f - 0.6f * __expf(-0.3f * (float)l));
    f32x16 o[4];
    float ss[16];
#pragma unroll
    for (int r = 0; r < 16; ++r) ss[r] = 0.f;
#pragma unroll
    for (int d = 0; d < 4; ++d)
#pragma unroll
        for (int r = 0; r < 16; ++r) { const float v = stash[(size_t)(d * 16 + r) * 512 + tid] - lam * stash[(size_t)((4 + d) * 16 + r) * 512 + tid]; o[d][r] = v; ss[r] += v * v; }
#pragma unroll
    for (int r = 0; r < 16; ++r) {
#pragma unroll
        for (int s = 1; s < 32; s <<= 1) ss[r] += __shfl_xor(ss[r], s);
        ss[r] = rsqrtf(ss[r] * (1.f / 128.f) + EPS) * post; }
    bf16_t* att = (h < 2) ? wsp<bf16_t>(A, W.attlo) : wsp<bf16_t>(A, W.atthi);
    const size_t t0 = ctx ? (size_t)NLAT + b * CTX : (size_t)b * SEQ + qb * 256;
    float gsv[4];
#pragma unroll
    for (int d = 0; d < 4; ++d) gsv[d] = FIN(21)[l * 128 + 32 * d + r32];
#pragma unroll
    for (int d = 0; d < 4; ++d) { const float gs = gsv[d];
#pragma unroll
        for (int r = 0; r < 16; ++r) att[(t0 + wid * 32 + crow(r, hi)) * 256 + (h & 1) * 128 + 32 * d + r32] = (bf16_t)f2bf(o[d][r] * ss[r] * gs); }
}
#undef ASWZ
#undef SBAR
}

namespace hy {
template <int L, int NBH> struct Geo {
    static constexpr int NBLK = L / 32, IB = 32 / NBH, NG = NBLK / IB, GPW = (NG >= 8) ? NG / 8 : 1, AW = NG / GPW;
    static constexpr int PADB = IB * GPW - 1, RL = (NBLK + 2 * PADB) * 32, ZRS = RL * 2 + 16;
    static constexpr int TLn = (L == 2048) ? TLL : TLC, TCS = TLn * 2 + ((L == 2048) ? 32 : 160);
    static constexpr int OFF_Z = 0, OFF_G = NBH * ZRS, OFF_T = 2 * NBH * ZRS, END = OFF_T + 8 * TCS;
};
__device__ __forceinline__ int crow(int r, int hi) { return (r & 3) + 8 * (r >> 2) + 4 * hi; }
template <int L, int NBH>
__device__ __forceinline__ void unit(AP A, FK_LAS char* lds, int l, int ch, int boff) {
    using Gm = Geo<L, NBH>;
    static_assert(Gm::END <= LDS_MISC, "hyena LDS");
    const int tid = opaque_tid(), wid = __builtin_amdgcn_readfirstlane(tid >> 6), lane = tid & 63, r32 = lane & 31, hi = lane >> 5;
    const bf16_t* hyt = wsp<bf16_t>(A, W.hyt);
    const float* cw = FIN(9) + l * 3 * 768; const float* cb = FIN(10) + l * 768;
    const int tbl = tid / (L / 32), tb = boff + tbl, tp0 = (tid % (L / 32)) * 32; const bool ld_act = tid < NBH * (L / 32);
    unsigned x2p[16];
    u32x4 raw[3][4]; unsigned short e0[3], e1[3]; float cwv[3][4];
#pragma unroll
    for (int sel = 0; sel < 3; ++sel) { const int row = sel * 256 + ch; cwv[sel][0] = cw[row]; cwv[sel][1] = cw[768 + row]; cwv[sel][2] = cw[1536 + row]; cwv[sel][3] = cb[row];
        e0[sel] = 0; e1[sel] = 0;
#pragma unroll
        for (int q = 0; q < 4; ++q) raw[sel][q] = (u32x4){0u, 0u, 0u, 0u};
        if (ld_act && tb < NB) { const size_t tok0 = (L == 2048) ? (size_t)tb * SEQ + tp0 : (size_t)NLAT + tb * CTX + tp0; const bf16_t* src = hyt + (size_t)row * NTOK + tok0;
#pragma unroll
            for (int q = 0; q < 4; ++q) raw[sel][q] = *(const u32x4*)(src + q * 8);
            if (tp0 > 0) e0[sel] = src[-1]; if (tp0 + 32 < L) e1[sel] = src[32]; } }
    constexpr int NC = Gm::TLn / 8;
    static_assert(NC <= 2 * NTHR, "tap line chunks per thread");
    const bf16_t* TLb = (L == 2048 ? wsp<bf16_t>(A, W.tapl) + ((size_t)l * 512 + ch) * TLL : wsp<bf16_t>(A, W.tapc) + ((size_t)l * 512 + ch) * TLC);
    constexpr size_t TLO = (size_t)256 * ((L == 2048) ? TLL : TLC);
    u32x4 tq0 = {0u, 0u, 0u, 0u}, tq1 = tq0;
    if (tid < NC) tq0 = *(const u32x4*)(TLb + tid * 8);
    if (tid + NTHR < NC) tq1 = *(const u32x4*)(TLb + (tid + NTHR) * 8);
    const float bias0 = FIN(17)[l * 512 + ch], bias1 = FIN(17)[l * 512 + 256 + ch];
    __syncthreads();
    for (int i = tid; i < 2 * NBH * Gm::ZRS / 16; i += NTHR) *(FK_LAS u32x4*)(lds + i * 16) = (u32x4){0u, 0u, 0u, 0u};
    __syncthreads();
    if (ld_act) {
#pragma unroll
        for (int sel = 0; sel < 3; ++sel) {
            const float w0 = cwv[sel][0], w1 = cwv[sel][1], w2 = cwv[sel][2], bs = cwv[sel][3];
            float vals[34];
            if (tb < NB) {
#pragma unroll
                for (int q = 0; q < 4; ++q) { const u32x4 w = raw[sel][q];
                    vals[1 + q * 8 + 0] = bflo(w.x); vals[1 + q * 8 + 1] = bfhi(w.x); vals[1 + q * 8 + 2] = bflo(w.y); vals[1 + q * 8 + 3] = bfhi(w.y);
                    vals[1 + q * 8 + 4] = bflo(w.z); vals[1 + q * 8 + 5] = bfhi(w.z); vals[1 + q * 8 + 6] = bflo(w.w); vals[1 + q * 8 + 7] = bfhi(w.w); }
                vals[0] = bf2f(e0[sel]); vals[33] = bf2f(e1[sel]);
            } else {
#pragma unroll
                for (int i = 0; i < 34; ++i) vals[i] = 0.f;
            }
            unsigned pk[16];
#pragma unroll
            for (int i = 0; i < 16; ++i) { const float a = tb < NB ? vals[2 * i] * w0 + vals[2 * i + 1] * w1 + vals[2 * i + 2] * w2 + bs : 0.f, b2 = tb < NB ? vals[2 * i + 1] * w0 + vals[2 * i + 2] * w1 + vals[2 * i + 3] * w2 + bs : 0.f;
                pk[i] = cvt_pk_bf16(a, b2); }
            if (sel < 2) { FK_LAS char* dst = lds + (sel == 0 ? Gm::OFF_Z : Gm::OFF_G) + tbl * Gm::ZRS + (Gm::PADB * 32 + tp0) * 2;
#pragma unroll
                for (int q = 0; q < 4; ++q) *(FK_LAS u32x4*)(dst + q * 16) = (u32x4){pk[4 * q], pk[4 * q + 1], pk[4 * q + 2], pk[4 * q + 3]}; }
            else {
#pragma unroll
                for (int i = 0; i < 16; ++i) x2p[i] = pk[i]; }
        }
    }
    const int G0 = wid * Gm::GPW; const bool act = wid < Gm::AW;
    const int dlo = Gm::IB * G0 - (Gm::NBLK - 1), dhi = Gm::IB * (G0 + Gm::GPW) - 1;
    const int il = r32 & (Gm::IB - 1), bb = r32 / Gm::IB;
    for (int o = 0; o < 2; ++o) {
        { if (tid < NC) *(FK_LAS u32x4*)(lds + Gm::OFF_T + tid * 16) = tq0;
          if (tid + NTHR < NC) *(FK_LAS u32x4*)(lds + Gm::OFF_T + (tid + NTHR) * 16) = tq1;
          if (o == 0) { if (tid < NC) tq0 = *(const u32x4*)(TLb + TLO + tid * 8); if (tid + NTHR < NC) tq1 = *(const u32x4*)(TLb + TLO + (tid + NTHR) * 8); }
          __syncthreads();
          for (int i = tid; i < 7 * NC; i += NTHR) { const int sft = 1 + i / NC, c = i % NC;
              const FK_LAS unsigned* src = (const FK_LAS unsigned*)(lds + Gm::OFF_T + c * 16 + 4 * (sft >> 1)); const unsigned sh = 16u * (unsigned)(sft & 1);
              const bool tail = (c == NC - 1);
              unsigned w0 = src[0], w1 = tail && (1 + (sft >> 1)) >= 4 ? 0u : src[1], w2 = tail && (2 + (sft >> 1)) >= 4 ? 0u : src[2], w3 = tail && (3 + (sft >> 1)) >= 4 ? 0u : src[3], w4 = tail ? 0u : src[4];
              u32x4 ov; ov.x = __builtin_amdgcn_alignbit(w1, w0, sh); ov.y = __builtin_amdgcn_alignbit(w2, w1, sh); ov.z = __builtin_amdgcn_alignbit(w3, w2, sh); ov.w = __builtin_amdgcn_alignbit(w4, w3, sh);
              *(FK_LAS u32x4*)(lds + Gm::OFF_T + sft * Gm::TCS + c * 16) = ov; } }
        __syncthreads();
        f32x16 acc[Gm::GPW];
#pragma unroll
        for (int g = 0; g < Gm::GPW; ++g) acc[g] = f32x16{};
        if (act) {
            const int c0 = (L + 32) - r32 + 8 * hi, sc = c0 & 7;
            int pa = Gm::OFF_T + sc * Gm::TCS + (c0 - sc - 32 * dlo) * 2;
            int pb = Gm::OFF_Z + bb * Gm::ZRS + ((Gm::PADB + Gm::IB * G0 + il - dlo) * 32 + 8 * hi) * 2;
            const int nd = dhi - dlo + 1;
            if constexpr (Gm::GPW == 2 && Gm::IB == 4) {
                bf16x8 a0, a1, r0[5], r1[5];
#pragma unroll
                for (int q = 0; q < 4; ++q) { r0[q + 1] = *(const FK_LAS bf16x8*)(lds + pb + 256 - 64 * q); r1[q + 1] = *(const FK_LAS bf16x8*)(lds + pb + 256 - 64 * q + 32); }
                a0 = *(const FK_LAS bf16x8*)(lds + pa); a1 = *(const FK_LAS bf16x8*)(lds + pa + 32); r0[0] = *(const FK_LAS bf16x8*)(lds + pb); r1[0] = *(const FK_LAS bf16x8*)(lds + pb + 32);
#define HY_STEP(k, more) do { \
                    acc[0] = __builtin_amdgcn_mfma_f32_32x32x16_bf16(a0, r0[k], acc[0], 0, 0, 0); acc[0] = __builtin_amdgcn_mfma_f32_32x32x16_bf16(a1, r1[k], acc[0], 0, 0, 0); \
                    acc[1] = __builtin_amdgcn_mfma_f32_32x32x16_bf16(a0, r0[((k) + 1) % 5], acc[1], 0, 0, 0); acc[1] = __builtin_amdgcn_mfma_f32_32x32x16_bf16(a1, r1[((k) + 1) % 5], acc[1], 0, 0, 0); \
                    if (more) { pa -= 64; pb -= 64; a0 = *(const FK_LAS bf16x8*)(lds + pa); a1 = *(const FK_LAS bf16x8*)(lds + pa + 32); \
                        r0[((k) + 1) % 5] = *(const FK_LAS bf16x8*)(lds + pb); r1[((k) + 1) % 5] = *(const FK_LAS bf16x8*)(lds + pb + 32); } } while (0)
                int d = 0;
#pragma unroll 1
                for (; d + 5 < nd; d += 5) { HY_STEP(0, true); HY_STEP(1, true); HY_STEP(2, true); HY_STEP(3, true); HY_STEP(4, true); }
                { const int rem = nd - d;
                  HY_STEP(0, rem > 1); if (rem > 1) { HY_STEP(1, rem > 2); if (rem > 2) { HY_STEP(2, rem > 3); if (rem > 3) { HY_STEP(3, rem > 4); if (rem > 4) HY_STEP(4, false); } } } }
#undef HY_STEP
            } else {
#define HY_LOAD(A0, A1, B0, B1) do { A0 = *(const FK_LAS bf16x8*)(lds + pa); A1 = *(const FK_LAS bf16x8*)(lds + pa + 32); \
                _Pragma("unroll") for (int g = 0; g < Gm::GPW; ++g) { B0[g] = *(const FK_LAS bf16x8*)(lds + pb + g * Gm::IB * 64); B1[g] = *(const FK_LAS bf16x8*)(lds + pb + g * Gm::IB * 64 + 32); } \
                pa -= 64; pb -= 64; } while (0)
#define HY_MMA(A0, A1, B0, B1) do { _Pragma("unroll") for (int g = 0; g < Gm::GPW; ++g) { acc[g] = __builtin_amdgcn_mfma_f32_32x32x16_bf16(A0, B0[g], acc[g], 0, 0, 0); \
                acc[g] = __builtin_amdgcn_mfma_f32_32x32x16_bf16(A1, B1[g], acc[g], 0, 0, 0); } } while (0)
            bf16x8 xa0, xa1, ya0, ya1, xb0[Gm::GPW], xb1[Gm::GPW], yb0[Gm::GPW], yb1[Gm::GPW];
            HY_LOAD(xa0, xa1, xb0, xb1);
            int d = 0;
#pragma unroll 1
            for (; d + 2 <= nd - 1; d += 2) {
                HY_LOAD(ya0, ya1, yb0, yb1);
                HY_MMA(xa0, xa1, xb0, xb1);
                HY_LOAD(xa0, xa1, xb0, xb1);
                HY_MMA(ya0, ya1, yb0, yb1);
            }
            if (d + 1 <= nd - 1) { HY_LOAD(ya0, ya1, yb0, yb1); HY_MMA(xa0, xa1, xb0, xb1); HY_MMA(ya0, ya1, yb0, yb1); }
            else HY_MMA(xa0, xa1, xb0, xb1);
#undef HY_LOAD
#undef HY_MMA
            }
        }
        __syncthreads();
        const float bias = o ? bias1 : bias0;
        if (act) {
#pragma unroll
            for (int g = 0; g < Gm::GPW; ++g) {
                unsigned short zv[16], gv[16];
#pragma unroll
                for (int r = 0; r < 16; ++r) { const int pos = 32 * (Gm::IB * (G0 + g) + il) + crow(r, hi);
                    zv[r] = *(FK_LAS unsigned short*)(lds + Gm::OFF_Z + bb * Gm::ZRS + (Gm::PADB * 32 + pos) * 2);
                    gv[r] = *(FK_LAS unsigned short*)(lds + Gm::OFF_G + bb * Gm::ZRS + (Gm::PADB * 32 + pos) * 2); }
                asm volatile("" ::: "memory");
#pragma unroll
                for (int r = 0; r < 16; ++r) { const int pos = 32 * (Gm::IB * (G0 + g) + il) + crow(r, hi);
                    const float zn = bf2f(gv[r]) * (acc[g][r] + bias * bf2f(zv[r]));
                    *(FK_LAS unsigned short*)(lds + Gm::OFF_Z + bb * Gm::ZRS + (Gm::PADB * 32 + pos) * 2) = (unsigned short)f2bf(zn); }
                asm volatile("" ::: "memory"); }
        }
        __syncthreads();
        if (o == 0 && ld_act) { FK_LAS char* dst = lds + Gm::OFF_G + tbl * Gm::ZRS + (Gm::PADB * 32 + tp0) * 2;
#pragma unroll
            for (int q = 0; q < 4; ++q) *(FK_LAS u32x4*)(dst + q * 16) = (u32x4){x2p[4 * q], x2p[4 * q + 1], x2p[4 * q + 2], x2p[4 * q + 3]}; }
    }
    __syncthreads();
    if (ld_act && tb < NB) { const size_t tok0 = (L == 2048) ? (size_t)tb * SEQ + tp0 : (size_t)NLAT + tb * CTX + tp0;
        bf16_t* dst = wsp<bf16_t>(A, W.hyo) + (size_t)ch * NTOK + tok0; const FK_LAS char* srcz = lds + Gm::OFF_Z + tbl * Gm::ZRS + (Gm::PADB * 32 + tp0) * 2;
#pragma unroll
        for (int q = 0; q < 4; ++q) *(u32x4*)(dst + q * 8) = *(const FK_LAS u32x4*)(srcz + q * 16); }
    __syncthreads();
}
}

struct FnSched {
    int G, c, big; const char* dft; const char* ft;
    __device__ bool next(int i, Unit& u) const {
        const long Li = (long)i * G + (G - 1 - c);
        const int n = big ? NB * 8 : NB; if (Li >= n) return false;
        const int b = big ? (int)Li >> 3 : (int)Li, mt = big ? (int)Li & 7 : 0;
        u.pm = mt; u.pn = b; u.kind = big; u.aux = 0;
        u.a = dft + (size_t)mt * 256 * (big ? 4096 : 512) * 2; u.b = ft + (size_t)b * 256 * (big ? 4096 : 512) * 2; return true;
    }
};
struct FnEpi {
    bf16_t* fno;
    __device__ __forceinline__ bool operator()(Acc& acc, const Unit& u, int wr, int wc, int fr, int fq) const {
        const size_t t0 = u.kind ? (size_t)u.pn * SEQ + u.pm * 256 : (size_t)NLAT + u.pn * CTX;
#pragma unroll
        for (int ai = 0; ai < 2; ++ai)
#pragma unroll
            for (int m = 0; m < 4; ++m) { bf16_t* rowp = fno + (t0 + 128 * ai + 64 * wr + 16 * m + fr) * 256 + 32 * wc + 8 * fq;
#pragma unroll
                for (int bj = 0; bj < 2; ++bj) { const f32x4 v0 = acc[ai][bj][m][0], v1 = acc[ai][bj][m][1];
                    u32x4 w; w.x = cvt_pk_bf16(v0[0], v0[1]); w.y = cvt_pk_bf16(v0[2], v0[3]); w.z = cvt_pk_bf16(v1[0], v1[1]); w.w = cvt_pk_bf16(v1[2], v1[3]);
                    *(u32x4*)(rowp + 128 * bj) = w; } }
        return true;
    }
};

__device__ __forceinline__ void phase_mix(AP A, FK_LAS unsigned char* lds, int l, int vcu, int G) {
    const int n_lat = NB * 32, n_all = n_lat + (l == 0 ? NB * 4 : 0);
#ifndef FK_REP_SUB
#define FK_REP_SUB 0
#endif
#ifndef FK_NO_ATTN
    for (int rp = (FK_REP_SUB == 1 ? 1 : 0); rp >= 0; --rp)
    for (int u = vcu; u < n_all; u += G) {
        if (u < n_lat) attn::unit(A, (FK_LAS char*)lds, l, u >> 5, (u >> 3) & 3, u & 7);
        else { const int v = u - n_lat; attn::unit(A, (FK_LAS char*)lds, l, v >> 2, v & 3, 8); }
    }
#endif
#ifndef FK_NO_HY
    for (int rp = (FK_REP_SUB == 2 ? 1 : 0); rp >= 0; --rp)
    if (G == 256) { if (vcu < 192) hy::unit<2048, 8>(A, (FK_LAS char*)lds, l, vcu, 0); if (vcu >= 64 && vcu < 128) hy::unit<2048, 8>(A, (FK_LAS char*)lds, l, vcu + 128, 0); }
    else for (int ch = vcu; ch < 256; ch += G) hy::unit<2048, 8>(A, (FK_LAS char*)lds, l, ch, 0);
    if (l == 0) { if (G == 256) { const int slot = vcu < 64 ? vcu : (vcu >= 128 && vcu < 192) ? vcu - 64 : -1;
                      if (slot >= 0) { hy::unit<256, 8>(A, (FK_LAS char*)lds, l, slot, 0); hy::unit<256, 8>(A, (FK_LAS char*)lds, l, slot + 128, 0); } }
                  else for (int ch = vcu; ch < 256; ch += G) hy::unit<256, 8>(A, (FK_LAS char*)lds, l, ch, 0); }
#endif
#ifndef FK_NO_FN
    for (int rp = (FK_REP_SUB == 3 ? 1 : 0); rp >= 0; --rp)
    { FnSched S{G, vcu, 1, (const char*)wsp<bf16_t>(A, W.dftl), (const char*)wsp<bf16_t>(A, W.ftl)}; FnEpi E{wsp<bf16_t>(A, W.fno)}; gemm_phase(lds, 4096, S, E); }
    if (l == 0) { const int cctx = (G == 256) ? ((vcu >= 128 && vcu < 136) ? G - 1 - (vcu - 128) : 0) : vcu;
                  FnSched S{G, cctx, 0, (const char*)wsp<bf16_t>(A, W.dftc), (const char*)wsp<bf16_t>(A, W.ftc)}; FnEpi E{wsp<bf16_t>(A, W.fno)}; gemm_phase(lds, 512, S, E); }
#endif
    if (l == 1 && G == 256) { const int slot = vcu < 64 ? vcu : (vcu >= 128 && vcu < 192) ? vcu - 64 : -1;
        if (slot >= 0) conv_tables(A, 1, wsp<unsigned char>(A, W.ub1), wsp<unsigned char>(A, W.vb1), slot, 128, opaque_tid()); }
}
#define FK_HAVE_MERGE 1
#define FK_HAVE_OUT 1
#define FK_HAVE_NORM 1
#define FK_HAVE_PQ 1
#ifndef FK_MERGE_XCD
#define FK_MERGE_XCD 0
#endif
__device__ __forceinline__ bool merge_tile(int mode, int j, int c, int G, int ntile, int& pm, int& pn) {
    if (mode == 1) { const int T = c < 224 ? c : c + 32; pm = T >> 2; pn = T & 3; return j == 0; }
    if (mode == 2) { const int T = 224 + c; pm = T >> 2; pn = T & 3; return j == 0 && c < 32; }
    if (FK_MERGE_XCD && G == 256 && ntile <= 288) { const int xcd = c & 7, loc = c >> 3;
        if (j == 0) { pm = xcd * 8 + (loc >> 2); pn = loc & 3; return true; }
        pm = 64 + xcd; pn = loc & 3; return j == 1 && loc < 4 && pm * 4 < ntile; }
    const long T = (long)j * G + c; pm = (int)(T >> 2); pn = (int)(T & 3); return T < ntile;
}
struct MergeSched {
    int G, c, ntile, mode; const char *a0, *a1, *a2, *a3; const char* w;
    __device__ bool next(int i, Unit& u) const {
        const int j = i >> 2, s = i & 3; int pm_, pn_; if (!merge_tile(mode, j, c, G, ntile, pm_, pn_)) return false;
        u.pm = pm_; u.pn = pn_; u.kind = s; u.aux = 0;
        u.a = (s == 0) ? a0 + (size_t)(j * 256 + c) * 256 * 256 * 2 : (s == 1 ? a1 : s == 2 ? a2 : a3) + (size_t)u.pm * 256 * 256 * 2; u.b = w + ((size_t)s * 1024 + u.pn * 256) * 256 * 2; return true;
    }
};
struct MergeEpi {
    const bf16_t* g; bf16_t* y;
    __device__ __forceinline__ bool operator()(Acc& acc, const Unit& u, int wr, int wc, int fr, int fq) const {
        const int s = u.kind; if (s == 2) return false;
        const unsigned char* gpn = (const unsigned char*)g + gate_frag(u.pm, (s == 3 ? 2 : s) * 4 + u.pn, wr, wc, fr, fq); const unsigned char* gpd = (const unsigned char*)g + gate_frag(u.pm, (s == 3 ? 2 : s + 1) * 4 + u.pn, wr, wc, fr, fq);
#define FK_U8X4(w) (f32x4){(float)((w) & 0xffu), (float)(((w) >> 8) & 0xffu), (float)(((w) >> 16) & 0xffu), (float)((w) >> 24)}
        const bool fin = s == 3;
#pragma unroll
        for (int h = 0; h < 4; ++h) { const int ai = h >> 1, m0 = (h & 1) * 2; u32x2 wn[4], wd[4];
#pragma unroll
            for (int q = 0; q < 4; ++q) { wn[q] = *(const u32x2*)(gpn + (ai * 8 + m0 * 2 + q) * 512); wd[q] = *(const u32x2*)(gpd + (ai * 8 + m0 * 2 + q) * 512); }
#pragma unroll
            for (int q = 0; q < 4; ++q) { const int m = m0 + (q >> 1), bj = q & 1;
                f32x4 f0 = FK_U8X4(wn[q].x), f1 = FK_U8X4(wn[q].y); f32x4 d0 = FK_U8X4(wd[q].x), d1 = FK_U8X4(wd[q].y);
#pragma unroll
                for (int j = 0; j < 4; ++j) { d0[j] = fin ? 255.f : d0[j]; d1[j] = fin ? 255.f : d1[j]; f0[j] *= __builtin_amdgcn_rcpf(d0[j]); f1[j] *= __builtin_amdgcn_rcpf(d1[j]); }
                acc[ai][bj][m][0] = acc[ai][bj][m][0] * f0; acc[ai][bj][m][1] = acc[ai][bj][m][1] * f1; }
            asm volatile("" ::: "memory"); }
#undef FK_U8X4
        if (fin) {
#pragma unroll
            for (int ai = 0; ai < 2; ++ai)
#pragma unroll
                for (int m = 0; m < 4; ++m) { const size_t t = (size_t)u.pm * 256 + 128 * ai + 64 * wr + 16 * m + fr;
#pragma unroll
                    for (int bj = 0; bj < 2; ++bj) { const int c = u.pn * 256 + 128 * bj + 32 * wc + 8 * fq; const f32x4 v0 = acc[ai][bj][m][0], v1 = acc[ai][bj][m][1];
                        u32x4 w; w.x = cvt_pk_bf16(v0[0], v0[1]); w.y = cvt_pk_bf16(v0[2], v0[3]); w.z = cvt_pk_bf16(v1[0], v1[1]); w.w = cvt_pk_bf16(v1[2], v1[3]); ST_NT((u32x4*)(y + t * 1024 + c), w); } } }
        return fin;
    }
};
struct OneTileSched {
    int T, K; const char* a; const char* w;
    __device__ bool next(int i, Unit& u) const { if (i != 0 || T < 0) return false; u.pm = T >> 2; u.pn = T & 3; u.kind = 0; u.aux = 0; u.a = a + (size_t)u.pm * 256 * K * 2; u.b = w + (size_t)u.pn * 256 * K * 2; return true; }
};
struct OutEpi;
__device__ __forceinline__ void outproj_one(AP A, FK_LAS unsigned char* lds, int l, int T);
__device__ __forceinline__ bool l0_split(int l, int G, int use_bar) { return l == 0 && G == 256 && NTT == 72 && use_bar != 0; }
__device__ __forceinline__ void phase_merge(AP A, FK_LAS unsigned char* lds, int l, int G, const XcdBarrier bar, const int use_bar) {
    const bool split = l0_split(l, G, use_bar);
    MergeSched S; S.G = G; S.c = (int)blockIdx.x; S.ntile = (l == 0 ? NTT : NTL) * 4;
#pragma unroll 1
    for (int pass = 0; pass < (split ? 2 : 1); ++pass) {
    S.mode = split ? pass + 1 : 0;
    if (pass == 1) { xcd_barrier(bar); A = opaque_args(A);
        if (S.c >= 32) { outproj_one(A, lds, 0, S.c - 32);
            conv_tables(A, 0, wsp<unsigned char>(A, W.ub), wsp<unsigned char>(A, W.vb), S.c - 32, 224, opaque_tid(), 1); break; } }
#ifndef FK_REP_SUB
#define FK_REP_SUB 0
#endif
    for (int rp7 = (FK_REP_SUB == 7 && l == 1) ? 1 : 0; rp7 >= 0; --rp7)
    { const int tid = opaque_tid(); const bf16_t* hyot = wsp<bf16_t>(A, W.hyo); bf16_t* scr = wsp<bf16_t>(A, W.q);
      constexpr int RS = 516;
      for (int j = 0; ; ++j) { int pm, pn_; if (!merge_tile(S.mode, j, S.c, G, S.ntile, pm, pn_)) break; bf16_t* dst = scr + (size_t)(j * 256 + S.c) * 65536;
          u32x4 pv[4];
#pragma unroll
          for (int i = 0; i < 4; ++i) { const int idx = tid + 512 * i, chl = idx >> 5, t8 = (idx & 31) * 8; pv[i] = *(const u32x4*)(hyot + (size_t)chl * NTOK + (size_t)pm * 256 + t8); }
          for (int cq = 0; cq < 4; ++cq) {
              __syncthreads();
#pragma unroll
              for (int i = 0; i < 4; ++i) { const int idx = tid + 512 * i, chl = idx >> 5, t8 = (idx & 31) * 8;
                  FK_LAS unsigned* p = (FK_LAS unsigned*)(lds + chl * RS + t8 * 2); p[0] = pv[i].x; p[1] = pv[i].y; p[2] = pv[i].z; p[3] = pv[i].w; }
              if (cq < 3) {
#pragma unroll
                  for (int i = 0; i < 4; ++i) { const int idx = tid + 512 * i, chl = idx >> 5, t8 = (idx & 31) * 8; pv[i] = *(const u32x4*)(hyot + (size_t)((cq + 1) * 64 + chl) * NTOK + (size_t)pm * 256 + t8); } }
              __syncthreads();
#pragma unroll
              for (int i = 0; i < 4; ++i) { const int idx = tid + 512 * i, tok = idx >> 3, c8 = (idx & 7) * 8; unsigned short e[8];
#pragma unroll
                  for (int q = 0; q < 8; ++q) e[q] = *(const FK_LAS unsigned short*)(lds + (c8 + q) * RS + tok * 2);
                  *(u32x4*)(dst + (size_t)tok * 256 + cq * 64 + c8) = (u32x4){(unsigned)e[0] | ((unsigned)e[1] << 16), (unsigned)e[2] | ((unsigned)e[3] << 16), (unsigned)e[4] | ((unsigned)e[5] << 16), (unsigned)e[6] | ((unsigned)e[7] << 16)}; }
          } }
      asm volatile("s_waitcnt vmcnt(0)" ::: "memory"); __syncthreads(); }
    S.a0 = (const char*)wsp<bf16_t>(A, W.q); S.a1 = (const char*)wsp<bf16_t>(A, W.fno); S.a2 = (const char*)wsp<bf16_t>(A, W.attlo); S.a3 = (const char*)wsp<bf16_t>(A, W.atthi);
    S.w = (const char*)(wsp<bf16_t>(A, W.w_mrg) + (size_t)l * 4 * 1024 * 256);
    MergeEpi E{wsp<bf16_t>(A, W.g), wsp<bf16_t>(A, W.y)};
    gemm_phase(lds, 256, S, E);
    }
}
struct PlainSched {
    int G, c, nM, nN, K; const char* a; const char* w;
    __device__ bool next(int i, Unit& u) const {
        const long T = (long)i * G + c; if (T >= (long)nM * nN) return false;
        int wgid = (int)T; const int nwg = nM * nN; { const int q = nwg / 8, r = nwg % 8, xcd = wgid % 8, off = wgid / 8; wgid = (xcd < r ? xcd * (q + 1) : r * (q + 1) + (xcd - r) * q) + off; }
        const int nig = 8 * nN, gid = wgid / nig, fm = gid * 8, gsz = (nM - fm) < 8 ? (nM - fm) : 8;
        u.pm = fm + ((wgid % nig) % gsz); u.pn = (wgid % nig) / gsz; u.kind = 0; u.aux = 0;
        u.a = a + (size_t)u.pm * 256 * K * 2; u.b = w + (size_t)u.pn * 256 * K * 2; return true;
    }
};
struct OutEpi {
    const float* x_in; const float* ctx_in; const float* xl; float* xc; const float* mod; int l; float* xo;
    __device__ __forceinline__ bool operator()(Acc& acc, const Unit& u, int wr, int wc, int fr, int fq) const {
        const bool lat = u.pm < NTL; const int mr = lat ? u.pm >> 3 : 8;
        const float* gate = mod + (size_t)mr * 6144 + 2 * 1024;
#pragma unroll
        for (int bj = 0; bj < 2; ++bj) { const int c = u.pn * 256 + 128 * bj + 32 * wc + 8 * fq;
            const f32x4 g0 = *(const f32x4*)(gate + c), g1 = *(const f32x4*)(gate + c + 4);
#pragma unroll
            for (int ai = 0; ai < 2; ++ai)
#pragma unroll
                for (int m = 0; m < 4; ++m) { const int rl = 128 * ai + 64 * wr + 16 * m + fr;
                    const size_t t = (size_t)u.pm * 256 + rl, tc = t - NLAT;
                    const float* bp = lat ? ((l == 0 ? x_in : xl) + t * 1024 + c) : (ctx_in + tc * 1024 + c);
                    float* op = lat ? (xo + t * 1024 + c) : (xc + tc * 1024 + c);
                    const f32x4 b0 = *(const f32x4*)bp, b1 = *(const f32x4*)(bp + 4);
                    ST_NT((f32x4*)op, b0 + g0 * acc[ai][bj][m][0]); ST_NT((f32x4*)(op + 4), b1 + g1 * acc[ai][bj][m][1]); } }
        return true;
    }
};
__device__ __forceinline__ void outproj_one(AP A, FK_LAS unsigned char* lds, int l, int T) {
    OneTileSched S{T, 1024, (const char*)wsp<bf16_t>(A, W.y), (const char*)(wsp<bf16_t>(A, W.w_out) + (size_t)l * 1024 * 1024)};
    OutEpi E{FIN(0), FIN(2), A->xl, wsp<float>(A, W.xc), wsp<float>(A, W.mod) + (size_t)l * 9 * 6144, l, A->xl};
    gemm_phase(lds, 1024, S, E);
}
__device__ __forceinline__ void phase_outproj(AP A, FK_LAS unsigned char* lds, int l, int G, int dry, int use_bar) {
    if (l0_split(l, G, use_bar) && !dry) {
        const int c = (int)blockIdx.x;
        if (c < 64) outproj_one(A, lds, 0, 224 + c); else conv_tables(A, 0, wsp<unsigned char>(A, W.ub), wsp<unsigned char>(A, W.vb), c - 64, 192, opaque_tid(), 2);
        return; }
    PlainSched S{G, (int)blockIdx.x, l == 0 ? NTT : NTL, 4, 1024, (const char*)wsp<bf16_t>(A, W.y), (const char*)(wsp<bf16_t>(A, W.w_out) + (size_t)l * 1024 * 1024)};
    OutEpi E{FIN(0), FIN(2), A->xl, wsp<float>(A, W.xc), wsp<float>(A, W.mod) + (size_t)l * 9 * 6144, l, dry ? wsp<float>(A, W.g) : A->xl};
    gemm_phase(lds, 1024, S, E);
    if (l == 0 && G == 256 && !dry && (int)blockIdx.x >= 32) conv_tables(A, 0, wsp<unsigned char>(A, W.ub), wsp<unsigned char>(A, W.vb), (int)blockIdx.x - 32, 224, opaque_tid());
}
__device__ __forceinline__ void phase_norm(AP A, int l, int vcu, int G) {
    const int tid = opaque_tid(), lane = tid & 63, wave = __builtin_amdgcn_readfirstlane(tid >> 6);
    const int gw = vcu * NWAVES + wave, NGW = G * NWAVES;
    const float* mod = wsp<float>(A, W.mod) + (size_t)l * 9 * 6144;
    const int nrow = l == 0 ? NTOK : NLAT;
    { const int R = (nrow + NGW - 1) / NGW, t0 = gw * R, t1 = (t0 + R) < nrow ? (t0 + R) : nrow;
      if (t0 < nrow) modulate_wave_rows<5>(A->xl, wsp<float>(A, W.xc), FIN(7) + l * DM, mod, 4 * 1024, 3 * 1024, wsp<bf16_t>(A, W.nn), t0, t1, lane); }
}
struct PqEpi {
    bf16_t* pq;
    __device__ __forceinline__ bool operator()(Acc& acc, const Unit& u, int wr, int wc, int fr, int fq) const {
#pragma unroll
        for (int ai = 0; ai < 2; ++ai)
#pragma unroll
            for (int m = 0; m < 4; ++m) { bf16_t* rowp = pq + ((size_t)u.pm * 256 + 128 * ai + 64 * wr + 16 * m + fr) * 2048 + u.pn * 256 + 32 * wc + 8 * fq;
#pragma unroll
                for (int bj = 0; bj < 2; ++bj) { const f32x4 v0 = acc[ai][bj][m][0], v1 = acc[ai][bj][m][1];
                    u32x4 w; w.x = cvt_pk_bf16(v0[0], v0[1]); w.y = cvt_pk_bf16(v0[2], v0[3]); w.z = cvt_pk_bf16(v1[0], v1[1]); w.w = cvt_pk_bf16(v1[2], v1[3]);
                    ST_NT((u32x4*)(rowp + 128 * bj), w); } }
        return true;
    }
};
__device__ __forceinline__ void phase_peerq(AP A, FK_LAS unsigned char* lds, int l, int G) {
    PlainSched S{G, (int)blockIdx.x, l == 0 ? NTT : NTL, 8, 1024, (const char*)wsp<bf16_t>(A, W.nn), (const char*)(wsp<bf16_t>(A, W.w_q) + (size_t)l * 2048 * 1024)};
    PqEpi E{wsp<bf16_t>(A, W.pq)};
    gemm_phase(lds, 1024, S, E);
}
#define FK_HAVE_PEER 1
namespace peer {
typedef __bf16 bf16x2v __attribute__((ext_vector_type(2)));
__device__ __forceinline__ float dot2(unsigned a, unsigned b, float c) { return __builtin_amdgcn_fdot2_f32_bf16(__builtin_bit_cast(bf16x2v, a), __builtin_bit_cast(bf16x2v, b), c, false); }
__device__ __forceinline__ unsigned ford(float f) { const unsigned u = __float_as_uint(f); return (u & 0x80000000u) ? ~u : (u | 0x80000000u); }
__device__ __forceinline__ float funord(unsigned o) { return __uint_as_float((o & 0x80000000u) ? (o & 0x7fffffffu) : ~o); }
__device__ __forceinline__ unsigned umax(unsigned a, unsigned b) { return a > b ? a : b; }
__device__ __forceinline__ unsigned umin(unsigned a, unsigned b) { return a < b ? a : b; }
template <int N> __device__ __forceinline__ void sort_desc(unsigned (&v)[N]) {
#pragma unroll
    for (int k = 2; k <= N; k <<= 1)
#pragma unroll
        for (int j = k >> 1; j > 0; j >>= 1)
#pragma unroll
            for (int i = 0; i < N; ++i) { const int l = i ^ j;
                if (l > i) { const unsigned a = v[i], b = v[l], mx = umax(a, b), mn = umin(a, b); if ((i & k) == 0) { v[i] = mx; v[l] = mn; } else { v[i] = mn; v[l] = mx; } } }
}
template <int N> __device__ __forceinline__ void merge_desc(unsigned (&v)[N]) {
#pragma unroll
    for (int j = N >> 1; j > 0; j >>= 1)
#pragma unroll
        for (int i = 0; i < N; ++i) { const int l = i ^ j; if (l > i) { const unsigned a = v[i], b = v[l]; v[i] = umax(a, b); v[l] = umin(a, b); } }
}
__device__ __forceinline__ int crow(int r, int hi) { return (r & 3) + 8 * (r >> 2) + 4 * hi; }
constexpr int L_RIDX = 0, L_RG = 32 * 128 * 2, L_TBL = L_RG + 32 * 128 * 4, L_WK = L_TBL + 8 * 32 * 32, L_END = L_WK + 8 * 128 * 4;

template <bool PF> __device__ __forceinline__ void score_top16(const bf16_t* keys  , const bf16_t* qrow  , int r32, int hi, unsigned (&top)[16], const unsigned* pf, unsigned& pf0, unsigned& pf1) {
    f32x16 acc[4];
    int koff = r32 * 128 + 8 * hi; asm volatile("" : "+v"(koff));
    const bf16_t* kbase = keys + koff; const bf16_t* qb = qrow + 8 * hi;
#pragma unroll
    for (int kt = 0; kt < 4; ++kt) acc[kt] = f32x16{};
    bf16x8 bq[8], ka[8], kb2[8];
#pragma unroll
    for (int ks = 0; ks < 8; ++ks) bq[ks] = *(const bf16x8*)(qb + 16 * ks);
#define KLOAD(dst, kt) do { _Pragma("unroll") for (int ks = 0; ks < 8; ++ks) dst[ks] = *(const bf16x8*)(kbase + 32 * (kt) * 128 + 16 * ks); } while (0)
#define KMMA(src, kt) do { _Pragma("unroll") for (int ks = 0; ks < 8; ++ks) acc[kt] = __builtin_amdgcn_mfma_f32_32x32x16_bf16(src[ks], bq[ks], acc[kt], 0, 0, 0); } while (0)
    KLOAD(ka, 0); asm volatile("" ::: "memory");
    KLOAD(kb2, 1); KMMA(ka, 0); asm volatile("" ::: "memory");
    KLOAD(ka, 2); KMMA(kb2, 1); asm volatile("" ::: "memory");
    KLOAD(kb2, 3); KMMA(ka, 2); asm volatile("" ::: "memory");
    KMMA(kb2, 3);
    if (PF) { asm volatile("" ::: "memory"); pf0 = pf[0]; pf1 = pf[32]; asm volatile("" ::: "memory"); }
#undef KLOAD
#undef KMMA
    unsigned v[64]; const unsigned hi4 = 4u * (unsigned)hi;
#pragma unroll
    for (int kt = 0; kt < 4; ++kt)
#pragma unroll
        for (int r = 0; r < 16; ++r) v[kt * 16 + r] = ((ford(acc[kt][r]) & ~0x7fu) | (unsigned)(127 - (32 * kt + (r & 3) + 8 * (r >> 2)))) - hi4;
    unsigned g0[16], g1[16], g2[16], g3[16];
#pragma unroll
    for (int i = 0; i < 16; ++i) { g0[i] = v[i]; g1[i] = v[16 + i]; g2[i] = v[32 + i]; g3[i] = v[48 + i]; }
    sort_desc<16>(g0); sort_desc<16>(g1); sort_desc<16>(g2); sort_desc<16>(g3);
#pragma unroll
    for (int i = 0; i < 16; ++i) { g0[i] = umax(g0[i], g1[15 - i]); g2[i] = umax(g2[i], g3[15 - i]); }
    merge_desc<16>(g0); merge_desc<16>(g2);
#pragma unroll
    for (int i = 0; i < 16; ++i) g0[i] = umax(g0[i], g2[15 - i]);
    merge_desc<16>(g0);
#pragma unroll
    for (int i = 0; i < 16; ++i) { const unsigned o = (unsigned)__shfl_xor((int)g0[15 - i], 32); top[i] = umax(g0[i], o); }
    merge_desc<16>(top);
}
__device__ __forceinline__ void phase(AP A, FK_LAS unsigned char* lds, int l, int vcu, int G, int dry_in, const XcdBarrier bar, const int use_bar) {
    const int dry = dry_in;
#define GBAR() do { if (use_bar) xcd_barrier(bar); } while (0)
    const int tid = opaque_tid(), lane = tid & 63, wave = __builtin_amdgcn_readfirstlane(tid >> 6), r32 = lane & 31, hi = lane >> 5;
    const int TS = (l == 0 && (NTOK % 24) == 0) ? 24 : 32, TPW = TS / 8;
    const int ntile = (l == 0 ? NTOK : NLAT) / TS;
    const bf16_t* keys = wsp<bf16_t>(A, W.keys) + (size_t)l * 16 * 128 * 128;
    const float* mod = wsp<float>(A, W.mod) + (size_t)l * 9 * 6144;
    FK_LAS unsigned char* tbl = (FK_LAS unsigned char*)(lds + L_TBL) + wave * 32 * 32;
    for (int tile = vcu; tile < ntile; tile += G) {
        const int t0 = tile * TS; const int rtok = r32 < TS ? r32 : TS - 1;
        __syncthreads();
#ifndef FK_REP_SUB
#define FK_REP_SUB 0
#endif
        for (int rp = (FK_REP_SUB == 4 ? 1 : 0); rp >= 0; --rp) {
            const int h = wave; unsigned s1[16], s2[16];
            const bf16_t* qrow = wsp<bf16_t>(A, W.pq) + (size_t)(t0 + rtok) * 2048 + h * 256;
            const int ntl = (tile + G < ntile) ? tile + G : tile; unsigned pf0 = 0u, pf1 = 0u;
            const unsigned* pfp = (const unsigned*)(wsp<bf16_t>(A, W.pq) + (size_t)(ntl * TS + rtok) * 2048 + h * 256 + hi * 128);
            score_top16<false>(keys + (size_t)(h * 2 + 0) * 128 * 128, qrow, r32, hi, s1, pfp, pf0, pf1);
            score_top16<true>(keys + (size_t)(h * 2 + 1) * 128 * 128, qrow + 128, r32, hi, s2, pfp, pf0, pf1);
            if (hi == 0) {
#pragma unroll
                for (int i = 0; i < 16; ++i) { tbl[r32 * 32 + i] = (unsigned char)(127 - (s1[i] & 127u)); tbl[r32 * 32 + 16 + i] = (unsigned char)(127 - (s2[i] & 127u)); } }
            float f1[16], f2[16];
#pragma unroll
            for (int i = 0; i < 16; ++i) { f1[i] = funord(s1[i] & ~0x7fu); f2[i] = funord(s2[i] & ~0x7fu); }
            unsigned c[32]; int cn = 0;
#pragma unroll
            for (int i = 0; i < 16; ++i)
#pragma unroll
                for (int j = 0; j < 16; ++j) if ((i + 1) * (j + 1) <= 16) {
                    const unsigned pk = (ford(f1[i] + f2[j]) & ~0xffu) | (unsigned)(255 - (i * 16 + j));
                    if ((cn & 1) == 0) c[cn >> 1] = pk; else c[cn >> 1] = hi ? pk : c[cn >> 1];
                    ++cn; }
#pragma unroll
            for (int q = 25; q < 32; ++q) c[q] = 0u;
            sort_desc<32>(c);
            unsigned ct[16];
#pragma unroll
            for (int i = 0; i < 16; ++i) { const unsigned o = (unsigned)__shfl_xor((int)c[15 - i], 32); ct[i] = umax(c[i], o); }
            merge_desc<16>(ct);
            if (hi == 0 && r32 < TS) {
                float e[16]; float sum = 0.f; const float mx = funord(ct[0] & ~0xffu);
#pragma unroll
                for (int t = 0; t < 16; ++t) { e[t] = __expf(funord(ct[t] & ~0xffu) - mx); sum += e[t]; }
                const float inv = 1.f / sum;
#pragma unroll
                for (int t = 0; t < 16; ++t) { const int ci = 255 - (int)(ct[t] & 0xffu); const int e1 = tbl[r32 * 32 + (ci >> 4)], e2 = tbl[r32 * 32 + 16 + (ci & 15)];
                    const int idx = e1 * 128 + e2; const float gg = e[t] * inv;
                    wsp<unsigned short>(A, W.pidx)[(size_t)(t0 + r32) * 128 + ((h * 16 + t) & 7) * 16 + ((h * 16 + t) >> 3)] = (unsigned short)idx; wsp<float>(A, W.pg)[(size_t)(t0 + r32) * 128 + h * 16 + t] = gg; }
            }
            asm volatile("" :: "v"(pf0), "v"(pf1));
        }
    }
    if (G != 256) return;
    GBAR();
    const int sl = (int)blockIdx.x & 7, rk = (int)blockIdx.x >> 3, ntok = (l == 0 ? NTOK : NLAT);
    const int r8 = lane >> 3, cc = lane & 7;
    A = opaque_args(A);
    const unsigned short* pidx = wsp<unsigned short>(A, W.pidx); const float* pgw = wsp<float>(A, W.pg);
    unsigned* hidp = wsp<unsigned>(A, W.pq);
    for (int rp = (FK_REP_SUB == 5 ? 1 : 0); rp >= 0; --rp) {
        const unsigned char* Us = wsp<unsigned char>(A, l == 0 ? W.ub : W.ub1) + (size_t)sl * 16384 * 128; const unsigned cc16 = 16u * (unsigned)cc;
        const bf16_t* nn = wsp<bf16_t>(A, W.nn) + 128 * sl + 16 * cc;
#define TLOAD(IK, N0, N1, t) do { const u32x4 i0_ = *(const u32x4*)(pidx + (size_t)(t) * 128 + r8 * 16), i1_ = *(const u32x4*)(pidx + (size_t)(t) * 128 + r8 * 16 + 8); \
            IK[0] = i0_.x; IK[1] = i0_.y; IK[2] = i0_.z; IK[3] = i0_.w; IK[4] = i1_.x; IK[5] = i1_.y; IK[6] = i1_.z; IK[7] = i1_.w; \
            N0 = *(const u32x4*)(nn + (size_t)(t) * DM); N1 = *(const u32x4*)(nn + (size_t)(t) * DM + 8); } while (0)
#define GLOAD(GB, IK) do { _Pragma("unroll") for (int i = 0; i < 16; ++i) GB[i] = *(const u32x4*)(Us + (((IK[i >> 1] >> (16 * (i & 1))) & 0xffffu) * 128u + cc16)); } while (0)
#define NUNPK(N0, N1) do { nf[0] = bflo(N0.x); nf[1] = bfhi(N0.x); nf[2] = bflo(N0.y); nf[3] = bfhi(N0.y); nf[4] = bflo(N0.z); nf[5] = bfhi(N0.z); nf[6] = bflo(N0.w); nf[7] = bfhi(N0.w); \
            nf[8] = bflo(N1.x); nf[9] = bfhi(N1.x); nf[10] = bflo(N1.y); nf[11] = bfhi(N1.y); nf[12] = bflo(N1.z); nf[13] = bfhi(N1.z); nf[14] = bflo(N1.w); nf[15] = bfhi(N1.w); } while (0)
#define HDOT(GB, t, h) do { float p[8]; \
            _Pragma("unroll") for (int i = 0; i < 8; ++i) { const unsigned aw[4] = {GB[8 * (h) + i].x, GB[8 * (h) + i].y, GB[8 * (h) + i].z, GB[8 * (h) + i].w}; f32x2 d2 = {0.f, 0.f}; \
                _Pragma("unroll") for (int q = 0; q < 4; ++q) { const f32x2 lo = __builtin_amdgcn_cvt_pk_f32_fp8(aw[q], false), hh = __builtin_amdgcn_cvt_pk_f32_fp8(aw[q], true); \
                    d2 = lo * (f32x2){nf[4 * q], nf[4 * q + 1]} + d2; d2 = hh * (f32x2){nf[4 * q + 2], nf[4 * q + 3]} + d2; }     \
                p[i] = d2[0] + d2[1]; } \
            _Pragma("unroll") for (int i = 0; i < 4; ++i) { const float send = (cc & 1) ? p[i] : p[i + 4], keep = (cc & 1) ? p[i + 4] : p[i]; p[i] = keep + __shfl_xor(send, 1); } \
            _Pragma("unroll") for (int i = 0; i < 2; ++i) { const float send = (cc & 2) ? p[i] : p[i + 2], keep = (cc & 2) ? p[i + 2] : p[i]; p[i] = keep + __shfl_xor(send, 2); } \
            { const float send = (cc & 4) ? p[0] : p[1], keep = (cc & 4) ? p[1] : p[0]; p[0] = keep + __shfl_xor(send, 4); } \
            const int v = 4 * (cc & 1) + 2 * ((cc >> 1) & 1) + ((cc >> 2) & 1); \
            if ((h) == 0) ph0 = p[0]; else hidp[((size_t)(t) * 8 + sl) * 64 + 8 * v + r8] = cvt_pk_bf16(ph0, p[0]); } while (0)
        unsigned ikA[8], ikB[8]; u32x4 nA0, nA1, nB0, nB1, ga[16], gb[16]; float nf[16], ph0 = 0.f;
        int t = rk + 32 * wave, t1 = t + 256;
        if (t < ntok) TLOAD(ikA, nA0, nA1, t);
        if (t1 < ntok) TLOAD(ikB, nB0, nB1, t1);
        if (t < ntok) GLOAD(ga, ikA);
#pragma unroll 1
        while (t < ntok) {
            NUNPK(nA0, nA1);
            const int t2 = t + 512;
            if (t2 < ntok) TLOAD(ikA, nA0, nA1, t2);
            if (t1 < ntok) GLOAD(gb, ikB);
            HDOT(ga, t, 0); HDOT(ga, t, 1);
            if (t1 >= ntok) break;
            NUNPK(nB0, nB1);
            const int t3 = t1 + 512;
            if (t3 < ntok) TLOAD(ikB, nB0, nB1, t3);
            if (t2 < ntok) GLOAD(ga, ikA);
            HDOT(gb, t1, 0); HDOT(gb, t1, 1);
            t = t2; t1 = t3;
        }
#undef TLOAD
#undef GLOAD
#undef NUNPK
#undef HDOT
    }
    GBAR();
    for (int rp = (FK_REP_SUB == 6 ? 1 : 0); rp >= 0; --rp) { const int dry = dry_in | rp;
        const unsigned char* Vs = wsp<unsigned char>(A, l == 0 ? W.vb : W.vb1) + (size_t)sl * 16384 * 128; const unsigned cc16 = 16u * (unsigned)cc;
#define TLOADI(IK, t) do { const u32x4 i0_ = *(const u32x4*)(pidx + (size_t)(t) * 128 + r8 * 16), i1_ = *(const u32x4*)(pidx + (size_t)(t) * 128 + r8 * 16 + 8); \
            IK[0] = i0_.x; IK[1] = i0_.y; IK[2] = i0_.z; IK[3] = i0_.w; IK[4] = i1_.x; IK[5] = i1_.y; IK[6] = i1_.z; IK[7] = i1_.w; } while (0)
#define TLOADH(H, PGV, t) do { const unsigned* hp_ = hidp + (size_t)(t) * 512 + lane; _Pragma("unroll") for (int q = 0; q < 8; ++q) H[q] = hp_[q * 64]; \
            PGV[0] = pgw[(size_t)(t) * 128 + lane]; PGV[1] = pgw[(size_t)(t) * 128 + 64 + lane]; \
            { const bool lat_ = (t) < NLAT; xN = *(const f32x2*)((lat_ ? A->xl + (size_t)(t) * DM : wsp<float>(A, W.xc) + (size_t)((t) - NLAT) * DM) + xcol); \
              gN = *(const f32x2*)(mod + (size_t)(lat_ ? (t) / SEQ : 8) * 6144 + 5 * 1024 + xcol); } } while (0)
#define GLOAD2(GB, IK) do { _Pragma("unroll") for (int i = 0; i < 16; ++i) GB[i] = *(const u32x4*)(Vs + (((IK[i >> 1] >> (16 * (i & 1))) & 0xffffu) * 128u + cc16)); } while (0)
#define WCALC(H, PGV) do { float h0 = 0.f, h1 = 0.f; _Pragma("unroll") for (int q = 0; q < 8; ++q) { h0 += bflo(H[q]); h1 += bfhi(H[q]); } h0 *= (1.f / SU); h1 *= (1.f / SU); \
            w0 = PGV[0] * 0.5f * h0 * (1.f + erff(h0 * 0.70710678118654752f)) * (1.f / SV); w1 = PGV[1] * 0.5f * h1 * (1.f + erff(h1 * 0.70710678118654752f)) * (1.f / SV); xC = xN; gC = gN; } while (0)
#define VACC(GB, h) do { _Pragma("unroll") for (int i = 0; i < 8; ++i) { const float w = __shfl((h) ? w1 : w0, 8 * i + r8); const unsigned aw[4] = {GB[8 * (h) + i].x, GB[8 * (h) + i].y, GB[8 * (h) + i].z, GB[8 * (h) + i].w}; \
                _Pragma("unroll") for (int q = 0; q < 4; ++q) { const f32x2 lo = __builtin_amdgcn_cvt_pk_f32_fp8(aw[q], false), hh = __builtin_amdgcn_cvt_pk_f32_fp8(aw[q], true); const f32x2 w2 = {w, w}; \
                    f32x2 ya = {y[4 * q], y[4 * q + 1]}, yb = {y[4 * q + 2], y[4 * q + 3]}; ya = w2 * lo + ya; yb = w2 * hh + yb; y[4 * q] = ya[0]; y[4 * q + 1] = ya[1]; y[4 * q + 2] = yb[0]; y[4 * q + 3] = yb[1]; } } } while (0)
#define XUPD(t) do { \
            _Pragma("unroll") for (int q = 0; q < 8; ++q) { const float send = (r8 & 1) ? y[q] : y[q + 8], keep = (r8 & 1) ? y[q + 8] : y[q]; y[q] = keep + __shfl_xor(send, 8); } \
            _Pragma("unroll") for (int q = 0; q < 4; ++q) { const float send = (r8 & 2) ? y[q] : y[q + 4], keep = (r8 & 2) ? y[q + 4] : y[q]; y[q] = keep + __shfl_xor(send, 16); } \
            _Pragma("unroll") for (int q = 0; q < 2; ++q) { const float send = (r8 & 4) ? y[q] : y[q + 2], keep = (r8 & 4) ? y[q + 2] : y[q]; y[q] = keep + __shfl_xor(send, 32); } \
            const bool lat_ = (t) < NLAT; float* xr_ = (lat_ ? A->xl + (size_t)(t) * DM : wsp<float>(A, W.xc) + (size_t)((t) - NLAT) * DM) + xcol; \
            f32x2 xv_ = xC; xv_[0] += gC[0] * y[0]; xv_[1] += gC[1] * y[1]; if (!dry) *(f32x2*)xr_ = xv_; } while (0)
        unsigned ikA[8], ikB[8], hN[8]; float pgN[2]; u32x4 ga[16], gb[16]; float y[16], w0, w1; f32x2 xN = {0.f, 0.f}, gN = {0.f, 0.f}, xC, gC;
        const int xcol = 128 * sl + 16 * cc + 8 * (r8 & 1) + 4 * ((r8 >> 1) & 1) + 2 * ((r8 >> 2) & 1);
        int t = rk + 32 * wave, t1 = t + 256;
        if (t < ntok) { TLOADI(ikA, t); TLOADH(hN, pgN, t); }
        if (t1 < ntok) TLOADI(ikB, t1);
        if (t < ntok) GLOAD2(ga, ikA);
#pragma unroll 1
        while (t < ntok) {
            WCALC(hN, pgN);
            const int t2 = t + 512;
            if (t1 < ntok) TLOADH(hN, pgN, t1);
            if (t2 < ntok) TLOADI(ikA, t2);
            if (t1 < ntok) GLOAD2(gb, ikB);
#pragma unroll
            for (int i = 0; i < 16; ++i) y[i] = 0.f;
            VACC(ga, 0); VACC(ga, 1); XUPD(t);
            if (t1 >= ntok) break;
            WCALC(hN, pgN);
            const int t3 = t1 + 512;
            if (t2 < ntok) TLOADH(hN, pgN, t2);
            if (t3 < ntok) TLOADI(ikB, t3);
            if (t2 < ntok) GLOAD2(ga, ikA);
#pragma unroll
            for (int i = 0; i < 16; ++i) y[i] = 0.f;
            VACC(gb, 0); VACC(gb, 1); XUPD(t1);
            t = t2; t1 = t3;
        }
#undef TLOADI
#undef TLOADH
#undef GLOAD2
#undef WCALC
#undef VACC
#undef XUPD
    }
    if (l == 0 && !dry) {
        GBAR();
        const float* mod1 = wsp<float>(A, W.mod) + (size_t)9 * 6144; const int gw = vcu * NWAVES + wave, NGW = G * NWAVES;
        { const int R = (NTOK + NGW - 1) / NGW, t0 = gw * R, t1 = (t0 + R) < NTOK ? (t0 + R) : NTOK;
          if (t0 < NTOK) modulate_wave_rows<5>(A->xl, wsp<float>(A, W.xc), FIN(6) + DM, mod1, 1024, 0, wsp<bf16_t>(A, W.xn), t0, t1, lane); }
    }
}
#undef GBAR
}
__device__ __forceinline__ void phase_peer(AP A, FK_LAS unsigned char* lds, int l, int vcu, int G, int dry, const XcdBarrier bar, const int use_bar) { peer::phase(A, lds, l, vcu, G, dry, bar, use_bar); }
constexpr int N_PHASES = 16;
__global__ void __launch_bounds__(NTHR, 2) mega(Args A_unused) {
    extern __shared__ __attribute__((aligned(16))) unsigned char lds_raw[];
    FK_LAS unsigned char* lds = (FK_LAS unsigned char*)lds_raw;
    const int tid = threadIdx.x;
    AP A0 = (AP)__builtin_amdgcn_kernarg_segment_ptr();
#define AA() opaque_args(A0)
    const int G = gridDim.x, bx = blockIdx.x, vcu = (G % 8 == 0) ? (bx % 8) * (G / 8) + bx / 8 : bx;
    volatile FK_LAS unsigned* MISC = (volatile FK_LAS unsigned*)(lds + LDS_MISC);
    if (tid < 64) MISC[tid] = 0u;
    __syncthreads();
    XcdBarrier bar; bar.bar = wsp<unsigned>(A0, W.ctl) + 1024; bar.x = 0; bar.st = MISC + 8;
    if (A0->use_bar) bar = xcd_barrier_post(wsp<unsigned>(A0, W.ctl) + 1024, MISC + 8);
    const int lo = A0->ph_lo, hi = A0->ph_hi;
#ifndef FK_TSTAMP
#define FK_TSTAMP -1
#endif
#ifndef FK_TSTAMP_END
#define FK_TSTAMP_END (FK_TSTAMP + 1)
#endif
#ifndef FK_TSCALE
#define FK_TSCALE 1000.f
#endif
#define STAMP(k) do { if (FK_TSTAMP >= 0 && bx == 0 && tid == 0) { const unsigned long long ts_ = __builtin_amdgcn_s_memrealtime(); MISC[16 + 2 * (k)] = (unsigned)ts_; MISC[17 + 2 * (k)] = (unsigned)(ts_ >> 32); } } while (0)
    STAMP(0);
#define IN(k) (lo <= (k) && (k) < hi)
#ifndef FK_REP_PHASE
#define FK_REP_PHASE -1
#endif
#define REP(k) for (int rep_ = (FK_REP_PHASE == (k)) ? 1 : 0; rep_ >= 0; --rep_)
#ifndef FK_REP_BAR
#define FK_REP_BAR 0
#endif
#define SEAM(k) do { if (IN(k) && IN((k) + 1)) { xcd_barrier(bar); if (FK_REP_BAR) xcd_barrier(bar); } STAMP((k) + 1); } while (0)
#ifndef FK_REP_ALL
#define FK_REP_ALL 0
#endif
    for (int pass = FK_REP_ALL ? 1 : 0; pass >= 0; --pass) {
    if (IN(0)) REP(0) phase_pa(AA(), lds, vcu, G);
    SEAM(0);
    if (IN(1)) REP(1) phase_pb(AA(), vcu, G);
    SEAM(1);
    for (int l = 0; l < 2; ++l) {
        const int pb = 2 + 7 * l;
        if (IN(pb + 0)) REP(pb + 0) phase_inproj(AA(), lds, l, G);
        SEAM(pb + 0);
#ifdef FK_HAVE_MIX
        if (IN(pb + 1)) REP(pb + 1) phase_mix(AA(), lds, l, vcu, G);
#endif
        SEAM(pb + 1);
#ifdef FK_HAVE_MERGE
        if (IN(pb + 2)) REP(pb + 2) phase_merge(AA(), lds, l, G, bar, A0->use_bar);
#endif
        SEAM(pb + 2);
#ifdef FK_HAVE_OUT
        if (IN(pb + 3)) REP(pb + 3) phase_outproj(AA(), lds, l, G, rep_ | (pass & l), A0->use_bar);
#endif
        SEAM(pb + 3);
#ifdef FK_HAVE_NORM
        if (IN(pb + 4)) REP(pb + 4) phase_norm(AA(), l, vcu, G);
#endif
        SEAM(pb + 4);
#ifdef FK_HAVE_PQ
        if (IN(pb + 5)) REP(pb + 5) phase_peerq(AA(), lds, l, G);
#endif
        SEAM(pb + 5);
#ifdef FK_HAVE_PEER
        if (IN(pb + 6)) REP(pb + 6) phase_peer(AA(), lds, l, vcu, G, rep_ | pass, bar, A0->use_bar);
#endif
        SEAM(pb + 6);
    }
    if (pass) xcd_barrier(bar);
    }
    if (FK_TSTAMP >= 0 && bx == 0 && tid == 0) {
        const unsigned long long a_ = ((unsigned long long)MISC[17 + 2 * FK_TSTAMP] << 32) | MISC[16 + 2 * FK_TSTAMP], b_ = ((unsigned long long)MISC[17 + 2 * (FK_TSTAMP_END)] << 32) | MISC[16 + 2 * (FK_TSTAMP_END)];
        const float us_ = (float)(b_ - a_) * 0.01f; asm volatile("s_waitcnt vmcnt(0)" ::: "memory");
        A0->out[0] += 0.25f + 0.30f * fminf(1.f, us_ * (1.f / FK_TSCALE)); }
#undef IN
#undef SEAM
}
inline void launch(void* const* d_in, float* out, unsigned char* ws, float* xl, int lo, int hi, bool one_launch, hipStream_t st) {
    static int ok = 0;
    if (!ok) { if (hipFuncSetAttribute((const void*)mega, hipFuncAttributeMaxDynamicSharedMemorySize, LDS_BYTES) != hipSuccess) { fprintf(stderr, "hipFuncSetAttribute failed\n"); return; } ok = 1; }
    (void)hipMemsetAsync(ws + W.ctl, 0, 65536, st);
    Args a{}; for (int i = 0; i < 30; ++i) a.in[i] = (const float*)d_in[i];
    a.out = out; a.ws = ws; a.xl = xl; a.pad = 0;
    if (one_launch) { a.ph_lo = lo; a.ph_hi = hi; a.use_bar = 1; hipLaunchKernelGGL(mega, dim3(256), dim3(NTHR), LDS_BYTES, st, a); }
    else for (int p = lo; p < hi; ++p) { a.ph_lo = p; a.ph_hi = p + 1; a.use_bar = 0; hipLaunchKernelGGL(mega, dim3(256), dim3(NTHR), LDS_BYTES, st, a); }
}
}
#ifndef FK_ONE_LAUNCH
#define FK_ONE_LAUNCH 1
#endif
extern "C" void kernel_launch(void* const* d_in, const int* in_sizes, int n_in, void* d_out, int out_size, void* d_ws, size_t ws_size, hipStream_t stream) {
    if (n_in != 30 || ws_size < fk::W.end || out_size != fk::NLAT * 1024) { fprintf(stderr, "kernel_launch: n_in %d ws %zu (need %zu) out %d\n", n_in, ws_size, (size_t)fk::W.end, out_size); return; }
    fk::launch(d_in, (float*)d_out, (unsigned char*)d_ws, (float*)d_out, 0, fk::N_PHASES, FK_ONE_LAUNCH != 0, stream);
}
```
